# Optimizing an MI355X kernel written in HIP

```python
import math
import numpy as np
import jax
import jax.numpy as jnp
from jax import lax

D_MODEL = 2048
BATCH = 8
SEQ = 4096
DEPTH = 2
DEC_BATCH = 2
DEC_SEQ = 8192
PAST_LEN = 128

GRID_W = 64
EPS = 1e-6

NA_HEADS = 8
NA_HEAD_DIM = 128
NA_WIDTH = NA_HEADS * NA_HEAD_DIM
NA_KR_MAX = 8
NA_KC = 16
NA_QBLK = 16
NA_KBLK = 32

ML_HEADS = 4
ML_HEAD_DIM = 256
ML_WIDTH = ML_HEADS * ML_HEAD_DIM
ML_CHUNK = 64
ML_CONV_W = 3

SG_GROUPS = 8
SG_CHUNK = 128
SG_WIDTH = 1024
SG_GROUP_DIM = SG_WIDTH // SG_GROUPS

D_FF = 4 * D_MODEL
N_BRANCH = 3

OFF_A = 0
OFF_B = OFF_A + 3 * NA_WIDTH
OFF_BG = OFF_B + 4 * ML_WIDTH
OFF_C = OFF_BG + 4 * ML_HEADS
OFF_G = OFF_C + 2 * SG_WIDTH
D_IN = OFF_G + N_BRANCH * D_MODEL

kernel_name = "hybrid_bidir_natten_mlstm_sgmlp_encoder"


def rmsnorm(x, g):
    xf = x.astype(jnp.float32)
    y = xf * lax.rsqrt(jnp.mean(xf * xf, axis=-1, keepdims=True) + EPS)
    return (y * g.astype(jnp.float32)).astype(x.dtype)


def centred_dwconv(x, w):
    K = w.shape[0]
    p = K // 2
    T = x.shape[1]
    xp = jnp.pad(x, ((0, 0), (p, p), (0, 0)))
    return sum(xp[:, j:j + T] * w[j] for j in range(K))


def neighbourhood_attention(q, k, v, rpb):
    B, T, H, Dh = q.shape
    rows = T // GRID_W
    kr = min(NA_KR_MAX, rows)
    n_cb = GRID_W // NA_QBLK
    q_cols = np.arange(GRID_W).reshape(n_cb, NA_QBLK)
    kc0 = np.clip(q_cols[:, 0] - NA_KC // 2, 0, GRID_W - NA_KBLK)
    k_cols = kc0[:, None] + np.arange(NA_KBLK)[None, :]
    cs = np.clip(q_cols - NA_KC // 2, 0, GRID_W - NA_KC)
    col_ok = (k_cols[:, None, :] >= cs[:, :, None]) & (k_cols[:, None, :] < cs[:, :, None] + NA_KC)
    dc_idx = np.clip(k_cols[:, None, :] - q_cols[:, :, None] + NA_KC - 1, 0, 2 * NA_KC - 2)
    col_bias = rpb[:, :, dc_idx]
    mask = jnp.asarray(col_ok)[None, None, :, :, None, :]
    qg = q.reshape(B, rows, n_cb, NA_QBLK, H, Dh)
    kg = k.reshape(B, rows, GRID_W, H, Dh)
    vg = v.reshape(B, rows, GRID_W, H, Dh)
    scale = Dh ** -0.5

    def one_row(r):
        rs = jnp.clip(r - kr // 2, 0, rows - kr)
        q_r = lax.dynamic_index_in_dim(qg, r, axis=1, keepdims=False)
        k_r = lax.dynamic_slice_in_dim(kg, rs, kr, axis=1)[:, :, k_cols]
        v_r = lax.dynamic_slice_in_dim(vg, rs, kr, axis=1)[:, :, k_cols]
        bias = col_bias[:, rs - r + NA_KR_MAX - 1 + jnp.arange(kr)]
        bias = bias.transpose(0, 2, 3, 1, 4)[None].astype(jnp.float32)
        s = jnp.einsum('bnqhd,brnkhd->bhnqrk', q_r, k_r).astype(jnp.float32) * scale + bias
        s = jnp.where(mask, s, -jnp.inf)
        p = jax.nn.softmax(s.reshape(B, H, n_cb, NA_QBLK, kr * NA_KBLK), axis=-1)
        p = p.reshape(B, H, n_cb, NA_QBLK, kr, NA_KBLK).astype(v.dtype)
        return jnp.einsum('bhnqrk,brnkhd->bnqhd', p, v_r)

    out = lax.map(one_row, jnp.arange(rows))
    return jnp.moveaxis(out, 0, 1).reshape(B, T, H * Dh)


def mlstm_chunkwise(q, k, v, i_pre, f_pre):
    B, H, T, Dh = q.shape
    L = ML_CHUNK
    nc = T // L

    def to_chunks(a):
        a = a.reshape(B, H, nc, L, *a.shape[3:])
        return jnp.moveaxis(a, 2, 0)

    logf = jax.nn.log_sigmoid(f_pre)
    xs = (to_chunks(q), to_chunks(k), to_chunks(v), to_chunks(i_pre), to_chunks(logf))
    lower = jnp.tril(jnp.ones((L, L), dtype=bool))

    def step(carry, inp):
        C, n, m = carry
        qc, kc, vc, ic, lfc = inp
        b = jnp.cumsum(lfc, axis=-1)
        dlog = jnp.where(lower, b[..., :, None] - b[..., None, :] + ic[..., None, :], -jnp.inf)
        inter = b + m[..., None]
        m_row = jnp.maximum(inter, jnp.max(dlog, axis=-1))
        s = jnp.einsum('bhqd,bhkd->bhqk', qc, kc) * jnp.exp(dlog - m_row[..., None])
        w_inter = jnp.exp(inter - m_row)
        num = jnp.einsum('bhqk,bhkd->bhqd', s, vc) + w_inter[..., None] * jnp.einsum('bhqd,bhde->bhqe', qc, C)
        nq = jnp.sum(s, axis=-1) + w_inter * jnp.einsum('bhqd,bhd->bhq', qc, n)
        h = num / jnp.maximum(jnp.abs(nq), jnp.exp(-m_row))[..., None]
        b_last = b[..., -1]
        wlog = b_last[..., None] - b + ic
        m_new = jnp.maximum(b_last + m, jnp.max(wlog, axis=-1))
        w = jnp.exp(wlog - m_new[..., None])
        decay = jnp.exp(b_last + m - m_new)
        C_new = decay[..., None, None] * C + jnp.einsum('bhs,bhsd,bhse->bhde', w, kc, vc)
        n_new = decay[..., None] * n + jnp.einsum('bhs,bhsd->bhd', w, kc)
        return (C_new, n_new, m_new), h

    init = (jnp.zeros((B, H, Dh, Dh), jnp.float32), jnp.zeros((B, H, Dh), jnp.float32),
            jnp.zeros((B, H), jnp.float32))
    _, hs = lax.scan(step, init, xs)
    return jnp.moveaxis(hs, 0, 2).reshape(B, H, T, Dh)


def mlstm_branch(qkvo, gate_pre, conv_w, norm_g):
    B, T, _ = qkvo.shape
    qk = jax.nn.silu(centred_dwconv(qkvo[..., :2 * ML_WIDTH], conv_w))
    v = qkvo[..., 2 * ML_WIDTH:3 * ML_WIDTH]
    o = qkvo[..., 3 * ML_WIDTH:]

    def heads(a):
        return a.reshape(B, T, ML_HEADS, ML_HEAD_DIM).transpose(0, 2, 1, 3).astype(jnp.float32)

    qh = heads(qk[..., :ML_WIDTH]) * (ML_HEAD_DIM ** -0.5)
    kh = heads(qk[..., ML_WIDTH:])
    vh = heads(v)
    g = gate_pre.astype(jnp.float32).reshape(B, T, 4, ML_HEADS).transpose(2, 0, 3, 1)
    h_fwd = mlstm_chunkwise(qh, kh, vh, g[0], g[1])
    flip = lambda a: jnp.flip(a, axis=2)
    h_bwd = flip(mlstm_chunkwise(flip(qh), flip(kh), flip(vh), flip(g[2]), flip(g[3])))
    h = h_fwd + h_bwd
    h = h * lax.rsqrt(jnp.mean(h * h, axis=-1, keepdims=True) + EPS)
    h = h.transpose(0, 2, 1, 3).reshape(B, T, ML_WIDTH) * norm_g.astype(jnp.float32)
    return (h * jax.nn.sigmoid(o.astype(jnp.float32))).astype(qkvo.dtype)


def spatial_gating_branch(uv, norm_g, w_s, b_s):
    B, T, _ = uv.shape
    z = jax.nn.gelu(uv)
    u = z[..., :SG_WIDTH]
    v = rmsnorm(z[..., SG_WIDTH:], norm_g)
    vg = v.reshape(B, T // SG_CHUNK, SG_CHUNK, SG_GROUPS, SG_GROUP_DIM)
    mixed = jnp.einsum('gpq,bcqgd->bcpgd', w_s, vg) + b_s.T[None, None, :, :, None]
    return u * mixed.reshape(B, T, SG_WIDTH)


def trunk_layer(x, pre_mix_g, post_mix_g, pre_mlp_g, post_mlp_g, w_in, b_gate, conv_w, na_rpb,
                ml_norm_g, sg_norm_g, w_s, b_s, w_a, w_b, w_c, w_out, w_up, w_down):
    B, T, _ = x.shape
    h = rmsnorm(x, pre_mix_g)
    proj = lambda lo, hi: h @ w_in[:, lo:hi]
    qkv_a = proj(OFF_A, OFF_B).reshape(B, T, 3, NA_HEADS, NA_HEAD_DIM)
    y_a = neighbourhood_attention(qkv_a[:, :, 0], qkv_a[:, :, 1], qkv_a[:, :, 2], na_rpb)
    y_b = mlstm_branch(proj(OFF_B, OFF_BG), proj(OFF_BG, OFF_C) + b_gate, conv_w, ml_norm_g)
    y_c = spatial_gating_branch(proj(OFF_C, OFF_G), sg_norm_g, w_s, b_s)
    gates = jax.nn.sigmoid(proj(OFF_G, D_IN).reshape(B, T, N_BRANCH, D_MODEL))
    merged = gates[:, :, 0] * (y_a @ w_a) + gates[:, :, 1] * (y_b @ w_b) + gates[:, :, 2] * (y_c @ w_c)
    x = x + rmsnorm(merged @ w_out, post_mix_g)
    h = rmsnorm(x, pre_mlp_g)
    f = jnp.square(jax.nn.relu(h @ w_up)) @ w_down
    return x + rmsnorm(f, post_mlp_g)


def setup_inputs(seed: int = 0) -> dict:
    key = jax.random.key(seed)
    ks = jax.random.split(key, 24)
    L = DEPTH

    def nrm(k, shape, scale):
        return jax.random.normal(k, shape, jnp.float32) * scale

    i_bias = nrm(ks[8], (L, 2, ML_HEADS), 0.1)
    f_bias = jnp.linspace(3.0, 6.0, ML_HEADS, dtype=jnp.float32)[None, None, :] + nrm(ks[9], (L, 2, ML_HEADS), 0.1)
    b_gate = jnp.stack([i_bias[:, 0], f_bias[:, 0], i_bias[:, 1], f_bias[:, 1]], axis=1).reshape(L, 4 * ML_HEADS)
    return {
        "x_prompt": nrm(ks[0], (BATCH, SEQ, D_MODEL), 1.0),
        "x_sample": nrm(ks[1], (DEC_BATCH, DEC_SEQ, D_MODEL), 1.0),
        "pre_mix_g": 1.0 + nrm(ks[2], (L, D_MODEL), 0.1),
        "post_mix_g": 1.0 + nrm(ks[3], (L, D_MODEL), 0.1),
        "pre_mlp_g": 1.0 + nrm(ks[4], (L, D_MODEL), 0.1),
        "post_mlp_g": 1.0 + nrm(ks[5], (L, D_MODEL), 0.1),
        "w_in": nrm(ks[6], (L, D_MODEL, D_IN), D_MODEL ** -0.5),
        "b_gate": b_gate,
        "conv_w": nrm(ks[7], (L, ML_CONV_W, 2 * ML_WIDTH), ML_CONV_W ** -0.5),
        "na_rpb": nrm(ks[10], (L, NA_HEADS, 2 * NA_KR_MAX - 1, 2 * NA_KC - 1), 0.1),
        "ml_norm_g": 1.0 + nrm(ks[11], (L, ML_WIDTH), 0.1),
        "sg_norm_g": 1.0 + nrm(ks[12], (L, SG_WIDTH), 0.1),
        "w_s": nrm(ks[13], (L, SG_GROUPS, SG_CHUNK, SG_CHUNK), SG_CHUNK ** -0.5),
        "b_s": 1.0 + nrm(ks[14], (L, SG_GROUPS, SG_CHUNK), 0.1),
        "w_a": nrm(ks[15], (L, NA_WIDTH, D_MODEL), NA_WIDTH ** -0.5),
        "w_b": nrm(ks[16], (L, ML_WIDTH, D_MODEL), ML_WIDTH ** -0.5),
        "w_c": nrm(ks[17], (L, SG_WIDTH, D_MODEL), SG_WIDTH ** -0.5),
        "w_out": nrm(ks[18], (L, D_MODEL, D_MODEL), D_MODEL ** -0.5),
        "w_up": nrm(ks[19], (L, D_MODEL, D_FF), D_MODEL ** -0.5),
        "w_down": nrm(ks[20], (L, D_FF, D_MODEL), D_FF ** -0.5),
    }


def reference(x_prompt, x_sample, pre_mix_g, post_mix_g, pre_mlp_g, post_mlp_g, w_in, b_gate, conv_w,
              na_rpb, ml_norm_g, sg_norm_g, w_s, b_s, w_a, w_b, w_c, w_out, w_up, w_down):
    def run(x):
        for l in range(DEPTH):
            x = trunk_layer(x, pre_mix_g[l], post_mix_g[l], pre_mlp_g[l], post_mlp_g[l], w_in[l], b_gate[l],
                            conv_w[l], na_rpb[l], ml_norm_g[l], sg_norm_g[l], w_s[l], b_s[l], w_a[l], w_b[l],
                            w_c[l], w_out[l], w_up[l], w_down[l])
        return x

    y_prompt = run(x_prompt)
    y_sample = run(x_sample)
    return (y_prompt, y_sample)
```

```cpp
#include <hip/hip_runtime.h>
#include <cstdio>
#include <cstdint>
namespace pg8 {
#define PG8_LAS __attribute__((address_space(3)))
typedef unsigned short bf16_t;
typedef short bf16x8 __attribute__((ext_vector_type(8)));
typedef float f32x4 __attribute__((ext_vector_type(4)));
typedef unsigned u32x4 __attribute__((ext_vector_type(4)));
typedef unsigned u32x2 __attribute__((ext_vector_type(2)));
constexpr int BM = 256, BK = 64, HALF = 128, HTB = HALF * BK * 2  , STAGE_BYTES = 8 * HTB, NXCD = 8, WGM = 8;

__host__ __device__ __forceinline__ int lds_byte(int r, int c) { const int st = (r >> 4) * 2 + (c >> 5), rr = r & 15, cc = c & 31, ob = rr * 64 + cc * 2; return st * 1024 + (ob ^ (((ob >> 9) & 1) << 5)); }
__host__ __device__ __forceinline__ void stage_rc(int b, int& R, int& C) { const int st = b / 1024, sb = b % 1024, swz = sb ^ (((sb >> 9) & 1) << 5); R = (st >> 1) * 16 + swz / 64; C = (st & 1) * 32 + (swz % 64) / 2; }
__host__ __device__ __forceinline__ int perm32(int rho) { const int n = rho >> 4, i = rho & 15; return 8 * (i >> 2) + 4 * n + (i & 3); }

struct Unit { int pm, pn, z; };
struct Gemm { const bf16_t* A; const bf16_t* Bt; int M, N, K; size_t zA, zB; };

struct StaticOrder {
    int nM, nN, nwg, G, c;
    __host__ __device__ void init(int M, int N, int G_, int c_) { nM = M / BM; nN = N / BM; nwg = nM * nN; G = G_; c = c_; }
    __host__ __device__ bool tile(long L, Unit& u) const {
        if (L >= nwg) return false;
        int wgid = (int)L; { const int q = nwg / NXCD, r = nwg % NXCD, xcd = wgid % NXCD, off = wgid / NXCD; wgid = (xcd < r ? xcd * (q + 1) : r * (q + 1) + (xcd - r) * q) + off; }
        const int nig = WGM * nN, gid = wgid / nig, fm = gid * WGM, gsz = (nM - fm) < WGM ? (nM - fm) : WGM;
        u.pm = fm + ((wgid % nig) % gsz); u.pn = (wgid % nig) / gsz; return true;
    }
    __host__ __device__ bool next(int i, Unit& u) const { u.z = 0; return tile((long)i * G + c, u); }
    __device__ __forceinline__ void a_ready(const Unit&) const {}
    __device__ __forceinline__ void done(const Unit&) const {}
};
template <int NZ> struct ZOrder : StaticOrder {
    __host__ __device__ bool next(int i, Unit& u) const { const int k = i / NZ; u.z = i - k * NZ; return tile((long)k * G + c, u); }
};

__device__ __forceinline__ unsigned cvt_pk_bf16(float lo, float hi) { unsigned r; asm volatile("v_cvt_pk_bf16_f32 %0, %1, %2" : "=v"(r) : "v"(lo), "v"(hi)); return r; }
__device__ __forceinline__ float sigm(float x) { return __builtin_amdgcn_rcpf(1.0f + __builtin_amdgcn_exp2f(-1.4426950408889634f * x)); }
__device__ __forceinline__ float gelu_tanh(float x) { return x * sigm(1.5957691216057308f * x * (1.0f + 0.044715f * x * x)); }
__device__ __forceinline__ float act_apply(int act, float x) { return act == 1 ? sigm(x) : (act == 2 ? gelu_tanh(x) : x); }

struct EpiIn {
    static constexpr bool PERM = true, AFTER_DRAIN = false;
    bf16_t *qkva, *qkvob, *zuv, *g; float* gates; const float* bgate;
    __device__ __forceinline__ void operator()(const f32x4 (&acc)[2][2][4][2], const Unit& u, int wr, int wc, int fr, int fq) const {
        const int pn = u.pn, row0 = u.pm * BM + wr * 64 + fr;
        if (pn == 60) {
            if (wc == 0 && fq < 2) {
#pragma unroll
                for (int ai = 0; ai < 2; ++ai)
#pragma unroll
                    for (int m = 0; m < 4; ++m)
#pragma unroll
                        for (int n = 0; n < 2; ++n) { const int col = 8 * fq + 4 * n; *(f32x4*)(gates + (size_t)(row0 + ai * HALF + m * 16) * 16 + col) = acc[ai][0][m][n] + *(const f32x4*)(bgate + col); }
            }
            return;
        }
        bf16_t* base; int ldc, colt, act;
        if (pn < 12) { base = qkva; ldc = 3072; colt = pn * BM; act = 0; }
        else if (pn < 28) { base = qkvob; ldc = 4096; colt = (pn - 12) * BM; act = pn >= 24 ? 1 : 0; }
        else if (pn < 36) { base = zuv; ldc = 2048; colt = (pn - 28) * BM; act = 2; }
        else { base = g; ldc = 6144; colt = (pn - 36) * BM; act = 1; }
        const int col0 = colt + wc * 32 + 8 * fq;
#pragma unroll
        for (int ai = 0; ai < 2; ++ai)
#pragma unroll
            for (int m = 0; m < 4; ++m) { bf16_t* rowp = base + (size_t)(row0 + ai * HALF + m * 16) * ldc + col0;
#pragma unroll
                for (int bj = 0; bj < 2; ++bj) { f32x4 v0 = acc[ai][bj][m][0], v1 = acc[ai][bj][m][1];
                    if (act != 0) {
#pragma unroll
                        for (int j = 0; j < 4; ++j) { v0[j] = act_apply(act, v0[j]); v1[j] = act_apply(act, v1[j]); } }
                    u32x4 w; w.x = cvt_pk_bf16(v0[0], v0[1]); w.y = cvt_pk_bf16(v0[2], v0[3]); w.z = cvt_pk_bf16(v1[0], v1[1]); w.w = cvt_pk_bf16(v1[2], v1[3]);
                    *(u32x4*)(rowp + bj * HALF) = w; } }
    }
};
struct EpiMerge {
    static constexpr bool PERM = false, AFTER_DRAIN = false;
    const bf16_t* g; float* mrg; bf16_t* mrgb;
    __device__ __forceinline__ void operator()(const f32x4 (&acc)[2][2][4][2], const Unit& u, int wr, int wc, int fr, int fq) const {
        const int z = u.z, row0 = u.pm * BM + wr * 64 + fr, col0 = u.pn * BM + wc * 32 + 4 * fq;
#pragma unroll
        for (int ai = 0; ai < 2; ++ai)
#pragma unroll
            for (int m = 0; m < 4; ++m) { const size_t row = (size_t)(row0 + ai * HALF + m * 16);
#pragma unroll
                for (int bj = 0; bj < 2; ++bj)
#pragma unroll
                    for (int n = 0; n < 2; ++n) { const int col = col0 + bj * HALF + n * 16;
                        const u32x2 gw = *(const u32x2*)(g + row * 6144 + (size_t)z * 2048 + col);
                        f32x4 gv; gv[0] = __uint_as_float(gw.x << 16); gv[1] = __uint_as_float(gw.x & 0xffff0000u); gv[2] = __uint_as_float(gw.y << 16); gv[3] = __uint_as_float(gw.y & 0xffff0000u);
                        f32x4 v = acc[ai][bj][m][n] * gv;
                        if (z > 0) v += *(const f32x4*)(mrg + row * 2048 + col);
                        if (z < 2) *(f32x4*)(mrg + row * 2048 + col) = v;
                        else { u32x2 w; w.x = cvt_pk_bf16(v[0], v[1]); w.y = cvt_pk_bf16(v[2], v[3]); *(u32x2*)(mrgb + row * 2048 + col) = w; } }
                asm volatile("" ::: "memory"); }
    }
};
struct EpiF32 {
    static constexpr bool PERM = false, AFTER_DRAIN = false;
    float* C; int ldc;
    __device__ __forceinline__ void operator()(const f32x4 (&acc)[2][2][4][2], const Unit& u, int wr, int wc, int fr, int fq) const {
        const int row0 = u.pm * BM + wr * 64 + fr, col0 = u.pn * BM + wc * 32 + 4 * fq;
#pragma unroll
        for (int ai = 0; ai < 2; ++ai)
#pragma unroll
            for (int m = 0; m < 4; ++m) { float* rowp = C + (size_t)(row0 + ai * HALF + m * 16) * ldc + col0;
#pragma unroll
                for (int bj = 0; bj < 2; ++bj)
#pragma unroll
                    for (int n = 0; n < 2; ++n) *(f32x4*)(rowp + bj * HALF + n * 16) = acc[ai][bj][m][n]; }
    }
};
struct EpiRelu2 {
    static constexpr bool PERM = true, AFTER_DRAIN = false;
    bf16_t* O; int ldc;
    __device__ __forceinline__ void operator()(const f32x4 (&acc)[2][2][4][2], const Unit& u, int wr, int wc, int fr, int fq) const {
        const int row0 = u.pm * BM + wr * 64 + fr, col0 = u.pn * BM + wc * 32 + 8 * fq;
#pragma unroll
        for (int ai = 0; ai < 2; ++ai)
#pragma unroll
            for (int m = 0; m < 4; ++m) { bf16_t* rowp = O + (size_t)(row0 + ai * HALF + m * 16) * ldc + col0;
#pragma unroll
                for (int bj = 0; bj < 2; ++bj) { f32x4 v0 = acc[ai][bj][m][0], v1 = acc[ai][bj][m][1];
#pragma unroll
                    for (int j = 0; j < 4; ++j) { const float a = fmaxf(v0[j], 0.f), b = fmaxf(v1[j], 0.f); v0[j] = a * a; v1[j] = b * b; }
                    u32x4 w; w.x = cvt_pk_bf16(v0[0], v0[1]); w.y = cvt_pk_bf16(v0[2], v0[3]); w.z = cvt_pk_bf16(v1[0], v1[1]); w.w = cvt_pk_bf16(v1[2], v1[3]);
                    *(u32x4*)(rowp + bj * HALF) = w; } }
    }
};

template <class Epi, class Sched, bool ALIGN_EPI = false, bool SP2 = false>
__device__ __forceinline__ void gemm_phase(PG8_LAS unsigned char* lds, const Gemm g, const Sched& S, const Epi& E) {
    int tid_l = threadIdx.x; asm volatile("" : "+v"(tid_l));
    const int tid = tid_l, wid = __builtin_amdgcn_readfirstlane(tid >> 6), lane = tid & 63, wr = wid >> 2, wc = wid & 3, fr = lane & 15, fq = lane >> 4;
    const int K = g.K, nt = K / BK;
    unsigned voffA[2], voffB[2];
#pragma unroll
    for (int i = 0; i < 2; ++i) { int R, C; stage_rc(tid * 16 + i * 8192, R, C); const int Rb = Epi::PERM ? ((R & ~31) + perm32(R & 31)) : R;
        voffA[i] = (unsigned)(R * K + C) * 2u; voffB[i] = (unsigned)(Rb * K + C) * 2u; }
    const size_t kstep = (size_t)(BK * 2);
    const size_t hstep = (size_t)HALF * K * 2;
    const size_t tstep = 2 * hstep;
    const unsigned ldsw = (unsigned)wid * 1024u;
    const int aoff = lds_byte(wr * 64 + fr, fq * 8), boff = lds_byte(wc * 32 + fr, fq * 8);
#define PG8_SA(b, h) (((b) * 2 + (h)) * HTB)
#define PG8_SB(b, h) ((4 + (b) * 2 + (h)) * HTB)
#define PG8_STAGE(bufoff, gbase, voff) do { _Pragma("unroll") for (int _i = 0; _i < 2; ++_i) \
        __builtin_amdgcn_global_load_lds((const unsigned*)((const char*)(gbase) + (voff)[_i]), (PG8_LAS unsigned*)(lds + (bufoff) + ldsw + _i * 8192), 16, 0, 0); } while (0)
#define PG8_LDA(dst, b, h) do { _Pragma("unroll") for (int m = 0; m < 4; ++m) _Pragma("unroll") for (int k = 0; k < 2; ++k) dst[m][k] = *(const PG8_LAS bf16x8*)(lds + PG8_SA(b, h) + aoff + m * 2048 + k * 1024); } while (0)
#define PG8_LDB(dst, b, h) do { _Pragma("unroll") for (int n = 0; n < 2; ++n) _Pragma("unroll") for (int k = 0; k < 2; ++k) dst[n][k] = *(const PG8_LAS bf16x8*)(lds + PG8_SB(b, h) + boff + n * 2048 + k * 1024); } while (0)
#define PG8_MMA(ai, bj, At, Bt) do { __builtin_amdgcn_s_setprio(1); _Pragma("unroll") for (int m = 0; m < 4; ++m) _Pragma("unroll") for (int n = 0; n < 2; ++n) _Pragma("unroll") for (int k = 0; k < 2; ++k) \
        acc[ai][bj][m][n] = __builtin_amdgcn_mfma_f32_16x16x32_bf16(Bt[n][k], At[m][k], acc[ai][bj][m][n], 0, 0, 0); __builtin_amdgcn_s_setprio(0); } while (0)
#define PG8_WAIT_V(n) asm volatile("s_waitcnt vmcnt(" #n ")" ::: "memory")
#define PG8_WAIT_L(n) asm volatile("s_waitcnt lgkmcnt(" #n ")" ::: "memory")
#define PG8_BAR __builtin_amdgcn_s_barrier()
#define PG8_SCHED __builtin_amdgcn_sched_barrier(0)
    Unit cur, nxt; int ui = 0;
    if (!S.next(0, cur)) return;
    f32x4 acc[2][2][4][2];
#pragma unroll
    for (int a = 0; a < 2; ++a)
#pragma unroll
        for (int b = 0; b < 2; ++b)
#pragma unroll
            for (int m = 0; m < 4; ++m)
#pragma unroll
                for (int n = 0; n < 2; ++n) acc[a][b][m][n] = (f32x4){0.f, 0.f, 0.f, 0.f};
    bf16x8 At[4][2], B0[2][2], B1[2][2];
    const char* cA = (const char*)g.A + (size_t)cur.pm * tstep + (size_t)cur.z * g.zA; const char* cB = (const char*)g.Bt + (size_t)cur.pn * tstep + (size_t)cur.z * g.zB;
    S.a_ready(cur);
    if constexpr (SP2) {
        PG8_STAGE(PG8_SB(0, 0), cB, voffB); PG8_STAGE(PG8_SB(0, 1), cB + hstep, voffB); PG8_STAGE(PG8_SA(0, 0), cA, voffA); PG8_STAGE(PG8_SA(0, 1), cA + hstep, voffA);
        if (wr == 1) PG8_BAR;
        PG8_WAIT_V(2); PG8_BAR;
        PG8_STAGE(PG8_SB(1, 0), cB + kstep, voffB); PG8_STAGE(PG8_SA(1, 0), cA + kstep, voffA); PG8_STAGE(PG8_SB(1, 1), cB + hstep + kstep, voffB);
        PG8_WAIT_V(6); PG8_BAR;
    } else {
        PG8_STAGE(PG8_SB(0, 0), cB, voffB); PG8_STAGE(PG8_SA(0, 0), cA, voffA); PG8_STAGE(PG8_SB(0, 1), cB + hstep, voffB); PG8_STAGE(PG8_SA(0, 1), cA + hstep, voffA);
        if (wr == 1) PG8_BAR;
        PG8_WAIT_V(4); PG8_BAR;
        PG8_STAGE(PG8_SB(1, 0), cB + kstep, voffB); PG8_STAGE(PG8_SA(1, 0), cA + kstep, voffA); PG8_STAGE(PG8_SB(1, 1), cB + hstep + kstep, voffB);
        PG8_WAIT_V(6); PG8_BAR;
    }
    for (;;) {
        const bool has_next = S.next(ui + 1, nxt);
        const char* nA = has_next ? (const char*)g.A + (size_t)nxt.pm * tstep + (size_t)nxt.z * g.zA : cA; const char* nB = has_next ? (const char*)g.Bt + (size_t)nxt.pn * tstep + (size_t)nxt.z * g.zB : cB;
        for (int t = 0; t < nt; t += 2) {
            const bool last = (t == nt - 2);
            const char* a1 = cA + (size_t)(t + 1) * kstep;
            const char* a2 = last ? nA : cA + (size_t)(t + 2) * kstep; const char* b2 = last ? nB : cB + (size_t)(t + 2) * kstep;
            const char* a3 = a2 + kstep; const char* b3 = b2 + kstep;
            if (last && has_next) S.a_ready(nxt);
            if constexpr (SP2) {
            PG8_LDB(B0, 0, 0); PG8_LDB(B1, 0, 1); PG8_SCHED; PG8_LDA(At, 0, 0); PG8_STAGE(PG8_SA(1, 1), a1 + hstep, voffA);
            PG8_WAIT_V(8); PG8_WAIT_L(0); PG8_BAR; PG8_MMA(0, 0, At, B0); PG8_MMA(0, 1, At, B1); PG8_BAR; PG8_SCHED;
            PG8_LDA(At, 0, 1); PG8_STAGE(PG8_SB(0, 0), b2, voffB); PG8_STAGE(PG8_SB(0, 1), b2 + hstep, voffB); PG8_STAGE(PG8_SA(0, 0), a2, voffA);
            PG8_WAIT_V(8); PG8_WAIT_L(0); PG8_BAR; PG8_MMA(1, 0, At, B0); PG8_MMA(1, 1, At, B1); PG8_BAR; PG8_SCHED;
            PG8_LDB(B0, 1, 0); PG8_LDB(B1, 1, 1); PG8_SCHED; PG8_LDA(At, 1, 0); PG8_STAGE(PG8_SA(0, 1), a2 + hstep, voffA);
            PG8_WAIT_V(8); PG8_WAIT_L(0); PG8_BAR; PG8_MMA(0, 0, At, B0); PG8_MMA(0, 1, At, B1); PG8_BAR; PG8_SCHED;
            PG8_LDA(At, 1, 1); PG8_STAGE(PG8_SB(1, 0), b3, voffB); PG8_STAGE(PG8_SB(1, 1), b3 + hstep, voffB); PG8_STAGE(PG8_SA(1, 0), a3, voffA);
            PG8_WAIT_V(8); PG8_WAIT_L(0); PG8_BAR; PG8_MMA(1, 0, At, B0); PG8_MMA(1, 1, At, B1); PG8_BAR; PG8_SCHED;
            } else {
            PG8_LDB(B0, 0, 0); PG8_SCHED; PG8_LDA(At, 0, 0); PG8_STAGE(PG8_SA(1, 1), a1 + hstep, voffA);
            PG8_WAIT_L(8); PG8_BAR; PG8_WAIT_L(0); PG8_MMA(0, 0, At, B0); PG8_BAR; PG8_SCHED;
            PG8_LDB(B1, 0, 1); PG8_STAGE(PG8_SB(0, 0), b2, voffB);
            PG8_BAR; PG8_WAIT_L(0); PG8_MMA(0, 1, At, B1); PG8_BAR;
            PG8_LDA(At, 0, 1); PG8_STAGE(PG8_SA(0, 0), a2, voffA);
            PG8_BAR; PG8_WAIT_L(0); PG8_MMA(1, 0, At, B0); PG8_BAR; PG8_SCHED;
            PG8_STAGE(PG8_SB(0, 1), b2 + hstep, voffB);
            PG8_WAIT_V(6); PG8_BAR; PG8_MMA(1, 1, At, B1); PG8_BAR;
            PG8_LDB(B0, 1, 0); PG8_SCHED; PG8_LDA(At, 1, 0); PG8_STAGE(PG8_SA(0, 1), a2 + hstep, voffA);
            PG8_WAIT_L(8); PG8_BAR; PG8_WAIT_L(0); PG8_MMA(0, 0, At, B0); PG8_BAR; PG8_SCHED;
            PG8_LDB(B1, 1, 1); PG8_STAGE(PG8_SB(1, 0), b3, voffB);
            PG8_BAR; PG8_WAIT_L(0); PG8_MMA(0, 1, At, B1); PG8_BAR;
            PG8_LDA(At, 1, 1); PG8_STAGE(PG8_SA(1, 0), a3, voffA);
            PG8_BAR; PG8_WAIT_L(0); PG8_MMA(1, 0, At, B0); PG8_BAR; PG8_SCHED;
            PG8_STAGE(PG8_SB(1, 1), b3 + hstep, voffB);
            PG8_WAIT_V(6); PG8_BAR; PG8_MMA(1, 1, At, B1); PG8_BAR;
            }
        }
        if constexpr (ALIGN_EPI) { if (wr == 0) PG8_BAR; }
        if constexpr (!Epi::AFTER_DRAIN) { E(acc, cur, wr, wc, fr, fq); S.done(cur); }
        if (!has_next) break;
#pragma unroll
        for (int a = 0; a < 2; ++a)
#pragma unroll
            for (int b = 0; b < 2; ++b)
#pragma unroll
                for (int m = 0; m < 4; ++m)
#pragma unroll
                    for (int n = 0; n < 2; ++n) acc[a][b][m][n] = (f32x4){0.f, 0.f, 0.f, 0.f};
        cur = nxt; cA = nA; cB = nB; ++ui;
        if constexpr (ALIGN_EPI) { if (wr == 1) PG8_BAR; }
    }
    PG8_WAIT_V(0);
    if constexpr (!ALIGN_EPI) { if (wr == 0) PG8_BAR; }
    PG8_BAR;
    if constexpr (Epi::AFTER_DRAIN) { E.fused(acc, cur, wr, wc, fr, fq, lds, wid, lane); S.done(cur); }
#undef PG8_SA
#undef PG8_SB
#undef PG8_STAGE
#undef PG8_LDA
#undef PG8_LDB
#undef PG8_MMA
#undef PG8_WAIT_V
#undef PG8_WAIT_L
#undef PG8_BAR
#undef PG8_SCHED
}
}

constexpr int NWAVES = 8;
constexpr int D = 2048, DEPTH = 2, DFF = 8192;
constexpr int NA_W = 1024, ML_W = 1024, SG_W = 1024;
constexpr int D_IN = 15376, N_IN_PAD = 15616;
constexpr int M_PROMPT = 8 * 4096, M_SAMPLE = 2 * 8192, M_ALL = M_PROMPT + M_SAMPLE;
constexpr int MS = 8192, NSLAB = M_ALL / MS;
constexpr float EPS = 1e-6f;

constexpr size_t MiB = 1u << 20;
constexpr size_t WS_CTL = 0, CTL_ZERO_BYTES = 1 * MiB;
constexpr size_t WL_IN = 0, WL_ABC = 61 * MiB, WL_OUT = 73 * MiB, WL_UP = 81 * MiB, WL_DN = 113 * MiB, WL_BYTES = 145 * MiB;
constexpr size_t WS_W = 1 * MiB;
constexpr size_t WS_H = 291 * MiB;
constexpr size_t WS_QKVA = 323 * MiB;
constexpr size_t WS_QKVOB = 371 * MiB;
constexpr size_t WS_ZUV = 435 * MiB;
constexpr size_t WS_U = WS_QKVA;
constexpr size_t WS_G = 467 * MiB;
constexpr size_t WS_GATES = 563 * MiB;
constexpr size_t WS_SGR = WS_GATES + MiB / 2;
constexpr size_t WS_QC = 564 * MiB, WS_KC = 580 * MiB;
constexpr size_t WS_Y = 596 * MiB;
constexpr size_t WS_HF = 644 * MiB, WS_HB = 676 * MiB;
constexpr size_t WS_MRG = 708 * MiB;
constexpr size_t WS_MRGB = 772 * MiB;
constexpr size_t WS_T = 804 * MiB;
constexpr size_t WS_END = 868 * MiB;
static_assert(WS_W + 2 * WL_BYTES <= WS_H && WS_U + (size_t)MS * DFF * 2 <= WS_G && WS_SGR + (size_t)MS * 4 <= WS_QC, "d_ws map");
constexpr int CW_BAR = 4096;

constexpr int RING_OFF = 0, RING_BYTES = 131072;
constexpr int LDSCTL_OFF = RING_BYTES, MISC_OFF = LDSCTL_OFF + 320;
constexpr int LDS_BYTES = 147456;

#define GAS __attribute__((address_space(1)))
#define LAS __attribute__((address_space(3)))
typedef unsigned short bf16;
typedef unsigned v4u __attribute__((ext_vector_type(4)));
typedef float f32x4 __attribute__((ext_vector_type(4)));
typedef short bf16x8 __attribute__((ext_vector_type(8)));
typedef GAS unsigned gu32;
typedef GAS unsigned long long gu64;
#define RLX_AGENT __ATOMIC_RELAXED, __HIP_MEMORY_SCOPE_AGENT
#define LDS_WAIT() asm volatile("s_waitcnt lgkmcnt(0)" ::: "memory")
#define VM_WAIT() asm volatile("s_waitcnt vmcnt(0)" ::: "memory")
__device__ __forceinline__ unsigned long long rt() { return __builtin_amdgcn_s_memrealtime(); }
__device__ __forceinline__ unsigned f2bf(float f) { unsigned u = __builtin_bit_cast(unsigned, f); return (u + 0x7fffu + ((u >> 16) & 1u)) >> 16; }
__device__ __forceinline__ unsigned pk2(float lo, float hi) { return f2bf(lo) | (f2bf(hi) << 16); }

#define XB_TMO      128
#define XB_XCNT(j)  (256  + 64 * (j))
#define XB_XSUB(j)  (1280 + 64 * (j))
#define XB_XGEN(j)  (2304 + 64 * (j))
#define XB_TOP      3328
#define XB_TOPGEN   3392
#define XCD_BAR_WORDS 3456
#define XB_SPIN_CAP (1u << 18)

__device__ __forceinline__ unsigned xb_ld(unsigned* p)              { return __hip_atomic_load(p, __ATOMIC_RELAXED, __HIP_MEMORY_SCOPE_AGENT); }
__device__ __forceinline__ unsigned xb_add(unsigned* p, unsigned v) { return __hip_atomic_fetch_add(p, v, __ATOMIC_RELAXED, __HIP_MEMORY_SCOPE_AGENT); }
__device__ __forceinline__ unsigned xb_xcc_id() { return (unsigned)__builtin_amdgcn_s_getreg((3 << 11) | 20) & 0xFu; }
#define XB_SPIN(cond, bar) do { unsigned _sp = 0; while (cond) { __builtin_amdgcn_s_sleep(1); \
    if ((++_sp & 255u) == 0u) { if (xb_ld(&(bar)[XB_TMO])) break; if (_sp > XB_SPIN_CAP) { atomicAdd(&(bar)[XB_TMO], 1u); break; } } } } while (0)

struct XcdBarrier {
    unsigned* bar; unsigned x;
    volatile LAS unsigned* st;
};

__device__ __forceinline__ XcdBarrier xcd_barrier_post(unsigned* bar, volatile LAS unsigned* st) {
    XcdBarrier b; b.bar = bar; b.x = xb_xcc_id(); b.st = st;
    if (threadIdx.x == 0) (void)xb_add(&bar[XB_XCNT(b.x)], 1u);
    return b;
}
__device__ __forceinline__ void xcd_barrier_complete(unsigned* bar, unsigned x, unsigned& nloc, unsigned& nx) {
    const unsigned G = gridDim.x * gridDim.y * gridDim.z;
    unsigned sum, cnt, mine, sp = 0u;
    for (;;) {
        sum = 0u; cnt = 0u; mine = 0u;
#pragma unroll
        for (unsigned j = 0; j < 16; ++j) { const unsigned c = xb_ld(&bar[XB_XCNT(j)]); sum += c; cnt += (c > 0u) ? 1u : 0u; mine = (j == x) ? c : mine; }
        if (sum == G) break;
        __builtin_amdgcn_s_sleep(1);
        if ((++sp & 255u) == 0u) { if (xb_ld(&bar[XB_TMO])) break; if (sp > XB_SPIN_CAP) { atomicAdd(&bar[XB_TMO], 1u); break; } }
    }
    nloc = mine > 0u ? mine : 1u; nx = cnt > 0u ? cnt : 1u;
}

__device__ __forceinline__ void xcd_barrier(const XcdBarrier& b) {
    asm volatile("s_waitcnt vmcnt(0)" ::: "memory");
    __syncthreads();
    if (threadIdx.x == 0) {
        unsigned* bar = b.bar;
        __builtin_amdgcn_s_waitcnt(0);
        unsigned nloc = b.st[0], nx = b.st[1];
        if (nloc == 0u) { xcd_barrier_complete(bar, b.x, nloc, nx); b.st[0] = nloc; b.st[1] = nx; }
        const unsigned old = xb_add(&bar[XB_XSUB(b.x)], 1u);
        const unsigned gen = old / nloc;
        if (old + 1u == (gen + 1u) * nloc) {
            __builtin_amdgcn_fence(__ATOMIC_RELEASE, "agent");
            asm volatile("s_waitcnt vmcnt(0)" ::: "memory");
            const unsigned og = xb_add(&bar[XB_TOP], 1u);
            const unsigned tg = og / nx;
            if (og + 1u == (tg + 1u) * nx) xb_add(&bar[XB_TOPGEN], 1u);
            else XB_SPIN(xb_ld(&bar[XB_TOPGEN]) == tg, bar);
            __builtin_amdgcn_fence(__ATOMIC_ACQUIRE, "agent");
            xb_add(&bar[XB_XGEN(b.x)], 1u);
            asm volatile("s_waitcnt vmcnt(0)" ::: "memory");
        } else {
            XB_SPIN(xb_ld(&bar[XB_XGEN(b.x)]) == gen, bar);
            __builtin_amdgcn_fence(__ATOMIC_ACQUIRE, "agent");
            asm volatile("s_waitcnt vmcnt(0)" ::: "memory");
        }
    }
    __syncthreads();
}

struct Frame {
    LAS unsigned char* lds;
    int tid, lane, wave;
    int vcu, G;
};
struct Args {
    const float* x_prompt; const float* x_sample; const float* pre_mix_g; const float* post_mix_g; const float* pre_mlp_g; const float* post_mlp_g;
    const float* w_in; const float* b_gate; const float* conv_w; const float* na_rpb; const float* ml_norm_g; const float* sg_norm_g; const float* w_s; const float* b_s;
    const float* w_a; const float* w_b; const float* w_c; const float* w_out; const float* w_up; const float* w_down;
    float* out; unsigned char* ws;
    int ph_lo, ph_hi;
};

__device__ __forceinline__ float wave_sum(float v) {
#pragma unroll
    for (int o = 1; o < 64; o <<= 1) v += __shfl_xor(v, o);
    return v;
}
__device__ __forceinline__ float wave_max(float v) {
#pragma unroll
    for (int o = 1; o < 64; o <<= 1) v = fmaxf(v, __shfl_xor(v, o));
    return v;
}
__device__ __forceinline__ float bf_lo(unsigned u) { return __uint_as_float(u << 16); }
__device__ __forceinline__ float bf_hi(unsigned u) { return __uint_as_float(u & 0xffff0000u); }
__device__ __forceinline__ float sigmoid_f(float x) { return __builtin_amdgcn_rcpf(1.0f + __builtin_amdgcn_exp2f(-1.4426950408889634f * x)); }

__device__ __forceinline__ void p0_transpose_item(const float* W, int K, int N, bf16* WT, int k0, int n0, int ncols, int drow0, float sc, LAS float* scr, int lane) {
    const int cl = lane & 31;
#pragma unroll 8
    for (int i = 0; i < 32; ++i) { const int kk = 2 * i + (lane >> 5); scr[kk * 33 + cl] = (cl < ncols) ? W[(size_t)(k0 + kk) * N + n0 + cl] * sc : 0.f; }
    LDS_WAIT(); asm volatile("" ::: "memory");
    const int c = lane & 7;
#pragma unroll
    for (int j = 0; j < 4; ++j) { const int n = (lane >> 3) + 8 * j; const LAS float* s = scr + (8 * c) * 33 + n;
        v4u o; o.x = pk2(s[0 * 33], s[1 * 33]); o.y = pk2(s[2 * 33], s[3 * 33]); o.z = pk2(s[4 * 33], s[5 * 33]); o.w = pk2(s[6 * 33], s[7 * 33]);
        if (n < ncols) *(GAS v4u*)(WT + (size_t)(drow0 + n) * K + k0 + 8 * c) = o; }
    LDS_WAIT(); asm volatile("" ::: "memory");
}
__device__ __forceinline__ void p0_matrix(Frame& F, const float* W, int K, int N, bf16* WT, LAS float* scr) {
    const int gw = F.vcu * NWAVES + F.wave, NGW = F.G * NWAVES, nblk = N / 32, nit = (K / 64) * nblk;
    for (int it = gw; it < nit; it += NGW) { const int kb = it / nblk, nb = it % nblk; p0_transpose_item(W, K, N, WT, 64 * kb, 32 * nb, 32, 32 * nb, 1.f, scr, F.lane); }
}
__device__ __forceinline__ void p0_win(Frame& F, const float* W, bf16* WT, LAS float* scr) {
    const int gw = F.vcu * NWAVES + F.wave, NGW = F.G * NWAVES;
    constexpr int NB1 = 7168 / 32, NB2 = 8192 / 32, NBLK = NB1 + 1 + NB2, NIT = (D / 64) * NBLK;
    for (int it = gw; it < NIT; it += NGW) { const int kb = it / NBLK, nb = it % NBLK; int n0, ncols, drow0; float sc = 1.f;
        if (nb < NB1) { n0 = 32 * nb; ncols = 32; drow0 = n0; if (n0 < 1024) sc = 0.08838834764831845f; }
        else if (nb == NB1) { n0 = 7168; ncols = 16; drow0 = 15360; }
        else { n0 = 7184 + 32 * (nb - NB1 - 1); ncols = 32; drow0 = n0 - 16; }
        p0_transpose_item(W, D, D_IN, WT, 64 * kb, n0, ncols, drow0, sc, scr, F.lane); }
    const int gt = (F.vcu * NWAVES + F.wave) * 64 + F.lane, NGT = F.G * NWAVES * 64; constexpr int NZ16 = (N_IN_PAD - D_IN) * D / 8;
    GAS v4u* z = (GAS v4u*)(WT + (size_t)D_IN * D);
    for (int i = gt; i < NZ16; i += NGT) z[i] = (v4u){0u, 0u, 0u, 0u};
}

__device__ __forceinline__ void row_phase(Frame& F, const float* xin, const float* add, const float* g_add, float* xout, const float* g_next, bf16* hout) {
    const int gw = F.vcu * NWAVES + F.wave, NGW = F.G * NWAVES;
    for (int m = gw; m < MS; m += NGW) {
        const GAS f32x4* xr = (const GAS f32x4*)(xin + (size_t)m * D) + F.lane;
        f32x4 v[8];
#pragma unroll
        for (int j = 0; j < 8; ++j) v[j] = xr[64 * j];
        if (add) {
            const GAS f32x4* ar = (const GAS f32x4*)(add + (size_t)m * D) + F.lane; f32x4 a[8]; float s = 0.f;
#pragma unroll
            for (int j = 0; j < 8; ++j) { a[j] = ar[64 * j]; s += (a[j].x * a[j].x + a[j].y * a[j].y) + (a[j].z * a[j].z + a[j].w * a[j].w); }
            const float rs = 1.0f / sqrtf(wave_sum(s) * (1.f / D) + EPS);
#pragma unroll
            for (int j = 0; j < 8; ++j) { const f32x4 gv = ((const GAS f32x4*)g_add)[F.lane + 64 * j]; v[j] = v[j] + (a[j] * rs) * gv; }
        }
        if (xout) { GAS f32x4* o = (GAS f32x4*)(xout + (size_t)m * D) + F.lane;
#pragma unroll
            for (int j = 0; j < 8; ++j) o[64 * j] = v[j]; }
        if (hout) {
            float s = 0.f;
#pragma unroll
            for (int j = 0; j < 8; ++j) s += (v[j].x * v[j].x + v[j].y * v[j].y) + (v[j].z * v[j].z + v[j].w * v[j].w);
            const float rs = 1.0f / sqrtf(wave_sum(s) * (1.f / D) + EPS);
            GAS unsigned long long* o8 = (GAS unsigned long long*)(hout + (size_t)m * D) + F.lane;
#pragma unroll
            for (int j = 0; j < 8; ++j) { const f32x4 gv = ((const GAS f32x4*)g_next)[F.lane + 64 * j]; const f32x4 y = (v[j] * rs) * gv;
                o8[64 * j] = (unsigned long long)pk2(y.x, y.y) | ((unsigned long long)pk2(y.z, y.w) << 32); }
        }
    }
}

__device__ __forceinline__ void prep_phase(Frame& F, const bf16* qkvob, const float* convw, bf16* qc, bf16* kc, const bf16* zuv, float* sgr, int T) {
    const int gt = (F.vcu * NWAVES + F.wave) * 64 + F.lane, NGT = F.G * NWAVES * 64;
    {
        const int c8 = gt & 255; float w0[8], w1[8], w2[8];
#pragma unroll
        for (int j = 0; j < 8; ++j) { w0[j] = convw[c8 * 8 + j]; w1[j] = convw[2048 + c8 * 8 + j]; w2[j] = convw[4096 + c8 * 8 + j]; }
        const float osc = c8 < 128 ? 0.0625f : 1.0f;
        bf16* dst = c8 < 128 ? qc + c8 * 8 : kc + (c8 - 128) * 8;
        for (int t = gt >> 8; t < MS; t += NGT >> 8) {
            const int ts = t % T; const GAS v4u* src = (const GAS v4u*)(qkvob + (size_t)t * 4096 + c8 * 8);
            const v4u xc = src[0]; v4u xm = (v4u){0u, 0u, 0u, 0u}, xp = xm;
            if (ts > 0) xm = *(const GAS v4u*)(qkvob + (size_t)(t - 1) * 4096 + c8 * 8);
            if (ts < T - 1) xp = *(const GAS v4u*)(qkvob + (size_t)(t + 1) * 4096 + c8 * 8);
            float r[8];
#pragma unroll
            for (int j = 0; j < 4; ++j) {
                const float a0 = w0[2 * j] * bf_lo(xm[j]) + w1[2 * j] * bf_lo(xc[j]) + w2[2 * j] * bf_lo(xp[j]);
                const float a1 = w0[2 * j + 1] * bf_hi(xm[j]) + w1[2 * j + 1] * bf_hi(xc[j]) + w2[2 * j + 1] * bf_hi(xp[j]);
                r[2 * j] = a0 * sigmoid_f(a0) * osc; r[2 * j + 1] = a1 * sigmoid_f(a1) * osc; }
            v4u o; o.x = pk2(r[0], r[1]); o.y = pk2(r[2], r[3]); o.z = pk2(r[4], r[5]); o.w = pk2(r[6], r[7]);
            *(GAS v4u*)(dst + (size_t)t * 1024) = o;
        }
    }
    {
        const int gw = F.vcu * NWAVES + F.wave, NGW = F.G * NWAVES;
        for (int t = gw; t < MS; t += NGW) {
            const GAS v4u* src = (const GAS v4u*)(zuv + (size_t)t * 2048 + 1024) + 2 * F.lane; float s = 0.f;
#pragma unroll
            for (int i = 0; i < 2; ++i) { const v4u x = src[i];
#pragma unroll
                for (int j = 0; j < 4; ++j) { const float a = bf_lo(x[j]), b = bf_hi(x[j]); s += a * a + b * b; } }
            s = wave_sum(s);
            if (F.lane == 0) sgr[t] = 1.0f / sqrtf(s * (1.f / 1024.f) + EPS);
        }
    }
}

__device__ __forceinline__ void comb_phase(Frame& F, const float* hf, const float* hb, const bf16* qkvob, const float* mlg, bf16* yb) {
    const int gw = F.vcu * NWAVES + F.wave, NGW = F.G * NWAVES;
    for (int it = gw; it < MS * 4; it += NGW) { const int t = it >> 2, h = it & 3; const size_t o = (size_t)t * 1024 + h * 256 + 4 * F.lane;
        const f32x4 a = *(const GAS f32x4*)(hf + o), b = *(const GAS f32x4*)(hb + o); const f32x4 s = a + b;
        const float ss = wave_sum((s.x * s.x + s.y * s.y) + (s.z * s.z + s.w * s.w)); const float rs = 1.0f / sqrtf(ss * (1.f / 256.f) + EPS);
        const f32x4 gv = *(const GAS f32x4*)(mlg + h * 256 + 4 * F.lane);
        const unsigned long long ow = *(const GAS unsigned long long*)(qkvob + (size_t)t * 4096 + 3072 + h * 256 + 4 * F.lane);
        const unsigned o0 = (unsigned)ow, o1 = (unsigned)(ow >> 32);
        const float y0 = s.x * rs * gv.x * bf_lo(o0), y1 = s.y * rs * gv.y * bf_hi(o0), y2 = s.z * rs * gv.z * bf_lo(o1), y3 = s.w * rs * gv.w * bf_hi(o1);
        *(GAS unsigned long long*)(yb + o) = (unsigned long long)pk2(y0, y1) | ((unsigned long long)pk2(y2, y3) << 32);
    }
}

__device__ __forceinline__ void na_naive(Frame& F, const bf16* qkva, const float* rpb, bf16* ya, int T, int gw, int NGW) {
    const int rows = T / 64;
    for (int it = gw; it < MS * 8; it += NGW) {
        const int m = it >> 3, h = it & 7, seq = m / T, t = m % T, r = t >> 6, qc = t & 63;
        int rs = r - 4; rs = rs < 0 ? 0 : (rs > rows - 8 ? rows - 8 : rs);
        int cs = qc - 8; cs = cs < 0 ? 0 : (cs > 48 ? 48 : cs);
        const bf16* qrow = qkva + (size_t)m * 3072 + h * 128;
        float sc[2];
#pragma unroll
        for (int kk = 0; kk < 2; ++kk) { const int kap = F.lane + 64 * kk, j = kap >> 4, cc = kap & 15;
            const int ktok = seq * T + (rs + j) * 64 + cs + cc; const bf16* krow = qkva + (size_t)ktok * 3072 + 1024 + h * 128; float d = 0.f;
#pragma unroll 4
            for (int i = 0; i < 16; ++i) { const v4u qv = *(const GAS v4u*)(qrow + 8 * i), kv = *(const GAS v4u*)(krow + 8 * i);
#pragma unroll
                for (int e = 0; e < 4; ++e) d += bf_lo(qv[e]) * bf_lo(kv[e]) + bf_hi(qv[e]) * bf_hi(kv[e]); }
            sc[kk] = d + rpb[(h * 15 + (rs + j - r + 7)) * 31 + (cs + cc - qc + 15)]; }
        const float mx = wave_max(fmaxf(sc[0], sc[1]));
        const float e0 = __expf(sc[0] - mx), e1 = __expf(sc[1] - mx); const float inv = 1.0f / wave_sum(e0 + e1);
        const float p0 = e0 * inv, p1 = e1 * inv;
        float o0 = 0.f, o1 = 0.f;
        for (int kap = 0; kap < 128; ++kap) { const int j = kap >> 4, cc = kap & 15; const int ktok = seq * T + (rs + j) * 64 + cs + cc;
            const float p = __shfl(kap < 64 ? p0 : p1, kap & 63);
            const unsigned vv = *(const GAS unsigned*)(qkva + (size_t)ktok * 3072 + 2048 + h * 128 + 2 * F.lane);
            o0 += p * bf_lo(vv); o1 += p * bf_hi(vv); }
        *(GAS unsigned*)(ya + (size_t)m * 1024 + h * 128 + 2 * F.lane) = pk2(o0, o1);
    }
}
__device__ __forceinline__ void sg_naive(Frame& F, const bf16* zuv, const float* sgr, const float* sgn, const float* ws_, const float* bs, bf16* yc, int gw, int NGW) {
    for (int it = gw; it < MS * 8; it += NGW) {
        const int t = it >> 3, g = it & 7, p = t & 127, cb = t & ~127; const int c = g * 128 + 2 * F.lane;
        const float* wrow = ws_ + ((size_t)g * 128 + p) * 128; float a0 = 0.f, a1 = 0.f;
        for (int q = 0; q < 128; ++q) { const float wq = wrow[q] * sgr[cb + q]; const unsigned zz = *(const GAS unsigned*)(zuv + (size_t)(cb + q) * 2048 + 1024 + c);
            a0 += wq * bf_lo(zz); a1 += wq * bf_hi(zz); }
        const float b = bs[g * 128 + p]; const unsigned uu = *(const GAS unsigned*)(zuv + (size_t)t * 2048 + c);
        const float y0 = bf_lo(uu) * (a0 * sgn[c] + b), y1 = bf_hi(uu) * (a1 * sgn[c + 1] + b);
        *(GAS unsigned*)(yc + (size_t)t * 1024 + c) = pk2(y0, y1);
    }
}
__device__ __forceinline__ void mlstm_naive(Frame& F, int unit, const bf16* qc, const bf16* kc, const bf16* qkvob, const float* gates, float* hf, float* hb, int T) {
    const int es = unit & 3, dir = (unit >> 2) & 1, h = (unit >> 3) & 3, seq = unit >> 5, nc = T / 64, tid = F.tid;
    LAS unsigned char* L = F.lds;
    LAS bf16* Qs = (LAS bf16*)(L);
    LAS bf16* Ks = (LAS bf16*)(L + 33792);
    LAS float* Vs = (LAS float*)(L + 67584);
    LAS float* Ss = (LAS float*)(L + 83968);
    LAS float* NUM = (LAS float*)(L + 100608);
    LAS float* vb = (LAS float*)(L + 116992);
    LAS float* va = vb + 64;
    LAS float* vmr = vb + 128;
    LAS float* vw = vb + 192;
    LAS float* vwi = vb + 256;
    LAS float* NQ = vb + 320;
    LAS float* nst = vb + 384;
    LAS float* scal = vb + 640;
    float* hout = dir ? hb : hf;
    float Creg[32];
#pragma unroll
    for (int i = 0; i < 32; ++i) Creg[i] = 0.f;
    if (tid < 256) nst[tid] = 0.f;
    float m_prev = 0.f;
    const int e = tid & 63, dg = tid >> 6;
    for (int ci = 0; ci < nc; ++ci) {
        __syncthreads();
#pragma unroll
        for (int i = 0; i < 4; ++i) { const int p = tid + 512 * i, tau = p >> 5, c8 = p & 31; const int pos = ci * 64 + tau; const int tok = seq * T + (dir ? T - 1 - pos : pos);
            *(LAS v4u*)(Qs + tau * 264 + c8 * 8) = *(const GAS v4u*)(qc + (size_t)tok * 1024 + h * 256 + c8 * 8);
            *(LAS v4u*)(Ks + tau * 264 + c8 * 8) = *(const GAS v4u*)(kc + (size_t)tok * 1024 + h * 256 + c8 * 8); }
        { const int tau = tid >> 3, c8 = tid & 7; const int pos = ci * 64 + tau; const int tok = seq * T + (dir ? T - 1 - pos : pos);
            const v4u vv = *(const GAS v4u*)(qkvob + (size_t)tok * 4096 + 2048 + h * 256 + es * 64 + c8 * 8);
#pragma unroll
            for (int j = 0; j < 4; ++j) { Vs[tau * 64 + c8 * 8 + 2 * j] = bf_lo(vv[j]); Vs[tau * 64 + c8 * 8 + 2 * j + 1] = bf_hi(vv[j]); } }
        if (tid < 64) {
            const int pos = ci * 64 + tid; const int tok = seq * T + (dir ? T - 1 - pos : pos);
            const float ipre = gates[(size_t)tok * 16 + dir * 8 + h], fpre = gates[(size_t)tok * 16 + dir * 8 + 4 + h];
            const float logf = fminf(fpre, 0.f) - log1pf(__expf(-fabsf(fpre)));
            float b = logf;
#pragma unroll
            for (int o = 1; o < 64; o <<= 1) { const float y = __shfl_up(b, o); if (tid >= o) b += y; }
            const float a = ipre - b; float pm = a;
#pragma unroll
            for (int o = 1; o < 64; o <<= 1) { const float y = __shfl_up(pm, o); if (tid >= o) pm = fmaxf(pm, y); }
            const float mrow = fmaxf(b + m_prev, b + pm);
            const float blast = __shfl(b, 63), amax = __shfl(pm, 63);
            const float mnew = fmaxf(blast + m_prev, blast + amax);
            vb[tid] = b; va[tid] = a; vmr[tid] = mrow; vw[tid] = __expf(blast + a - mnew); vwi[tid] = __expf(b + m_prev - mrow);
            if (tid == 0) { scal[0] = __expf(blast + m_prev - mnew); scal[1] = mnew; }
        }
#pragma unroll
        for (int i = 0; i < 8; ++i) NUM[tid + 512 * i] = 0.f;
        __syncthreads();
        const float decay = scal[0]; m_prev = scal[1];
        {
            const int tau = tid >> 3, sg = tid & 7; float rowpart = 0.f; const float bt = vb[tau], mr = vmr[tau];
#pragma unroll 1
            for (int j = 0; j < 8; ++j) { const int s = sg * 8 + j; float val = 0.f;
                if (s <= tau) { float d = 0.f;
#pragma unroll 4
                    for (int c8 = 0; c8 < 32; ++c8) { const v4u qv = *(const LAS v4u*)(Qs + tau * 264 + c8 * 8), kv = *(const LAS v4u*)(Ks + s * 264 + c8 * 8);
#pragma unroll
                        for (int x = 0; x < 4; ++x) d += bf_lo(qv[x]) * bf_lo(kv[x]) + bf_hi(qv[x]) * bf_hi(kv[x]); }
                    val = d * __expf(bt + va[s] - mr); }
                Ss[tau * 65 + s] = val; rowpart += val; }
            float qn = 0.f;
#pragma unroll 4
            for (int c8 = 0; c8 < 4; ++c8) { const v4u qv = *(const LAS v4u*)(Qs + tau * 264 + sg * 32 + c8 * 8);
#pragma unroll
                for (int x = 0; x < 4; ++x) qn += bf_lo(qv[x]) * nst[sg * 32 + c8 * 8 + 2 * x] + bf_hi(qv[x]) * nst[sg * 32 + c8 * 8 + 2 * x + 1]; }
            float tot = rowpart + vwi[tau] * qn;
            tot += __shfl_xor(tot, 1); tot += __shfl_xor(tot, 2); tot += __shfl_xor(tot, 4);
            if (sg == 0) NQ[tau] = tot;
        }
        {
#pragma unroll 1
            for (int tau = 0; tau < 64; ++tau) { float part = 0.f;
#pragma unroll
                for (int c8 = 0; c8 < 4; ++c8) { const v4u qv = *(const LAS v4u*)(Qs + tau * 264 + dg * 32 + c8 * 8);
#pragma unroll
                    for (int x = 0; x < 4; ++x) part += bf_lo(qv[x]) * Creg[c8 * 8 + 2 * x] + bf_hi(qv[x]) * Creg[c8 * 8 + 2 * x + 1]; }
                __hip_atomic_fetch_add(&NUM[tau * 64 + e], vwi[tau] * part, __ATOMIC_RELAXED, __HIP_MEMORY_SCOPE_WORKGROUP); }
        }
        __syncthreads();
        {
#pragma unroll 1
            for (int j = 0; j < 8; ++j) { const int tau = dg * 8 + j; float acc = 0.f;
#pragma unroll 8
                for (int s = 0; s < 64; ++s) acc += Ss[tau * 65 + s] * Vs[s * 64 + e];
                __hip_atomic_fetch_add(&NUM[tau * 64 + e], acc, __ATOMIC_RELAXED, __HIP_MEMORY_SCOPE_WORKGROUP); }
        }
        __syncthreads();
#pragma unroll
        for (int i = 0; i < 8; ++i) { const int idx = tid + 512 * i, tau = idx >> 6, ee = idx & 63; const int pos = ci * 64 + tau; const int tok = seq * T + (dir ? T - 1 - pos : pos);
            const float den = fmaxf(fabsf(NQ[tau]), __expf(-vmr[tau]));
            hout[(size_t)tok * 1024 + h * 256 + es * 64 + ee] = NUM[idx] / den; }
#pragma unroll
        for (int i = 0; i < 32; ++i) Creg[i] *= decay;
#pragma unroll 1
        for (int s = 0; s < 64; ++s) { const float wv = vw[s] * Vs[s * 64 + e];
#pragma unroll
            for (int c8 = 0; c8 < 4; ++c8) { const v4u kv = *(const LAS v4u*)(Ks + s * 264 + dg * 32 + c8 * 8);
#pragma unroll
                for (int x = 0; x < 4; ++x) { Creg[c8 * 8 + 2 * x] += bf_lo(kv[x]) * wv; Creg[c8 * 8 + 2 * x + 1] += bf_hi(kv[x]) * wv; } } }
        if (tid < 256) { float a = decay * nst[tid];
#pragma unroll 8
            for (int s = 0; s < 64; ++s) a += vw[s] * __uint_as_float(((unsigned)Ks[s * 264 + tid]) << 16);
            nst[tid] = a; }
    }
    __syncthreads();
}

typedef short s16x4 __attribute__((ext_vector_type(4)));
__device__ __forceinline__ bf16x8 tr_pair(const LAS bf16* p0, const LAS bf16* p1) {
    const s16x4 a = __builtin_amdgcn_ds_read_tr16_b64_v4i16((LAS s16x4*)p0), b = __builtin_amdgcn_ds_read_tr16_b64_v4i16((LAS s16x4*)p1);
    return __builtin_shufflevector(a, b, 0, 1, 2, 3, 4, 5, 6, 7);
}
#define MFMA16(a, b, c) __builtin_amdgcn_mfma_f32_16x16x32_bf16((a), (b), (c), 0, 0, 0)

__device__ __forceinline__ void sg_fast(Frame& F, const bf16* zuv, const float* sgr, const float* sgn, const float* ws_, const float* bs, bf16* yc, int u0, int ustride) {
    LAS bf16* Z = (LAS bf16*)F.lds;
    const int lane = F.lane, kg = lane >> 4, li = lane & 15, qq = li >> 2, pp = li & 3;
    for (int unit = u0; unit < (MS / 128) * 8; unit += ustride) {
        const int c = unit >> 3, g = unit & 7, t0 = c * 128;
        __syncthreads();
#pragma unroll
        for (int i = 0; i < 4; ++i) { const int idx = F.tid + 512 * i, row = idx >> 4, ch = idx & 15;
            *(LAS v4u*)(Z + row * 136 + ch * 8) = *(const GAS v4u*)(zuv + (size_t)(t0 + row) * 2048 + 1024 + g * 128 + ch * 8); }
        const int p = F.wave * 16 + li;
        bf16x8 bw[4];
#pragma unroll
        for (int ks = 0; ks < 4; ++ks) { const int q0 = ks * 32 + 8 * kg;
            const f32x4 w0 = *(const GAS f32x4*)(ws_ + ((size_t)g * 128 + p) * 128 + q0), w1 = *(const GAS f32x4*)(ws_ + ((size_t)g * 128 + p) * 128 + q0 + 4);
            const f32x4 r0 = *(const GAS f32x4*)(sgr + t0 + q0), r1 = *(const GAS f32x4*)(sgr + t0 + q0 + 4);
            v4u pk; pk.x = pk2(w0.x * r0.x, w0.y * r0.y); pk.y = pk2(w0.z * r0.z, w0.w * r0.w); pk.z = pk2(w1.x * r1.x, w1.y * r1.y); pk.w = pk2(w1.z * r1.z, w1.w * r1.w);
            bw[ks] = __builtin_bit_cast(bf16x8, pk); }
        __syncthreads();
        const float bsv = bs[g * 128 + p];
#pragma unroll 2
        for (int dt = 0; dt < 8; ++dt) {
            f32x4 acc = (f32x4){0.f, 0.f, 0.f, 0.f};
#pragma unroll
            for (int ks = 0; ks < 4; ++ks) { const LAS bf16* a0 = Z + (ks * 32 + 8 * kg + qq) * 136 + dt * 16 + 4 * pp;
                acc = MFMA16(tr_pair(a0, a0 + 4 * 136), bw[ks], acc); }
            const int d0 = g * 128 + dt * 16 + 4 * kg;
            const f32x4 sg = *(const GAS f32x4*)(sgn + d0);
            const unsigned long long uw = *(const GAS unsigned long long*)(zuv + (size_t)(t0 + p) * 2048 + d0); const unsigned u0w = (unsigned)uw, u1w = (unsigned)(uw >> 32);
            const float y0 = bf_lo(u0w) * (sg.x * acc[0] + bsv), y1 = bf_hi(u0w) * (sg.y * acc[1] + bsv), y2 = bf_lo(u1w) * (sg.z * acc[2] + bsv), y3 = bf_hi(u1w) * (sg.w * acc[3] + bsv);
            *(GAS unsigned long long*)(yc + (size_t)(t0 + p) * 1024 + d0) = (unsigned long long)pk2(y0, y1) | ((unsigned long long)pk2(y2, y3) << 32);
        }
    }
    __syncthreads();
}

__device__ __forceinline__ void na_fast(Frame& F, const bf16* qkva, const float* rpb, bf16* ya, int T, int gw, int NGW) {
    const int rows = T / 64, lane = F.lane, kg = lane >> 4, li = lane & 15, qq = li >> 2, pp = li & 3;
    LAS bf16* Vt = (LAS bf16*)(F.lds + F.wave * 8192);
    for (int it = gw; it < (MS / 16) * 8; it += NGW) {
        const int h = it & 7, blk = it >> 3, n = blk & 3, rowg = blk >> 2, seq = rowg / rows, r = rowg % rows;
        int rs = r - 4; rs = rs < 0 ? 0 : (rs > rows - 8 ? rows - 8 : rs);
        int kc0 = 16 * n - 8; kc0 = kc0 < 0 ? 0 : (kc0 > 32 ? 32 : kc0);
        const int qc = 16 * n + li; const size_t qtok = (size_t)seq * T + r * 64 + qc;
        bf16x8 bq[4];
#pragma unroll
        for (int ks = 0; ks < 4; ++ks) bq[ks] = __builtin_bit_cast(bf16x8, *(const GAS v4u*)(qkva + qtok * 3072 + h * 128 + ks * 32 + 8 * kg));
        f32x4 s[8][2];
#pragma unroll
        for (int j = 0; j < 8; ++j)
#pragma unroll
            for (int ct = 0; ct < 2; ++ct) { const size_t ktok = (size_t)seq * T + (rs + j) * 64 + kc0 + 16 * ct + li; f32x4 a = (f32x4){0.f, 0.f, 0.f, 0.f};
#pragma unroll
                for (int ks = 0; ks < 4; ++ks) a = MFMA16(__builtin_bit_cast(bf16x8, *(const GAS v4u*)(qkva + ktok * 3072 + 1024 + h * 128 + ks * 32 + 8 * kg)), bq[ks], a);
                s[j][ct] = a; }
        int cs = qc - 8; cs = cs < 0 ? 0 : (cs > 48 ? 48 : cs);
        float mx = -3.0e38f;
#pragma unroll
        for (int j = 0; j < 8; ++j)
#pragma unroll
            for (int ct = 0; ct < 2; ++ct)
#pragma unroll
                for (int e = 0; e < 4; ++e) { const int kc = kc0 + 16 * ct + 4 * kg + e; const bool ok = kc >= cs && kc < cs + 16;
                    const int bi = (h * 15 + (rs + j - r + 7)) * 31 + (ok ? kc - qc + 15 : 15);
                    const float v = ok ? s[j][ct][e] + rpb[bi] : -3.0e38f; s[j][ct][e] = v; mx = fmaxf(mx, v); }
        mx = fmaxf(mx, __shfl_xor(mx, 16)); mx = fmaxf(mx, __shfl_xor(mx, 32));
        float sum = 0.f;
#pragma unroll
        for (int j = 0; j < 8; ++j)
#pragma unroll
            for (int ct = 0; ct < 2; ++ct)
#pragma unroll
                for (int e = 0; e < 4; ++e) { const float pv = s[j][ct][e] > -1.0e38f ? __expf(s[j][ct][e] - mx) : 0.f; s[j][ct][e] = pv; sum += pv; }
        sum += __shfl_xor(sum, 16); sum += __shfl_xor(sum, 32);
        const float inv = 1.0f / sum;
        f32x4 o[8];
#pragma unroll
        for (int dt = 0; dt < 8; ++dt) o[dt] = (f32x4){0.f, 0.f, 0.f, 0.f};
#pragma unroll 1
        for (int j = 0; j < 8; ++j) {
            asm volatile("" ::: "memory");
#pragma unroll
            for (int i = 0; i < 8; ++i) { const int key = 4 * i + kg; const size_t vtok = (size_t)seq * T + (rs + j) * 64 + kc0 + key;
                *(LAS v4u*)(Vt + key * 128 + li * 8) = *(const GAS v4u*)(qkva + vtok * 3072 + 2048 + h * 128 + li * 8); }
            asm volatile("" ::: "memory");
            f32x4 p0, p1;
            p0 = s[0][0]; p1 = s[0][1];
#pragma unroll
            for (int jj = 1; jj < 8; ++jj) if (j == jj) { p0 = s[jj][0]; p1 = s[jj][1]; }
            v4u pk; pk.x = pk2(p0[0], p0[1]); pk.y = pk2(p0[2], p0[3]); pk.z = pk2(p1[0], p1[1]); pk.w = pk2(p1[2], p1[3]);
            const bf16x8 bp = __builtin_bit_cast(bf16x8, pk);
#pragma unroll
            for (int dt = 0; dt < 8; ++dt) { const LAS bf16* a0 = Vt + (4 * kg + qq) * 128 + dt * 16 + 4 * pp;
                o[dt] = MFMA16(tr_pair(a0, a0 + 16 * 128), bp, o[dt]); }
            asm volatile("" ::: "memory");
        }
#pragma unroll
        for (int dt = 0; dt < 8; ++dt) { const f32x4 v = o[dt] * inv;
            *(GAS unsigned long long*)(ya + qtok * 1024 + h * 128 + dt * 16 + 4 * kg) = (unsigned long long)pk2(v[0], v[1]) | ((unsigned long long)pk2(v[2], v[3]) << 32); }
    }
}

#ifndef KNOB_NO_ROW
#define KNOB_NO_ROW 0
#endif
#ifndef KNOB_NO_WIN
#define KNOB_NO_WIN 0
#endif
#ifndef KNOB_NO_PREP
#define KNOB_NO_PREP 0
#endif
#ifndef KNOB_NO_ML
#define KNOB_NO_ML 0
#endif
#ifndef KNOB_NO_NA
#define KNOB_NO_NA 0
#endif
#ifndef KNOB_NO_SG
#define KNOB_NO_SG 0
#endif
#ifndef KNOB_NO_COMB
#define KNOB_NO_COMB 0
#endif
#ifndef KNOB_NO_MERGE
#define KNOB_NO_MERGE 0
#endif
#ifndef KNOB_NO_WOUT
#define KNOB_NO_WOUT 0
#endif
#ifndef KNOB_NO_UP
#define KNOB_NO_UP 0
#endif
#ifndef KNOB_NO_DOWN
#define KNOB_NO_DOWN 0
#endif
#ifndef KNOB_NO_P0
#define KNOB_NO_P0 0
#endif
#ifndef USE_NA_FAST
#define USE_NA_FAST 1
#endif
#ifndef USE_SG_FAST
#define USE_SG_FAST 1
#endif
constexpr int STEPS_PER = 11, N_STEPS = 1 + NSLAB * DEPTH * STEPS_PER;
__global__ void __launch_bounds__(NWAVES * 64, 2) trunk_fwd(Args args) {
    extern __shared__ __attribute__((aligned(16))) unsigned char lds[];
#define MKF() Frame F; { int t_ = threadIdx.x; asm volatile("" : "+v"(t_)); F.lds = (LAS unsigned char*)lds; F.tid = t_; F.lane = t_ & 63; F.wave = __builtin_amdgcn_readfirstlane(t_ >> 6); \
        F.G = gridDim.x; const int bx_ = blockIdx.x; F.vcu = (F.G % 8 == 0) ? (bx_ % 8) * (F.G / 8) + bx_ / 8 : bx_; }
#define ARGS() ({ const __attribute__((address_space(4))) Args* _p = (const __attribute__((address_space(4))) Args*)__builtin_amdgcn_kernarg_segment_ptr(); asm volatile("" : "+s"(_p)); _p; })
    gu32* ctl = (gu32*)(ARGS()->ws + WS_CTL);
    for (int u = threadIdx.x; u < (LDS_BYTES - LDSCTL_OFF) / 4; u += NWAVES * 64) ((LAS unsigned*)((LAS unsigned char*)lds + LDSCTL_OFF))[u] = 0u;
    __syncthreads();
    volatile LAS unsigned* MISC = (volatile LAS unsigned*)((LAS unsigned char*)lds + MISC_OFF);
    XcdBarrier bar = xcd_barrier_post((unsigned*)ctl + CW_BAR, MISC + 8);
    const int lo = ARGS()->ph_lo, hi = ARGS()->ph_hi;
#define IN(k) (lo <= (k) && (k) < hi)
#define SEAM(k) do { if (IN(k) && IN((k) + 1)) xcd_barrier(bar); } while (0)

#define WSB(T_, off) ((T_*)(A->ws + (off)))
#define Hb WSB(bf16, WS_H)
#define QKVA WSB(bf16, WS_QKVA)
#define QKVOB WSB(bf16, WS_QKVOB)
#define ZUV WSB(bf16, WS_ZUV)
#define Ub WSB(bf16, WS_U)
#define Gb WSB(bf16, WS_G)
#define GATES WSB(float, WS_GATES)
#define SGR WSB(float, WS_SGR)
#define QC WSB(bf16, WS_QC)
#define KC WSB(bf16, WS_KC)
#define Yb WSB(bf16, WS_Y)
#define HF WSB(float, WS_HF)
#define HB WSB(float, WS_HB)
#define MRG WSB(float, WS_MRG)
#define MRGB WSB(bf16, WS_MRGB)
#define Tb WSB(float, WS_T)

    if (IN(0) && !KNOB_NO_P0) { MKF();
        LAS float* scr = (LAS float*)(F.lds + RING_OFF + F.wave * 16384);
        for (int l = 0; l < DEPTH; ++l) {
            const auto* A = ARGS(); unsigned char* wl = A->ws + WS_W + (size_t)l * WL_BYTES;
            p0_win(F, A->w_in + (size_t)l * D * D_IN, (bf16*)(wl + WL_IN), scr);
            p0_matrix(F, A->w_a + (size_t)l * NA_W * D, NA_W, D, (bf16*)(wl + WL_ABC), scr);
            p0_matrix(F, A->w_b + (size_t)l * ML_W * D, ML_W, D, (bf16*)(wl + WL_ABC) + (size_t)D * 1024, scr);
            p0_matrix(F, A->w_c + (size_t)l * SG_W * D, SG_W, D, (bf16*)(wl + WL_ABC) + (size_t)2 * D * 1024, scr);
            p0_matrix(F, A->w_out + (size_t)l * D * D, D, D, (bf16*)(wl + WL_OUT), scr);
            p0_matrix(F, A->w_up + (size_t)l * D * DFF, D, DFF, (bf16*)(wl + WL_UP), scr);
            p0_matrix(F, A->w_down + (size_t)l * DFF * D, DFF, D, (bf16*)(wl + WL_DN), scr);
        }
    }
    SEAM(0);

    for (int s = 0; s < NSLAB; ++s) {
        const int T = s < 4 ? 4096 : 8192, nseq = MS / T;
        for (int l = 0; l < DEPTH; ++l) {
            const int sb = 1 + (s * DEPTH + l) * STEPS_PER;
            if (sb + STEPS_PER <= lo || sb >= hi) continue;
#define XIN0 (s < 4 ? A->x_prompt + (size_t)s * MS * D : A->x_sample + (size_t)(s - 4) * MS * D)
#define XO (A->out + (size_t)s * MS * D)
#define WL (A->ws + WS_W + (size_t)l * WL_BYTES)
            if (IN(sb + 0) && l == 0 && !KNOB_NO_ROW) { MKF(); const auto* A = ARGS(); row_phase(F, XIN0, nullptr, nullptr, nullptr, A->pre_mix_g, Hb); }
            SEAM(sb + 0);
            if (IN(sb + 1) && !KNOB_NO_WIN) { MKF(); const auto* A = ARGS();
                pg8::Gemm g{Hb, (const bf16*)(WL + WL_IN), MS, N_IN_PAD, D, 0, 0}; pg8::StaticOrder S; S.init(MS, N_IN_PAD, (int)gridDim.x, (int)blockIdx.x);
                pg8::EpiIn E{QKVA, QKVOB, ZUV, Gb, GATES, A->b_gate + l * 16};
                pg8::gemm_phase<pg8::EpiIn, pg8::StaticOrder, true, true>((PG8_LAS unsigned char*)lds + RING_OFF, g, S, E);
            }
            SEAM(sb + 1);
            if (IN(sb + 2) && !KNOB_NO_PREP) { MKF(); const auto* A = ARGS(); prep_phase(F, QKVOB, A->conv_w + (size_t)l * 3 * 2048, QC, KC, ZUV, SGR, T); }
            SEAM(sb + 2);
            if (IN(sb + 3)) { MKF(); const auto* A = ARGS();
                const int nml = nseq * 32;
                if (F.vcu < nml) { if (!KNOB_NO_ML) mlstm_naive(F, F.vcu, QC, KC, QKVOB, GATES, HF, HB, T); }
                else { const int gw = (F.vcu - nml) * NWAVES + F.wave, NGW = (F.G - nml) * NWAVES;
                    if (USE_NA_FAST) na_fast(F, QKVA, A->na_rpb + (size_t)l * 8 * 15 * 31, Yb, T, gw, NGW); else na_naive(F, QKVA, A->na_rpb + (size_t)l * 8 * 15 * 31, Yb, T, gw, NGW);
                    if (USE_SG_FAST) sg_fast(F, ZUV, SGR, A->sg_norm_g + l * 1024, A->w_s + (size_t)l * 8 * 128 * 128, A->b_s + l * 1024, Yb + (size_t)2 * MS * 1024, F.vcu - nml, F.G - nml);
                    else sg_naive(F, ZUV, SGR, A->sg_norm_g + l * 1024, A->w_s + (size_t)l * 8 * 128 * 128, A->b_s + l * 1024, Yb + (size_t)2 * MS * 1024, gw, NGW); }
            }
            SEAM(sb + 3);
            if (IN(sb + 4) && !KNOB_NO_COMB) { MKF(); const auto* A = ARGS(); comb_phase(F, HF, HB, QKVOB, A->ml_norm_g + l * 1024, Yb + (size_t)MS * 1024); }
            SEAM(sb + 4);
            if (IN(sb + 5) && !KNOB_NO_MERGE) { MKF(); const auto* A = ARGS();
                pg8::Gemm g{Yb, (const bf16*)(WL + WL_ABC), MS, D, 1024, (size_t)MS * 1024 * 2, (size_t)D * 1024 * 2}; pg8::ZOrder<3> S; S.init(MS, D, (int)gridDim.x, (int)blockIdx.x);
                pg8::EpiMerge E{Gb, MRG, MRGB};
                pg8::gemm_phase<pg8::EpiMerge, pg8::ZOrder<3>, true, true>((PG8_LAS unsigned char*)lds + RING_OFF, g, S, E);
            }
            SEAM(sb + 5);
            if (IN(sb + 6) && !KNOB_NO_WOUT) { MKF(); const auto* A = ARGS();
                pg8::Gemm g{MRGB, (const bf16*)(WL + WL_OUT), MS, D, D, 0, 0}; pg8::StaticOrder S; S.init(MS, D, (int)gridDim.x, (int)blockIdx.x);
                pg8::EpiF32 E{Tb, D};
                pg8::gemm_phase<pg8::EpiF32, pg8::StaticOrder, true, true>((PG8_LAS unsigned char*)lds + RING_OFF, g, S, E);
            }
            SEAM(sb + 6);
            if (IN(sb + 7) && !KNOB_NO_ROW) { MKF(); const auto* A = ARGS(); row_phase(F, l == 0 ? XIN0 : XO, Tb, A->post_mix_g + l * D, XO, A->pre_mlp_g + l * D, Hb); }
            SEAM(sb + 7);
            if (IN(sb + 8) && !KNOB_NO_UP) { MKF(); const auto* A = ARGS();
                pg8::Gemm g{Hb, (const bf16*)(WL + WL_UP), MS, DFF, D, 0, 0}; pg8::StaticOrder S; S.init(MS, DFF, (int)gridDim.x, (int)blockIdx.x);
                pg8::EpiRelu2 E{Ub, DFF};
                pg8::gemm_phase<pg8::EpiRelu2, pg8::StaticOrder, true, true>((PG8_LAS unsigned char*)lds + RING_OFF, g, S, E);
            }
            SEAM(sb + 8);
            if (IN(sb + 9) && !KNOB_NO_DOWN) { MKF(); const auto* A = ARGS();
                pg8::Gemm g{Ub, (const bf16*)(WL + WL_DN), MS, D, DFF, 0, 0}; pg8::StaticOrder S; S.init(MS, D, (int)gridDim.x, (int)blockIdx.x);
                pg8::EpiF32 E{Tb, D};
                pg8::gemm_phase<pg8::EpiF32, pg8::StaticOrder, true, true>((PG8_LAS unsigned char*)lds + RING_OFF, g, S, E);
            }
            SEAM(sb + 9);
            if (IN(sb + 10) && !KNOB_NO_ROW) { MKF(); const auto* A = ARGS(); row_phase(F, XO, Tb, A->post_mlp_g + l * D, XO, l + 1 < DEPTH ? A->pre_mix_g + (l + 1) * D : nullptr, l + 1 < DEPTH ? Hb : nullptr); }
            SEAM(sb + 10);
        }
    }
#undef IN
#undef SEAM
}

#ifndef MK_LAUNCH_PER_STEP
#define MK_LAUNCH_PER_STEP 0
#endif
extern "C" void kernel_launch(void* const* d_in, const int* in_sizes, int n_in, void* d_out, int out_size, void* d_ws, size_t ws_size, hipStream_t stream) {
    static int grid = 0;
    if (grid == 0) {
        if (n_in != 20 || in_sizes[0] != M_PROMPT * D || in_sizes[1] != M_SAMPLE * D || out_size != M_ALL * D || ws_size < WS_END) {
            fprintf(stderr, "kernel_launch: unexpected shapes (n_in %d, in0 %d, in1 %d, out %d, ws %zu); nothing launched\n", n_in, n_in > 0 ? in_sizes[0] : -1, n_in > 1 ? in_sizes[1] : -1, out_size, ws_size); grid = -1; return; }
        int dev = 0, cus = 0;
        if (hipGetDevice(&dev) != hipSuccess || hipDeviceGetAttribute(&cus, hipDeviceAttributeMultiprocessorCount, dev) != hipSuccess) { grid = -1; return; }
        if (hipFuncSetAttribute((const void*)trunk_fwd, hipFuncAttributeMaxDynamicSharedMemorySize, LDS_BYTES) != hipSuccess) { fprintf(stderr, "kernel_launch: hipFuncSetAttribute failed\n"); grid = -1; return; }
        int per_cu = 0;
        if (hipOccupancyMaxActiveBlocksPerMultiprocessor(&per_cu, (const void*)trunk_fwd, NWAVES * 64, LDS_BYTES) != hipSuccess || per_cu < 1)
            fprintf(stderr, "kernel_launch: note: occupancy query reports %d workgroups per CU\n", per_cu);
        (void)hipGetLastError();
        grid = cus;
    }
    if (grid < 0) return;
    if (hipMemsetAsync((char*)d_ws + WS_CTL, 0, CTL_ZERO_BYTES, stream) != hipSuccess) return;
    Args a{};
    a.x_prompt = (const float*)d_in[0]; a.x_sample = (const float*)d_in[1]; a.pre_mix_g = (const float*)d_in[2]; a.post_mix_g = (const float*)d_in[3];
    a.pre_mlp_g = (const float*)d_in[4]; a.post_mlp_g = (const float*)d_in[5]; a.w_in = (const float*)d_in[6]; a.b_gate = (const float*)d_in[7];
    a.conv_w = (const float*)d_in[8]; a.na_rpb = (const float*)d_in[9]; a.ml_norm_g = (const float*)d_in[10]; a.sg_norm_g = (const float*)d_in[11];
    a.w_s = (const float*)d_in[12]; a.b_s = (const float*)d_in[13]; a.w_a = (const float*)d_in[14]; a.w_b = (const float*)d_in[15]; a.w_c = (const float*)d_in[16];
    a.w_out = (const float*)d_in[17]; a.w_up = (const float*)d_in[18]; a.w_down = (const float*)d_in[19];
    a.out = (float*)d_out; a.ws = (unsigned char*)d_ws;
#if MK_LAUNCH_PER_STEP
    for (int k = 0; k < N_STEPS; ++k) { a.ph_lo = k; a.ph_hi = k + 1; hipLaunchKernelGGL(trunk_fwd, dim3(grid), dim3(NWAVES * 64), LDS_BYTES, stream, a); }
#else
    a.ph_lo = 0; a.ph_hi = N_STEPS;
    hipLaunchKernelGGL(trunk_fwd, dim3(grid), dim3(NWAVES * 64), LDS_BYTES, stream, a);
#endif
}
```

```cpp
#include <hip/hip_runtime.h>
#include <cstdio>
#include <cstdint>
namespace pg8 {
#define PG8_LAS __attribute__((address_space(3)))
typedef unsigned short bf16_t;
typedef short bf16x8 __attribute__((ext_vector_type(8)));
typedef float f32x4 __attribute__((ext_vector_type(4)));
typedef unsigned u32x4 __attribute__((ext_vector_type(4)));
typedef unsigned u32x2 __attribute__((ext_vector_type(2)));
constexpr int BM = 256, BK = 64, HALF = 128, HTB = HALF * BK * 2  , STAGE_BYTES = 8 * HTB, NXCD = 8, WGM = 8;

__host__ __device__ __forceinline__ int lds_byte(int r, int c) { const int st = (r >> 4) * 2 + (c >> 5), rr = r & 15, cc = c & 31, ob = rr * 64 + cc * 2; return st * 1024 + (ob ^ (((ob >> 9) & 1) << 5)); }
__host__ __device__ __forceinline__ void stage_rc(int b, int& R, int& C) { const int st = b / 1024, sb = b % 1024, swz = sb ^ (((sb >> 9) & 1) << 5); R = (st >> 1) * 16 + swz / 64; C = (st & 1) * 32 + (swz % 64) / 2; }
__host__ __device__ __forceinline__ int perm32(int rho) { const int n = rho >> 4, i = rho & 15; return 8 * (i >> 2) + 4 * n + (i & 3); }

struct Unit { int pm, pn, z; };
struct Gemm { const bf16_t* A; const bf16_t* Bt; int M, N, K; size_t zA, zB; };

struct StaticOrder {
    int nM, nN, nwg, G, c;
    __host__ __device__ void init(int M, int N, int G_, int c_) { nM = M / BM; nN = N / BM; nwg = nM * nN; G = G_; c = c_; }
    __host__ __device__ bool tile(long L, Unit& u) const {
        if (L >= nwg) return false;
        int wgid = (int)L; { const int q = nwg / NXCD, r = nwg % NXCD, xcd = wgid % NXCD, off = wgid / NXCD; wgid = (xcd < r ? xcd * (q + 1) : r * (q + 1) + (xcd - r) * q) + off; }
        const int nig = WGM * nN, gid = wgid / nig, fm = gid * WGM, gsz = (nM - fm) < WGM ? (nM - fm) : WGM;
        u.pm = fm + ((wgid % nig) % gsz); u.pn = (wgid % nig) / gsz; return true;
    }
    __host__ __device__ bool next(int i, Unit& u) const { u.z = 0; return tile((long)i * G + c, u); }
    __device__ __forceinline__ void a_ready(const Unit&) const {}
    __device__ __forceinline__ void done(const Unit&) const {}
};
template <int NZ> struct ZOrder : StaticOrder {
    __host__ __device__ bool next(int i, Unit& u) const { const int k = i / NZ; u.z = i - k * NZ; return tile((long)k * G + c, u); }
};

__device__ __forceinline__ unsigned cvt_pk_bf16(float lo, float hi) { unsigned r; asm volatile("v_cvt_pk_bf16_f32 %0, %1, %2" : "=v"(r) : "v"(lo), "v"(hi)); return r; }
__device__ __forceinline__ float sigm(float x) { return __builtin_amdgcn_rcpf(1.0f + __builtin_amdgcn_exp2f(-1.4426950408889634f * x)); }
__device__ __forceinline__ float gelu_tanh(float x) { return x * sigm(1.5957691216057308f * x * (1.0f + 0.044715f * x * x)); }
__device__ __forceinline__ float act_apply(int act, float x) { return act == 1 ? sigm(x) : (act == 2 ? gelu_tanh(x) : x); }

struct EpiIn {
    static constexpr bool PERM = true, AFTER_DRAIN = false;
    bf16_t *qkva, *qkvob, *zuv, *g; float* gates; const float* bgate;
    __device__ __forceinline__ void operator()(const f32x4 (&acc)[2][2][4][2], const Unit& u, int wr, int wc, int fr, int fq) const {
        const int pn = u.pn, row0 = u.pm * BM + wr * 64 + fr;
        if (pn == 60) {
            if (wc == 0 && fq < 2) {
#pragma unroll
                for (int ai = 0; ai < 2; ++ai)
#pragma unroll
                    for (int m = 0; m < 4; ++m)
#pragma unroll
                        for (int n = 0; n < 2; ++n) { const int col = 8 * fq + 4 * n; *(f32x4*)(gates + (size_t)(row0 + ai * HALF + m * 16) * 16 + col) = acc[ai][0][m][n] + *(const f32x4*)(bgate + col); }
            }
            return;
        }
        bf16_t* base; int ldc, colt, act;
        if (pn < 12) { base = qkva; ldc = 3072; colt = pn * BM; act = 0; }
        else if (pn < 28) { base = qkvob; ldc = 4096; colt = (pn - 12) * BM; act = pn >= 24 ? 1 : 0; }
        else if (pn < 36) { base = zuv; ldc = 2048; colt = (pn - 28) * BM; act = 2; }
        else { base = g; ldc = 6144; colt = (pn - 36) * BM; act = 1; }
        const int col0 = colt + wc * 32 + 8 * fq;
#pragma unroll
        for (int ai = 0; ai < 2; ++ai)
#pragma unroll
            for (int m = 0; m < 4; ++m) { bf16_t* rowp = base + (size_t)(row0 + ai * HALF + m * 16) * ldc + col0;
#pragma unroll
                for (int bj = 0; bj < 2; ++bj) { f32x4 v0 = acc[ai][bj][m][0], v1 = acc[ai][bj][m][1];
                    if (act != 0) {
#pragma unroll
                        for (int j = 0; j < 4; ++j) { v0[j] = act_apply(act, v0[j]); v1[j] = act_apply(act, v1[j]); } }
                    u32x4 w; w.x = cvt_pk_bf16(v0[0], v0[1]); w.y = cvt_pk_bf16(v0[2], v0[3]); w.z = cvt_pk_bf16(v1[0], v1[1]); w.w = cvt_pk_bf16(v1[2], v1[3]);
                    *(u32x4*)(rowp + bj * HALF) = w; } }
    }
};
struct EpiMerge {
    static constexpr bool PERM = false, AFTER_DRAIN = false;
    const bf16_t* g; float* mrg; bf16_t* mrgb;
    __device__ __forceinline__ void operator()(const f32x4 (&acc)[2][2][4][2], const Unit& u, int wr, int wc, int fr, int fq) const {
        const int z = u.z, row0 = u.pm * BM + wr * 64 + fr, col0 = u.pn * BM + wc * 32 + 4 * fq;
#pragma unroll
        for (int ai = 0; ai < 2; ++ai)
#pragma unroll
            for (int m = 0; m < 4; ++m) { const size_t row = (size_t)(row0 + ai * HALF + m * 16);
#pragma unroll
                for (int bj = 0; bj < 2; ++bj)
#pragma unroll
                    for (int n = 0; n < 2; ++n) { const int col = col0 + bj * HALF + n * 16;
                        const u32x2 gw = *(const u32x2*)(g + row * 6144 + (size_t)z * 2048 + col);
                        f32x4 gv; gv[0] = __uint_as_float(gw.x << 16); gv[1] = __uint_as_float(gw.x & 0xffff0000u); gv[2] = __uint_as_float(gw.y << 16); gv[3] = __uint_as_float(gw.y & 0xffff0000u);
                        f32x4 v = acc[ai][bj][m][n] * gv;
                        if (z > 0) v += *(const f32x4*)(mrg + row * 2048 + col);
                        if (z < 2) *(f32x4*)(mrg + row * 2048 + col) = v;
                        else { u32x2 w; w.x = cvt_pk_bf16(v[0], v[1]); w.y = cvt_pk_bf16(v[2], v[3]); *(u32x2*)(mrgb + row * 2048 + col) = w; } }
                asm volatile("" ::: "memory"); }
    }
};
struct EpiF32 {
    static constexpr bool PERM = false, AFTER_DRAIN = false;
    float* C; int ldc;
    __device__ __forceinline__ void operator()(const f32x4 (&acc)[2][2][4][2], const Unit& u, int wr, int wc, int fr, int fq) const {
        const int row0 = u.pm * BM + wr * 64 + fr, col0 = u.pn * BM + wc * 32 + 4 * fq;
#pragma unroll
        for (int ai = 0; ai < 2; ++ai)
#pragma unroll
            for (int m = 0; m < 4; ++m) { float* rowp = C + (size_t)(row0 + ai * HALF + m * 16) * ldc + col0;
#pragma unroll
                for (int bj = 0; bj < 2; ++bj)
#pragma unroll
                    for (int n = 0; n < 2; ++n) *(f32x4*)(rowp + bj * HALF + n * 16) = acc[ai][bj][m][n]; }
    }
};
struct EpiRelu2 {
    static constexpr bool PERM = true, AFTER_DRAIN = false;
    bf16_t* O; int ldc;
    __device__ __forceinline__ void operator()(const f32x4 (&acc)[2][2][4][2], const Unit& u, int wr, int wc, int fr, int fq) const {
        const int row0 = u.pm * BM + wr * 64 + fr, col0 = u.pn * BM + wc * 32 + 8 * fq;
#pragma unroll
        for (int ai = 0; ai < 2; ++ai)
#pragma unroll
            for (int m = 0; m < 4; ++m) { bf16_t* rowp = O + (size_t)(row0 + ai * HALF + m * 16) * ldc + col0;
#pragma unroll
                for (int bj = 0; bj < 2; ++bj) { f32x4 v0 = acc[ai][bj][m][0], v1 = acc[ai][bj][m][1];
#pragma unroll
                    for (int j = 0; j < 4; ++j) { const float a = fmaxf(v0[j], 0.f), b = fmaxf(v1[j], 0.f); v0[j] = a * a; v1[j] = b * b; }
                    u32x4 w; w.x = cvt_pk_bf16(v0[0], v0[1]); w.y = cvt_pk_bf16(v0[2], v0[3]); w.z = cvt_pk_bf16(v1[0], v1[1]); w.w = cvt_pk_bf16(v1[2], v1[3]);
                    *(u32x4*)(rowp + bj * HALF) = w; } }
    }
};

template <class Epi, class Sched, bool ALIGN_EPI = false, bool SP2 = false>
__device__ __forceinline__ void gemm_phase(PG8_LAS unsigned char* lds, const Gemm g, const Sched& S, const Epi& E) {
    int tid_l = threadIdx.x; asm volatile("" : "+v"(tid_l));
    const int tid = tid_l, wid = __builtin_amdgcn_readfirstlane(tid >> 6), lane = tid & 63, wr = wid >> 2, wc = wid & 3, fr = lane & 15, fq = lane >> 4;
    const int K = g.K, nt = K / BK;
    unsigned voffA[2], voffB[2];
#pragma unroll
    for (int i = 0; i < 2; ++i) { int R, C; stage_rc(tid * 16 + i * 8192, R, C); const int Rb = Epi::PERM ? ((R & ~31) + perm32(R & 31)) : R;
        voffA[i] = (unsigned)(R * K + C) * 2u; voffB[i] = (unsigned)(Rb * K + C) * 2u; }
    const size_t kstep = (size_t)(BK * 2);
    const size_t hstep = (size_t)HALF * K * 2;
    const size_t tstep = 2 * hstep;
    const unsigned ldsw = (unsigned)wid * 1024u;
    const int aoff = lds_byte(wr * 64 + fr, fq * 8), boff = lds_byte(wc * 32 + fr, fq * 8);
#define PG8_SA(b, h) (((b) * 2 + (h)) * HTB)
#define PG8_SB(b, h) ((4 + (b) * 2 + (h)) * HTB)
#define PG8_STAGE(bufoff, gbase, voff) do { _Pragma("unroll") for (int _i = 0; _i < 2; ++_i) \
        __builtin_amdgcn_global_load_lds((const unsigned*)((const char*)(gbase) + (voff)[_i]), (PG8_LAS unsigned*)(lds + (bufoff) + ldsw + _i * 8192), 16, 0, 0); } while (0)
#define PG8_LDA(dst, b, h) do { _Pragma("unroll") for (int m = 0; m < 4; ++m) _Pragma("unroll") for (int k = 0; k < 2; ++k) dst[m][k] = *(const PG8_LAS bf16x8*)(lds + PG8_SA(b, h) + aoff + m * 2048 + k * 1024); } while (0)
#define PG8_LDB(dst, b, h) do { _Pragma("unroll") for (int n = 0; n < 2; ++n) _Pragma("unroll") for (int k = 0; k < 2; ++k) dst[n][k] = *(const PG8_LAS bf16x8*)(lds + PG8_SB(b, h) + boff + n * 2048 + k * 1024); } while (0)
#define PG8_MMA(ai, bj, At, Bt) do { __builtin_amdgcn_s_setprio(1); _Pragma("unroll") for (int m = 0; m < 4; ++m) _Pragma("unroll") for (int n = 0; n < 2; ++n) _Pragma("unroll") for (int k = 0; k < 2; ++k) \
        acc[ai][bj][m][n] = __builtin_amdgcn_mfma_f32_16x16x32_bf16(Bt[n][k], At[m][k], acc[ai][bj][m][n], 0, 0, 0); __builtin_amdgcn_s_setprio(0); } while (0)
#define PG8_WAIT_V(n) asm volatile("s_waitcnt vmcnt(" #n ")" ::: "memory")
#define PG8_WAIT_L(n) asm volatile("s_waitcnt lgkmcnt(" #n ")" ::: "memory")
#define PG8_BAR __builtin_amdgcn_s_barrier()
#define PG8_SCHED __builtin_amdgcn_sched_barrier(0)
    Unit cur, nxt; int ui = 0;
    if (!S.next(0, cur)) return;
    f32x4 acc[2][2][4][2];
#pragma unroll
    for (int a = 0; a < 2; ++a)
#pragma unroll
        for (int b = 0; b < 2; ++b)
#pragma unroll
            for (int m = 0; m < 4; ++m)
#pragma unroll
                for (int n = 0; n < 2; ++n) acc[a][b][m][n] = (f32x4){0.f, 0.f, 0.f, 0.f};
    bf16x8 At[4][2], B0[2][2], B1[2][2];
    const char* cA = (const char*)g.A + (size_t)cur.pm * tstep + (size_t)cur.z * g.zA; const char* cB = (const char*)g.Bt + (size_t)cur.pn * tstep + (size_t)cur.z * g.zB;
    S.a_ready(cur);
    if constexpr (SP2) {
        PG8_STAGE(PG8_SB(0, 0), cB, voffB); PG8_STAGE(PG8_SB(0, 1), cB + hstep, voffB); PG8_STAGE(PG8_SA(0, 0), cA, voffA); PG8_STAGE(PG8_SA(0, 1), cA + hstep, voffA);
        if (wr == 1) PG8_BAR;
        PG8_WAIT_V(2); PG8_BAR;
        PG8_STAGE(PG8_SB(1, 0), cB + kstep, voffB); PG8_STAGE(PG8_SA(1, 0), cA + kstep, voffA); PG8_STAGE(PG8_SB(1, 1), cB + hstep + kstep, voffB);
        PG8_WAIT_V(6); PG8_BAR;
    } else {
        PG8_STAGE(PG8_SB(0, 0), cB, voffB); PG8_STAGE(PG8_SA(0, 0), cA, voffA); PG8_STAGE(PG8_SB(0, 1), cB + hstep, voffB); PG8_STAGE(PG8_SA(0, 1), cA + hstep, voffA);
        if (wr == 1) PG8_BAR;
        PG8_WAIT_V(4); PG8_BAR;
        PG8_STAGE(PG8_SB(1, 0), cB + kstep, voffB); PG8_STAGE(PG8_SA(1, 0), cA + kstep, voffA); PG8_STAGE(PG8_SB(1, 1), cB + hstep + kstep, voffB);
        PG8_WAIT_V(6); PG8_BAR;
    }
    for (;;) {
        const bool has_next = S.next(ui + 1, nxt);
        const char* nA = has_next ? (const char*)g.A + (size_t)nxt.pm * tstep + (size_t)nxt.z * g.zA : cA; const char* nB = has_next ? (const char*)g.Bt + (size_t)nxt.pn * tstep + (size_t)nxt.z * g.zB : cB;
        for (int t = 0; t < nt; t += 2) {
            const bool last = (t == nt - 2);
            const char* a1 = cA + (size_t)(t + 1) * kstep;
            const char* a2 = last ? nA : cA + (size_t)(t + 2) * kstep; const char* b2 = last ? nB : cB + (size_t)(t + 2) * kstep;
            const char* a3 = a2 + kstep; const char* b3 = b2 + kstep;
            if (last && has_next) S.a_ready(nxt);
            if constexpr (SP2) {
            PG8_LDB(B0, 0, 0); PG8_LDB(B1, 0, 1); PG8_SCHED; PG8_LDA(At, 0, 0); PG8_STAGE(PG8_SA(1, 1), a1 + hstep, voffA);
            PG8_WAIT_V(8); PG8_WAIT_L(0); PG8_BAR; PG8_MMA(0, 0, At, B0); PG8_MMA(0, 1, At, B1); PG8_BAR; PG8_SCHED;
            PG8_LDA(At, 0, 1); PG8_STAGE(PG8_SB(0, 0), b2, voffB); PG8_STAGE(PG8_SB(0, 1), b2 + hstep, voffB); PG8_STAGE(PG8_SA(0, 0), a2, voffA);
            PG8_WAIT_V(8); PG8_WAIT_L(0); PG8_BAR; PG8_MMA(1, 0, At, B0); PG8_MMA(1, 1, At, B1); PG8_BAR; PG8_SCHED;
            PG8_LDB(B0, 1, 0); PG8_LDB(B1, 1, 1); PG8_SCHED; PG8_LDA(At, 1, 0); PG8_STAGE(PG8_SA(0, 1), a2 + hstep, voffA);
            PG8_WAIT_V(8); PG8_WAIT_L(0); PG8_BAR; PG8_MMA(0, 0, At, B0); PG8_MMA(0, 1, At, B1); PG8_BAR; PG8_SCHED;
            PG8_LDA(At, 1, 1); PG8_STAGE(PG8_SB(1, 0), b3, voffB); PG8_STAGE(PG8_SB(1, 1), b3 + hstep, voffB); PG8_STAGE(PG8_SA(1, 0), a3, voffA);
            PG8_WAIT_V(8); PG8_WAIT_L(0); PG8_BAR; PG8_MMA(1, 0, At, B0); PG8_MMA(1, 1, At, B1); PG8_BAR; PG8_SCHED;
            } else {
            PG8_LDB(B0, 0, 0); PG8_SCHED; PG8_LDA(At, 0, 0); PG8_STAGE(PG8_SA(1, 1), a1 + hstep, voffA);
            PG8_WAIT_L(8); PG8_BAR; PG8_WAIT_L(0); PG8_MMA(0, 0, At, B0); PG8_BAR; PG8_SCHED;
            PG8_LDB(B1, 0, 1); PG8_STAGE(PG8_SB(0, 0), b2, voffB);
            PG8_BAR; PG8_WAIT_L(0); PG8_MMA(0, 1, At, B1); PG8_BAR;
            PG8_LDA(At, 0, 1); PG8_STAGE(PG8_SA(0, 0), a2, voffA);
            PG8_BAR; PG8_WAIT_L(0); PG8_MMA(1, 0, At, B0); PG8_BAR; PG8_SCHED;
            PG8_STAGE(PG8_SB(0, 1), b2 + hstep, voffB);
            PG8_WAIT_V(6); PG8_BAR; PG8_MMA(1, 1, At, B1); PG8_BAR;
            PG8_LDB(B0, 1, 0); PG8_SCHED; PG8_LDA(At, 1, 0); PG8_STAGE(PG8_SA(0, 1), a2 + hstep, voffA);
            PG8_WAIT_L(8); PG8_BAR; PG8_WAIT_L(0); PG8_MMA(0, 0, At, B0); PG8_BAR; PG8_SCHED;
            PG8_LDB(B1, 1, 1); PG8_STAGE(PG8_SB(1, 0), b3, voffB);
            PG8_BAR; PG8_WAIT_L(0); PG8_MMA(0, 1, At, B1); PG8_BAR;
            PG8_LDA(At, 1, 1); PG8_STAGE(PG8_SA(1, 0), a3, voffA);
            PG8_BAR; PG8_WAIT_L(0); PG8_MMA(1, 0, At, B0); PG8_BAR; PG8_SCHED;
            PG8_STAGE(PG8_SB(1, 1), b3 + hstep, voffB);
            PG8_WAIT_V(6); PG8_BAR; PG8_MMA(1, 1, At, B1); PG8_BAR;
            }
        }
        if constexpr (ALIGN_EPI) { if (wr == 0) PG8_BAR; }
        if constexpr (!Epi::AFTER_DRAIN) { E(acc, cur, wr, wc, fr, fq); S.done(cur); }
        if (!has_next) break;
#pragma unroll
        for (int a = 0; a < 2; ++a)
#pragma unroll
            for (int b = 0; b < 2; ++b)
#pragma unroll
                for (int m = 0; m < 4; ++m)
#pragma unroll
                    for (int n = 0; n < 2; ++n) acc[a][b][m][n] = (f32x4){0.f, 0.f, 0.f, 0.f};
        cur = nxt; cA = nA; cB = nB; ++ui;
        if constexpr (ALIGN_EPI) { if (wr == 1) PG8_BAR; }
    }
    PG8_WAIT_V(0);
    if constexpr (!ALIGN_EPI) { if (wr == 0) PG8_BAR; }
    PG8_BAR;
    if constexpr (Epi::AFTER_DRAIN) { E.fused(acc, cur, wr, wc, fr, fq, lds, wid, lane); S.done(cur); }
#undef PG8_SA
#undef PG8_SB
#undef PG8_STAGE
#undef PG8_LDA
#undef PG8_LDB
#undef PG8_MMA
#undef PG8_WAIT_V
#undef PG8_WAIT_L
#undef PG8_BAR
#undef PG8_SCHED
}
}

constexpr int NWAVES = 8;
constexpr int D = 2048, DEPTH = 2, DFF = 8192;
constexpr int NA_W = 1024, ML_W = 1024, SG_W = 1024;
constexpr int D_IN = 15376, N_IN_PAD = 15616;
constexpr int M_PROMPT = 8 * 4096, M_SAMPLE = 2 * 8192, M_ALL = M_PROMPT + M_SAMPLE;
constexpr int MS = 8192, NSLAB = M_ALL / MS;
constexpr float EPS = 1e-6f;

constexpr size_t MiB = 1u << 20;
constexpr size_t WS_CTL = 0, CTL_ZERO_BYTES = 1 * MiB;
constexpr size_t WL_IN = 0, WL_ABC = 61 * MiB, WL_OUT = 73 * MiB, WL_UP = 81 * MiB, WL_DN = 113 * MiB, WL_BYTES = 145 * MiB;
constexpr size_t WS_W = 1 * MiB;
constexpr size_t WS_H = 291 * MiB;
constexpr size_t WS_QKVA = 323 * MiB;
constexpr size_t WS_QKVOB = 371 * MiB;
constexpr size_t WS_ZUV = 435 * MiB;
constexpr size_t WS_U = WS_QKVA;
constexpr size_t WS_G = 467 * MiB;
constexpr size_t WS_GATES = 563 * MiB;
constexpr size_t WS_SGR = WS_GATES + MiB / 2;
constexpr size_t WS_QC = 564 * MiB, WS_KC = 580 * MiB;
constexpr size_t WS_Y = 596 * MiB;
constexpr size_t WS_HF = 644 * MiB, WS_HB = 676 * MiB;
constexpr size_t WS_MRG = 708 * MiB;
constexpr size_t WS_MRGB = 772 * MiB;
constexpr size_t WS_T = 804 * MiB;
constexpr size_t WS_GS = 868 * MiB;
constexpr size_t WS_GD = 870 * MiB;
constexpr size_t WS_LST = 871 * MiB;
constexpr size_t WS_NLOC = 887 * MiB;
constexpr size_t WS_END = 888 * MiB;
static_assert(WS_W + 2 * WL_BYTES <= WS_H && WS_U + (size_t)MS * DFF * 2 <= WS_G && WS_SGR + (size_t)MS * 4 <= WS_QC, "d_ws map");
constexpr int CW_BAR = 4096;

constexpr int RING_OFF = 0, RING_BYTES = 131072;
constexpr int LDSCTL_OFF = 153600, MISC_OFF = LDSCTL_OFF + 320;
constexpr int LDS_BYTES = 155648;

#define GAS __attribute__((address_space(1)))
#define LAS __attribute__((address_space(3)))
typedef unsigned short bf16;
typedef unsigned v4u __attribute__((ext_vector_type(4)));
typedef float f32x4 __attribute__((ext_vector_type(4)));
typedef short bf16x8 __attribute__((ext_vector_type(8)));
typedef GAS unsigned gu32;
typedef GAS unsigned long long gu64;
#define RLX_AGENT __ATOMIC_RELAXED, __HIP_MEMORY_SCOPE_AGENT
#define LDS_WAIT() asm volatile("s_waitcnt lgkmcnt(0)" ::: "memory")
#define VM_WAIT() asm volatile("s_waitcnt vmcnt(0)" ::: "memory")
__device__ __forceinline__ unsigned long long rt() { return __builtin_amdgcn_s_memrealtime(); }
__device__ __forceinline__ unsigned f2bf(float f) { unsigned u = __builtin_bit_cast(unsigned, f); return (u + 0x7fffu + ((u >> 16) & 1u)) >> 16; }
__device__ __forceinline__ unsigned pk2(float lo, float hi) { return f2bf(lo) | (f2bf(hi) << 16); }

#define XB_TMO      128
#define XB_XCNT(j)  (256  + 64 * (j))
#define XB_XSUB(j)  (1280 + 64 * (j))
#define XB_XGEN(j)  (2304 + 64 * (j))
#define XB_TOP      3328
#define XB_TOPGEN   3392
#define XCD_BAR_WORDS 3456
#define XB_SPIN_CAP (1u << 18)

__device__ __forceinline__ unsigned xb_ld(unsigned* p)              { return __hip_atomic_load(p, __ATOMIC_RELAXED, __HIP_MEMORY_SCOPE_AGENT); }
__device__ __forceinline__ unsigned xb_add(unsigned* p, unsigned v) { return __hip_atomic_fetch_add(p, v, __ATOMIC_RELAXED, __HIP_MEMORY_SCOPE_AGENT); }
__device__ __forceinline__ unsigned xb_xcc_id() { return (unsigned)__builtin_amdgcn_s_getreg((3 << 11) | 20) & 0xFu; }
#define XB_SPIN(cond, bar) do { unsigned _sp = 0; while (cond) { __builtin_amdgcn_s_sleep(1); \
    if ((++_sp & 255u) == 0u) { if (xb_ld(&(bar)[XB_TMO])) break; if (_sp > XB_SPIN_CAP) { atomicAdd(&(bar)[XB_TMO], 1u); break; } } } } while (0)

struct XcdBarrier {
    unsigned* bar; unsigned x;
    volatile LAS unsigned* st;
};

__device__ __forceinline__ XcdBarrier xcd_barrier_post(unsigned* bar, volatile LAS unsigned* st) {
    XcdBarrier b; b.bar = bar; b.x = xb_xcc_id(); b.st = st;
    if (threadIdx.x == 0) (void)xb_add(&bar[XB_XCNT(b.x)], 1u);
    return b;
}
__device__ __forceinline__ void xcd_barrier_complete(unsigned* bar, unsigned x, unsigned& nloc, unsigned& nx) {
    const unsigned G = gridDim.x * gridDim.y * gridDim.z;
    unsigned sum, cnt, mine, sp = 0u;
    for (;;) {
        sum = 0u; cnt = 0u; mine = 0u;
#pragma unroll
        for (unsigned j = 0; j < 16; ++j) { const unsigned c = xb_ld(&bar[XB_XCNT(j)]); sum += c; cnt += (c > 0u) ? 1u : 0u; mine = (j == x) ? c : mine; }
        if (sum == G) break;
        __builtin_amdgcn_s_sleep(1);
        if ((++sp & 255u) == 0u) { if (xb_ld(&bar[XB_TMO])) break; if (sp > XB_SPIN_CAP) { atomicAdd(&bar[XB_TMO], 1u); break; } }
    }
    nloc = mine > 0u ? mine : 1u; nx = cnt > 0u ? cnt : 1u;
}

__device__ __forceinline__ void xcd_barrier(const XcdBarrier& b) {
    asm volatile("s_waitcnt vmcnt(0)" ::: "memory");
    __syncthreads();
    if (threadIdx.x == 0) {
        unsigned* bar = b.bar;
        __builtin_amdgcn_s_waitcnt(0);
        unsigned nloc = b.st[0], nx = b.st[1];
        if (nloc == 0u) { xcd_barrier_complete(bar, b.x, nloc, nx); b.st[0] = nloc; b.st[1] = nx; }
        const unsigned old = xb_add(&bar[XB_XSUB(b.x)], 1u);
        const unsigned gen = old / nloc;
        if (old + 1u == (gen + 1u) * nloc) {
            __builtin_amdgcn_fence(__ATOMIC_RELEASE, "agent");
            asm volatile("s_waitcnt vmcnt(0)" ::: "memory");
            const unsigned og = xb_add(&bar[XB_TOP], 1u);
            const unsigned tg = og / nx;
            if (og + 1u == (tg + 1u) * nx) xb_add(&bar[XB_TOPGEN], 1u);
            else XB_SPIN(xb_ld(&bar[XB_TOPGEN]) == tg, bar);
            __builtin_amdgcn_fence(__ATOMIC_ACQUIRE, "agent");
            xb_add(&bar[XB_XGEN(b.x)], 1u);
            asm volatile("s_waitcnt vmcnt(0)" ::: "memory");
        } else {
            XB_SPIN(xb_ld(&bar[XB_XGEN(b.x)]) == gen, bar);
            __builtin_amdgcn_fence(__ATOMIC_ACQUIRE, "agent");
            asm volatile("s_waitcnt vmcnt(0)" ::: "memory");
        }
    }
    __syncthreads();
}

struct Frame {
    LAS unsigned char* lds;
    int tid, lane, wave;
    int vcu, G;
};
struct Args {
    const float* x_prompt; const float* x_sample; const float* pre_mix_g; const float* post_mix_g; const float* pre_mlp_g; const float* post_mlp_g;
    const float* w_in; const float* b_gate; const float* conv_w; const float* na_rpb; const float* ml_norm_g; const float* sg_norm_g; const float* w_s; const float* b_s;
    const float* w_a; const float* w_b; const float* w_c; const float* w_out; const float* w_up; const float* w_down;
    float* out; unsigned char* ws;
    int ph_lo, ph_hi;
};

__device__ __forceinline__ float wave_sum(float v) {
#pragma unroll
    for (int o = 1; o < 64; o <<= 1) v += __shfl_xor(v, o);
    return v;
}
__device__ __forceinline__ float wave_max(float v) {
#pragma unroll
    for (int o = 1; o < 64; o <<= 1) v = fmaxf(v, __shfl_xor(v, o));
    return v;
}
__device__ __forceinline__ float bf_lo(unsigned u) { return __uint_as_float(u << 16); }
__device__ __forceinline__ float bf_hi(unsigned u) { return __uint_as_float(u & 0xffff0000u); }
__device__ __forceinline__ float sigmoid_f(float x) { return __builtin_amdgcn_rcpf(1.0f + __builtin_amdgcn_exp2f(-1.4426950408889634f * x)); }

__device__ __forceinline__ void p0_transpose_item(const float* W, int K, int N, bf16* WT, int k0, int n0, int ncols, int drow0, float sc, LAS float* scr, int lane) {
    const int cl = lane & 31;
#pragma unroll 8
    for (int i = 0; i < 32; ++i) { const int kk = 2 * i + (lane >> 5); scr[kk * 33 + cl] = (cl < ncols) ? W[(size_t)(k0 + kk) * N + n0 + cl] * sc : 0.f; }
    LDS_WAIT(); asm volatile("" ::: "memory");
    const int c = lane & 7;
#pragma unroll
    for (int j = 0; j < 4; ++j) { const int n = (lane >> 3) + 8 * j; const LAS float* s = scr + (8 * c) * 33 + n;
        v4u o; o.x = pk2(s[0 * 33], s[1 * 33]); o.y = pk2(s[2 * 33], s[3 * 33]); o.z = pk2(s[4 * 33], s[5 * 33]); o.w = pk2(s[6 * 33], s[7 * 33]);
        if (n < ncols) *(GAS v4u*)(WT + (size_t)(drow0 + n) * K + k0 + 8 * c) = o; }
    LDS_WAIT(); asm volatile("" ::: "memory");
}
__device__ __forceinline__ void p0_matrix(Frame& F, const float* W, int K, int N, bf16* WT, LAS float* scr) {
    const int gw = F.vcu * NWAVES + F.wave, NGW = F.G * NWAVES, nblk = N / 32, nit = (K / 64) * nblk;
    for (int it = gw; it < nit; it += NGW) { const int kb = it / nblk, nb = it % nblk; p0_transpose_item(W, K, N, WT, 64 * kb, 32 * nb, 32, 32 * nb, 1.f, scr, F.lane); }
}
__device__ __forceinline__ void p0_win(Frame& F, const float* W, bf16* WT, LAS float* scr) {
    const int gw = F.vcu * NWAVES + F.wave, NGW = F.G * NWAVES;
    constexpr int NB1 = 7168 / 32, NB2 = 8192 / 32, NBLK = NB1 + 1 + NB2, NIT = (D / 64) * NBLK;
    for (int it = gw; it < NIT; it += NGW) { const int kb = it / NBLK, nb = it % NBLK; int n0, ncols, drow0; float sc = 1.f;
        if (nb < NB1) { n0 = 32 * nb; ncols = 32; drow0 = n0; if (n0 < 1024) sc = 0.08838834764831845f; }
        else if (nb == NB1) { n0 = 7168; ncols = 16; drow0 = 15360; }
        else { n0 = 7184 + 32 * (nb - NB1 - 1); ncols = 32; drow0 = n0 - 16; }
        p0_transpose_item(W, D, D_IN, WT, 64 * kb, n0, ncols, drow0, sc, scr, F.lane); }
    const int gt = (F.vcu * NWAVES + F.wave) * 64 + F.lane, NGT = F.G * NWAVES * 64; constexpr int NZ16 = (N_IN_PAD - D_IN) * D / 8;
    GAS v4u* z = (GAS v4u*)(WT + (size_t)D_IN * D);
    for (int i = gt; i < NZ16; i += NGT) z[i] = (v4u){0u, 0u, 0u, 0u};
}

__device__ __forceinline__ void row_phase(Frame& F, const float* xin, const float* add, const float* g_add, float* xout, const float* g_next, bf16* hout) {
    const int gw = F.vcu * NWAVES + F.wave, NGW = F.G * NWAVES;
    for (int m = gw; m < MS; m += NGW) {
        const GAS f32x4* xr = (const GAS f32x4*)(xin + (size_t)m * D) + F.lane;
        f32x4 v[8];
#pragma unroll
        for (int j = 0; j < 8; ++j) v[j] = xr[64 * j];
        if (add) {
            const GAS f32x4* ar = (const GAS f32x4*)(add + (size_t)m * D) + F.lane; f32x4 a[8]; float s = 0.f;
#pragma unroll
            for (int j = 0; j < 8; ++j) { a[j] = ar[64 * j]; s += (a[j].x * a[j].x + a[j].y * a[j].y) + (a[j].z * a[j].z + a[j].w * a[j].w); }
            const float rs = 1.0f / sqrtf(wave_sum(s) * (1.f / D) + EPS);
#pragma unroll
            for (int j = 0; j < 8; ++j) { const f32x4 gv = ((const GAS f32x4*)g_add)[F.lane + 64 * j]; v[j] = v[j] + (a[j] * rs) * gv; }
        }
        if (xout) { GAS f32x4* o = (GAS f32x4*)(xout + (size_t)m * D) + F.lane;
#pragma unroll
            for (int j = 0; j < 8; ++j) o[64 * j] = v[j]; }
        if (hout) {
            float s = 0.f;
#pragma unroll
            for (int j = 0; j < 8; ++j) s += (v[j].x * v[j].x + v[j].y * v[j].y) + (v[j].z * v[j].z + v[j].w * v[j].w);
            const float rs = 1.0f / sqrtf(wave_sum(s) * (1.f / D) + EPS);
            GAS unsigned long long* o8 = (GAS unsigned long long*)(hout + (size_t)m * D) + F.lane;
#pragma unroll
            for (int j = 0; j < 8; ++j) { const f32x4 gv = ((const GAS f32x4*)g_next)[F.lane + 64 * j]; const f32x4 y = (v[j] * rs) * gv;
                o8[64 * j] = (unsigned long long)pk2(y.x, y.y) | ((unsigned long long)pk2(y.z, y.w) << 32); }
        }
    }
}

__device__ __forceinline__ void prep_phase(Frame& F, const bf16* qkvob, const float* convw, bf16* qc, bf16* kc, const bf16* zuv, float* sgr, int T) {
    const int gt = (F.vcu * NWAVES + F.wave) * 64 + F.lane, NGT = F.G * NWAVES * 64;
    {
        const int c8 = gt & 255; float w0[8], w1[8], w2[8];
#pragma unroll
        for (int j = 0; j < 8; ++j) { w0[j] = convw[c8 * 8 + j]; w1[j] = convw[2048 + c8 * 8 + j]; w2[j] = convw[4096 + c8 * 8 + j]; }
        const float osc = c8 < 128 ? 0.0625f : 1.0f;
        bf16* dst = c8 < 128 ? qc + c8 * 8 : kc + (c8 - 128) * 8;
        for (int t = gt >> 8; t < MS; t += NGT >> 8) {
            const int ts = t % T; const GAS v4u* src = (const GAS v4u*)(qkvob + (size_t)t * 4096 + c8 * 8);
            const v4u xc = src[0]; v4u xm = (v4u){0u, 0u, 0u, 0u}, xp = xm;
            if (ts > 0) xm = *(const GAS v4u*)(qkvob + (size_t)(t - 1) * 4096 + c8 * 8);
            if (ts < T - 1) xp = *(const GAS v4u*)(qkvob + (size_t)(t + 1) * 4096 + c8 * 8);
            float r[8];
#pragma unroll
            for (int j = 0; j < 4; ++j) {
                const float a0 = w0[2 * j] * bf_lo(xm[j]) + w1[2 * j] * bf_lo(xc[j]) + w2[2 * j] * bf_lo(xp[j]);
                const float a1 = w0[2 * j + 1] * bf_hi(xm[j]) + w1[2 * j + 1] * bf_hi(xc[j]) + w2[2 * j + 1] * bf_hi(xp[j]);
                r[2 * j] = a0 * sigmoid_f(a0) * osc; r[2 * j + 1] = a1 * sigmoid_f(a1) * osc; }
            v4u o; o.x = pk2(r[0], r[1]); o.y = pk2(r[2], r[3]); o.z = pk2(r[4], r[5]); o.w = pk2(r[6], r[7]);
            *(GAS v4u*)(dst + (size_t)t * 1024) = o;
        }
    }
    {
        const int gw = F.vcu * NWAVES + F.wave, NGW = F.G * NWAVES;
        for (int t = gw; t < MS; t += NGW) {
            const GAS v4u* src = (const GAS v4u*)(zuv + (size_t)t * 2048 + 1024) + 2 * F.lane; float s = 0.f;
#pragma unroll
            for (int i = 0; i < 2; ++i) { const v4u x = src[i];
#pragma unroll
                for (int j = 0; j < 4; ++j) { const float a = bf_lo(x[j]), b = bf_hi(x[j]); s += a * a + b * b; } }
            s = wave_sum(s);
            if (F.lane == 0) sgr[t] = 1.0f / sqrtf(s * (1.f / 1024.f) + EPS);
        }
    }
}

__device__ __forceinline__ void comb_phase(Frame& F, const float* hf, const float* hb, const bf16* qkvob, const float* mlg, bf16* yb) {
    const int gw = F.vcu * NWAVES + F.wave, NGW = F.G * NWAVES;
    for (int it = gw; it < MS * 4; it += NGW) { const int t = it >> 2, h = it & 3; const size_t o = (size_t)t * 1024 + h * 256 + 4 * F.lane;
        const f32x4 a = *(const GAS f32x4*)(hf + o), b = *(const GAS f32x4*)(hb + o); const f32x4 s = a + b;
        const float ss = wave_sum((s.x * s.x + s.y * s.y) + (s.z * s.z + s.w * s.w)); const float rs = 1.0f / sqrtf(ss * (1.f / 256.f) + EPS);
        const f32x4 gv = *(const GAS f32x4*)(mlg + h * 256 + 4 * F.lane);
        const unsigned long long ow = *(const GAS unsigned long long*)(qkvob + (size_t)t * 4096 + 3072 + h * 256 + 4 * F.lane);
        const unsigned o0 = (unsigned)ow, o1 = (unsigned)(ow >> 32);
        const float y0 = s.x * rs * gv.x * bf_lo(o0), y1 = s.y * rs * gv.y * bf_hi(o0), y2 = s.z * rs * gv.z * bf_lo(o1), y3 = s.w * rs * gv.w * bf_hi(o1);
        *(GAS unsigned long long*)(yb + o) = (unsigned long long)pk2(y0, y1) | ((unsigned long long)pk2(y2, y3) << 32);
    }
}

__device__ __forceinline__ void na_naive(Frame& F, const bf16* qkva, const float* rpb, bf16* ya, int T, int gw, int NGW) {
    const int rows = T / 64;
    for (int it = gw; it < MS * 8; it += NGW) {
        const int m = it >> 3, h = it & 7, seq = m / T, t = m % T, r = t >> 6, qc = t & 63;
        int rs = r - 4; rs = rs < 0 ? 0 : (rs > rows - 8 ? rows - 8 : rs);
        int cs = qc - 8; cs = cs < 0 ? 0 : (cs > 48 ? 48 : cs);
        const bf16* qrow = qkva + (size_t)m * 3072 + h * 128;
        float sc[2];
#pragma unroll
        for (int kk = 0; kk < 2; ++kk) { const int kap = F.lane + 64 * kk, j = kap >> 4, cc = kap & 15;
            const int ktok = seq * T + (rs + j) * 64 + cs + cc; const bf16* krow = qkva + (size_t)ktok * 3072 + 1024 + h * 128; float d = 0.f;
#pragma unroll 4
            for (int i = 0; i < 16; ++i) { const v4u qv = *(const GAS v4u*)(qrow + 8 * i), kv = *(const GAS v4u*)(krow + 8 * i);
#pragma unroll
                for (int e = 0; e < 4; ++e) d += bf_lo(qv[e]) * bf_lo(kv[e]) + bf_hi(qv[e]) * bf_hi(kv[e]); }
            sc[kk] = d + rpb[(h * 15 + (rs + j - r + 7)) * 31 + (cs + cc - qc + 15)]; }
        const float mx = wave_max(fmaxf(sc[0], sc[1]));
        const float e0 = __expf(sc[0] - mx), e1 = __expf(sc[1] - mx); const float inv = 1.0f / wave_sum(e0 + e1);
        const float p0 = e0 * inv, p1 = e1 * inv;
        float o0 = 0.f, o1 = 0.f;
        for (int kap = 0; kap < 128; ++kap) { const int j = kap >> 4, cc = kap & 15; const int ktok = seq * T + (rs + j) * 64 + cs + cc;
            const float p = __shfl(kap < 64 ? p0 : p1, kap & 63);
            const unsigned vv = *(const GAS unsigned*)(qkva + (size_t)ktok * 3072 + 2048 + h * 128 + 2 * F.lane);
            o0 += p * bf_lo(vv); o1 += p * bf_hi(vv); }
        *(GAS unsigned*)(ya + (size_t)m * 1024 + h * 128 + 2 * F.lane) = pk2(o0, o1);
    }
}
__device__ __forceinline__ void sg_naive(Frame& F, const bf16* zuv, const float* sgr, const float* sgn, const float* ws_, const float* bs, bf16* yc, int gw, int NGW) {
    for (int it = gw; it < MS * 8; it += NGW) {
        const int t = it >> 3, g = it & 7, p = t & 127, cb = t & ~127; const int c = g * 128 + 2 * F.lane;
        const float* wrow = ws_ + ((size_t)g * 128 + p) * 128; float a0 = 0.f, a1 = 0.f;
        for (int q = 0; q < 128; ++q) { const float wq = wrow[q] * sgr[cb + q]; const unsigned zz = *(const GAS unsigned*)(zuv + (size_t)(cb + q) * 2048 + 1024 + c);
            a0 += wq * bf_lo(zz); a1 += wq * bf_hi(zz); }
        const float b = bs[g * 128 + p]; const unsigned uu = *(const GAS unsigned*)(zuv + (size_t)t * 2048 + c);
        const float y0 = bf_lo(uu) * (a0 * sgn[c] + b), y1 = bf_hi(uu) * (a1 * sgn[c + 1] + b);
        *(GAS unsigned*)(yc + (size_t)t * 1024 + c) = pk2(y0, y1);
    }
}
__device__ __forceinline__ void mlstm_naive(Frame& F, int unit, const bf16* qc, const bf16* kc, const bf16* qkvob, const float* gates, float* hf, float* hb, int T) {
    const int es = unit & 3, dir = (unit >> 2) & 1, h = (unit >> 3) & 3, seq = unit >> 5, nc = T / 64, tid = F.tid;
    LAS unsigned char* L = F.lds;
    LAS bf16* Qs = (LAS bf16*)(L);
    LAS bf16* Ks = (LAS bf16*)(L + 33792);
    LAS float* Vs = (LAS float*)(L + 67584);
    LAS float* Ss = (LAS float*)(L + 83968);
    LAS float* NUM = (LAS float*)(L + 100608);
    LAS float* vb = (LAS float*)(L + 116992);
    LAS float* va = vb + 64;
    LAS float* vmr = vb + 128;
    LAS float* vw = vb + 192;
    LAS float* vwi = vb + 256;
    LAS float* NQ = vb + 320;
    LAS float* nst = vb + 384;
    LAS float* scal = vb + 640;
    float* hout = dir ? hb : hf;
    float Creg[32];
#pragma unroll
    for (int i = 0; i < 32; ++i) Creg[i] = 0.f;
    if (tid < 256) nst[tid] = 0.f;
    float m_prev = 0.f;
    const int e = tid & 63, dg = tid >> 6;
    for (int ci = 0; ci < nc; ++ci) {
        __syncthreads();
#pragma unroll
        for (int i = 0; i < 4; ++i) { const int p = tid + 512 * i, tau = p >> 5, c8 = p & 31; const int pos = ci * 64 + tau; const int tok = seq * T + (dir ? T - 1 - pos : pos);
            *(LAS v4u*)(Qs + tau * 264 + c8 * 8) = *(const GAS v4u*)(qc + (size_t)tok * 1024 + h * 256 + c8 * 8);
            *(LAS v4u*)(Ks + tau * 264 + c8 * 8) = *(const GAS v4u*)(kc + (size_t)tok * 1024 + h * 256 + c8 * 8); }
        { const int tau = tid >> 3, c8 = tid & 7; const int pos = ci * 64 + tau; const int tok = seq * T + (dir ? T - 1 - pos : pos);
            const v4u vv = *(const GAS v4u*)(qkvob + (size_t)tok * 4096 + 2048 + h * 256 + es * 64 + c8 * 8);
#pragma unroll
            for (int j = 0; j < 4; ++j) { Vs[tau * 64 + c8 * 8 + 2 * j] = bf_lo(vv[j]); Vs[tau * 64 + c8 * 8 + 2 * j + 1] = bf_hi(vv[j]); } }
        if (tid < 64) {
            const int pos = ci * 64 + tid; const int tok = seq * T + (dir ? T - 1 - pos : pos);
            const float ipre = gates[(size_t)tok * 16 + dir * 8 + h], fpre = gates[(size_t)tok * 16 + dir * 8 + 4 + h];
            const float logf = fminf(fpre, 0.f) - log1pf(__expf(-fabsf(fpre)));
            float b = logf;
#pragma unroll
            for (int o = 1; o < 64; o <<= 1) { const float y = __shfl_up(b, o); if (tid >= o) b += y; }
            const float a = ipre - b; float pm = a;
#pragma unroll
            for (int o = 1; o < 64; o <<= 1) { const float y = __shfl_up(pm, o); if (tid >= o) pm = fmaxf(pm, y); }
            const float mrow = fmaxf(b + m_prev, b + pm);
            const float blast = __shfl(b, 63), amax = __shfl(pm, 63);
            const float mnew = fmaxf(blast + m_prev, blast + amax);
            vb[tid] = b; va[tid] = a; vmr[tid] = mrow; vw[tid] = __expf(blast + a - mnew); vwi[tid] = __expf(b + m_prev - mrow);
            if (tid == 0) { scal[0] = __expf(blast + m_prev - mnew); scal[1] = mnew; }
        }
#pragma unroll
        for (int i = 0; i < 8; ++i) NUM[tid + 512 * i] = 0.f;
        __syncthreads();
        const float decay = scal[0]; m_prev = scal[1];
        {
            const int tau = tid >> 3, sg = tid & 7; float rowpart = 0.f; const float bt = vb[tau], mr = vmr[tau];
#pragma unroll 1
            for (int j = 0; j < 8; ++j) { const int s = sg * 8 + j; float val = 0.f;
                if (s <= tau) { float d = 0.f;
#pragma unroll 4
                    for (int c8 = 0; c8 < 32; ++c8) { const v4u qv = *(const LAS v4u*)(Qs + tau * 264 + c8 * 8), kv = *(const LAS v4u*)(Ks + s * 264 + c8 * 8);
#pragma unroll
                        for (int x = 0; x < 4; ++x) d += bf_lo(qv[x]) * bf_lo(kv[x]) + bf_hi(qv[x]) * bf_hi(kv[x]); }
                    val = d * __expf(bt + va[s] - mr); }
                Ss[tau * 65 + s] = val; rowpart += val; }
            float qn = 0.f;
#pragma unroll 4
            for (int c8 = 0; c8 < 4; ++c8) { const v4u qv = *(const LAS v4u*)(Qs + tau * 264 + sg * 32 + c8 * 8);
#pragma unroll
                for (int x = 0; x < 4; ++x) qn += bf_lo(qv[x]) * nst[sg * 32 + c8 * 8 + 2 * x] + bf_hi(qv[x]) * nst[sg * 32 + c8 * 8 + 2 * x + 1]; }
            float tot = rowpart + vwi[tau] * qn;
            tot += __shfl_xor(tot, 1); tot += __shfl_xor(tot, 2); tot += __shfl_xor(tot, 4);
            if (sg == 0) NQ[tau] = tot;
        }
        {
#pragma unroll 1
            for (int tau = 0; tau < 64; ++tau) { float part = 0.f;
#pragma unroll
                for (int c8 = 0; c8 < 4; ++c8) { const v4u qv = *(const LAS v4u*)(Qs + tau * 264 + dg * 32 + c8 * 8);
#pragma unroll
                    for (int x = 0; x < 4; ++x) part += bf_lo(qv[x]) * Creg[c8 * 8 + 2 * x] + bf_hi(qv[x]) * Creg[c8 * 8 + 2 * x + 1]; }
                __hip_atomic_fetch_add(&NUM[tau * 64 + e], vwi[tau] * part, __ATOMIC_RELAXED, __HIP_MEMORY_SCOPE_WORKGROUP); }
        }
        __syncthreads();
        {
#pragma unroll 1
            for (int j = 0; j < 8; ++j) { const int tau = dg * 8 + j; float acc = 0.f;
#pragma unroll 8
                for (int s = 0; s < 64; ++s) acc += Ss[tau * 65 + s] * Vs[s * 64 + e];
                __hip_atomic_fetch_add(&NUM[tau * 64 + e], acc, __ATOMIC_RELAXED, __HIP_MEMORY_SCOPE_WORKGROUP); }
        }
        __syncthreads();
#pragma unroll
        for (int i = 0; i < 8; ++i) { const int idx = tid + 512 * i, tau = idx >> 6, ee = idx & 63; const int pos = ci * 64 + tau; const int tok = seq * T + (dir ? T - 1 - pos : pos);
            const float den = fmaxf(fabsf(NQ[tau]), __expf(-vmr[tau]));
            hout[(size_t)tok * 1024 + h * 256 + es * 64 + ee] = NUM[idx] / den; }
#pragma unroll
        for (int i = 0; i < 32; ++i) Creg[i] *= decay;
#pragma unroll 1
        for (int s = 0; s < 64; ++s) { const float wv = vw[s] * Vs[s * 64 + e];
#pragma unroll
            for (int c8 = 0; c8 < 4; ++c8) { const v4u kv = *(const LAS v4u*)(Ks + s * 264 + dg * 32 + c8 * 8);
#pragma unroll
                for (int x = 0; x < 4; ++x) { Creg[c8 * 8 + 2 * x] += bf_lo(kv[x]) * wv; Creg[c8 * 8 + 2 * x + 1] += bf_hi(kv[x]) * wv; } } }
        if (tid < 256) { float a = decay * nst[tid];
#pragma unroll 8
            for (int s = 0; s < 64; ++s) a += vw[s] * __uint_as_float(((unsigned)Ks[s * 264 + tid]) << 16);
            nst[tid] = a; }
    }
    __syncthreads();
}

typedef short s16x4 __attribute__((ext_vector_type(4)));
__device__ __forceinline__ bf16x8 tr_pair(const LAS bf16* p0, const LAS bf16* p1) {
    const s16x4 a = __builtin_amdgcn_ds_read_tr16_b64_v4i16((LAS s16x4*)p0), b = __builtin_amdgcn_ds_read_tr16_b64_v4i16((LAS s16x4*)p1);
    return __builtin_shufflevector(a, b, 0, 1, 2, 3, 4, 5, 6, 7);
}
#define MFMA16(a, b, c) __builtin_amdgcn_mfma_f32_16x16x32_bf16((a), (b), (c), 0, 0, 0)

__device__ __forceinline__ void sg_fast(Frame& F, const bf16* zuv, const float* sgr, const float* sgn, const float* ws_, const float* bs, bf16* yc, int u0, int ustride) {
    LAS bf16* Z = (LAS bf16*)F.lds;
    const int lane = F.lane, kg = lane >> 4, li = lane & 15, qq = li >> 2, pp = li & 3;
    for (int unit = u0; unit < (MS / 128) * 8; unit += ustride) {
        const int c = unit >> 3, g = unit & 7, t0 = c * 128;
        __syncthreads();
#pragma unroll
        for (int i = 0; i < 4; ++i) { const int idx = F.tid + 512 * i, row = idx >> 4, ch = idx & 15;
            *(LAS v4u*)(Z + row * 136 + ch * 8) = *(const GAS v4u*)(zuv + (size_t)(t0 + row) * 2048 + 1024 + g * 128 + ch * 8); }
        const int p = F.wave * 16 + li;
        bf16x8 bw[4];
#pragma unroll
        for (int ks = 0; ks < 4; ++ks) { const int q0 = ks * 32 + 8 * kg;
            const f32x4 w0 = *(const GAS f32x4*)(ws_ + ((size_t)g * 128 + p) * 128 + q0), w1 = *(const GAS f32x4*)(ws_ + ((size_t)g * 128 + p) * 128 + q0 + 4);
            const f32x4 r0 = *(const GAS f32x4*)(sgr + t0 + q0), r1 = *(const GAS f32x4*)(sgr + t0 + q0 + 4);
            v4u pk; pk.x = pk2(w0.x * r0.x, w0.y * r0.y); pk.y = pk2(w0.z * r0.z, w0.w * r0.w); pk.z = pk2(w1.x * r1.x, w1.y * r1.y); pk.w = pk2(w1.z * r1.z, w1.w * r1.w);
            bw[ks] = __builtin_bit_cast(bf16x8, pk); }
        __syncthreads();
        const float bsv = bs[g * 128 + p];
#pragma unroll 2
        for (int dt = 0; dt < 8; ++dt) {
            f32x4 acc = (f32x4){0.f, 0.f, 0.f, 0.f};
#pragma unroll
            for (int ks = 0; ks < 4; ++ks) { const LAS bf16* a0 = Z + (ks * 32 + 8 * kg + qq) * 136 + dt * 16 + 4 * pp;
                acc = MFMA16(tr_pair(a0, a0 + 4 * 136), bw[ks], acc); }
            const int d0 = g * 128 + dt * 16 + 4 * kg;
            const f32x4 sg = *(const GAS f32x4*)(sgn + d0);
            const unsigned long long uw = *(const GAS unsigned long long*)(zuv + (size_t)(t0 + p) * 2048 + d0); const unsigned u0w = (unsigned)uw, u1w = (unsigned)(uw >> 32);
            const float y0 = bf_lo(u0w) * (sg.x * acc[0] + bsv), y1 = bf_hi(u0w) * (sg.y * acc[1] + bsv), y2 = bf_lo(u1w) * (sg.z * acc[2] + bsv), y3 = bf_hi(u1w) * (sg.w * acc[3] + bsv);
            *(GAS unsigned long long*)(yc + (size_t)(t0 + p) * 1024 + d0) = (unsigned long long)pk2(y0, y1) | ((unsigned long long)pk2(y2, y3) << 32);
        }
    }
    __syncthreads();
}

__device__ __forceinline__ void na_fast(Frame& F, const bf16* qkva, const float* rpb, bf16* ya, int T, int gw, int NGW) {
    const int rows = T / 64, lane = F.lane, kg = lane >> 4, li = lane & 15, qq = li >> 2, pp = li & 3;
    LAS bf16* Vt = (LAS bf16*)(F.lds + F.wave * 8192);
    for (int it = gw; it < (MS / 16) * 8; it += NGW) {
        const int h = it & 7, blk = it >> 3, n = blk & 3, rowg = blk >> 2, seq = rowg / rows, r = rowg % rows;
        int rs = r - 4; rs = rs < 0 ? 0 : (rs > rows - 8 ? rows - 8 : rs);
        int kc0 = 16 * n - 8; kc0 = kc0 < 0 ? 0 : (kc0 > 32 ? 32 : kc0);
        const int qc = 16 * n + li; const size_t qtok = (size_t)seq * T + r * 64 + qc;
        bf16x8 bq[4];
#pragma unroll
        for (int ks = 0; ks < 4; ++ks) bq[ks] = __builtin_bit_cast(bf16x8, *(const GAS v4u*)(qkva + qtok * 3072 + h * 128 + ks * 32 + 8 * kg));
        f32x4 s[8][2];
#pragma unroll
        for (int j = 0; j < 8; ++j)
#pragma unroll
            for (int ct = 0; ct < 2; ++ct) { const size_t ktok = (size_t)seq * T + (rs + j) * 64 + kc0 + 16 * ct + li; f32x4 a = (f32x4){0.f, 0.f, 0.f, 0.f};
#pragma unroll
                for (int ks = 0; ks < 4; ++ks) a = MFMA16(__builtin_bit_cast(bf16x8, *(const GAS v4u*)(qkva + ktok * 3072 + 1024 + h * 128 + ks * 32 + 8 * kg)), bq[ks], a);
                s[j][ct] = a; }
        int cs = qc - 8; cs = cs < 0 ? 0 : (cs > 48 ? 48 : cs);
        float mx = -3.0e38f;
#pragma unroll
        for (int j = 0; j < 8; ++j)
#pragma unroll
            for (int ct = 0; ct < 2; ++ct)
#pragma unroll
                for (int e = 0; e < 4; ++e) { const int kc = kc0 + 16 * ct + 4 * kg + e; const bool ok = kc >= cs && kc < cs + 16;
                    const int bi = (h * 15 + (rs + j - r + 7)) * 31 + (ok ? kc - qc + 15 : 15);
                    const float v = ok ? s[j][ct][e] + rpb[bi] : -3.0e38f; s[j][ct][e] = v; mx = fmaxf(mx, v); }
        mx = fmaxf(mx, __shfl_xor(mx, 16)); mx = fmaxf(mx, __shfl_xor(mx, 32));
        float sum = 0.f;
#pragma unroll
        for (int j = 0; j < 8; ++j)
#pragma unroll
            for (int ct = 0; ct < 2; ++ct)
#pragma unroll
                for (int e = 0; e < 4; ++e) { const float pv = s[j][ct][e] > -1.0e38f ? __expf(s[j][ct][e] - mx) : 0.f; s[j][ct][e] = pv; sum += pv; }
        sum += __shfl_xor(sum, 16); sum += __shfl_xor(sum, 32);
        const float inv = 1.0f / sum;
        f32x4 o[8];
#pragma unroll
        for (int dt = 0; dt < 8; ++dt) o[dt] = (f32x4){0.f, 0.f, 0.f, 0.f};
#pragma unroll 1
        for (int j = 0; j < 8; ++j) {
            asm volatile("" ::: "memory");
#pragma unroll
            for (int i = 0; i < 8; ++i) { const int key = 4 * i + kg; const size_t vtok = (size_t)seq * T + (rs + j) * 64 + kc0 + key;
                *(LAS v4u*)(Vt + key * 128 + li * 8) = *(const GAS v4u*)(qkva + vtok * 3072 + 2048 + h * 128 + li * 8); }
            asm volatile("" ::: "memory");
            f32x4 p0, p1;
            p0 = s[0][0]; p1 = s[0][1];
#pragma unroll
            for (int jj = 1; jj < 8; ++jj) if (j == jj) { p0 = s[jj][0]; p1 = s[jj][1]; }
            v4u pk; pk.x = pk2(p0[0], p0[1]); pk.y = pk2(p0[2], p0[3]); pk.z = pk2(p1[0], p1[1]); pk.w = pk2(p1[2], p1[3]);
            const bf16x8 bp = __builtin_bit_cast(bf16x8, pk);
#pragma unroll
            for (int dt = 0; dt < 8; ++dt) { const LAS bf16* a0 = Vt + (4 * kg + qq) * 128 + dt * 16 + 4 * pp;
                o[dt] = MFMA16(tr_pair(a0, a0 + 16 * 128), bp, o[dt]); }
            asm volatile("" ::: "memory");
        }
#pragma unroll
        for (int dt = 0; dt < 8; ++dt) { const f32x4 v = o[dt] * inv;
            *(GAS unsigned long long*)(ya + qtok * 1024 + h * 128 + dt * 16 + 4 * kg) = (unsigned long long)pk2(v[0], v[1]) | ((unsigned long long)pk2(v[2], v[3]) << 32); }
    }
}

constexpr int GS_STRIDE = 65536;
constexpr int ML_QS = 264, ML_VS = 72;
constexpr int ML_OFF_Q = 0, ML_OFF_K = 33792, ML_OFF_CT = 67584, ML_OFF_V = 101376, ML_OFF_WV = 110592, ML_OFF_ST = 119808, ML_OFF_VEC = 129024, ML_OFF_N = 130560, ML_LDS_END = 131584;
static_assert(ML_LDS_END <= LDSCTL_OFF, "mLSTM LDS map");

__device__ __forceinline__ void ml_gate_scan(Frame& F, const float* gates, float* gs, float* gd, int T, int nchains) {
    const int gw = F.vcu * NWAVES + F.wave, NGW = F.G * NWAVES, lane = F.lane, nc = T / 64;
    for (int chain = gw; chain < nchains; chain += NGW) {
        const int seq = chain >> 3, h = (chain >> 1) & 3, dir = chain & 1; float m_prev = 0.f;
        for (int ci = 0; ci < nc; ++ci) {
            const int pos = ci * 64 + lane; const size_t tok = (size_t)seq * T + (dir ? T - 1 - pos : pos);
            const float ipre = gates[tok * 16 + dir * 8 + h], fpre = gates[tok * 16 + dir * 8 + 4 + h];
            const float logf = fminf(fpre, 0.f) - log1pf(__expf(-fabsf(fpre)));
            float b = logf;
#pragma unroll
            for (int o = 1; o < 64; o <<= 1) { const float y = __shfl_up(b, o); if (lane >= o) b += y; }
            const float a = ipre - b; float pm = a;
#pragma unroll
            for (int o = 1; o < 64; o <<= 1) { const float y = __shfl_up(pm, o); if (lane >= o) pm = fmaxf(pm, y); }
            const float mrow = fmaxf(b + m_prev, b + pm);
            const float blast = __shfl(b, 63), amax = __shfl(pm, 63);
            const float mnew = fmaxf(blast + m_prev, blast + amax);
            const size_t o = (size_t)chain * T + pos;
            gs[o] = b; gs[GS_STRIDE + o] = a; gs[2 * GS_STRIDE + o] = mrow; gs[3 * GS_STRIDE + o] = __expf(blast + a - mnew); gs[4 * GS_STRIDE + o] = __expf(b + m_prev - mrow);
            if (lane == 0) gd[chain * 128 + ci] = __expf(blast + m_prev - mnew);
            m_prev = mnew;
        }
    }
}

__device__ __forceinline__ void ml_cupdate(f32x4 (&cst)[2][4], const LAS bf16* Ks, const LAS bf16* WV, float decay, int wave, int kg, int qq, int pp) {
#pragma unroll
    for (int dd = 0; dd < 2; ++dd)
#pragma unroll
        for (int et = 0; et < 4; ++et) cst[dd][et] = cst[dd][et] * decay;
#pragma unroll
    for (int ks = 0; ks < 2; ++ks) {
        bf16x8 af[2], bfv[4];
#pragma unroll
        for (int dd = 0; dd < 2; ++dd) { const LAS bf16* p = Ks + (ks * 32 + 8 * kg + qq) * ML_QS + (2 * wave + dd) * 16 + 4 * pp; af[dd] = tr_pair(p, p + 4 * ML_QS); }
#pragma unroll
        for (int et = 0; et < 4; ++et) { const LAS bf16* p = WV + (ks * 32 + 8 * kg + qq) * ML_VS + et * 16 + 4 * pp; bfv[et] = tr_pair(p, p + 4 * ML_VS); }
#pragma unroll
        for (int dd = 0; dd < 2; ++dd)
#pragma unroll
            for (int et = 0; et < 4; ++et) cst[dd][et] = MFMA16(af[dd], bfv[et], cst[dd][et]);
    }
}

__device__ __forceinline__ void ml_phaseA(Frame& F, int unit, const bf16* kc, const bf16* qkvob, const float* gs, const float* gd, float* lst, float* nloc, int T) {
    const int nseg = T / 1024, es = unit & 3, cs_ = unit >> 2, seg = cs_ % nseg, chain = cs_ / nseg, seq = chain >> 3, h = (chain >> 1) & 3, dir = chain & 1;
    if (seg == nseg - 1) return;
    const int tid = F.tid, lane = F.lane, kg = lane >> 4, li = lane & 15, qq = li >> 2, pp = li & 3, wave = F.wave;
    LAS bf16* Ks = (LAS bf16*)(F.lds + ML_OFF_K); LAS bf16* WV = (LAS bf16*)(F.lds + ML_OFF_WV); LAS float* wvec = (LAS float*)(F.lds + ML_OFF_VEC);
    f32x4 cst[2][4];
#pragma unroll
    for (int dd = 0; dd < 2; ++dd)
#pragma unroll
        for (int et = 0; et < 4; ++et) cst[dd][et] = (f32x4){0.f, 0.f, 0.f, 0.f};
    float nacc = 0.f;
    for (int cc = 0; cc < 16; ++cc) {
        const int ci = seg * 16 + cc;
        __syncthreads();
#pragma unroll
        for (int i = 0; i < 4; ++i) { const int idx = tid + 512 * i, tau = idx >> 5, c8 = idx & 31; const int pos = ci * 64 + tau; const size_t tok = (size_t)seq * T + (dir ? T - 1 - pos : pos);
            *(LAS v4u*)(Ks + tau * ML_QS + c8 * 8) = *(const GAS v4u*)(kc + tok * 1024 + h * 256 + c8 * 8); }
        { const int tau = tid >> 3, c8 = tid & 7; const int pos = ci * 64 + tau; const size_t tok = (size_t)seq * T + (dir ? T - 1 - pos : pos);
            const v4u vv = *(const GAS v4u*)(qkvob + tok * 4096 + 2048 + h * 256 + es * 64 + c8 * 8); const float w = gs[3 * GS_STRIDE + (size_t)chain * T + pos];
            v4u o; o.x = pk2(bf_lo(vv.x) * w, bf_hi(vv.x) * w); o.y = pk2(bf_lo(vv.y) * w, bf_hi(vv.y) * w); o.z = pk2(bf_lo(vv.z) * w, bf_hi(vv.z) * w); o.w = pk2(bf_lo(vv.w) * w, bf_hi(vv.w) * w);
            *(LAS v4u*)(WV + tau * ML_VS + c8 * 8) = o; }
        if (tid < 64) wvec[tid] = gs[3 * GS_STRIDE + (size_t)chain * T + ci * 64 + tid];
        const float decay = gd[chain * 128 + ci];
        __syncthreads();
        ml_cupdate(cst, Ks, WV, decay, wave, kg, qq, pp);
        if (tid < 64) { float a = decay * nacc;
#pragma unroll 8
            for (int s = 0; s < 64; ++s) a += wvec[s] * __uint_as_float(((unsigned)Ks[s * ML_QS + es * 64 + tid]) << 16);
            nacc = a; }
    }
    float* dst = lst + (size_t)unit * 32 * 512 + tid;
#pragma unroll
    for (int dd = 0; dd < 2; ++dd)
#pragma unroll
        for (int et = 0; et < 4; ++et)
#pragma unroll
            for (int r = 0; r < 4; ++r) dst[(dd * 16 + et * 4 + r) * 512] = cst[dd][et][r];
    if (tid < 64) nloc[(size_t)(chain * nseg + seg) * 256 + es * 64 + tid] = nacc;
    __syncthreads();
}

__device__ __forceinline__ void ml_phaseC(Frame& F, int unit, const bf16* qc, const bf16* kc, const bf16* qkvob, const float* gs, const float* gd, const float* lst, const float* nloc, float* hf, float* hb, int T) {
    const int nseg = T / 1024, es = unit & 3, cs_ = unit >> 2, seg = cs_ % nseg, chain = cs_ / nseg, seq = chain >> 3, h = (chain >> 1) & 3, dir = chain & 1;
    const int tid = F.tid, lane = F.lane, kg = lane >> 4, li = lane & 15, qq = li >> 2, pp = li & 3, wave = F.wave;
    LAS bf16* Qs = (LAS bf16*)(F.lds + ML_OFF_Q); LAS bf16* Ks = (LAS bf16*)(F.lds + ML_OFF_K); LAS bf16* CT = (LAS bf16*)(F.lds + ML_OFF_CT);
    LAS bf16* Vs = (LAS bf16*)(F.lds + ML_OFF_V); LAS bf16* WV = (LAS bf16*)(F.lds + ML_OFF_WV); LAS bf16* ST = (LAS bf16*)(F.lds + ML_OFF_ST);
    LAS float* vec = (LAS float*)(F.lds + ML_OFF_VEC);
    LAS float* nst = (LAS float*)(F.lds + ML_OFF_N);
    float* hout = dir ? hb : hf;
    f32x4 cst[2][4];
#pragma unroll
    for (int dd = 0; dd < 2; ++dd)
#pragma unroll
        for (int et = 0; et < 4; ++et) cst[dd][et] = (f32x4){0.f, 0.f, 0.f, 0.f};
    float nreg = 0.f;
    for (int i = 0; i < seg; ++i) {
        float P = 1.f;
        for (int c = 0; c < 16; ++c) P *= gd[chain * 128 + i * 16 + c];
        const float* src = lst + (size_t)(((chain * nseg + i) << 2) + es) * 32 * 512 + tid;
#pragma unroll
        for (int dd = 0; dd < 2; ++dd)
#pragma unroll
            for (int et = 0; et < 4; ++et)
#pragma unroll
                for (int r = 0; r < 4; ++r) cst[dd][et][r] = P * cst[dd][et][r] + src[(dd * 16 + et * 4 + r) * 512];
        if (tid < 256) nreg = P * nreg + nloc[(size_t)(chain * nseg + i) * 256 + tid];
    }
    __syncthreads();
    if (tid < 256) nst[tid] = nreg;
#pragma unroll
    for (int dd = 0; dd < 2; ++dd)
#pragma unroll
        for (int et = 0; et < 4; ++et) { const int e = et * 16 + li, d = (2 * wave + dd) * 16 + 4 * kg;
            *(LAS unsigned long long*)(CT + e * ML_QS + d) = (unsigned long long)pk2(cst[dd][et][0], cst[dd][et][1]) | ((unsigned long long)pk2(cst[dd][et][2], cst[dd][et][3]) << 32); }
    const int tt = wave >> 1, x0 = 2 * (wave & 1);
    v4u pq[4], pk[4], pv; float pw, pg;
#define ML_LOAD(ci_) do { const int ci__ = (ci_); \
        _Pragma("unroll") for (int i = 0; i < 4; ++i) { const int idx = tid + 512 * i, tau = idx >> 5, c8 = idx & 31; const int pos = ci__ * 64 + tau; const size_t tok = (size_t)seq * T + (dir ? T - 1 - pos : pos); \
            pq[i] = *(const GAS v4u*)(qc + tok * 1024 + h * 256 + c8 * 8); pk[i] = *(const GAS v4u*)(kc + tok * 1024 + h * 256 + c8 * 8); } \
        { const int tau = tid >> 3, c8 = tid & 7; const int pos = ci__ * 64 + tau; const size_t tok = (size_t)seq * T + (dir ? T - 1 - pos : pos); \
            pv = *(const GAS v4u*)(qkvob + tok * 4096 + 2048 + h * 256 + es * 64 + c8 * 8); pw = gs[3 * GS_STRIDE + (size_t)chain * T + pos]; } \
        pg = tid < 320 ? gs[(size_t)(tid >> 6) * GS_STRIDE + (size_t)chain * T + ci__ * 64 + (tid & 63)] : 0.f; } while (0)
    ML_LOAD(seg * 16);
    for (int cc = 0; cc < 16; ++cc) {
        const int ci = seg * 16 + cc;
#pragma unroll
        for (int i = 0; i < 4; ++i) { const int idx = tid + 512 * i, tau = idx >> 5, c8 = idx & 31; *(LAS v4u*)(Qs + tau * ML_QS + c8 * 8) = pq[i]; *(LAS v4u*)(Ks + tau * ML_QS + c8 * 8) = pk[i]; }
        { const int tau = tid >> 3, c8 = tid & 7; *(LAS v4u*)(Vs + tau * ML_VS + c8 * 8) = pv;
            v4u o; o.x = pk2(bf_lo(pv.x) * pw, bf_hi(pv.x) * pw); o.y = pk2(bf_lo(pv.y) * pw, bf_hi(pv.y) * pw); o.z = pk2(bf_lo(pv.z) * pw, bf_hi(pv.z) * pw); o.w = pk2(bf_lo(pv.w) * pw, bf_hi(pv.w) * pw);
            *(LAS v4u*)(WV + tau * ML_VS + c8 * 8) = o; }
        if (tid < 320) vec[tid] = pg; else if (tid < 384) vec[tid] = 0.f;
        const float decay = gd[chain * 128 + ci];
        __syncthreads();
        if (cc + 1 < 16) ML_LOAD(ci + 1);
        { const int t = tid >> 3, part = tid & 7; float qn = 0.f;
#pragma unroll
            for (int c8 = 0; c8 < 4; ++c8) { const v4u qv = *(const LAS v4u*)(Qs + t * ML_QS + part * 32 + c8 * 8);
#pragma unroll
                for (int x = 0; x < 4; ++x) qn += bf_lo(qv[x]) * nst[part * 32 + c8 * 8 + 2 * x] + bf_hi(qv[x]) * nst[part * 32 + c8 * 8 + 2 * x + 1]; }
            qn += __shfl_xor(qn, 1); qn += __shfl_xor(qn, 2); qn += __shfl_xor(qn, 4);
            if (part == 0) __hip_atomic_fetch_add(&vec[320 + t], vec[256 + t] * qn, __ATOMIC_RELAXED, __HIP_MEMORY_SCOPE_WORKGROUP); }
        bf16x8 qf[8];
#pragma unroll
        for (int ks = 0; ks < 8; ++ks) qf[ks] = __builtin_bit_cast(bf16x8, *(const LAS v4u*)(Qs + (tt * 16 + li) * ML_QS + ks * 32 + 8 * kg));
        { const int t = tt * 16 + li; const float bt = vec[t], mrt = vec[128 + t]; float rsum = 0.f;
#pragma unroll
            for (int x = 0; x < 2; ++x) { const int st = x0 + x; f32x4 a = (f32x4){0.f, 0.f, 0.f, 0.f};
#pragma unroll
                for (int ks = 0; ks < 8; ++ks) a = MFMA16(__builtin_bit_cast(bf16x8, *(const LAS v4u*)(Ks + (st * 16 + li) * ML_QS + ks * 32 + 8 * kg)), qf[ks], a);
                float v[4];
#pragma unroll
                for (int r = 0; r < 4; ++r) { const int s = st * 16 + 4 * kg + r; v[r] = (s <= t) ? a[r] * __expf(bt + vec[64 + s] - mrt) : 0.f; rsum += v[r]; }
                *(LAS unsigned long long*)(ST + t * ML_VS + st * 16 + 4 * kg) = (unsigned long long)pk2(v[0], v[1]) | ((unsigned long long)pk2(v[2], v[3]) << 32); }
            rsum += __shfl_xor(rsum, 16); rsum += __shfl_xor(rsum, 32);
            if (kg == 0) __hip_atomic_fetch_add(&vec[320 + t], rsum, __ATOMIC_RELAXED, __HIP_MEMORY_SCOPE_WORKGROUP); }
        f32x4 accn[2];
#pragma unroll
        for (int x = 0; x < 2; ++x) { const int et = x0 + x; f32x4 a = (f32x4){0.f, 0.f, 0.f, 0.f};
#pragma unroll
            for (int ks = 0; ks < 8; ++ks) a = MFMA16(qf[ks], __builtin_bit_cast(bf16x8, *(const LAS v4u*)(CT + (et * 16 + li) * ML_QS + ks * 32 + 8 * kg)), a);
#pragma unroll
            for (int r = 0; r < 4; ++r) a[r] *= vec[256 + tt * 16 + 4 * kg + r];
            accn[x] = a; }
        __syncthreads();
#pragma unroll
        for (int ks = 0; ks < 2; ++ks) { const bf16x8 sa = __builtin_bit_cast(bf16x8, *(const LAS v4u*)(ST + (tt * 16 + li) * ML_VS + ks * 32 + 8 * kg));
#pragma unroll
            for (int x = 0; x < 2; ++x) { const LAS bf16* p = Vs + (ks * 32 + 8 * kg + qq) * ML_VS + (x0 + x) * 16 + 4 * pp; accn[x] = MFMA16(sa, tr_pair(p, p + 4 * ML_VS), accn[x]); } }
#pragma unroll
        for (int r = 0; r < 4; ++r) { const int t = tt * 16 + 4 * kg + r; const float den = fmaxf(fabsf(vec[320 + t]), __expf(-vec[128 + t])); const float inv = 1.0f / den;
            const int pos = ci * 64 + t; const size_t tok = (size_t)seq * T + (dir ? T - 1 - pos : pos);
#pragma unroll
            for (int x = 0; x < 2; ++x) hout[tok * 1024 + h * 256 + es * 64 + (x0 + x) * 16 + li] = accn[x][r] * inv; }
        ml_cupdate(cst, Ks, WV, decay, wave, kg, qq, pp);
#pragma unroll
        for (int dd = 0; dd < 2; ++dd)
#pragma unroll
            for (int et = 0; et < 4; ++et) { const int e = et * 16 + li, d = (2 * wave + dd) * 16 + 4 * kg;
                *(LAS unsigned long long*)(CT + e * ML_QS + d) = (unsigned long long)pk2(cst[dd][et][0], cst[dd][et][1]) | ((unsigned long long)pk2(cst[dd][et][2], cst[dd][et][3]) << 32); }
        if (tid < 256) { float a = decay * nst[tid];
#pragma unroll 8
            for (int s = 0; s < 64; ++s) a += vec[192 + s] * __uint_as_float(((unsigned)Ks[s * ML_QS + tid]) << 16);
            nst[tid] = a; }
        __syncthreads();
    }
#undef ML_LOAD
}

#ifndef KNOB_NO_ROW
#define KNOB_NO_ROW 0
#endif
#ifndef KNOB_NO_WIN
#define KNOB_NO_WIN 0
#endif
#ifndef KNOB_NO_PREP
#define KNOB_NO_PREP 0
#endif
#ifndef KNOB_NO_ML
#define KNOB_NO_ML 0
#endif
#ifndef KNOB_NO_NA
#define KNOB_NO_NA 0
#endif
#ifndef KNOB_NO_SG
#define KNOB_NO_SG 0
#endif
#ifndef KNOB_NO_COMB
#define KNOB_NO_COMB 0
#endif
#ifndef KNOB_NO_MERGE
#define KNOB_NO_MERGE 0
#endif
#ifndef KNOB_NO_WOUT
#define KNOB_NO_WOUT 0
#endif
#ifndef KNOB_NO_UP
#define KNOB_NO_UP 0
#endif
#ifndef KNOB_NO_DOWN
#define KNOB_NO_DOWN 0
#endif
#ifndef KNOB_NO_P0
#define KNOB_NO_P0 0
#endif
#ifndef USE_NA_FAST
#define USE_NA_FAST 1
#endif
#ifndef USE_SG_FAST
#define USE_SG_FAST 1
#endif
#ifndef USE_ML_FAST
#define USE_ML_FAST 1
#endif
constexpr int STEPS_PER = 12, N_STEPS = 1 + NSLAB * DEPTH * STEPS_PER;
__global__ void __launch_bounds__(NWAVES * 64, 2) trunk_fwd(Args args) {
    extern __shared__ __attribute__((aligned(16))) unsigned char lds[];
#define MKF() Frame F; { int t_ = threadIdx.x; asm volatile("" : "+v"(t_)); F.lds = (LAS unsigned char*)lds; F.tid = t_; F.lane = t_ & 63; F.wave = __builtin_amdgcn_readfirstlane(t_ >> 6); \
        F.G = gridDim.x; const int bx_ = blockIdx.x; F.vcu = (F.G % 8 == 0) ? (bx_ % 8) * (F.G / 8) + bx_ / 8 : bx_; }
#define ARGS() ({ const __attribute__((address_space(4))) Args* _p = (const __attribute__((address_space(4))) Args*)__builtin_amdgcn_kernarg_segment_ptr(); asm volatile("" : "+s"(_p)); _p; })
    gu32* ctl = (gu32*)(ARGS()->ws + WS_CTL);
    for (int u = threadIdx.x; u < (LDS_BYTES - LDSCTL_OFF) / 4; u += NWAVES * 64) ((LAS unsigned*)((LAS unsigned char*)lds + LDSCTL_OFF))[u] = 0u;
    __syncthreads();
    volatile LAS unsigned* MISC = (volatile LAS unsigned*)((LAS unsigned char*)lds + MISC_OFF);
    XcdBarrier bar = xcd_barrier_post((unsigned*)ctl + CW_BAR, MISC + 8);
    const int lo = ARGS()->ph_lo, hi = ARGS()->ph_hi;
#define IN(k) (lo <= (k) && (k) < hi)
#define SEAM(k) do { if (IN(k) && IN((k) + 1)) xcd_barrier(bar); } while (0)

#define WSB(T_, off) ((T_*)(A->ws + (off)))
#define Hb WSB(bf16, WS_H)
#define QKVA WSB(bf16, WS_QKVA)
#define QKVOB WSB(bf16, WS_QKVOB)
#define ZUV WSB(bf16, WS_ZUV)
#define Ub WSB(bf16, WS_U)
#define Gb WSB(bf16, WS_G)
#define GATES WSB(float, WS_GATES)
#define SGR WSB(float, WS_SGR)
#define QC WSB(bf16, WS_QC)
#define KC WSB(bf16, WS_KC)
#define Yb WSB(bf16, WS_Y)
#define HF WSB(float, WS_HF)
#define HB WSB(float, WS_HB)
#define MRG WSB(float, WS_MRG)
#define MRGB WSB(bf16, WS_MRGB)
#define Tb WSB(float, WS_T)
#define GSb WSB(float, WS_GS)
#define GDb WSB(float, WS_GD)
#define LSTb WSB(float, WS_LST)
#define NLOCb WSB(float, WS_NLOC)

    if (IN(0) && !KNOB_NO_P0) { MKF();
        LAS float* scr = (LAS float*)(F.lds + RING_OFF + F.wave * 16384);
        for (int l = 0; l < DEPTH; ++l) {
            const auto* A = ARGS(); unsigned char* wl = A->ws + WS_W + (size_t)l * WL_BYTES;
            p0_win(F, A->w_in + (size_t)l * D * D_IN, (bf16*)(wl + WL_IN), scr);
            p0_matrix(F, A->w_a + (size_t)l * NA_W * D, NA_W, D, (bf16*)(wl + WL_ABC), scr);
            p0_matrix(F, A->w_b + (size_t)l * ML_W * D, ML_W, D, (bf16*)(wl + WL_ABC) + (size_t)D * 1024, scr);
            p0_matrix(F, A->w_c + (size_t)l * SG_W * D, SG_W, D, (bf16*)(wl + WL_ABC) + (size_t)2 * D * 1024, scr);
            p0_matrix(F, A->w_out + (size_t)l * D * D, D, D, (bf16*)(wl + WL_OUT), scr);
            p0_matrix(F, A->w_up + (size_t)l * D * DFF, D, DFF, (bf16*)(wl + WL_UP), scr);
            p0_matrix(F, A->w_down + (size_t)l * DFF * D, DFF, D, (bf16*)(wl + WL_DN), scr);
        }
    }
    SEAM(0);

    for (int s = 0; s < NSLAB; ++s) {
        const int T = s < 4 ? 4096 : 8192, nseq = MS / T;
        for (int l = 0; l < DEPTH; ++l) {
            const int sb = 1 + (s * DEPTH + l) * STEPS_PER;
            if (sb + STEPS_PER <= lo || sb >= hi) continue;
#define XIN0 (s < 4 ? A->x_prompt + (size_t)s * MS * D : A->x_sample + (size_t)(s - 4) * MS * D)
#define XO (A->out + (size_t)s * MS * D)
#define WL (A->ws + WS_W + (size_t)l * WL_BYTES)
            if (IN(sb + 0) && l == 0 && !KNOB_NO_ROW) { MKF(); const auto* A = ARGS(); row_phase(F, XIN0, nullptr, nullptr, nullptr, A->pre_mix_g, Hb); }
            SEAM(sb + 0);
            if (IN(sb + 1) && !KNOB_NO_WIN) { MKF(); const auto* A = ARGS();
                pg8::Gemm g{Hb, (const bf16*)(WL + WL_IN), MS, N_IN_PAD, D, 0, 0}; pg8::StaticOrder S; S.init(MS, N_IN_PAD, (int)gridDim.x, (int)blockIdx.x);
                pg8::EpiIn E{QKVA, QKVOB, ZUV, Gb, GATES, A->b_gate + l * 16};
                pg8::gemm_phase<pg8::EpiIn, pg8::StaticOrder, true, true>((PG8_LAS unsigned char*)lds + RING_OFF, g, S, E);
            }
            SEAM(sb + 1);
            if (IN(sb + 2) && !KNOB_NO_PREP) { MKF(); const auto* A = ARGS(); prep_phase(F, QKVOB, A->conv_w + (size_t)l * 3 * 2048, QC, KC, ZUV, SGR, T); if (USE_ML_FAST) ml_gate_scan(F, GATES, GSb, GDb, T, nseq * 8); }
            SEAM(sb + 2);
            if (IN(sb + 3)) { MKF(); const auto* A = ARGS();
                if (USE_ML_FAST) {
                    for (int unit = F.vcu; unit < 256; unit += F.G) ml_phaseA(F, unit, KC, QKVOB, GSb, GDb, LSTb, NLOCb, T);
                    const int gw = F.vcu * NWAVES + F.wave, NGW = F.G * NWAVES;
                    na_fast(F, QKVA, A->na_rpb + (size_t)l * 8 * 15 * 31, Yb, T, gw, NGW);
                    sg_fast(F, ZUV, SGR, A->sg_norm_g + l * 1024, A->w_s + (size_t)l * 8 * 128 * 128, A->b_s + l * 1024, Yb + (size_t)2 * MS * 1024, F.vcu, F.G);
                } else {
                    const int nml = nseq * 32;
                    if (F.vcu < nml) mlstm_naive(F, F.vcu, QC, KC, QKVOB, GATES, HF, HB, T);
                    else { const int gw = (F.vcu - nml) * NWAVES + F.wave, NGW = (F.G - nml) * NWAVES;
                        na_fast(F, QKVA, A->na_rpb + (size_t)l * 8 * 15 * 31, Yb, T, gw, NGW);
                        sg_fast(F, ZUV, SGR, A->sg_norm_g + l * 1024, A->w_s + (size_t)l * 8 * 128 * 128, A->b_s + l * 1024, Yb + (size_t)2 * MS * 1024, F.vcu - nml, F.G - nml); }
                }
            }
            SEAM(sb + 3);
            if (IN(sb + 4) && USE_ML_FAST) { MKF(); const auto* A = ARGS();
                for (int unit = F.vcu; unit < 256; unit += F.G) ml_phaseC(F, unit, QC, KC, QKVOB, GSb, GDb, LSTb, NLOCb, HF, HB, T);
            }
            SEAM(sb + 4);
            if (IN(sb + 5) && !KNOB_NO_COMB) { MKF(); const auto* A = ARGS(); comb_phase(F, HF, HB, QKVOB, A->ml_norm_g + l * 1024, Yb + (size_t)MS * 1024); }
            SEAM(sb + 5);
            if (IN(sb + 6) && !KNOB_NO_MERGE) { MKF(); const auto* A = ARGS();
                pg8::Gemm g{Yb, (const bf16*)(WL + WL_ABC), MS, D, 1024, (size_t)MS * 1024 * 2, (size_t)D * 1024 * 2}; pg8::ZOrder<3> S; S.init(MS, D, (int)gridDim.x, (int)blockIdx.x);
                pg8::EpiMerge E{Gb, MRG, MRGB};
                pg8::gemm_phase<pg8::EpiMerge, pg8::ZOrder<3>, true, true>((PG8_LAS unsigned char*)lds + RING_OFF, g, S, E);
            }
            SEAM(sb + 6);
            if (IN(sb + 7) && !KNOB_NO_WOUT) { MKF(); const auto* A = ARGS();
                pg8::Gemm g{MRGB, (const bf16*)(WL + WL_OUT), MS, D, D, 0, 0}; pg8::StaticOrder S; S.init(MS, D, (int)gridDim.x, (int)blockIdx.x);
                pg8::EpiF32 E{Tb, D};
                pg8::gemm_phase<pg8::EpiF32, pg8::StaticOrder, true, true>((PG8_LAS unsigned char*)lds + RING_OFF, g, S, E);
            }
            SEAM(sb + 7);
            if (IN(sb + 8) && !KNOB_NO_ROW) { MKF(); const auto* A = ARGS(); row_phase(F, l == 0 ? XIN0 : XO, Tb, A->post_mix_g + l * D, XO, A->pre_mlp_g + l * D, Hb); }
            SEAM(sb + 8);
            if (IN(sb + 9) && !KNOB_NO_UP) { MKF(); const auto* A = ARGS();
                pg8::Gemm g{Hb, (const bf16*)(WL + WL_UP), MS, DFF, D, 0, 0}; pg8::StaticOrder S; S.init(MS, DFF, (int)gridDim.x, (int)blockIdx.x);
                pg8::EpiRelu2 E{Ub, DFF};
                pg8::gemm_phase<pg8::EpiRelu2, pg8::StaticOrder, true, true>((PG8_LAS unsigned char*)lds + RING_OFF, g, S, E);
            }
            SEAM(sb + 9);
            if (IN(sb + 10) && !KNOB_NO_DOWN) { MKF(); const auto* A = ARGS();
                pg8::Gemm g{Ub, (const bf16*)(WL + WL_DN), MS, D, DFF, 0, 0}; pg8::StaticOrder S; S.init(MS, D, (int)gridDim.x, (int)blockIdx.x);
                pg8::EpiF32 E{Tb, D};
                pg8::gemm_phase<pg8::EpiF32, pg8::StaticOrder, true, true>((PG8_LAS unsigned char*)lds + RING_OFF, g, S, E);
            }
            SEAM(sb + 10);
            if (IN(sb + 11) && !KNOB_NO_ROW) { MKF(); const auto* A = ARGS(); row_phase(F, XO, Tb, A->post_mlp_g + l * D, XO, l + 1 < DEPTH ? A->pre_mix_g + (l + 1) * D : nullptr, l + 1 < DEPTH ? Hb : nullptr); }
            SEAM(sb + 11);
        }
    }
#undef IN
#undef SEAM
}

#ifndef MK_LAUNCH_PER_STEP
#define MK_LAUNCH_PER_STEP 0
#endif
extern "C" void kernel_launch(void* const* d_in, const int* in_sizes, int n_in, void* d_out, int out_size, void* d_ws, size_t ws_size, hipStream_t stream) {
    static int grid = 0;
    if (grid == 0) {
        if (n_in != 20 || in_sizes[0] != M_PROMPT * D || in_sizes[1] != M_SAMPLE * D || out_size != M_ALL * D || ws_size < WS_END) {
            fprintf(stderr, "kernel_launch: unexpected shapes (n_in %d, in0 %d, in1 %d, out %d, ws %zu); nothing launched\n", n_in, n_in > 0 ? in_sizes[0] : -1, n_in > 1 ? in_sizes[1] : -1, out_size, ws_size); grid = -1; return; }
        int dev = 0, cus = 0;
        if (hipGetDevice(&dev) != hipSuccess || hipDeviceGetAttribute(&cus, hipDeviceAttributeMultiprocessorCount, dev) != hipSuccess) { grid = -1; return; }
        if (hipFuncSetAttribute((const void*)trunk_fwd, hipFuncAttributeMaxDynamicSharedMemorySize, LDS_BYTES) != hipSuccess) { fprintf(stderr, "kernel_launch: hipFuncSetAttribute failed\n"); grid = -1; return; }
        int per_cu = 0;
        if (hipOccupancyMaxActiveBlocksPerMultiprocessor(&per_cu, (const void*)trunk_fwd, NWAVES * 64, LDS_BYTES) != hipSuccess || per_cu < 1)
            fprintf(stderr, "kernel_launch: note: occupancy query reports %d workgroups per CU\n", per_cu);
        (void)hipGetLastError();
        grid = cus;
    }
    if (grid < 0) return;
    if (hipMemsetAsync((char*)d_ws + WS_CTL, 0, CTL_ZERO_BYTES, stream) != hipSuccess) return;
    Args a{};
    a.x_prompt = (const float*)d_in[0]; a.x_sample = (const float*)d_in[1]; a.pre_mix_g = (const float*)d_in[2]; a.post_mix_g = (const float*)d_in[3];
    a.pre_mlp_g = (const float*)d_in[4]; a.post_mlp_g = (const float*)d_in[5]; a.w_in = (const float*)d_in[6]; a.b_gate = (const float*)d_in[7];
    a.conv_w = (const float*)d_in[8]; a.na_rpb = (const float*)d_in[9]; a.ml_norm_g = (const float*)d_in[10]; a.sg_norm_g = (const float*)d_in[11];
    a.w_s = (const float*)d_in[12]; a.b_s = (const float*)d_in[13]; a.w_a = (const float*)d_in[14]; a.w_b = (const float*)d_in[15]; a.w_c = (const float*)d_in[16];
    a.w_out = (const float*)d_in[17]; a.w_up = (const float*)d_in[18]; a.w_down = (const float*)d_in[19];
    a.out = (float*)d_out; a.ws = (unsigned char*)d_ws;
#if MK_LAUNCH_PER_STEP
    for (int k = 0; k < N_STEPS; ++k) { a.ph_lo = k; a.ph_hi = k + 1; hipLaunchKernelGGL(trunk_fwd, dim3(grid), dim3(NWAVES * 64), LDS_BYTES, stream, a); }
#else
    a.ph_lo = 0; a.ph_hi = N_STEPS;
    hipLaunchKernelGGL(trunk_fwd, dim3(grid), dim3(NWAVES * 64), LDS_BYTES, stream, a);
#endif
}
```

```cpp
#include <hip/hip_runtime.h>
#include <cstdio>
#include <cstdint>
namespace pg8 {
#define PG8_LAS __attribute__((address_space(3)))
typedef unsigned short bf16_t;
typedef short bf16x8 __attribute__((ext_vector_type(8)));
typedef float f32x4 __attribute__((ext_vector_type(4)));
typedef unsigned u32x4 __attribute__((ext_vector_type(4)));
typedef unsigned u32x2 __attribute__((ext_vector_type(2)));
constexpr int BM = 256, BK = 64, HALF = 128, HTB = HALF * BK * 2  , STAGE_BYTES = 8 * HTB, NXCD = 8, WGM = 8;

__host__ __device__ __forceinline__ int lds_byte(int r, int c) { const int st = (r >> 4) * 2 + (c >> 5), rr = r & 15, cc = c & 31, ob = rr * 64 + cc * 2; return st * 1024 + (ob ^ (((ob >> 9) & 1) << 5)); }
__host__ __device__ __forceinline__ void stage_rc(int b, int& R, int& C) { const int st = b / 1024, sb = b % 1024, swz = sb ^ (((sb >> 9) & 1) << 5); R = (st >> 1) * 16 + swz / 64; C = (st & 1) * 32 + (swz % 64) / 2; }
__host__ __device__ __forceinline__ int perm32(int rho) { const int n = rho >> 4, i = rho & 15; return 8 * (i >> 2) + 4 * n + (i & 3); }

struct Unit { int pm, pn, z; };
struct Gemm { const bf16_t* A; const bf16_t* Bt; int M, N, K; size_t zA, zB; };

struct StaticOrder {
    int nM, nN, nwg, G, c;
    __host__ __device__ void init(int M, int N, int G_, int c_) { nM = M / BM; nN = N / BM; nwg = nM * nN; G = G_; c = c_; }
    __host__ __device__ bool tile(long L, Unit& u) const {
        if (L >= nwg) return false;
        int wgid = (int)L; { const int q = nwg / NXCD, r = nwg % NXCD, xcd = wgid % NXCD, off = wgid / NXCD; wgid = (xcd < r ? xcd * (q + 1) : r * (q + 1) + (xcd - r) * q) + off; }
        const int nig = WGM * nN, gid = wgid / nig, fm = gid * WGM, gsz = (nM - fm) < WGM ? (nM - fm) : WGM;
        u.pm = fm + ((wgid % nig) % gsz); u.pn = (wgid % nig) / gsz; return true;
    }
    __host__ __device__ bool next(int i, Unit& u) const { u.z = 0; return tile((long)i * G + c, u); }
    __device__ __forceinline__ void a_ready(const Unit&) const {}
    __device__ __forceinline__ void done(const Unit&) const {}
};
template <int NZ> struct ZOrder : StaticOrder {
    __host__ __device__ bool next(int i, Unit& u) const { const int k = i / NZ; u.z = i - k * NZ; return tile((long)k * G + c, u); }
};

__device__ __forceinline__ unsigned cvt_pk_bf16(float lo, float hi) { unsigned r; asm volatile("v_cvt_pk_bf16_f32 %0, %1, %2" : "=v"(r) : "v"(lo), "v"(hi)); return r; }
__device__ __forceinline__ float sigm(float x) { return __builtin_amdgcn_rcpf(1.0f + __builtin_amdgcn_exp2f(-1.4426950408889634f * x)); }
__device__ __forceinline__ float gelu_tanh(float x) { return x * sigm(1.5957691216057308f * x * (1.0f + 0.044715f * x * x)); }
__device__ __forceinline__ float act_apply(int act, float x) { return act == 1 ? sigm(x) : (act == 2 ? gelu_tanh(x) : x); }

struct EpiIn {
    static constexpr bool PERM = true, AFTER_DRAIN = false;
    bf16_t *qkva, *qkvob, *zuv, *g; float* gates; const float* bgate;
    __device__ __forceinline__ void operator()(const f32x4 (&acc)[2][2][4][2], const Unit& u, int wr, int wc, int fr, int fq) const {
        const int pn = u.pn, row0 = u.pm * BM + wr * 64 + fr;
        if (pn == 60) {
            if (wc == 0 && fq < 2) {
#pragma unroll
                for (int ai = 0; ai < 2; ++ai)
#pragma unroll
                    for (int m = 0; m < 4; ++m)
#pragma unroll
                        for (int n = 0; n < 2; ++n) { const int col = 8 * fq + 4 * n; *(f32x4*)(gates + (size_t)(row0 + ai * HALF + m * 16) * 16 + col) = acc[ai][0][m][n] + *(const f32x4*)(bgate + col); }
            }
            return;
        }
        bf16_t* base; int ldc, colt, act;
        if (pn < 12) { base = qkva; ldc = 3072; colt = pn * BM; act = 0; }
        else if (pn < 28) { base = qkvob; ldc = 4096; colt = (pn - 12) * BM; act = pn >= 24 ? 1 : 0; }
        else if (pn < 36) { base = zuv; ldc = 2048; colt = (pn - 28) * BM; act = 2; }
        else { base = g; ldc = 6144; colt = (pn - 36) * BM; act = 1; }
        const int col0 = colt + wc * 32 + 8 * fq;
#pragma unroll
        for (int ai = 0; ai < 2; ++ai)
#pragma unroll
            for (int m = 0; m < 4; ++m) { bf16_t* rowp = base + (size_t)(row0 + ai * HALF + m * 16) * ldc + col0;
#pragma unroll
                for (int bj = 0; bj < 2; ++bj) { f32x4 v0 = acc[ai][bj][m][0], v1 = acc[ai][bj][m][1];
                    if (act != 0) {
#pragma unroll
                        for (int j = 0; j < 4; ++j) { v0[j] = act_apply(act, v0[j]); v1[j] = act_apply(act, v1[j]); } }
                    u32x4 w; w.x = cvt_pk_bf16(v0[0], v0[1]); w.y = cvt_pk_bf16(v0[2], v0[3]); w.z = cvt_pk_bf16(v1[0], v1[1]); w.w = cvt_pk_bf16(v1[2], v1[3]);
                    *(u32x4*)(rowp + bj * HALF) = w; } }
    }
};
struct EpiMerge {
    static constexpr bool PERM = false, AFTER_DRAIN = false;
    const bf16_t* g; float* mrg; bf16_t* mrgb;
    __device__ __forceinline__ void operator()(const f32x4 (&acc)[2][2][4][2], const Unit& u, int wr, int wc, int fr, int fq) const {
        const int z = u.z, row0 = u.pm * BM + wr * 64 + fr, col0 = u.pn * BM + wc * 32 + 4 * fq;
#pragma unroll
        for (int ai = 0; ai < 2; ++ai)
#pragma unroll
            for (int m = 0; m < 4; ++m) { const size_t row = (size_t)(row0 + ai * HALF + m * 16);
#pragma unroll
                for (int bj = 0; bj < 2; ++bj)
#pragma unroll
                    for (int n = 0; n < 2; ++n) { const int col = col0 + bj * HALF + n * 16;
                        const u32x2 gw = *(const u32x2*)(g + row * 6144 + (size_t)z * 2048 + col);
                        f32x4 gv; gv[0] = __uint_as_float(gw.x << 16); gv[1] = __uint_as_float(gw.x & 0xffff0000u); gv[2] = __uint_as_float(gw.y << 16); gv[3] = __uint_as_float(gw.y & 0xffff0000u);
                        f32x4 v = acc[ai][bj][m][n] * gv;
                        if (z > 0) v += *(const f32x4*)(mrg + row * 2048 + col);
                        if (z < 2) *(f32x4*)(mrg + row * 2048 + col) = v;
                        else { u32x2 w; w.x = cvt_pk_bf16(v[0], v[1]); w.y = cvt_pk_bf16(v[2], v[3]); *(u32x2*)(mrgb + row * 2048 + col) = w; } }
                asm volatile("" ::: "memory"); }
    }
};
struct EpiF32 {
    static constexpr bool PERM = false, AFTER_DRAIN = false;
    float* C; int ldc;
    __device__ __forceinline__ void operator()(const f32x4 (&acc)[2][2][4][2], const Unit& u, int wr, int wc, int fr, int fq) const {
        const int row0 = u.pm * BM + wr * 64 + fr, col0 = u.pn * BM + wc * 32 + 4 * fq;
#pragma unroll
        for (int ai = 0; ai < 2; ++ai)
#pragma unroll
            for (int m = 0; m < 4; ++m) { float* rowp = C + (size_t)(row0 + ai * HALF + m * 16) * ldc + col0;
#pragma unroll
                for (int bj = 0; bj < 2; ++bj)
#pragma unroll
                    for (int n = 0; n < 2; ++n) *(f32x4*)(rowp + bj * HALF + n * 16) = acc[ai][bj][m][n]; }
    }
};
struct EpiRelu2 {
    static constexpr bool PERM = true, AFTER_DRAIN = false;
    bf16_t* O; int ldc;
    __device__ __forceinline__ void operator()(const f32x4 (&acc)[2][2][4][2], const Unit& u, int wr, int wc, int fr, int fq) const {
        const int row0 = u.pm * BM + wr * 64 + fr, col0 = u.pn * BM + wc * 32 + 8 * fq;
#pragma unroll
        for (int ai = 0; ai < 2; ++ai)
#pragma unroll
            for (int m = 0; m < 4; ++m) { bf16_t* rowp = O + (size_t)(row0 + ai * HALF + m * 16) * ldc + col0;
#pragma unroll
                for (int bj = 0; bj < 2; ++bj) { f32x4 v0 = acc[ai][bj][m][0], v1 = acc[ai][bj][m][1];
#pragma unroll
                    for (int j = 0; j < 4; ++j) { const float a = fmaxf(v0[j], 0.f), b = fmaxf(v1[j], 0.f); v0[j] = a * a; v1[j] = b * b; }
                    u32x4 w; w.x = cvt_pk_bf16(v0[0], v0[1]); w.y = cvt_pk_bf16(v0[2], v0[3]); w.z = cvt_pk_bf16(v1[0], v1[1]); w.w = cvt_pk_bf16(v1[2], v1[3]);
                    *(u32x4*)(rowp + bj * HALF) = w; } }
    }
};

template <class Epi, class Sched, bool ALIGN_EPI = false, bool SP2 = false>
__device__ __forceinline__ void gemm_phase(PG8_LAS unsigned char* lds, const Gemm g, const Sched& S, const Epi& E) {
    int tid_l = threadIdx.x; asm volatile("" : "+v"(tid_l));
    const int tid = tid_l, wid = __builtin_amdgcn_readfirstlane(tid >> 6), lane = tid & 63, wr = wid >> 2, wc = wid & 3, fr = lane & 15, fq = lane >> 4;
    const int K = g.K, nt = K / BK;
    unsigned voffA[2], voffB[2];
#pragma unroll
    for (int i = 0; i < 2; ++i) { int R, C; stage_rc(tid * 16 + i * 8192, R, C); const int Rb = Epi::PERM ? ((R & ~31) + perm32(R & 31)) : R;
        voffA[i] = (unsigned)(R * K + C) * 2u; voffB[i] = (unsigned)(Rb * K + C) * 2u; }
    const size_t kstep = (size_t)(BK * 2);
    const size_t hstep = (size_t)HALF * K * 2;
    const size_t tstep = 2 * hstep;
    const unsigned ldsw = (unsigned)wid * 1024u;
    const int aoff = lds_byte(wr * 64 + fr, fq * 8), boff = lds_byte(wc * 32 + fr, fq * 8);
#define PG8_SA(b, h) (((b) * 2 + (h)) * HTB)
#define PG8_SB(b, h) ((4 + (b) * 2 + (h)) * HTB)
#define PG8_STAGE(bufoff, gbase, voff) do { _Pragma("unroll") for (int _i = 0; _i < 2; ++_i) \
        __builtin_amdgcn_global_load_lds((const unsigned*)((const char*)(gbase) + (voff)[_i]), (PG8_LAS unsigned*)(lds + (bufoff) + ldsw + _i * 8192), 16, 0, 0); } while (0)
#define PG8_LDA(dst, b, h) do { _Pragma("unroll") for (int m = 0; m < 4; ++m) _Pragma("unroll") for (int k = 0; k < 2; ++k) dst[m][k] = *(const PG8_LAS bf16x8*)(lds + PG8_SA(b, h) + aoff + m * 2048 + k * 1024); } while (0)
#define PG8_LDB(dst, b, h) do { _Pragma("unroll") for (int n = 0; n < 2; ++n) _Pragma("unroll") for (int k = 0; k < 2; ++k) dst[n][k] = *(const PG8_LAS bf16x8*)(lds + PG8_SB(b, h) + boff + n * 2048 + k * 1024); } while (0)
#define PG8_MMA(ai, bj, At, Bt) do { __builtin_amdgcn_s_setprio(1); _Pragma("unroll") for (int m = 0; m < 4; ++m) _Pragma("unroll") for (int n = 0; n < 2; ++n) _Pragma("unroll") for (int k = 0; k < 2; ++k) \
        acc[ai][bj][m][n] = __builtin_amdgcn_mfma_f32_16x16x32_bf16(Bt[n][k], At[m][k], acc[ai][bj][m][n], 0, 0, 0); __builtin_amdgcn_s_setprio(0); } while (0)
#define PG8_WAIT_V(n) asm volatile("s_waitcnt vmcnt(" #n ")" ::: "memory")
#define PG8_WAIT_L(n) asm volatile("s_waitcnt lgkmcnt(" #n ")" ::: "memory")
#define PG8_BAR __builtin_amdgcn_s_barrier()
#define PG8_SCHED __builtin_amdgcn_sched_barrier(0)
    Unit cur, nxt; int ui = 0;
    if (!S.next(0, cur)) return;
    f32x4 acc[2][2][4][2];
#pragma unroll
    for (int a = 0; a < 2; ++a)
#pragma unroll
        for (int b = 0; b < 2; ++b)
#pragma unroll
            for (int m = 0; m < 4; ++m)
#pragma unroll
                for (int n = 0; n < 2; ++n) acc[a][b][m][n] = (f32x4){0.f, 0.f, 0.f, 0.f};
    bf16x8 At[4][2], B0[2][2], B1[2][2];
    const char* cA = (const char*)g.A + (size_t)cur.pm * tstep + (size_t)cur.z * g.zA; const char* cB = (const char*)g.Bt + (size_t)cur.pn * tstep + (size_t)cur.z * g.zB;
    S.a_ready(cur);
    if constexpr (SP2) {
        PG8_STAGE(PG8_SB(0, 0), cB, voffB); PG8_STAGE(PG8_SB(0, 1), cB + hstep, voffB); PG8_STAGE(PG8_SA(0, 0), cA, voffA); PG8_STAGE(PG8_SA(0, 1), cA + hstep, voffA);
        if (wr == 1) PG8_BAR;
        PG8_WAIT_V(2); PG8_BAR;
        PG8_STAGE(PG8_SB(1, 0), cB + kstep, voffB); PG8_STAGE(PG8_SA(1, 0), cA + kstep, voffA); PG8_STAGE(PG8_SB(1, 1), cB + hstep + kstep, voffB);
        PG8_WAIT_V(6); PG8_BAR;
    } else {
        PG8_STAGE(PG8_SB(0, 0), cB, voffB); PG8_STAGE(PG8_SA(0, 0), cA, voffA); PG8_STAGE(PG8_SB(0, 1), cB + hstep, voffB); PG8_STAGE(PG8_SA(0, 1), cA + hstep, voffA);
        if (wr == 1) PG8_BAR;
        PG8_WAIT_V(4); PG8_BAR;
        PG8_STAGE(PG8_SB(1, 0), cB + kstep, voffB); PG8_STAGE(PG8_SA(1, 0), cA + kstep, voffA); PG8_STAGE(PG8_SB(1, 1), cB + hstep + kstep, voffB);
        PG8_WAIT_V(6); PG8_BAR;
    }
    for (;;) {
        const bool has_next = S.next(ui + 1, nxt);
        const char* nA = has_next ? (const char*)g.A + (size_t)nxt.pm * tstep + (size_t)nxt.z * g.zA : cA; const char* nB = has_next ? (const char*)g.Bt + (size_t)nxt.pn * tstep + (size_t)nxt.z * g.zB : cB;
        for (int t = 0; t < nt; t += 2) {
            const bool last = (t == nt - 2);
            const char* a1 = cA + (size_t)(t + 1) * kstep;
            const char* a2 = last ? nA : cA + (size_t)(t + 2) * kstep; const char* b2 = last ? nB : cB + (size_t)(t + 2) * kstep;
            const char* a3 = a2 + kstep; const char* b3 = b2 + kstep;
            if (last && has_next) S.a_ready(nxt);
            if constexpr (SP2) {
            PG8_LDB(B0, 0, 0); PG8_LDB(B1, 0, 1); PG8_SCHED; PG8_LDA(At, 0, 0); PG8_STAGE(PG8_SA(1, 1), a1 + hstep, voffA);
            PG8_WAIT_V(8); PG8_WAIT_L(0); PG8_BAR; PG8_MMA(0, 0, At, B0); PG8_MMA(0, 1, At, B1); PG8_BAR; PG8_SCHED;
            PG8_LDA(At, 0, 1); PG8_STAGE(PG8_SB(0, 0), b2, voffB); PG8_STAGE(PG8_SB(0, 1), b2 + hstep, voffB); PG8_STAGE(PG8_SA(0, 0), a2, voffA);
            PG8_WAIT_V(8); PG8_WAIT_L(0); PG8_BAR; PG8_MMA(1, 0, At, B0); PG8_MMA(1, 1, At, B1); PG8_BAR; PG8_SCHED;
            PG8_LDB(B0, 1, 0); PG8_LDB(B1, 1, 1); PG8_SCHED; PG8_LDA(At, 1, 0); PG8_STAGE(PG8_SA(0, 1), a2 + hstep, voffA);
            PG8_WAIT_V(8); PG8_WAIT_L(0); PG8_BAR; PG8_MMA(0, 0, At, B0); PG8_MMA(0, 1, At, B1); PG8_BAR; PG8_SCHED;
            PG8_LDA(At, 1, 1); PG8_STAGE(PG8_SB(1, 0), b3, voffB); PG8_STAGE(PG8_SB(1, 1), b3 + hstep, voffB); PG8_STAGE(PG8_SA(1, 0), a3, voffA);
            PG8_WAIT_V(8); PG8_WAIT_L(0); PG8_BAR; PG8_MMA(1, 0, At, B0); PG8_MMA(1, 1, At, B1); PG8_BAR; PG8_SCHED;
            } else {
            PG8_LDB(B0, 0, 0); PG8_SCHED; PG8_LDA(At, 0, 0); PG8_STAGE(PG8_SA(1, 1), a1 + hstep, voffA);
            PG8_WAIT_L(8); PG8_BAR; PG8_WAIT_L(0); PG8_MMA(0, 0, At, B0); PG8_BAR; PG8_SCHED;
            PG8_LDB(B1, 0, 1); PG8_STAGE(PG8_SB(0, 0), b2, voffB);
            PG8_BAR; PG8_WAIT_L(0); PG8_MMA(0, 1, At, B1); PG8_BAR;
            PG8_LDA(At, 0, 1); PG8_STAGE(PG8_SA(0, 0), a2, voffA);
            PG8_BAR; PG8_WAIT_L(0); PG8_MMA(1, 0, At, B0); PG8_BAR; PG8_SCHED;
            PG8_STAGE(PG8_SB(0, 1), b2 + hstep, voffB);
            PG8_WAIT_V(6); PG8_BAR; PG8_MMA(1, 1, At, B1); PG8_BAR;
            PG8_LDB(B0, 1, 0); PG8_SCHED; PG8_LDA(At, 1, 0); PG8_STAGE(PG8_SA(0, 1), a2 + hstep, voffA);
            PG8_WAIT_L(8); PG8_BAR; PG8_WAIT_L(0); PG8_MMA(0, 0, At, B0); PG8_BAR; PG8_SCHED;
            PG8_LDB(B1, 1, 1); PG8_STAGE(PG8_SB(1, 0), b3, voffB);
            PG8_BAR; PG8_WAIT_L(0); PG8_MMA(0, 1, At, B1); PG8_BAR;
            PG8_LDA(At, 1, 1); PG8_STAGE(PG8_SA(1, 0), a3, voffA);
            PG8_BAR; PG8_WAIT_L(0); PG8_MMA(1, 0, At, B0); PG8_BAR; PG8_SCHED;
            PG8_STAGE(PG8_SB(1, 1), b3 + hstep, voffB);
            PG8_WAIT_V(6); PG8_BAR; PG8_MMA(1, 1, At, B1); PG8_BAR;
            }
        }
        if constexpr (ALIGN_EPI) { if (wr == 0) PG8_BAR; }
        if constexpr (!Epi::AFTER_DRAIN) { E(acc, cur, wr, wc, fr, fq); S.done(cur); }
        if (!has_next) break;
#pragma unroll
        for (int a = 0; a < 2; ++a)
#pragma unroll
            for (int b = 0; b < 2; ++b)
#pragma unroll
                for (int m = 0; m < 4; ++m)
#pragma unroll
                    for (int n = 0; n < 2; ++n) acc[a][b][m][n] = (f32x4){0.f, 0.f, 0.f, 0.f};
        cur = nxt; cA = nA; cB = nB; ++ui;
        if constexpr (ALIGN_EPI) { if (wr == 1) PG8_BAR; }
    }
    PG8_WAIT_V(0);
    if constexpr (!ALIGN_EPI) { if (wr == 0) PG8_BAR; }
    PG8_BAR;
    if constexpr (Epi::AFTER_DRAIN) { E.fused(acc, cur, wr, wc, fr, fq, lds, wid, lane); S.done(cur); }
#undef PG8_SA
#undef PG8_SB
#undef PG8_STAGE
#undef PG8_LDA
#undef PG8_LDB
#undef PG8_MMA
#undef PG8_WAIT_V
#undef PG8_WAIT_L
#undef PG8_BAR
#undef PG8_SCHED
}
}

constexpr int NWAVES = 8;
constexpr int D = 2048, DEPTH = 2, DFF = 8192;
constexpr int NA_W = 1024, ML_W = 1024, SG_W = 1024;
constexpr int D_IN = 15376, N_IN_PAD = 15616;
constexpr int M_PROMPT = 8 * 4096, M_SAMPLE = 2 * 8192, M_ALL = M_PROMPT + M_SAMPLE;
constexpr int MS = 8192, NSLAB = M_ALL / MS;
constexpr float EPS = 1e-6f;

constexpr size_t MiB = 1u << 20;
constexpr size_t WS_CTL = 0, CTL_ZERO_BYTES = 1 * MiB;
constexpr size_t WL_IN = 0, WL_ABC = 61 * MiB, WL_OUT = 73 * MiB, WL_UP = 81 * MiB, WL_DN = 113 * MiB, WL_BYTES = 145 * MiB;
constexpr size_t WS_W = 1 * MiB;
constexpr size_t WS_H = 291 * MiB;
constexpr size_t WS_QKVA = 323 * MiB;
constexpr size_t WS_QKVOB = 371 * MiB;
constexpr size_t WS_ZUV = 435 * MiB;
constexpr size_t WS_U = WS_QKVA;
constexpr size_t WS_G = 467 * MiB;
constexpr size_t WS_GATES = 563 * MiB;
constexpr size_t WS_SGR = WS_GATES + MiB / 2;
constexpr size_t WS_QC = 564 * MiB, WS_KC = 580 * MiB;
constexpr size_t WS_Y = 596 * MiB;
constexpr size_t WS_HF = 644 * MiB, WS_HB = 676 * MiB;
constexpr size_t WS_MRG = 708 * MiB;
constexpr size_t WS_MRGB = 772 * MiB;
constexpr size_t WS_T = 804 * MiB;
constexpr size_t WS_GS = 868 * MiB;
constexpr size_t WS_GD = 870 * MiB;
constexpr size_t WS_LST = 871 * MiB;
constexpr size_t WS_NLOC = 887 * MiB;
constexpr size_t WS_END = 888 * MiB;
static_assert(WS_W + 2 * WL_BYTES <= WS_H && WS_U + (size_t)MS * DFF * 2 <= WS_G && WS_SGR + (size_t)MS * 4 <= WS_QC, "d_ws map");
constexpr int CW_BAR = 4096;

constexpr int RING_OFF = 0, RING_BYTES = 131072;
constexpr int LDSCTL_OFF = 153600, MISC_OFF = LDSCTL_OFF + 320;
constexpr int LDS_BYTES = 155648;

#define GAS __attribute__((address_space(1)))
#define LAS __attribute__((address_space(3)))
typedef unsigned short bf16;
typedef unsigned v4u __attribute__((ext_vector_type(4)));
typedef float f32x4 __attribute__((ext_vector_type(4)));
typedef short bf16x8 __attribute__((ext_vector_type(8)));
typedef GAS unsigned gu32;
typedef GAS unsigned long long gu64;
#define RLX_AGENT __ATOMIC_RELAXED, __HIP_MEMORY_SCOPE_AGENT
#define LDS_WAIT() asm volatile("s_waitcnt lgkmcnt(0)" ::: "memory")
#define VM_WAIT() asm volatile("s_waitcnt vmcnt(0)" ::: "memory")
__device__ __forceinline__ unsigned long long rt() { return __builtin_amdgcn_s_memrealtime(); }
__device__ __forceinline__ unsigned f2bf(float f) { unsigned u = __builtin_bit_cast(unsigned, f); return (u + 0x7fffu + ((u >> 16) & 1u)) >> 16; }
__device__ __forceinline__ unsigned pk2(float lo, float hi) { return f2bf(lo) | (f2bf(hi) << 16); }

#define XB_TMO      128
#define XB_XCNT(j)  (256  + 64 * (j))
#define XB_XSUB(j)  (1280 + 64 * (j))
#define XB_XGEN(j)  (2304 + 64 * (j))
#define XB_TOP      3328
#define XB_TOPGEN   3392
#define XCD_BAR_WORDS 3456
#define XB_SPIN_CAP (1u << 18)

__device__ __forceinline__ unsigned xb_ld(unsigned* p)              { return __hip_atomic_load(p, __ATOMIC_RELAXED, __HIP_MEMORY_SCOPE_AGENT); }
__device__ __forceinline__ unsigned xb_add(unsigned* p, unsigned v) { return __hip_atomic_fetch_add(p, v, __ATOMIC_RELAXED, __HIP_MEMORY_SCOPE_AGENT); }
__device__ __forceinline__ unsigned xb_xcc_id() { return (unsigned)__builtin_amdgcn_s_getreg((3 << 11) | 20) & 0xFu; }
#define XB_SPIN(cond, bar) do { unsigned _sp = 0; while (cond) { __builtin_amdgcn_s_sleep(1); \
    if ((++_sp & 255u) == 0u) { if (xb_ld(&(bar)[XB_TMO])) break; if (_sp > XB_SPIN_CAP) { atomicAdd(&(bar)[XB_TMO], 1u); break; } } } } while (0)

struct XcdBarrier {
    unsigned* bar; unsigned x;
    volatile LAS unsigned* st;
};

__device__ __forceinline__ XcdBarrier xcd_barrier_post(unsigned* bar, volatile LAS unsigned* st) {
    XcdBarrier b; b.bar = bar; b.x = xb_xcc_id(); b.st = st;
    if (threadIdx.x == 0) (void)xb_add(&bar[XB_XCNT(b.x)], 1u);
    return b;
}
__device__ __forceinline__ void xcd_barrier_complete(unsigned* bar, unsigned x, unsigned& nloc, unsigned& nx) {
    const unsigned G = gridDim.x * gridDim.y * gridDim.z;
    unsigned sum, cnt, mine, sp = 0u;
    for (;;) {
        sum = 0u; cnt = 0u; mine = 0u;
#pragma unroll
        for (unsigned j = 0; j < 16; ++j) { const unsigned c = xb_ld(&bar[XB_XCNT(j)]); sum += c; cnt += (c > 0u) ? 1u : 0u; mine = (j == x) ? c : mine; }
        if (sum == G) break;
        __builtin_amdgcn_s_sleep(1);
        if ((++sp & 255u) == 0u) { if (xb_ld(&bar[XB_TMO])) break; if (sp > XB_SPIN_CAP) { atomicAdd(&bar[XB_TMO], 1u); break; } }
    }
    nloc = mine > 0u ? mine : 1u; nx = cnt > 0u ? cnt : 1u;
}

__device__ __forceinline__ void xcd_barrier(const XcdBarrier& b) {
    asm volatile("s_waitcnt vmcnt(0)" ::: "memory");
    __syncthreads();
    if (threadIdx.x == 0) {
        unsigned* bar = b.bar;
        __builtin_amdgcn_s_waitcnt(0);
        unsigned nloc = b.st[0], nx = b.st[1];
        if (nloc == 0u) { xcd_barrier_complete(bar, b.x, nloc, nx); b.st[0] = nloc; b.st[1] = nx; }
        const unsigned old = xb_add(&bar[XB_XSUB(b.x)], 1u);
        const unsigned gen = old / nloc;
        if (old + 1u == (gen + 1u) * nloc) {
            __builtin_amdgcn_fence(__ATOMIC_RELEASE, "agent");
            asm volatile("s_waitcnt vmcnt(0)" ::: "memory");
            const unsigned og = xb_add(&bar[XB_TOP], 1u);
            const unsigned tg = og / nx;
            if (og + 1u == (tg + 1u) * nx) xb_add(&bar[XB_TOPGEN], 1u);
            else XB_SPIN(xb_ld(&bar[XB_TOPGEN]) == tg, bar);
            __builtin_amdgcn_fence(__ATOMIC_ACQUIRE, "agent");
            xb_add(&bar[XB_XGEN(b.x)], 1u);
            asm volatile("s_waitcnt vmcnt(0)" ::: "memory");
        } else {
            XB_SPIN(xb_ld(&bar[XB_XGEN(b.x)]) == gen, bar);
            __builtin_amdgcn_fence(__ATOMIC_ACQUIRE, "agent");
            asm volatile("s_waitcnt vmcnt(0)" ::: "memory");
        }
    }
    __syncthreads();
}

struct Frame {
    LAS unsigned char* lds;
    int tid, lane, wave;
    int vcu, G;
};
struct Args {
    const float* x_prompt; const float* x_sample; const float* pre_mix_g; const float* post_mix_g; const float* pre_mlp_g; const float* post_mlp_g;
    const float* w_in; const float* b_gate; const float* conv_w; const float* na_rpb; const float* ml_norm_g; const float* sg_norm_g; const float* w_s; const float* b_s;
    const float* w_a; const float* w_b; const float* w_c; const float* w_out; const float* w_up; const float* w_down;
    float* out; unsigned char* ws;
    int ph_lo, ph_hi;
};

__device__ __forceinline__ float wave_sum(float v) {
#pragma unroll
    for (int o = 1; o < 64; o <<= 1) v += __shfl_xor(v, o);
    return v;
}
__device__ __forceinline__ float wave_max(float v) {
#pragma unroll
    for (int o = 1; o < 64; o <<= 1) v = fmaxf(v, __shfl_xor(v, o));
    return v;
}
__device__ __forceinline__ float bf_lo(unsigned u) { return __uint_as_float(u << 16); }
__device__ __forceinline__ float bf_hi(unsigned u) { return __uint_as_float(u & 0xffff0000u); }
__device__ __forceinline__ float sigmoid_f(float x) { return __builtin_amdgcn_rcpf(1.0f + __builtin_amdgcn_exp2f(-1.4426950408889634f * x)); }

__device__ __forceinline__ void p0_transpose_item(const float* W, int K, int N, bf16* WT, int k0, int n0, int ncols, int drow0, float sc, LAS float* scr, int lane) {
    const int cl = lane & 31;
#pragma unroll 8
    for (int i = 0; i < 32; ++i) { const int kk = 2 * i + (lane >> 5); scr[kk * 33 + cl] = (cl < ncols) ? W[(size_t)(k0 + kk) * N + n0 + cl] * sc : 0.f; }
    LDS_WAIT(); asm volatile("" ::: "memory");
    const int c = lane & 7;
#pragma unroll
    for (int j = 0; j < 4; ++j) { const int n = (lane >> 3) + 8 * j; const LAS float* s = scr + (8 * c) * 33 + n;
        v4u o; o.x = pk2(s[0 * 33], s[1 * 33]); o.y = pk2(s[2 * 33], s[3 * 33]); o.z = pk2(s[4 * 33], s[5 * 33]); o.w = pk2(s[6 * 33], s[7 * 33]);
        if (n < ncols) *(GAS v4u*)(WT + (size_t)(drow0 + n) * K + k0 + 8 * c) = o; }
    LDS_WAIT(); asm volatile("" ::: "memory");
}
__device__ __forceinline__ void p0_matrix(Frame& F, const float* W, int K, int N, bf16* WT, LAS float* scr) {
    const int gw = F.vcu * NWAVES + F.wave, NGW = F.G * NWAVES, nblk = N / 32, nit = (K / 64) * nblk;
    for (int it = gw; it < nit; it += NGW) { const int kb = it / nblk, nb = it % nblk; p0_transpose_item(W, K, N, WT, 64 * kb, 32 * nb, 32, 32 * nb, 1.f, scr, F.lane); }
}
__device__ __forceinline__ void p0_win(Frame& F, const float* W, bf16* WT, LAS float* scr) {
    const int gw = F.vcu * NWAVES + F.wave, NGW = F.G * NWAVES;
    constexpr int NB1 = 7168 / 32, NB2 = 8192 / 32, NBLK = NB1 + 1 + NB2, NIT = (D / 64) * NBLK;
    for (int it = gw; it < NIT; it += NGW) { const int kb = it / NBLK, nb = it % NBLK; int n0, ncols, drow0; float sc = 1.f;
        if (nb < NB1) { n0 = 32 * nb; ncols = 32; drow0 = n0; if (n0 < 1024) sc = 0.08838834764831845f; }
        else if (nb == NB1) { n0 = 7168; ncols = 16; drow0 = 15360; }
        else { n0 = 7184 + 32 * (nb - NB1 - 1); ncols = 32; drow0 = n0 - 16; }
        p0_transpose_item(W, D, D_IN, WT, 64 * kb, n0, ncols, drow0, sc, scr, F.lane); }
    const int gt = (F.vcu * NWAVES + F.wave) * 64 + F.lane, NGT = F.G * NWAVES * 64; constexpr int NZ16 = (N_IN_PAD - D_IN) * D / 8;
    GAS v4u* z = (GAS v4u*)(WT + (size_t)D_IN * D);
    for (int i = gt; i < NZ16; i += NGT) z[i] = (v4u){0u, 0u, 0u, 0u};
}

__device__ __forceinline__ void row_phase(Frame& F, const float* xin, const float* add, const float* g_add, float* xout, const float* g_next, bf16* hout) {
    const int gw = F.vcu * NWAVES + F.wave, NGW = F.G * NWAVES;
    for (int m = gw; m < MS; m += NGW) {
        const GAS f32x4* xr = (const GAS f32x4*)(xin + (size_t)m * D) + F.lane;
        f32x4 v[8];
#pragma unroll
        for (int j = 0; j < 8; ++j) v[j] = xr[64 * j];
        if (add) {
            const GAS f32x4* ar = (const GAS f32x4*)(add + (size_t)m * D) + F.lane; f32x4 a[8]; float s = 0.f;
#pragma unroll
            for (int j = 0; j < 8; ++j) { a[j] = ar[64 * j]; s += (a[j].x * a[j].x + a[j].y * a[j].y) + (a[j].z * a[j].z + a[j].w * a[j].w); }
            const float rs = 1.0f / sqrtf(wave_sum(s) * (1.f / D) + EPS);
#pragma unroll
            for (int j = 0; j < 8; ++j) { const f32x4 gv = ((const GAS f32x4*)g_add)[F.lane + 64 * j]; v[j] = v[j] + (a[j] * rs) * gv; }
        }
        if (xout) { GAS f32x4* o = (GAS f32x4*)(xout + (size_t)m * D) + F.lane;
#pragma unroll
            for (int j = 0; j < 8; ++j) o[64 * j] = v[j]; }
        if (hout) {
            float s = 0.f;
#pragma unroll
            for (int j = 0; j < 8; ++j) s += (v[j].x * v[j].x + v[j].y * v[j].y) + (v[j].z * v[j].z + v[j].w * v[j].w);
            const float rs = 1.0f / sqrtf(wave_sum(s) * (1.f / D) + EPS);
            GAS unsigned long long* o8 = (GAS unsigned long long*)(hout + (size_t)m * D) + F.lane;
#pragma unroll
            for (int j = 0; j < 8; ++j) { const f32x4 gv = ((const GAS f32x4*)g_next)[F.lane + 64 * j]; const f32x4 y = (v[j] * rs) * gv;
                o8[64 * j] = (unsigned long long)pk2(y.x, y.y) | ((unsigned long long)pk2(y.z, y.w) << 32); }
        }
    }
}

__device__ __forceinline__ void prep_phase(Frame& F, const bf16* qkvob, const float* convw, bf16* qc, bf16* kc, const bf16* zuv, float* sgr, int T) {
    const int gt = (F.vcu * NWAVES + F.wave) * 64 + F.lane, NGT = F.G * NWAVES * 64;
    {
        const int c8 = gt & 255; float w0[8], w1[8], w2[8];
#pragma unroll
        for (int j = 0; j < 8; ++j) { w0[j] = convw[c8 * 8 + j]; w1[j] = convw[2048 + c8 * 8 + j]; w2[j] = convw[4096 + c8 * 8 + j]; }
        const float osc = c8 < 128 ? 0.0625f : 1.0f;
        bf16* dst = c8 < 128 ? qc + c8 * 8 : kc + (c8 - 128) * 8;
        for (int t = gt >> 8; t < MS; t += NGT >> 8) {
            const int ts = t % T; const GAS v4u* src = (const GAS v4u*)(qkvob + (size_t)t * 4096 + c8 * 8);
            const v4u xc = src[0]; v4u xm = (v4u){0u, 0u, 0u, 0u}, xp = xm;
            if (ts > 0) xm = *(const GAS v4u*)(qkvob + (size_t)(t - 1) * 4096 + c8 * 8);
            if (ts < T - 1) xp = *(const GAS v4u*)(qkvob + (size_t)(t + 1) * 4096 + c8 * 8);
            float r[8];
#pragma unroll
            for (int j = 0; j < 4; ++j) {
                const float a0 = w0[2 * j] * bf_lo(xm[j]) + w1[2 * j] * bf_lo(xc[j]) + w2[2 * j] * bf_lo(xp[j]);
                const float a1 = w0[2 * j + 1] * bf_hi(xm[j]) + w1[2 * j + 1] * bf_hi(xc[j]) + w2[2 * j + 1] * bf_hi(xp[j]);
                r[2 * j] = a0 * sigmoid_f(a0) * osc; r[2 * j + 1] = a1 * sigmoid_f(a1) * osc; }
            v4u o; o.x = pk2(r[0], r[1]); o.y = pk2(r[2], r[3]); o.z = pk2(r[4], r[5]); o.w = pk2(r[6], r[7]);
            *(GAS v4u*)(dst + (size_t)t * 1024) = o;
        }
    }
    {
        const int gw = F.vcu * NWAVES + F.wave, NGW = F.G * NWAVES;
        for (int t = gw; t < MS; t += NGW) {
            const GAS v4u* src = (const GAS v4u*)(zuv + (size_t)t * 2048 + 1024) + 2 * F.lane; float s = 0.f;
#pragma unroll
            for (int i = 0; i < 2; ++i) { const v4u x = src[i];
#pragma unroll
                for (int j = 0; j < 4; ++j) { const float a = bf_lo(x[j]), b = bf_hi(x[j]); s += a * a + b * b; } }
            s = wave_sum(s);
            if (F.lane == 0) sgr[t] = 1.0f / sqrtf(s * (1.f / 1024.f) + EPS);
        }
    }
}

__device__ __forceinline__ void comb_phase(Frame& F, const float* hf, const float* hb, const bf16* qkvob, const float* mlg, bf16* yb) {
    const int gw = F.vcu * NWAVES + F.wave, NGW = F.G * NWAVES;
    for (int it = gw; it < MS * 4; it += NGW) { const int t = it >> 2, h = it & 3; const size_t o = (size_t)t * 1024 + h * 256 + 4 * F.lane;
        const f32x4 a = *(const GAS f32x4*)(hf + o), b = *(const GAS f32x4*)(hb + o); const f32x4 s = a + b;
        const float ss = wave_sum((s.x * s.x + s.y * s.y) + (s.z * s.z + s.w * s.w)); const float rs = 1.0f / sqrtf(ss * (1.f / 256.f) + EPS);
        const f32x4 gv = *(const GAS f32x4*)(mlg + h * 256 + 4 * F.lane);
        const unsigned long long ow = *(const GAS unsigned long long*)(qkvob + (size_t)t * 4096 + 3072 + h * 256 + 4 * F.lane);
        const unsigned o0 = (unsigned)ow, o1 = (unsigned)(ow >> 32);
        const float y0 = s.x * rs * gv.x * bf_lo(o0), y1 = s.y * rs * gv.y * bf_hi(o0), y2 = s.z * rs * gv.z * bf_lo(o1), y3 = s.w * rs * gv.w * bf_hi(o1);
        *(GAS unsigned long long*)(yb + o) = (unsigned long long)pk2(y0, y1) | ((unsigned long long)pk2(y2, y3) << 32);
    }
}

__device__ __forceinline__ void na_naive(Frame& F, const bf16* qkva, const float* rpb, bf16* ya, int T, int gw, int NGW) {
    const int rows = T / 64;
    for (int it = gw; it < MS * 8; it += NGW) {
        const int m = it >> 3, h = it & 7, seq = m / T, t = m % T, r = t >> 6, qc = t & 63;
        int rs = r - 4; rs = rs < 0 ? 0 : (rs > rows - 8 ? rows - 8 : rs);
        int cs = qc - 8; cs = cs < 0 ? 0 : (cs > 48 ? 48 : cs);
        const bf16* qrow = qkva + (size_t)m * 3072 + h * 128;
        float sc[2];
#pragma unroll
        for (int kk = 0; kk < 2; ++kk) { const int kap = F.lane + 64 * kk, j = kap >> 4, cc = kap & 15;
            const int ktok = seq * T + (rs + j) * 64 + cs + cc; const bf16* krow = qkva + (size_t)ktok * 3072 + 1024 + h * 128; float d = 0.f;
#pragma unroll 4
            for (int i = 0; i < 16; ++i) { const v4u qv = *(const GAS v4u*)(qrow + 8 * i), kv = *(const GAS v4u*)(krow + 8 * i);
#pragma unroll
                for (int e = 0; e < 4; ++e) d += bf_lo(qv[e]) * bf_lo(kv[e]) + bf_hi(qv[e]) * bf_hi(kv[e]); }
            sc[kk] = d + rpb[(h * 15 + (rs + j - r + 7)) * 31 + (cs + cc - qc + 15)]; }
        const float mx = wave_max(fmaxf(sc[0], sc[1]));
        const float e0 = __expf(sc[0] - mx), e1 = __expf(sc[1] - mx); const float inv = 1.0f / wave_sum(e0 + e1);
        const float p0 = e0 * inv, p1 = e1 * inv;
        float o0 = 0.f, o1 = 0.f;
        for (int kap = 0; kap < 128; ++kap) { const int j = kap >> 4, cc = kap & 15; const int ktok = seq * T + (rs + j) * 64 + cs + cc;
            const float p = __shfl(kap < 64 ? p0 : p1, kap & 63);
            const unsigned vv = *(const GAS unsigned*)(qkva + (size_t)ktok * 3072 + 2048 + h * 128 + 2 * F.lane);
            o0 += p * bf_lo(vv); o1 += p * bf_hi(vv); }
        *(GAS unsigned*)(ya + (size_t)m * 1024 + h * 128 + 2 * F.lane) = pk2(o0, o1);
    }
}
__device__ __forceinline__ void sg_naive(Frame& F, const bf16* zuv, const float* sgr, const float* sgn, const float* ws_, const float* bs, bf16* yc, int gw, int NGW) {
    for (int it = gw; it < MS * 8; it += NGW) {
        const int t = it >> 3, g = it & 7, p = t & 127, cb = t & ~127; const int c = g * 128 + 2 * F.lane;
        const float* wrow = ws_ + ((size_t)g * 128 + p) * 128; float a0 = 0.f, a1 = 0.f;
        for (int q = 0; q < 128; ++q) { const float wq = wrow[q] * sgr[cb + q]; const unsigned zz = *(const GAS unsigned*)(zuv + (size_t)(cb + q) * 2048 + 1024 + c);
            a0 += wq * bf_lo(zz); a1 += wq * bf_hi(zz); }
        const float b = bs[g * 128 + p]; const unsigned uu = *(const GAS unsigned*)(zuv + (size_t)t * 2048 + c);
        const float y0 = bf_lo(uu) * (a0 * sgn[c] + b), y1 = bf_hi(uu) * (a1 * sgn[c + 1] + b);
        *(GAS unsigned*)(yc + (size_t)t * 1024 + c) = pk2(y0, y1);
    }
}
__device__ __forceinline__ void mlstm_naive(Frame& F, int unit, const bf16* qc, const bf16* kc, const bf16* qkvob, const float* gates, float* hf, float* hb, int T) {
    const int es = unit & 3, dir = (unit >> 2) & 1, h = (unit >> 3) & 3, seq = unit >> 5, nc = T / 64, tid = F.tid;
    LAS unsigned char* L = F.lds;
    LAS bf16* Qs = (LAS bf16*)(L);
    LAS bf16* Ks = (LAS bf16*)(L + 33792);
    LAS float* Vs = (LAS float*)(L + 67584);
    LAS float* Ss = (LAS float*)(L + 83968);
    LAS float* NUM = (LAS float*)(L + 100608);
    LAS float* vb = (LAS float*)(L + 116992);
    LAS float* va = vb + 64;
    LAS float* vmr = vb + 128;
    LAS float* vw = vb + 192;
    LAS float* vwi = vb + 256;
    LAS float* NQ = vb + 320;
    LAS float* nst = vb + 384;
    LAS float* scal = vb + 640;
    float* hout = dir ? hb : hf;
    float Creg[32];
#pragma unroll
    for (int i = 0; i < 32; ++i) Creg[i] = 0.f;
    if (tid < 256) nst[tid] = 0.f;
    float m_prev = 0.f;
    const int e = tid & 63, dg = tid >> 6;
    for (int ci = 0; ci < nc; ++ci) {
        __syncthreads();
#pragma unroll
        for (int i = 0; i < 4; ++i) { const int p = tid + 512 * i, tau = p >> 5, c8 = p & 31; const int pos = ci * 64 + tau; const int tok = seq * T + (dir ? T - 1 - pos : pos);
            *(LAS v4u*)(Qs + tau * 264 + c8 * 8) = *(const GAS v4u*)(qc + (size_t)tok * 1024 + h * 256 + c8 * 8);
            *(LAS v4u*)(Ks + tau * 264 + c8 * 8) = *(const GAS v4u*)(kc + (size_t)tok * 1024 + h * 256 + c8 * 8); }
        { const int tau = tid >> 3, c8 = tid & 7; const int pos = ci * 64 + tau; const int tok = seq * T + (dir ? T - 1 - pos : pos);
            const v4u vv = *(const GAS v4u*)(qkvob + (size_t)tok * 4096 + 2048 + h * 256 + es * 64 + c8 * 8);
#pragma unroll
            for (int j = 0; j < 4; ++j) { Vs[tau * 64 + c8 * 8 + 2 * j] = bf_lo(vv[j]); Vs[tau * 64 + c8 * 8 + 2 * j + 1] = bf_hi(vv[j]); } }
        if (tid < 64) {
            const int pos = ci * 64 + tid; const int tok = seq * T + (dir ? T - 1 - pos : pos);
            const float ipre = gates[(size_t)tok * 16 + dir * 8 + h], fpre = gates[(size_t)tok * 16 + dir * 8 + 4 + h];
            const float logf = fminf(fpre, 0.f) - log1pf(__expf(-fabsf(fpre)));
            float b = logf;
#pragma unroll
            for (int o = 1; o < 64; o <<= 1) { const float y = __shfl_up(b, o); if (tid >= o) b += y; }
            const float a = ipre - b; float pm = a;
#pragma unroll
            for (int o = 1; o < 64; o <<= 1) { const float y = __shfl_up(pm, o); if (tid >= o) pm = fmaxf(pm, y); }
            const float mrow = fmaxf(b + m_prev, b + pm);
            const float blast = __shfl(b, 63), amax = __shfl(pm, 63);
            const float mnew = fmaxf(blast + m_prev, blast + amax);
            vb[tid] = b; va[tid] = a; vmr[tid] = mrow; vw[tid] = __expf(blast + a - mnew); vwi[tid] = __expf(b + m_prev - mrow);
            if (tid == 0) { scal[0] = __expf(blast + m_prev - mnew); scal[1] = mnew; }
        }
#pragma unroll
        for (int i = 0; i < 8; ++i) NUM[tid + 512 * i] = 0.f;
        __syncthreads();
        const float decay = scal[0]; m_prev = scal[1];
        {
            const int tau = tid >> 3, sg = tid & 7; float rowpart = 0.f; const float bt = vb[tau], mr = vmr[tau];
#pragma unroll 1
            for (int j = 0; j < 8; ++j) { const int s = sg * 8 + j; float val = 0.f;
                if (s <= tau) { float d = 0.f;
#pragma unroll 4
                    for (int c8 = 0; c8 < 32; ++c8) { const v4u qv = *(const LAS v4u*)(Qs + tau * 264 + c8 * 8), kv = *(const LAS v4u*)(Ks + s * 264 + c8 * 8);
#pragma unroll
                        for (int x = 0; x < 4; ++x) d += bf_lo(qv[x]) * bf_lo(kv[x]) + bf_hi(qv[x]) * bf_hi(kv[x]); }
                    val = d * __expf(bt + va[s] - mr); }
                Ss[tau * 65 + s] = val; rowpart += val; }
            float qn = 0.f;
#pragma unroll 4
            for (int c8 = 0; c8 < 4; ++c8) { const v4u qv = *(const LAS v4u*)(Qs + tau * 264 + sg * 32 + c8 * 8);
#pragma unroll
                for (int x = 0; x < 4; ++x) qn += bf_lo(qv[x]) * nst[sg * 32 + c8 * 8 + 2 * x] + bf_hi(qv[x]) * nst[sg * 32 + c8 * 8 + 2 * x + 1]; }
            float tot = rowpart + vwi[tau] * qn;
            tot += __shfl_xor(tot, 1); tot += __shfl_xor(tot, 2); tot += __shfl_xor(tot, 4);
            if (sg == 0) NQ[tau] = tot;
        }
        {
#pragma unroll 1
            for (int tau = 0; tau < 64; ++tau) { float part = 0.f;
#pragma unroll
                for (int c8 = 0; c8 < 4; ++c8) { const v4u qv = *(const LAS v4u*)(Qs + tau * 264 + dg * 32 + c8 * 8);
#pragma unroll
                    for (int x = 0; x < 4; ++x) part += bf_lo(qv[x]) * Creg[c8 * 8 + 2 * x] + bf_hi(qv[x]) * Creg[c8 * 8 + 2 * x + 1]; }
                __hip_atomic_fetch_add(&NUM[tau * 64 + e], vwi[tau] * part, __ATOMIC_RELAXED, __HIP_MEMORY_SCOPE_WORKGROUP); }
        }
        __syncthreads();
        {
#pragma unroll 1
            for (int j = 0; j < 8; ++j) { const int tau = dg * 8 + j; float acc = 0.f;
#pragma unroll 8
                for (int s = 0; s < 64; ++s) acc += Ss[tau * 65 + s] * Vs[s * 64 + e];
                __hip_atomic_fetch_add(&NUM[tau * 64 + e], acc, __ATOMIC_RELAXED, __HIP_MEMORY_SCOPE_WORKGROUP); }
        }
        __syncthreads();
#pragma unroll
        for (int i = 0; i < 8; ++i) { const int idx = tid + 512 * i, tau = idx >> 6, ee = idx & 63; const int pos = ci * 64 + tau; const int tok = seq * T + (dir ? T - 1 - pos : pos);
            const float den = fmaxf(fabsf(NQ[tau]), __expf(-vmr[tau]));
            hout[(size_t)tok * 1024 + h * 256 + es * 64 + ee] = NUM[idx] / den; }
#pragma unroll
        for (int i = 0; i < 32; ++i) Creg[i] *= decay;
#pragma unroll 1
        for (int s = 0; s < 64; ++s) { const float wv = vw[s] * Vs[s * 64 + e];
#pragma unroll
            for (int c8 = 0; c8 < 4; ++c8) { const v4u kv = *(const LAS v4u*)(Ks + s * 264 + dg * 32 + c8 * 8);
#pragma unroll
                for (int x = 0; x < 4; ++x) { Creg[c8 * 8 + 2 * x] += bf_lo(kv[x]) * wv; Creg[c8 * 8 + 2 * x + 1] += bf_hi(kv[x]) * wv; } } }
        if (tid < 256) { float a = decay * nst[tid];
#pragma unroll 8
            for (int s = 0; s < 64; ++s) a += vw[s] * __uint_as_float(((unsigned)Ks[s * 264 + tid]) << 16);
            nst[tid] = a; }
    }
    __syncthreads();
}

typedef short s16x4 __attribute__((ext_vector_type(4)));
__device__ __forceinline__ bf16x8 tr_pair(const LAS bf16* p0, const LAS bf16* p1) {
    const s16x4 a = __builtin_amdgcn_ds_read_tr16_b64_v4i16((LAS s16x4*)p0), b = __builtin_amdgcn_ds_read_tr16_b64_v4i16((LAS s16x4*)p1);
    return __builtin_shufflevector(a, b, 0, 1, 2, 3, 4, 5, 6, 7);
}
#define MFMA16(a, b, c) __builtin_amdgcn_mfma_f32_16x16x32_bf16((a), (b), (c), 0, 0, 0)

__device__ __forceinline__ void sg_fast(Frame& F, const bf16* zuv, const float* sgr, const float* sgn, const float* ws_, const float* bs, bf16* yc, int u0, int ustride) {
    LAS bf16* Z = (LAS bf16*)F.lds;
    const int lane = F.lane, kg = lane >> 4, li = lane & 15, qq = li >> 2, pp = li & 3;
    for (int unit = u0; unit < (MS / 128) * 8; unit += ustride) {
        const int c = unit >> 3, g = unit & 7, t0 = c * 128;
        __syncthreads();
#pragma unroll
        for (int i = 0; i < 4; ++i) { const int idx = F.tid + 512 * i, row = idx >> 4, ch = idx & 15;
            *(LAS v4u*)(Z + row * 136 + ch * 8) = *(const GAS v4u*)(zuv + (size_t)(t0 + row) * 2048 + 1024 + g * 128 + ch * 8); }
        const int p = F.wave * 16 + li;
        bf16x8 bw[4];
#pragma unroll
        for (int ks = 0; ks < 4; ++ks) { const int q0 = ks * 32 + 8 * kg;
            const f32x4 w0 = *(const GAS f32x4*)(ws_ + ((size_t)g * 128 + p) * 128 + q0), w1 = *(const GAS f32x4*)(ws_ + ((size_t)g * 128 + p) * 128 + q0 + 4);
            const f32x4 r0 = *(const GAS f32x4*)(sgr + t0 + q0), r1 = *(const GAS f32x4*)(sgr + t0 + q0 + 4);
            v4u pk; pk.x = pk2(w0.x * r0.x, w0.y * r0.y); pk.y = pk2(w0.z * r0.z, w0.w * r0.w); pk.z = pk2(w1.x * r1.x, w1.y * r1.y); pk.w = pk2(w1.z * r1.z, w1.w * r1.w);
            bw[ks] = __builtin_bit_cast(bf16x8, pk); }
        __syncthreads();
        const float bsv = bs[g * 128 + p];
#pragma unroll 2
        for (int dt = 0; dt < 8; ++dt) {
            f32x4 acc = (f32x4){0.f, 0.f, 0.f, 0.f};
#pragma unroll
            for (int ks = 0; ks < 4; ++ks) { const LAS bf16* a0 = Z + (ks * 32 + 8 * kg + qq) * 136 + dt * 16 + 4 * pp;
                acc = MFMA16(tr_pair(a0, a0 + 4 * 136), bw[ks], acc); }
            const int d0 = g * 128 + dt * 16 + 4 * kg;
            const f32x4 sg = *(const GAS f32x4*)(sgn + d0);
            const unsigned long long uw = *(const GAS unsigned long long*)(zuv + (size_t)(t0 + p) * 2048 + d0); const unsigned u0w = (unsigned)uw, u1w = (unsigned)(uw >> 32);
            const float y0 = bf_lo(u0w) * (sg.x * acc[0] + bsv), y1 = bf_hi(u0w) * (sg.y * acc[1] + bsv), y2 = bf_lo(u1w) * (sg.z * acc[2] + bsv), y3 = bf_hi(u1w) * (sg.w * acc[3] + bsv);
            *(GAS unsigned long long*)(yc + (size_t)(t0 + p) * 1024 + d0) = (unsigned long long)pk2(y0, y1) | ((unsigned long long)pk2(y2, y3) << 32);
        }
    }
    __syncthreads();
}

__device__ __forceinline__ void na_fast(Frame& F, const bf16* qkva, const float* rpb, bf16* ya, int T, int gw, int NGW) {
    const int rows = T / 64, lane = F.lane, kg = lane >> 4, li = lane & 15, qq = li >> 2, pp = li & 3;
    LAS bf16* Vt = (LAS bf16*)(F.lds + F.wave * 8192);
    for (int it = gw; it < (MS / 16) * 8; it += NGW) {
        const int h = it & 7, blk = it >> 3, n = blk & 3, rowg = blk >> 2, seq = rowg / rows, r = rowg % rows;
        int rs = r - 4; rs = rs < 0 ? 0 : (rs > rows - 8 ? rows - 8 : rs);
        int kc0 = 16 * n - 8; kc0 = kc0 < 0 ? 0 : (kc0 > 32 ? 32 : kc0);
        const int qc = 16 * n + li; const size_t qtok = (size_t)seq * T + r * 64 + qc;
        bf16x8 bq[4];
#pragma unroll
        for (int ks = 0; ks < 4; ++ks) bq[ks] = __builtin_bit_cast(bf16x8, *(const GAS v4u*)(qkva + qtok * 3072 + h * 128 + ks * 32 + 8 * kg));
        f32x4 s[8][2];
#pragma unroll
        for (int j = 0; j < 8; ++j)
#pragma unroll
            for (int ct = 0; ct < 2; ++ct) { const size_t ktok = (size_t)seq * T + (rs + j) * 64 + kc0 + 16 * ct + li; f32x4 a = (f32x4){0.f, 0.f, 0.f, 0.f};
#pragma unroll
                for (int ks = 0; ks < 4; ++ks) a = MFMA16(__builtin_bit_cast(bf16x8, *(const GAS v4u*)(qkva + ktok * 3072 + 1024 + h * 128 + ks * 32 + 8 * kg)), bq[ks], a);
                s[j][ct] = a; }
        int cs = qc - 8; cs = cs < 0 ? 0 : (cs > 48 ? 48 : cs);
        float mx = -3.0e38f;
#pragma unroll
        for (int j = 0; j < 8; ++j)
#pragma unroll
            for (int ct = 0; ct < 2; ++ct)
#pragma unroll
                for (int e = 0; e < 4; ++e) { const int kc = kc0 + 16 * ct + 4 * kg + e; const bool ok = kc >= cs && kc < cs + 16;
                    const int bi = (h * 15 + (rs + j - r + 7)) * 31 + (ok ? kc - qc + 15 : 15);
                    const float v = ok ? s[j][ct][e] + rpb[bi] : -3.0e38f; s[j][ct][e] = v; mx = fmaxf(mx, v); }
        mx = fmaxf(mx, __shfl_xor(mx, 16)); mx = fmaxf(mx, __shfl_xor(mx, 32));
        float sum = 0.f;
#pragma unroll
        for (int j = 0; j < 8; ++j)
#pragma unroll
            for (int ct = 0; ct < 2; ++ct)
#pragma unroll
                for (int e = 0; e < 4; ++e) { const float pv = s[j][ct][e] > -1.0e38f ? __expf(s[j][ct][e] - mx) : 0.f; s[j][ct][e] = pv; sum += pv; }
        sum += __shfl_xor(sum, 16); sum += __shfl_xor(sum, 32);
        const float inv = 1.0f / sum;
        f32x4 o[8];
#pragma unroll
        for (int dt = 0; dt < 8; ++dt) o[dt] = (f32x4){0.f, 0.f, 0.f, 0.f};
#pragma unroll 1
        for (int j = 0; j < 8; ++j) {
            asm volatile("" ::: "memory");
#pragma unroll
            for (int i = 0; i < 8; ++i) { const int key = 4 * i + kg; const size_t vtok = (size_t)seq * T + (rs + j) * 64 + kc0 + key;
                *(LAS v4u*)(Vt + key * 128 + li * 8) = *(const GAS v4u*)(qkva + vtok * 3072 + 2048 + h * 128 + li * 8); }
            asm volatile("" ::: "memory");
            f32x4 p0, p1;
            p0 = s[0][0]; p1 = s[0][1];
#pragma unroll
            for (int jj = 1; jj < 8; ++jj) if (j == jj) { p0 = s[jj][0]; p1 = s[jj][1]; }
            v4u pk; pk.x = pk2(p0[0], p0[1]); pk.y = pk2(p0[2], p0[3]); pk.z = pk2(p1[0], p1[1]); pk.w = pk2(p1[2], p1[3]);
            const bf16x8 bp = __builtin_bit_cast(bf16x8, pk);
#pragma unroll
            for (int dt = 0; dt < 8; ++dt) { const LAS bf16* a0 = Vt + (4 * kg + qq) * 128 + dt * 16 + 4 * pp;
                o[dt] = MFMA16(tr_pair(a0, a0 + 16 * 128), bp, o[dt]); }
            asm volatile("" ::: "memory");
        }
#pragma unroll
        for (int dt = 0; dt < 8; ++dt) { const f32x4 v = o[dt] * inv;
            *(GAS unsigned long long*)(ya + qtok * 1024 + h * 128 + dt * 16 + 4 * kg) = (unsigned long long)pk2(v[0], v[1]) | ((unsigned long long)pk2(v[2], v[3]) << 32); }
    }
}

constexpr int GS_STRIDE = 65536;
constexpr int ML_QS = 264, ML_VS = 72;
constexpr int ML_OFF_Q = 0, ML_OFF_K = 33792, ML_OFF_CT = 67584, ML_OFF_V = 101376, ML_OFF_WV = 110592, ML_OFF_ST = 119808, ML_OFF_VEC = 129024, ML_OFF_N = 130560, ML_OFF_CM = 131584, ML_LDS_END = 133120;
static_assert(ML_LDS_END <= LDSCTL_OFF, "mLSTM LDS map");

__device__ __forceinline__ void ml_gate_local(Frame& F, const float* gates, float* gs, float* gd, int T, int nchains) {
    const int gw = F.vcu * NWAVES + F.wave, NGW = F.G * NWAVES, lane = F.lane, nc = T / 64;
    for (int it = gw; it < nchains * nc; it += NGW) {
        const int chain = it / nc, ci = it % nc, seq = chain >> 3, h = (chain >> 1) & 3, dir = chain & 1;
        const int pos = ci * 64 + lane; const size_t tok = (size_t)seq * T + (dir ? T - 1 - pos : pos);
        const float ipre = gates[tok * 16 + dir * 8 + h], fpre = gates[tok * 16 + dir * 8 + 4 + h];
        const float logf = fminf(fpre, 0.f) - log1pf(__expf(-fabsf(fpre)));
        float b = logf;
#pragma unroll
        for (int o = 1; o < 64; o <<= 1) { const float y = __shfl_up(b, o); if (lane >= o) b += y; }
        const float a = ipre - b; float pm = a;
#pragma unroll
        for (int o = 1; o < 64; o <<= 1) { const float y = __shfl_up(pm, o); if (lane >= o) pm = fmaxf(pm, y); }
        const size_t o = (size_t)chain * T + pos;
        gs[o] = b; gs[GS_STRIDE + o] = a; gs[2 * GS_STRIDE + o] = pm;
        if (lane == 63) { gd[chain * 128 + ci] = b; gd[2048 + chain * 128 + ci] = b + pm; }
    }
}
__device__ __forceinline__ void ml_chain_m(Frame& F, const float* gd, int chain, int nc, LAS float* cm) {
    if (F.wave == 0) {
        const int lane = F.lane, cpl = nc >> 6;
        float sB0, sD0, sB1 = 0.f, sD1 = -3.0e38f;
        if (cpl == 2) { sB0 = gd[chain * 128 + 2 * lane]; sD0 = gd[2048 + chain * 128 + 2 * lane]; sB1 = gd[chain * 128 + 2 * lane + 1]; sD1 = gd[2048 + chain * 128 + 2 * lane + 1]; }
        else { sB0 = gd[chain * 128 + lane]; sD0 = gd[2048 + chain * 128 + lane]; }
        float B = sB0, Dm = sD0;
        if (cpl == 2) { Dm = fmaxf(sD0 + sB1, sD1); B = sB0 + sB1; }
#pragma unroll
        for (int o = 1; o < 64; o <<= 1) { const float Bp = __shfl_up(B, o), Dp = __shfl_up(Dm, o); if (lane >= o) { Dm = fmaxf(Dp + B, Dm); B = Bp + B; } }
        const float mend = fmaxf(B, Dm);
        float mp0 = __shfl_up(mend, 1); if (lane == 0) mp0 = 0.f;
        const float mn0 = fmaxf(mp0 + sB0, sD0);
        if (cpl == 2) { const float mn1 = fmaxf(mn0 + sB1, sD1);
            cm[2 * lane] = sB0; cm[2 * lane + 1] = sB1; cm[128 + 2 * lane] = mp0; cm[128 + 2 * lane + 1] = mn0; cm[256 + 2 * lane] = mn0; cm[256 + 2 * lane + 1] = mn1; }
        else { cm[lane] = sB0; cm[128 + lane] = mp0; cm[256 + lane] = mn0; }
    }
    __syncthreads();
}

__device__ __forceinline__ void ml_cupdate(f32x4 (&cst)[2][4], const LAS bf16* Ks, const LAS bf16* WV, float decay, int wave, int kg, int qq, int pp) {
#pragma unroll
    for (int dd = 0; dd < 2; ++dd)
#pragma unroll
        for (int et = 0; et < 4; ++et) cst[dd][et] = cst[dd][et] * decay;
#pragma unroll
    for (int ks = 0; ks < 2; ++ks) {
        bf16x8 af[2], bfv[4];
#pragma unroll
        for (int dd = 0; dd < 2; ++dd) { const LAS bf16* p = Ks + (ks * 32 + 8 * kg + qq) * ML_QS + (2 * wave + dd) * 16 + 4 * pp; af[dd] = tr_pair(p, p + 4 * ML_QS); }
#pragma unroll
        for (int et = 0; et < 4; ++et) { const LAS bf16* p = WV + (ks * 32 + 8 * kg + qq) * ML_VS + et * 16 + 4 * pp; bfv[et] = tr_pair(p, p + 4 * ML_VS); }
#pragma unroll
        for (int dd = 0; dd < 2; ++dd)
#pragma unroll
            for (int et = 0; et < 4; ++et) cst[dd][et] = MFMA16(af[dd], bfv[et], cst[dd][et]);
    }
}

__device__ __forceinline__ void ml_phaseA(Frame& F, int unit, const bf16* kc, const bf16* qkvob, const float* gs, const float* gd, float* lst, float* nloc, int T) {
    const int nseg = T / 1024, es = unit & 3, cs_ = unit >> 2, seg = cs_ % nseg, chain = cs_ / nseg, seq = chain >> 3, h = (chain >> 1) & 3, dir = chain & 1;
    if (seg == nseg - 1) return;
    const int tid = F.tid, lane = F.lane, kg = lane >> 4, li = lane & 15, qq = li >> 2, pp = li & 3, wave = F.wave;
    LAS bf16* Ks = (LAS bf16*)(F.lds + ML_OFF_K); LAS bf16* WV = (LAS bf16*)(F.lds + ML_OFF_WV); LAS float* wvec = (LAS float*)(F.lds + ML_OFF_VEC); LAS float* cm = (LAS float*)(F.lds + ML_OFF_CM);
    __syncthreads();
    ml_chain_m(F, gd, chain, T / 64, cm);
    f32x4 cst[2][4];
#pragma unroll
    for (int dd = 0; dd < 2; ++dd)
#pragma unroll
        for (int et = 0; et < 4; ++et) cst[dd][et] = (f32x4){0.f, 0.f, 0.f, 0.f};
    float nacc = 0.f;
    v4u pk[4], pv; float pw, pwv;
#define MLA_LOAD(ci_) do { const int ci__ = (ci_); \
        _Pragma("unroll") for (int i = 0; i < 4; ++i) { const int idx = tid + 512 * i, tau = idx >> 5, c8 = idx & 31; const int pos = ci__ * 64 + tau; const size_t tok = (size_t)seq * T + (dir ? T - 1 - pos : pos); \
            pk[i] = *(const GAS v4u*)(kc + tok * 1024 + h * 256 + c8 * 8); } \
        { const int tau = tid >> 3, c8 = tid & 7; const int pos = ci__ * 64 + tau; const size_t tok = (size_t)seq * T + (dir ? T - 1 - pos : pos); \
            pv = *(const GAS v4u*)(qkvob + tok * 4096 + 2048 + h * 256 + es * 64 + c8 * 8); pw = gs[GS_STRIDE + (size_t)chain * T + pos]; } \
        pwv = gs[GS_STRIDE + (size_t)chain * T + ci__ * 64 + (tid & 63)]; } while (0)
    MLA_LOAD(seg * 16);
    for (int cc = 0; cc < 16; ++cc) {
        const int ci = seg * 16 + cc;
        __syncthreads();
#pragma unroll
        for (int i = 0; i < 4; ++i) { const int idx = tid + 512 * i, tau = idx >> 5, c8 = idx & 31; *(LAS v4u*)(Ks + tau * ML_QS + c8 * 8) = pk[i]; }
        const float cB = cm[ci], cmp = cm[128 + ci], cmn = cm[256 + ci];
        { const int tau = tid >> 3, c8 = tid & 7; const float w = __expf(cB + pw - cmn);
            v4u o; o.x = pk2(bf_lo(pv.x) * w, bf_hi(pv.x) * w); o.y = pk2(bf_lo(pv.y) * w, bf_hi(pv.y) * w); o.z = pk2(bf_lo(pv.z) * w, bf_hi(pv.z) * w); o.w = pk2(bf_lo(pv.w) * w, bf_hi(pv.w) * w);
            *(LAS v4u*)(WV + tau * ML_VS + c8 * 8) = o; }
        if (tid < 64) wvec[tid] = __expf(cB + pwv - cmn);
        const float decay = __expf(cB + cmp - cmn);
        __syncthreads();
        if (cc + 1 < 16) MLA_LOAD(ci + 1);
        ml_cupdate(cst, Ks, WV, decay, wave, kg, qq, pp);
        if (tid < 64) { float a = decay * nacc;
#pragma unroll 8
            for (int s = 0; s < 64; ++s) a += wvec[s] * __uint_as_float(((unsigned)Ks[s * ML_QS + es * 64 + tid]) << 16);
            nacc = a; }
    }
#undef MLA_LOAD
    float* dst = lst + (size_t)unit * 32 * 512 + tid;
#pragma unroll
    for (int dd = 0; dd < 2; ++dd)
#pragma unroll
        for (int et = 0; et < 4; ++et)
#pragma unroll
            for (int r = 0; r < 4; ++r) dst[(dd * 16 + et * 4 + r) * 512] = cst[dd][et][r];
    if (tid < 64) nloc[(size_t)(chain * nseg + seg) * 256 + es * 64 + tid] = nacc;
    __syncthreads();
}

__device__ __forceinline__ void ml_phaseC(Frame& F, int unit, const bf16* qc, const bf16* kc, const bf16* qkvob, const float* gs, const float* gd, const float* lst, const float* nloc, float* hf, float* hb, int T) {
    const int nseg = T / 1024, es = unit & 3, cs_ = unit >> 2, seg = cs_ % nseg, chain = cs_ / nseg, seq = chain >> 3, h = (chain >> 1) & 3, dir = chain & 1;
    const int tid = F.tid, lane = F.lane, kg = lane >> 4, li = lane & 15, qq = li >> 2, pp = li & 3, wave = F.wave;
    LAS bf16* Qs = (LAS bf16*)(F.lds + ML_OFF_Q); LAS bf16* Ks = (LAS bf16*)(F.lds + ML_OFF_K); LAS bf16* CT = (LAS bf16*)(F.lds + ML_OFF_CT);
    LAS bf16* Vs = (LAS bf16*)(F.lds + ML_OFF_V); LAS bf16* WV = (LAS bf16*)(F.lds + ML_OFF_WV); LAS bf16* ST = (LAS bf16*)(F.lds + ML_OFF_ST);
    LAS float* vec = (LAS float*)(F.lds + ML_OFF_VEC);
    LAS float* nst = (LAS float*)(F.lds + ML_OFF_N);
    LAS float* cm = (LAS float*)(F.lds + ML_OFF_CM);
    float* hout = dir ? hb : hf;
    __syncthreads();
    ml_chain_m(F, gd, chain, T / 64, cm);
    f32x4 cst[2][4];
#pragma unroll
    for (int dd = 0; dd < 2; ++dd)
#pragma unroll
        for (int et = 0; et < 4; ++et) cst[dd][et] = (f32x4){0.f, 0.f, 0.f, 0.f};
    float nreg = 0.f;
    for (int i = 0; i < seg; ++i) {
        float sb = 0.f;
        for (int c = 0; c < 16; ++c) sb += cm[i * 16 + c];
        const float P = __expf(sb + cm[128 + i * 16] - cm[256 + i * 16 + 15]);
        const float* src = lst + (size_t)(((chain * nseg + i) << 2) + es) * 32 * 512 + tid;
#pragma unroll
        for (int dd = 0; dd < 2; ++dd)
#pragma unroll
            for (int et = 0; et < 4; ++et)
#pragma unroll
                for (int r = 0; r < 4; ++r) cst[dd][et][r] = P * cst[dd][et][r] + src[(dd * 16 + et * 4 + r) * 512];
        if (tid < 256) nreg = P * nreg + nloc[(size_t)(chain * nseg + i) * 256 + tid];
    }
    if (tid < 256) nst[tid] = nreg;
#pragma unroll
    for (int dd = 0; dd < 2; ++dd)
#pragma unroll
        for (int et = 0; et < 4; ++et) { const int e = et * 16 + li, d = (2 * wave + dd) * 16 + 4 * kg;
            *(LAS unsigned long long*)(CT + e * ML_QS + d) = (unsigned long long)pk2(cst[dd][et][0], cst[dd][et][1]) | ((unsigned long long)pk2(cst[dd][et][2], cst[dd][et][3]) << 32); }
    const int tt = wave >> 1, x0 = 2 * (wave & 1);
    v4u pq[4], pk[4], pv; float pw, pgb = 0.f, pga = 0.f, pgm = 0.f;
#define ML_LOAD(ci_) do { const int ci__ = (ci_); \
        _Pragma("unroll") for (int i = 0; i < 4; ++i) { const int idx = tid + 512 * i, tau = idx >> 5, c8 = idx & 31; const int pos = ci__ * 64 + tau; const size_t tok = (size_t)seq * T + (dir ? T - 1 - pos : pos); \
            pq[i] = *(const GAS v4u*)(qc + tok * 1024 + h * 256 + c8 * 8); pk[i] = *(const GAS v4u*)(kc + tok * 1024 + h * 256 + c8 * 8); } \
        { const int tau = tid >> 3, c8 = tid & 7; const int pos = ci__ * 64 + tau; const size_t tok = (size_t)seq * T + (dir ? T - 1 - pos : pos); \
            pv = *(const GAS v4u*)(qkvob + tok * 4096 + 2048 + h * 256 + es * 64 + c8 * 8); pw = gs[GS_STRIDE + (size_t)chain * T + pos]; } \
        if (tid < 64) { const size_t o_ = (size_t)chain * T + ci__ * 64 + tid; pgb = gs[o_]; pga = gs[GS_STRIDE + o_]; pgm = gs[2 * GS_STRIDE + o_]; } } while (0)
    ML_LOAD(seg * 16);
    for (int cc = 0; cc < 16; ++cc) {
        const int ci = seg * 16 + cc;
#pragma unroll
        for (int i = 0; i < 4; ++i) { const int idx = tid + 512 * i, tau = idx >> 5, c8 = idx & 31; *(LAS v4u*)(Qs + tau * ML_QS + c8 * 8) = pq[i]; *(LAS v4u*)(Ks + tau * ML_QS + c8 * 8) = pk[i]; }
        const float cB = cm[ci], cmp = cm[128 + ci], cmn = cm[256 + ci];
        { const int tau = tid >> 3, c8 = tid & 7; *(LAS v4u*)(Vs + tau * ML_VS + c8 * 8) = pv; const float w = __expf(cB + pw - cmn);
            v4u o; o.x = pk2(bf_lo(pv.x) * w, bf_hi(pv.x) * w); o.y = pk2(bf_lo(pv.y) * w, bf_hi(pv.y) * w); o.z = pk2(bf_lo(pv.z) * w, bf_hi(pv.z) * w); o.w = pk2(bf_lo(pv.w) * w, bf_hi(pv.w) * w);
            *(LAS v4u*)(WV + tau * ML_VS + c8 * 8) = o; }
        if (tid < 64) { const float mrow = fmaxf(pgb + cmp, pgb + pgm);
            vec[tid] = pgb; vec[64 + tid] = pga; vec[128 + tid] = mrow; vec[192 + tid] = __expf(cB + pga - cmn); vec[256 + tid] = __expf(pgb + cmp - mrow); vec[320 + tid] = 0.f; }
        const float decay = __expf(cB + cmp - cmn);
        __syncthreads();
        if (cc + 1 < 16) ML_LOAD(ci + 1);
        { const int t = tid >> 3, part = tid & 7; float qn = 0.f;
#pragma unroll
            for (int c8 = 0; c8 < 4; ++c8) { const v4u qv = *(const LAS v4u*)(Qs + t * ML_QS + part * 32 + c8 * 8);
#pragma unroll
                for (int x = 0; x < 4; ++x) qn += bf_lo(qv[x]) * nst[part * 32 + c8 * 8 + 2 * x] + bf_hi(qv[x]) * nst[part * 32 + c8 * 8 + 2 * x + 1]; }
            qn += __shfl_xor(qn, 1); qn += __shfl_xor(qn, 2); qn += __shfl_xor(qn, 4);
            if (part == 0) __hip_atomic_fetch_add(&vec[320 + t], vec[256 + t] * qn, __ATOMIC_RELAXED, __HIP_MEMORY_SCOPE_WORKGROUP); }
        bf16x8 qf[8];
#pragma unroll
        for (int ks = 0; ks < 8; ++ks) qf[ks] = __builtin_bit_cast(bf16x8, *(const LAS v4u*)(Qs + (tt * 16 + li) * ML_QS + ks * 32 + 8 * kg));
        { const int t = tt * 16 + li; const float bt = vec[t], mrt = vec[128 + t]; float rsum = 0.f;
#pragma unroll
            for (int x = 0; x < 2; ++x) { const int st = x0 + x; f32x4 a = (f32x4){0.f, 0.f, 0.f, 0.f};
#pragma unroll
                for (int ks = 0; ks < 8; ++ks) a = MFMA16(__builtin_bit_cast(bf16x8, *(const LAS v4u*)(Ks + (st * 16 + li) * ML_QS + ks * 32 + 8 * kg)), qf[ks], a);
                float v[4];
#pragma unroll
                for (int r = 0; r < 4; ++r) { const int s = st * 16 + 4 * kg + r; v[r] = (s <= t) ? a[r] * __expf(bt + vec[64 + s] - mrt) : 0.f; rsum += v[r]; }
                *(LAS unsigned long long*)(ST + t * ML_VS + st * 16 + 4 * kg) = (unsigned long long)pk2(v[0], v[1]) | ((unsigned long long)pk2(v[2], v[3]) << 32); }
            rsum += __shfl_xor(rsum, 16); rsum += __shfl_xor(rsum, 32);
            if (kg == 0) __hip_atomic_fetch_add(&vec[320 + t], rsum, __ATOMIC_RELAXED, __HIP_MEMORY_SCOPE_WORKGROUP); }
        f32x4 accn[2];
#pragma unroll
        for (int x = 0; x < 2; ++x) { const int et = x0 + x; f32x4 a = (f32x4){0.f, 0.f, 0.f, 0.f};
#pragma unroll
            for (int ks = 0; ks < 8; ++ks) a = MFMA16(qf[ks], __builtin_bit_cast(bf16x8, *(const LAS v4u*)(CT + (et * 16 + li) * ML_QS + ks * 32 + 8 * kg)), a);
#pragma unroll
            for (int r = 0; r < 4; ++r) a[r] *= vec[256 + tt * 16 + 4 * kg + r];
            accn[x] = a; }
        __syncthreads();
#pragma unroll
        for (int ks = 0; ks < 2; ++ks) { const bf16x8 sa = __builtin_bit_cast(bf16x8, *(const LAS v4u*)(ST + (tt * 16 + li) * ML_VS + ks * 32 + 8 * kg));
#pragma unroll
            for (int x = 0; x < 2; ++x) { const LAS bf16* p = Vs + (ks * 32 + 8 * kg + qq) * ML_VS + (x0 + x) * 16 + 4 * pp; accn[x] = MFMA16(sa, tr_pair(p, p + 4 * ML_VS), accn[x]); } }
#pragma unroll
        for (int r = 0; r < 4; ++r) { const int t = tt * 16 + 4 * kg + r; const float den = fmaxf(fabsf(vec[320 + t]), __expf(-vec[128 + t])); const float inv = 1.0f / den;
            const int pos = ci * 64 + t; const size_t tok = (size_t)seq * T + (dir ? T - 1 - pos : pos);
#pragma unroll
            for (int x = 0; x < 2; ++x) hout[tok * 1024 + h * 256 + es * 64 + (x0 + x) * 16 + li] = accn[x][r] * inv; }
        ml_cupdate(cst, Ks, WV, decay, wave, kg, qq, pp);
#pragma unroll
        for (int dd = 0; dd < 2; ++dd)
#pragma unroll
            for (int et = 0; et < 4; ++et) { const int e = et * 16 + li, d = (2 * wave + dd) * 16 + 4 * kg;
                *(LAS unsigned long long*)(CT + e * ML_QS + d) = (unsigned long long)pk2(cst[dd][et][0], cst[dd][et][1]) | ((unsigned long long)pk2(cst[dd][et][2], cst[dd][et][3]) << 32); }
        if (tid < 256) { float a = decay * nst[tid];
#pragma unroll 8
            for (int s = 0; s < 64; ++s) a += vec[192 + s] * __uint_as_float(((unsigned)Ks[s * ML_QS + tid]) << 16);
            nst[tid] = a; }
        __syncthreads();
    }
#undef ML_LOAD
}

#ifndef KNOB_NO_ROW
#define KNOB_NO_ROW 0
#endif
#ifndef KNOB_NO_WIN
#define KNOB_NO_WIN 0
#endif
#ifndef KNOB_NO_PREP
#define KNOB_NO_PREP 0
#endif
#ifndef KNOB_NO_ML
#define KNOB_NO_ML 0
#endif
#ifndef KNOB_NO_NA
#define KNOB_NO_NA 0
#endif
#ifndef KNOB_NO_SG
#define KNOB_NO_SG 0
#endif
#ifndef KNOB_NO_COMB
#define KNOB_NO_COMB 0
#endif
#ifndef KNOB_NO_MERGE
#define KNOB_NO_MERGE 0
#endif
#ifndef KNOB_NO_WOUT
#define KNOB_NO_WOUT 0
#endif
#ifndef KNOB_NO_UP
#define KNOB_NO_UP 0
#endif
#ifndef KNOB_NO_DOWN
#define KNOB_NO_DOWN 0
#endif
#ifndef KNOB_NO_P0
#define KNOB_NO_P0 0
#endif
#ifndef USE_NA_FAST
#define USE_NA_FAST 1
#endif
#ifndef USE_SG_FAST
#define USE_SG_FAST 1
#endif
#ifndef REP_WIN
#define REP_WIN 1
#endif
#ifndef REP_MERGE
#define REP_MERGE 1
#endif
#ifndef REP_WOUT
#define REP_WOUT 1
#endif
#ifndef REP_UP
#define REP_UP 1
#endif
#ifndef REP_DOWN
#define REP_DOWN 1
#endif
#ifndef REP_MIX1
#define REP_MIX1 1
#endif
#ifndef REP_MIX2
#define REP_MIX2 1
#endif
#ifndef REP_PREP
#define REP_PREP 1
#endif
#ifndef REP_COMB
#define REP_COMB 1
#endif
#ifndef REP_BAR
#define REP_BAR 1
#endif
#ifndef USE_ML_FAST
#define USE_ML_FAST 1
#endif
constexpr int STEPS_PER = 12, N_STEPS = 1 + NSLAB * DEPTH * STEPS_PER;
__global__ void __launch_bounds__(NWAVES * 64, 2) trunk_fwd(Args args) {
    extern __shared__ __attribute__((aligned(16))) unsigned char lds[];
#define MKF() Frame F; { int t_ = threadIdx.x; asm volatile("" : "+v"(t_)); F.lds = (LAS unsigned char*)lds; F.tid = t_; F.lane = t_ & 63; F.wave = __builtin_amdgcn_readfirstlane(t_ >> 6); \
        F.G = gridDim.x; const int bx_ = blockIdx.x; F.vcu = (F.G % 8 == 0) ? (bx_ % 8) * (F.G / 8) + bx_ / 8 : bx_; }
#define ARGS() ({ const __attribute__((address_space(4))) Args* _p = (const __attribute__((address_space(4))) Args*)__builtin_amdgcn_kernarg_segment_ptr(); asm volatile("" : "+s"(_p)); _p; })
    gu32* ctl = (gu32*)(ARGS()->ws + WS_CTL);
    for (int u = threadIdx.x; u < (LDS_BYTES - LDSCTL_OFF) / 4; u += NWAVES * 64) ((LAS unsigned*)((LAS unsigned char*)lds + LDSCTL_OFF))[u] = 0u;
    __syncthreads();
    volatile LAS unsigned* MISC = (volatile LAS unsigned*)((LAS unsigned char*)lds + MISC_OFF);
    XcdBarrier bar = xcd_barrier_post((unsigned*)ctl + CW_BAR, MISC + 8);
    const int lo = ARGS()->ph_lo, hi = ARGS()->ph_hi;
#define IN(k) (lo <= (k) && (k) < hi)
#define SEAM(k) do { if (IN(k) && IN((k) + 1)) { _Pragma("unroll") for (int rb_ = 0; rb_ < REP_BAR; ++rb_) xcd_barrier(bar); } } while (0)

#define WSB(T_, off) ((T_*)(A->ws + (off)))
#define Hb WSB(bf16, WS_H)
#define QKVA WSB(bf16, WS_QKVA)
#define QKVOB WSB(bf16, WS_QKVOB)
#define ZUV WSB(bf16, WS_ZUV)
#define Ub WSB(bf16, WS_U)
#define Gb WSB(bf16, WS_G)
#define GATES WSB(float, WS_GATES)
#define SGR WSB(float, WS_SGR)
#define QC WSB(bf16, WS_QC)
#define KC WSB(bf16, WS_KC)
#define Yb WSB(bf16, WS_Y)
#define HF WSB(float, WS_HF)
#define HB WSB(float, WS_HB)
#define MRG WSB(float, WS_MRG)
#define MRGB WSB(bf16, WS_MRGB)
#define Tb WSB(float, WS_T)
#define GSb WSB(float, WS_GS)
#define GDb WSB(float, WS_GD)
#define LSTb WSB(float, WS_LST)
#define NLOCb WSB(float, WS_NLOC)

    if (IN(0) && !KNOB_NO_P0) { MKF();
        LAS float* scr = (LAS float*)(F.lds + RING_OFF + F.wave * 16384);
        for (int l = 0; l < DEPTH; ++l) {
            const auto* A = ARGS(); unsigned char* wl = A->ws + WS_W + (size_t)l * WL_BYTES;
            p0_win(F, A->w_in + (size_t)l * D * D_IN, (bf16*)(wl + WL_IN), scr);
            p0_matrix(F, A->w_a + (size_t)l * NA_W * D, NA_W, D, (bf16*)(wl + WL_ABC), scr);
            p0_matrix(F, A->w_b + (size_t)l * ML_W * D, ML_W, D, (bf16*)(wl + WL_ABC) + (size_t)D * 1024, scr);
            p0_matrix(F, A->w_c + (size_t)l * SG_W * D, SG_W, D, (bf16*)(wl + WL_ABC) + (size_t)2 * D * 1024, scr);
            p0_matrix(F, A->w_out + (size_t)l * D * D, D, D, (bf16*)(wl + WL_OUT), scr);
            p0_matrix(F, A->w_up + (size_t)l * D * DFF, D, DFF, (bf16*)(wl + WL_UP), scr);
            p0_matrix(F, A->w_down + (size_t)l * DFF * D, DFF, D, (bf16*)(wl + WL_DN), scr);
        }
    }
    SEAM(0);

    for (int s = 0; s < NSLAB; ++s) {
        const int T = s < 4 ? 4096 : 8192, nseq = MS / T;
        for (int l = 0; l < DEPTH; ++l) {
            const int sb = 1 + (s * DEPTH + l) * STEPS_PER;
            if (sb + STEPS_PER <= lo || sb >= hi) continue;
#define XIN0 (s < 4 ? A->x_prompt + (size_t)s * MS * D : A->x_sample + (size_t)(s - 4) * MS * D)
#define XO (A->out + (size_t)s * MS * D)
#define WL (A->ws + WS_W + (size_t)l * WL_BYTES)
            if (IN(sb + 0) && l == 0 && !KNOB_NO_ROW) { MKF(); const auto* A = ARGS(); row_phase(F, XIN0, nullptr, nullptr, nullptr, A->pre_mix_g, Hb); }
            SEAM(sb + 0);
            if (IN(sb + 1) && !KNOB_NO_WIN) { MKF(); const auto* A = ARGS();
                pg8::Gemm g{Hb, (const bf16*)(WL + WL_IN), MS, N_IN_PAD, D, 0, 0}; pg8::StaticOrder S; S.init(MS, N_IN_PAD, (int)gridDim.x, (int)blockIdx.x);
                pg8::EpiIn E{QKVA, QKVOB, ZUV, Gb, GATES, A->b_gate + l * 16};
                _Pragma("unroll") for (int rep_ = 0; rep_ < REP_WIN; ++rep_) pg8::gemm_phase<pg8::EpiIn, pg8::StaticOrder, true, true>((PG8_LAS unsigned char*)lds + RING_OFF, g, S, E);
            }
            SEAM(sb + 1);
            if (IN(sb + 2) && !KNOB_NO_PREP) { MKF(); const auto* A = ARGS(); _Pragma("unroll") for (int rep_ = 0; rep_ < REP_PREP; ++rep_) { prep_phase(F, QKVOB, A->conv_w + (size_t)l * 3 * 2048, QC, KC, ZUV, SGR, T); if (USE_ML_FAST) ml_gate_local(F, GATES, GSb, GDb, T, nseq * 8); } }
            SEAM(sb + 2);
            if (IN(sb + 3)) { MKF(); const auto* A = ARGS();
                if (USE_ML_FAST) {
                  _Pragma("unroll") for (int rep_ = 0; rep_ < REP_MIX1; ++rep_) {
                    for (int unit = F.vcu; unit < 256; unit += F.G) ml_phaseA(F, unit, KC, QKVOB, GSb, GDb, LSTb, NLOCb, T);
                    const int gw = F.vcu * NWAVES + F.wave, NGW = F.G * NWAVES;
                    na_fast(F, QKVA, A->na_rpb + (size_t)l * 8 * 15 * 31, Yb, T, gw, NGW);
                    sg_fast(F, ZUV, SGR, A->sg_norm_g + l * 1024, A->w_s + (size_t)l * 8 * 128 * 128, A->b_s + l * 1024, Yb + (size_t)2 * MS * 1024, F.vcu, F.G);
                  }
                } else {
                    const int nml = nseq * 32;
                    if (F.vcu < nml) mlstm_naive(F, F.vcu, QC, KC, QKVOB, GATES, HF, HB, T);
                    else { const int gw = (F.vcu - nml) * NWAVES + F.wave, NGW = (F.G - nml) * NWAVES;
                        na_fast(F, QKVA, A->na_rpb + (size_t)l * 8 * 15 * 31, Yb, T, gw, NGW);
                        sg_fast(F, ZUV, SGR, A->sg_norm_g + l * 1024, A->w_s + (size_t)l * 8 * 128 * 128, A->b_s + l * 1024, Yb + (size_t)2 * MS * 1024, F.vcu - nml, F.G - nml); }
                }
            }
            SEAM(sb + 3);
            if (IN(sb + 4) && USE_ML_FAST) { MKF(); const auto* A = ARGS();
                _Pragma("unroll") for (int rep_ = 0; rep_ < REP_MIX2; ++rep_) for (int unit = F.vcu; unit < 256; unit += F.G) ml_phaseC(F, unit, QC, KC, QKVOB, GSb, GDb, LSTb, NLOCb, HF, HB, T);
            }
            SEAM(sb + 4);
            if (IN(sb + 5) && !KNOB_NO_COMB) { MKF(); const auto* A = ARGS(); _Pragma("unroll") for (int rep_ = 0; rep_ < REP_COMB; ++rep_) comb_phase(F, HF, HB, QKVOB, A->ml_norm_g + l * 1024, Yb + (size_t)MS * 1024); }
            SEAM(sb + 5);
            if (IN(sb + 6) && !KNOB_NO_MERGE) { MKF(); const auto* A = ARGS();
                pg8::Gemm g{Yb, (const bf16*)(WL + WL_ABC), MS, D, 1024, (size_t)MS * 1024 * 2, (size_t)D * 1024 * 2}; pg8::ZOrder<3> S; S.init(MS, D, (int)gridDim.x, (int)blockIdx.x);
                pg8::EpiMerge E{Gb, MRG, MRGB};
                _Pragma("unroll") for (int rep_ = 0; rep_ < REP_MERGE; ++rep_) pg8::gemm_phase<pg8::EpiMerge, pg8::ZOrder<3>, true, true>((PG8_LAS unsigned char*)lds + RING_OFF, g, S, E);
            }
            SEAM(sb + 6);
            if (IN(sb + 7) && !KNOB_NO_WOUT) { MKF(); const auto* A = ARGS();
                pg8::Gemm g{MRGB, (const bf16*)(WL + WL_OUT), MS, D, D, 0, 0}; pg8::StaticOrder S; S.init(MS, D, (int)gridDim.x, (int)blockIdx.x);
                pg8::EpiF32 E{Tb, D};
                _Pragma("unroll") for (int rep_ = 0; rep_ < REP_WOUT; ++rep_) pg8::gemm_phase<pg8::EpiF32, pg8::StaticOrder, true, true>((PG8_LAS unsigned char*)lds + RING_OFF, g, S, E);
            }
            SEAM(sb + 7);
            if (IN(sb + 8) && !KNOB_NO_ROW) { MKF(); const auto* A = ARGS(); row_phase(F, l == 0 ? XIN0 : XO, Tb, A->post_mix_g + l * D, XO, A->pre_mlp_g + l * D, Hb); }
            SEAM(sb + 8);
            if (IN(sb + 9) && !KNOB_NO_UP) { MKF(); const auto* A = ARGS();
                pg8::Gemm g{Hb, (const bf16*)(WL + WL_UP), MS, DFF, D, 0, 0}; pg8::StaticOrder S; S.init(MS, DFF, (int)gridDim.x, (int)blockIdx.x);
                pg8::EpiRelu2 E{Ub, DFF};
                _Pragma("unroll") for (int rep_ = 0; rep_ < REP_UP; ++rep_) pg8::gemm_phase<pg8::EpiRelu2, pg8::StaticOrder, true, true>((PG8_LAS unsigned char*)lds + RING_OFF, g, S, E);
            }
            SEAM(sb + 9);
            if (IN(sb + 10) && !KNOB_NO_DOWN) { MKF(); const auto* A = ARGS();
                pg8::Gemm g{Ub, (const bf16*)(WL + WL_DN), MS, D, DFF, 0, 0}; pg8::StaticOrder S; S.init(MS, D, (int)gridDim.x, (int)blockIdx.x);
                pg8::EpiF32 E{Tb, D};
                _Pragma("unroll") for (int rep_ = 0; rep_ < REP_DOWN; ++rep_) pg8::gemm_phase<pg8::EpiF32, pg8::StaticOrder, true, true>((PG8_LAS unsigned char*)lds + RING_OFF, g, S, E);
            }
            SEAM(sb + 10);
            if (IN(sb + 11) && !KNOB_NO_ROW) { MKF(); const auto* A = ARGS(); row_phase(F, XO, Tb, A->post_mlp_g + l * D, XO, l + 1 < DEPTH ? A->pre_mix_g + (l + 1) * D : nullptr, l + 1 < DEPTH ? Hb : nullptr); }
            SEAM(sb + 11);
        }
    }
#undef IN
#undef SEAM
}

#ifndef MK_LAUNCH_PER_STEP
#define MK_LAUNCH_PER_STEP 0
#endif
extern "C" void kernel_launch(void* const* d_in, const int* in_sizes, int n_in, void* d_out, int out_size, void* d_ws, size_t ws_size, hipStream_t stream) {
    static int grid = 0;
    if (grid == 0) {
        if (n_in != 20 || in_sizes[0] != M_PROMPT * D || in_sizes[1] != M_SAMPLE * D || out_size != M_ALL * D || ws_size < WS_END) {
            fprintf(stderr, "kernel_launch: unexpected shapes (n_in %d, in0 %d, in1 %d, out %d, ws %zu); nothing launched\n", n_in, n_in > 0 ? in_sizes[0] : -1, n_in > 1 ? in_sizes[1] : -1, out_size, ws_size); grid = -1; return; }
        int dev = 0, cus = 0;
        if (hipGetDevice(&dev) != hipSuccess || hipDeviceGetAttribute(&cus, hipDeviceAttributeMultiprocessorCount, dev) != hipSuccess) { grid = -1; return; }
        if (hipFuncSetAttribute((const void*)trunk_fwd, hipFuncAttributeMaxDynamicSharedMemorySize, LDS_BYTES) != hipSuccess) { fprintf(stderr, "kernel_launch: hipFuncSetAttribute failed\n"); grid = -1; return; }
        int per_cu = 0;
        if (hipOccupancyMaxActiveBlocksPerMultiprocessor(&per_cu, (const void*)trunk_fwd, NWAVES * 64, LDS_BYTES) != hipSuccess || per_cu < 1)
            fprintf(stderr, "kernel_launch: note: occupancy query reports %d workgroups per CU\n", per_cu);
        (void)hipGetLastError();
        grid = cus;
    }
    if (grid < 0) return;
    if (hipMemsetAsync((char*)d_ws + WS_CTL, 0, CTL_ZERO_BYTES, stream) != hipSuccess) return;
    Args a{};
    a.x_prompt = (const float*)d_in[0]; a.x_sample = (const float*)d_in[1]; a.pre_mix_g = (const float*)d_in[2]; a.post_mix_g = (const float*)d_in[3];
    a.pre_mlp_g = (const float*)d_in[4]; a.post_mlp_g = (const float*)d_in[5]; a.w_in = (const float*)d_in[6]; a.b_gate = (const float*)d_in[7];
    a.conv_w = (const float*)d_in[8]; a.na_rpb = (const float*)d_in[9]; a.ml_norm_g = (const float*)d_in[10]; a.sg_norm_g = (const float*)d_in[11];
    a.w_s = (const float*)d_in[12]; a.b_s = (const float*)d_in[13]; a.w_a = (const float*)d_in[14]; a.w_b = (const float*)d_in[15]; a.w_c = (const float*)d_in[16];
    a.w_out = (const float*)d_in[17]; a.w_up = (const float*)d_in[18]; a.w_down = (const float*)d_in[19];
    a.out = (float*)d_out; a.ws = (unsigned char*)d_ws;
#if MK_LAUNCH_PER_STEP
    for (int k = 0; k < N_STEPS; ++k) { a.ph_lo = k; a.ph_hi = k + 1; hipLaunchKernelGGL(trunk_fwd, dim3(grid), dim3(NWAVES * 64), LDS_BYTES, stream, a); }
#else
    a.ph_lo = 0; a.ph_hi = N_STEPS;
    hipLaunchKernelGGL(trunk_fwd, dim3(grid), dim3(NWAVES * 64), LDS_BYTES, stream, a);
#endif
}
```

```cpp
#include <hip/hip_runtime.h>
#include <cstdio>
#include <cstdint>
namespace pg8 {
#define PG8_LAS __attribute__((address_space(3)))
typedef unsigned short bf16_t;
typedef short bf16x8 __attribute__((ext_vector_type(8)));
typedef float f32x4 __attribute__((ext_vector_type(4)));
typedef unsigned u32x4 __attribute__((ext_vector_type(4)));
typedef unsigned u32x2 __attribute__((ext_vector_type(2)));
constexpr int BM = 256, BK = 64, HALF = 128, HTB = HALF * BK * 2  , STAGE_BYTES = 8 * HTB, NXCD = 8, WGM = 8;

__host__ __device__ __forceinline__ int lds_byte(int r, int c) { const int st = (r >> 4) * 2 + (c >> 5), rr = r & 15, cc = c & 31, ob = rr * 64 + cc * 2; return st * 1024 + (ob ^ (((ob >> 9) & 1) << 5)); }
__host__ __device__ __forceinline__ void stage_rc(int b, int& R, int& C) { const int st = b / 1024, sb = b % 1024, swz = sb ^ (((sb >> 9) & 1) << 5); R = (st >> 1) * 16 + swz / 64; C = (st & 1) * 32 + (swz % 64) / 2; }
__host__ __device__ __forceinline__ int perm32(int rho) { const int n = rho >> 4, i = rho & 15; return 8 * (i >> 2) + 4 * n + (i & 3); }

struct Unit { int pm, pn, z; };
struct Gemm { const bf16_t* A; const bf16_t* Bt; int M, N, K; size_t zA, zB; };

struct StaticOrder {
    int nM, nN, nwg, G, c;
    __host__ __device__ void init(int M, int N, int G_, int c_) { nM = M / BM; nN = N / BM; nwg = nM * nN; G = G_; c = c_; }
    __host__ __device__ bool tile(long L, Unit& u) const {
        if (L >= nwg) return false;
        int wgid = (int)L; { const int q = nwg / NXCD, r = nwg % NXCD, xcd = wgid % NXCD, off = wgid / NXCD; wgid = (xcd < r ? xcd * (q + 1) : r * (q + 1) + (xcd - r) * q) + off; }
        const int nig = WGM * nN, gid = wgid / nig, fm = gid * WGM, gsz = (nM - fm) < WGM ? (nM - fm) : WGM;
        u.pm = fm + ((wgid % nig) % gsz); u.pn = (wgid % nig) / gsz; return true;
    }
    __host__ __device__ bool next(int i, Unit& u) const { u.z = 0; return tile((long)i * G + c, u); }
    __device__ __forceinline__ void a_ready(const Unit&) const {}
    __device__ __forceinline__ void done(const Unit&) const {}
};
template <int NZ> struct ZOrder : StaticOrder {
    __host__ __device__ bool next(int i, Unit& u) const { const int k = i / NZ; u.z = i - k * NZ; return tile((long)k * G + c, u); }
};

__device__ __forceinline__ unsigned cvt_pk_bf16(float lo, float hi) { unsigned r; asm volatile("v_cvt_pk_bf16_f32 %0, %1, %2" : "=v"(r) : "v"(lo), "v"(hi)); return r; }
__device__ __forceinline__ float sigm(float x) { return __builtin_amdgcn_rcpf(1.0f + __builtin_amdgcn_exp2f(-1.4426950408889634f * x)); }
__device__ __forceinline__ float gelu_tanh(float x) { return x * sigm(1.5957691216057308f * x * (1.0f + 0.044715f * x * x)); }
__device__ __forceinline__ float act_apply(int act, float x) { return act == 1 ? sigm(x) : (act == 2 ? gelu_tanh(x) : x); }

struct EpiIn {
    static constexpr bool PERM = true, AFTER_DRAIN = false;
    __device__ static __forceinline__ bool keep(const Unit&) { return false; }
    bf16_t *qkva, *qkvob, *zuv, *g; float* gates; const float* bgate;
    __device__ __forceinline__ void operator()(const f32x4 (&acc)[2][2][4][2], const Unit& u, int wr, int wc, int fr, int fq) const {
        const int pn = u.pn, row0 = u.pm * BM + wr * 64 + fr;
        if (pn == 60) {
            if (wc == 0 && fq < 2) {
#pragma unroll
                for (int ai = 0; ai < 2; ++ai)
#pragma unroll
                    for (int m = 0; m < 4; ++m)
#pragma unroll
                        for (int n = 0; n < 2; ++n) { const int col = 8 * fq + 4 * n; *(f32x4*)(gates + (size_t)(row0 + ai * HALF + m * 16) * 16 + col) = acc[ai][0][m][n] + *(const f32x4*)(bgate + col); }
            }
            return;
        }
        bf16_t* base; int ldc, colt, act;
        if (pn < 12) { base = qkva; ldc = 3072; colt = pn * BM; act = 0; }
        else if (pn < 28) { base = qkvob; ldc = 4096; colt = (pn - 12) * BM; act = pn >= 24 ? 1 : 0; }
        else if (pn < 36) { base = zuv; ldc = 2048; colt = (pn - 28) * BM; act = 2; }
        else { base = g; ldc = 6144; colt = (pn - 36) * BM; act = 1; }
        const int col0 = colt + wc * 32 + 8 * fq;
#pragma unroll
        for (int ai = 0; ai < 2; ++ai)
#pragma unroll
            for (int m = 0; m < 4; ++m) { bf16_t* rowp = base + (size_t)(row0 + ai * HALF + m * 16) * ldc + col0;
#pragma unroll
                for (int bj = 0; bj < 2; ++bj) { f32x4 v0 = acc[ai][bj][m][0], v1 = acc[ai][bj][m][1];
                    if (act != 0) {
#pragma unroll
                        for (int j = 0; j < 4; ++j) { v0[j] = act_apply(act, v0[j]); v1[j] = act_apply(act, v1[j]); } }
                    u32x4 w; w.x = cvt_pk_bf16(v0[0], v0[1]); w.y = cvt_pk_bf16(v0[2], v0[3]); w.z = cvt_pk_bf16(v1[0], v1[1]); w.w = cvt_pk_bf16(v1[2], v1[3]);
                    *(u32x4*)(rowp + bj * HALF) = w; } }
    }
};
struct EpiMerge {
    static constexpr bool PERM = false, AFTER_DRAIN = false;
    __device__ static __forceinline__ bool keep(const Unit&) { return false; }
    const bf16_t* g; float* mrg; bf16_t* mrgb;
    __device__ __forceinline__ void operator()(const f32x4 (&acc)[2][2][4][2], const Unit& u, int wr, int wc, int fr, int fq) const {
        const int z = u.z, row0 = u.pm * BM + wr * 64 + fr, col0 = u.pn * BM + wc * 32 + 4 * fq;
#pragma unroll
        for (int ai = 0; ai < 2; ++ai)
#pragma unroll
            for (int m = 0; m < 4; ++m) { const size_t row = (size_t)(row0 + ai * HALF + m * 16);
#pragma unroll
                for (int bj = 0; bj < 2; ++bj)
#pragma unroll
                    for (int n = 0; n < 2; ++n) { const int col = col0 + bj * HALF + n * 16;
                        const u32x2 gw = *(const u32x2*)(g + row * 6144 + (size_t)z * 2048 + col);
                        f32x4 gv; gv[0] = __uint_as_float(gw.x << 16); gv[1] = __uint_as_float(gw.x & 0xffff0000u); gv[2] = __uint_as_float(gw.y << 16); gv[3] = __uint_as_float(gw.y & 0xffff0000u);
                        f32x4 v = acc[ai][bj][m][n] * gv;
                        if (z > 0) v += *(const f32x4*)(mrg + row * 2048 + col);
                        if (z < 2) *(f32x4*)(mrg + row * 2048 + col) = v;
                        else { u32x2 w; w.x = cvt_pk_bf16(v[0], v[1]); w.y = cvt_pk_bf16(v[2], v[3]); *(u32x2*)(mrgb + row * 2048 + col) = w; } }
                asm volatile("" ::: "memory"); }
    }
};
struct EpiMergeH {
    static constexpr bool PERM = true, AFTER_DRAIN = false;
    const bf16_t* g; bf16_t* mrgb;
    __device__ static __forceinline__ bool keep(const Unit& u) { return u.z < 2; }
    __device__ __forceinline__ void operator()(f32x4 (&acc)[2][2][4][2], const Unit& u, int wr, int wc, int fr, int fq) const {
        const int z = u.z, row0 = u.pm * BM + wr * 64 + fr, col0 = u.pn * BM + wc * 32 + 8 * fq;
#pragma unroll
        for (int ai = 0; ai < 2; ++ai)
#pragma unroll
            for (int m = 0; m < 4; ++m) { const size_t row = (size_t)(row0 + ai * HALF + m * 16);
#pragma unroll
                for (int bj = 0; bj < 2; ++bj) { const int col = col0 + bj * HALF;
                    const u32x4 gz = *(const u32x4*)(g + row * 6144 + (size_t)z * 2048 + col);
                    float f[8];
                    if (z < 2) { const u32x4 gn = *(const u32x4*)(g + row * 6144 + (size_t)(z + 1) * 2048 + col);
#pragma unroll
                        for (int j = 0; j < 4; ++j) { f[2 * j] = __uint_as_float(gz[j] << 16) * __builtin_amdgcn_rcpf(fmaxf(__uint_as_float(gn[j] << 16), 1e-30f));
                            f[2 * j + 1] = __uint_as_float(gz[j] & 0xffff0000u) * __builtin_amdgcn_rcpf(fmaxf(__uint_as_float(gn[j] & 0xffff0000u), 1e-30f)); }
                    } else {
#pragma unroll
                        for (int j = 0; j < 4; ++j) { f[2 * j] = __uint_as_float(gz[j] << 16); f[2 * j + 1] = __uint_as_float(gz[j] & 0xffff0000u); } }
#pragma unroll
                    for (int j = 0; j < 4; ++j) { acc[ai][bj][m][0][j] *= f[j]; acc[ai][bj][m][1][j] *= f[4 + j]; }
                    if (z == 2) { const f32x4 v0 = acc[ai][bj][m][0], v1 = acc[ai][bj][m][1];
                        u32x4 w; w.x = cvt_pk_bf16(v0[0], v0[1]); w.y = cvt_pk_bf16(v0[2], v0[3]); w.z = cvt_pk_bf16(v1[0], v1[1]); w.w = cvt_pk_bf16(v1[2], v1[3]);
                        *(u32x4*)(mrgb + row * 2048 + col) = w; } }
                asm volatile("" ::: "memory"); }
    }
};
struct EpiF32 {
    static constexpr bool PERM = false, AFTER_DRAIN = false;
    __device__ static __forceinline__ bool keep(const Unit&) { return false; }
    float* C; int ldc;
    __device__ __forceinline__ void operator()(const f32x4 (&acc)[2][2][4][2], const Unit& u, int wr, int wc, int fr, int fq) const {
        const int row0 = u.pm * BM + wr * 64 + fr, col0 = u.pn * BM + wc * 32 + 4 * fq;
#pragma unroll
        for (int ai = 0; ai < 2; ++ai)
#pragma unroll
            for (int m = 0; m < 4; ++m) { float* rowp = C + (size_t)(row0 + ai * HALF + m * 16) * ldc + col0;
#pragma unroll
                for (int bj = 0; bj < 2; ++bj)
#pragma unroll
                    for (int n = 0; n < 2; ++n) *(f32x4*)(rowp + bj * HALF + n * 16) = acc[ai][bj][m][n]; }
    }
};
struct EpiRelu2 {
    static constexpr bool PERM = true, AFTER_DRAIN = false;
    __device__ static __forceinline__ bool keep(const Unit&) { return false; }
    bf16_t* O; int ldc;
    __device__ __forceinline__ void operator()(const f32x4 (&acc)[2][2][4][2], const Unit& u, int wr, int wc, int fr, int fq) const {
        const int row0 = u.pm * BM + wr * 64 + fr, col0 = u.pn * BM + wc * 32 + 8 * fq;
#pragma unroll
        for (int ai = 0; ai < 2; ++ai)
#pragma unroll
            for (int m = 0; m < 4; ++m) { bf16_t* rowp = O + (size_t)(row0 + ai * HALF + m * 16) * ldc + col0;
#pragma unroll
                for (int bj = 0; bj < 2; ++bj) { f32x4 v0 = acc[ai][bj][m][0], v1 = acc[ai][bj][m][1];
#pragma unroll
                    for (int j = 0; j < 4; ++j) { const float a = fmaxf(v0[j], 0.f), b = fmaxf(v1[j], 0.f); v0[j] = a * a; v1[j] = b * b; }
                    u32x4 w; w.x = cvt_pk_bf16(v0[0], v0[1]); w.y = cvt_pk_bf16(v0[2], v0[3]); w.z = cvt_pk_bf16(v1[0], v1[1]); w.w = cvt_pk_bf16(v1[2], v1[3]);
                    *(u32x4*)(rowp + bj * HALF) = w; } }
    }
};

template <class Epi, class Sched, bool ALIGN_EPI = false, bool SP2 = false>
__device__ __forceinline__ void gemm_phase(PG8_LAS unsigned char* lds, const Gemm g, const Sched& S, const Epi& E) {
    int tid_l = threadIdx.x; asm volatile("" : "+v"(tid_l));
    const int tid = tid_l, wid = __builtin_amdgcn_readfirstlane(tid >> 6), lane = tid & 63, wr = wid >> 2, wc = wid & 3, fr = lane & 15, fq = lane >> 4;
    const int K = g.K, nt = K / BK;
    unsigned voffA[2], voffB[2];
#pragma unroll
    for (int i = 0; i < 2; ++i) { int R, C; stage_rc(tid * 16 + i * 8192, R, C); const int Rb = Epi::PERM ? ((R & ~31) + perm32(R & 31)) : R;
        voffA[i] = (unsigned)(R * K + C) * 2u; voffB[i] = (unsigned)(Rb * K + C) * 2u; }
    const size_t kstep = (size_t)(BK * 2);
    const size_t hstep = (size_t)HALF * K * 2;
    const size_t tstep = 2 * hstep;
    const unsigned ldsw = (unsigned)wid * 1024u;
    const int aoff = lds_byte(wr * 64 + fr, fq * 8), boff = lds_byte(wc * 32 + fr, fq * 8);
#define PG8_SA(b, h) (((b) * 2 + (h)) * HTB)
#define PG8_SB(b, h) ((4 + (b) * 2 + (h)) * HTB)
#define PG8_STAGE(bufoff, gbase, voff) do { _Pragma("unroll") for (int _i = 0; _i < 2; ++_i) \
        __builtin_amdgcn_global_load_lds((const unsigned*)((const char*)(gbase) + (voff)[_i]), (PG8_LAS unsigned*)(lds + (bufoff) + ldsw + _i * 8192), 16, 0, 0); } while (0)
#define PG8_LDA(dst, b, h) do { _Pragma("unroll") for (int m = 0; m < 4; ++m) _Pragma("unroll") for (int k = 0; k < 2; ++k) dst[m][k] = *(const PG8_LAS bf16x8*)(lds + PG8_SA(b, h) + aoff + m * 2048 + k * 1024); } while (0)
#define PG8_LDB(dst, b, h) do { _Pragma("unroll") for (int n = 0; n < 2; ++n) _Pragma("unroll") for (int k = 0; k < 2; ++k) dst[n][k] = *(const PG8_LAS bf16x8*)(lds + PG8_SB(b, h) + boff + n * 2048 + k * 1024); } while (0)
#define PG8_MMA(ai, bj, At, Bt) do { __builtin_amdgcn_s_setprio(1); _Pragma("unroll") for (int m = 0; m < 4; ++m) _Pragma("unroll") for (int n = 0; n < 2; ++n) _Pragma("unroll") for (int k = 0; k < 2; ++k) \
        acc[ai][bj][m][n] = __builtin_amdgcn_mfma_f32_16x16x32_bf16(Bt[n][k], At[m][k], acc[ai][bj][m][n], 0, 0, 0); __builtin_amdgcn_s_setprio(0); } while (0)
#define PG8_WAIT_V(n) asm volatile("s_waitcnt vmcnt(" #n ")" ::: "memory")
#define PG8_WAIT_L(n) asm volatile("s_waitcnt lgkmcnt(" #n ")" ::: "memory")
#define PG8_BAR __builtin_amdgcn_s_barrier()
#define PG8_SCHED __builtin_amdgcn_sched_barrier(0)
    Unit cur, nxt; int ui = 0;
    if (!S.next(0, cur)) return;
    f32x4 acc[2][2][4][2];
#pragma unroll
    for (int a = 0; a < 2; ++a)
#pragma unroll
        for (int b = 0; b < 2; ++b)
#pragma unroll
            for (int m = 0; m < 4; ++m)
#pragma unroll
                for (int n = 0; n < 2; ++n) acc[a][b][m][n] = (f32x4){0.f, 0.f, 0.f, 0.f};
    bf16x8 At[4][2], B0[2][2], B1[2][2];
    const char* cA = (const char*)g.A + (size_t)cur.pm * tstep + (size_t)cur.z * g.zA; const char* cB = (const char*)g.Bt + (size_t)cur.pn * tstep + (size_t)cur.z * g.zB;
    S.a_ready(cur);
    if constexpr (SP2) {
        PG8_STAGE(PG8_SB(0, 0), cB, voffB); PG8_STAGE(PG8_SB(0, 1), cB + hstep, voffB); PG8_STAGE(PG8_SA(0, 0), cA, voffA); PG8_STAGE(PG8_SA(0, 1), cA + hstep, voffA);
        if (wr == 1) PG8_BAR;
        PG8_WAIT_V(2); PG8_BAR;
        PG8_STAGE(PG8_SB(1, 0), cB + kstep, voffB); PG8_STAGE(PG8_SA(1, 0), cA + kstep, voffA); PG8_STAGE(PG8_SB(1, 1), cB + hstep + kstep, voffB);
        PG8_WAIT_V(6); PG8_BAR;
    } else {
        PG8_STAGE(PG8_SB(0, 0), cB, voffB); PG8_STAGE(PG8_SA(0, 0), cA, voffA); PG8_STAGE(PG8_SB(0, 1), cB + hstep, voffB); PG8_STAGE(PG8_SA(0, 1), cA + hstep, voffA);
        if (wr == 1) PG8_BAR;
        PG8_WAIT_V(4); PG8_BAR;
        PG8_STAGE(PG8_SB(1, 0), cB + kstep, voffB); PG8_STAGE(PG8_SA(1, 0), cA + kstep, voffA); PG8_STAGE(PG8_SB(1, 1), cB + hstep + kstep, voffB);
        PG8_WAIT_V(6); PG8_BAR;
    }
    for (;;) {
        const bool has_next = S.next(ui + 1, nxt);
        const char* nA = has_next ? (const char*)g.A + (size_t)nxt.pm * tstep + (size_t)nxt.z * g.zA : cA; const char* nB = has_next ? (const char*)g.Bt + (size_t)nxt.pn * tstep + (size_t)nxt.z * g.zB : cB;
        for (int t = 0; t < nt; t += 2) {
            const bool last = (t == nt - 2);
            const char* a1 = cA + (size_t)(t + 1) * kstep;
            const char* a2 = last ? nA : cA + (size_t)(t + 2) * kstep; const char* b2 = last ? nB : cB + (size_t)(t + 2) * kstep;
            const char* a3 = a2 + kstep; const char* b3 = b2 + kstep;
            if (last && has_next) S.a_ready(nxt);
            if constexpr (SP2) {
            PG8_LDB(B0, 0, 0); PG8_LDB(B1, 0, 1); PG8_SCHED; PG8_LDA(At, 0, 0); PG8_STAGE(PG8_SA(1, 1), a1 + hstep, voffA);
            PG8_WAIT_V(8); PG8_WAIT_L(0); PG8_BAR; PG8_MMA(0, 0, At, B0); PG8_MMA(0, 1, At, B1); PG8_BAR; PG8_SCHED;
            PG8_LDA(At, 0, 1); PG8_STAGE(PG8_SB(0, 0), b2, voffB); PG8_STAGE(PG8_SB(0, 1), b2 + hstep, voffB); PG8_STAGE(PG8_SA(0, 0), a2, voffA);
            PG8_WAIT_V(8); PG8_WAIT_L(0); PG8_BAR; PG8_MMA(1, 0, At, B0); PG8_MMA(1, 1, At, B1); PG8_BAR; PG8_SCHED;
            PG8_LDB(B0, 1, 0); PG8_LDB(B1, 1, 1); PG8_SCHED; PG8_LDA(At, 1, 0); PG8_STAGE(PG8_SA(0, 1), a2 + hstep, voffA);
            PG8_WAIT_V(8); PG8_WAIT_L(0); PG8_BAR; PG8_MMA(0, 0, At, B0); PG8_MMA(0, 1, At, B1); PG8_BAR; PG8_SCHED;
            PG8_LDA(At, 1, 1); PG8_STAGE(PG8_SB(1, 0), b3, voffB); PG8_STAGE(PG8_SB(1, 1), b3 + hstep, voffB); PG8_STAGE(PG8_SA(1, 0), a3, voffA);
            PG8_WAIT_V(8); PG8_WAIT_L(0); PG8_BAR; PG8_MMA(1, 0, At, B0); PG8_MMA(1, 1, At, B1); PG8_BAR; PG8_SCHED;
            } else {
            PG8_LDB(B0, 0, 0); PG8_SCHED; PG8_LDA(At, 0, 0); PG8_STAGE(PG8_SA(1, 1), a1 + hstep, voffA);
            PG8_WAIT_L(8); PG8_BAR; PG8_WAIT_L(0); PG8_MMA(0, 0, At, B0); PG8_BAR; PG8_SCHED;
            PG8_LDB(B1, 0, 1); PG8_STAGE(PG8_SB(0, 0), b2, voffB);
            PG8_BAR; PG8_WAIT_L(0); PG8_MMA(0, 1, At, B1); PG8_BAR;
            PG8_LDA(At, 0, 1); PG8_STAGE(PG8_SA(0, 0), a2, voffA);
            PG8_BAR; PG8_WAIT_L(0); PG8_MMA(1, 0, At, B0); PG8_BAR; PG8_SCHED;
            PG8_STAGE(PG8_SB(0, 1), b2 + hstep, voffB);
            PG8_WAIT_V(6); PG8_BAR; PG8_MMA(1, 1, At, B1); PG8_BAR;
            PG8_LDB(B0, 1, 0); PG8_SCHED; PG8_LDA(At, 1, 0); PG8_STAGE(PG8_SA(0, 1), a2 + hstep, voffA);
            PG8_WAIT_L(8); PG8_BAR; PG8_WAIT_L(0); PG8_MMA(0, 0, At, B0); PG8_BAR; PG8_SCHED;
            PG8_LDB(B1, 1, 1); PG8_STAGE(PG8_SB(1, 0), b3, voffB);
            PG8_BAR; PG8_WAIT_L(0); PG8_MMA(0, 1, At, B1); PG8_BAR;
            PG8_LDA(At, 1, 1); PG8_STAGE(PG8_SA(1, 0), a3, voffA);
            PG8_BAR; PG8_WAIT_L(0); PG8_MMA(1, 0, At, B0); PG8_BAR; PG8_SCHED;
            PG8_STAGE(PG8_SB(1, 1), b3 + hstep, voffB);
            PG8_WAIT_V(6); PG8_BAR; PG8_MMA(1, 1, At, B1); PG8_BAR;
            }
        }
        if constexpr (ALIGN_EPI) { if (wr == 0) PG8_BAR; }
        if constexpr (!Epi::AFTER_DRAIN) { E(acc, cur, wr, wc, fr, fq); S.done(cur); }
        if (!has_next) break;
        if (!Epi::keep(cur)) {
#pragma unroll
        for (int a = 0; a < 2; ++a)
#pragma unroll
            for (int b = 0; b < 2; ++b)
#pragma unroll
                for (int m = 0; m < 4; ++m)
#pragma unroll
                    for (int n = 0; n < 2; ++n) acc[a][b][m][n] = (f32x4){0.f, 0.f, 0.f, 0.f};
        }
        cur = nxt; cA = nA; cB = nB; ++ui;
        if constexpr (ALIGN_EPI) { if (wr == 1) PG8_BAR; }
    }
    PG8_WAIT_V(0);
    if constexpr (!ALIGN_EPI) { if (wr == 0) PG8_BAR; }
    PG8_BAR;
    if constexpr (Epi::AFTER_DRAIN) { E.fused(acc, cur, wr, wc, fr, fq, lds, wid, lane); S.done(cur); }
#undef PG8_SA
#undef PG8_SB
#undef PG8_STAGE
#undef PG8_LDA
#undef PG8_LDB
#undef PG8_MMA
#undef PG8_WAIT_V
#undef PG8_WAIT_L
#undef PG8_BAR
#undef PG8_SCHED
}
}

constexpr int NWAVES = 8;
constexpr int D = 2048, DEPTH = 2, DFF = 8192;
constexpr int NA_W = 1024, ML_W = 1024, SG_W = 1024;
constexpr int D_IN = 15376, N_IN_PAD = 15616;
constexpr int M_PROMPT = 8 * 4096, M_SAMPLE = 2 * 8192, M_ALL = M_PROMPT + M_SAMPLE;
constexpr int MS = 8192, NSLAB = M_ALL / MS;
constexpr float EPS = 1e-6f;

constexpr size_t MiB = 1u << 20;
constexpr size_t WS_CTL = 0, CTL_ZERO_BYTES = 1 * MiB;
constexpr size_t WL_IN = 0, WL_ABC = 61 * MiB, WL_OUT = 73 * MiB, WL_UP = 81 * MiB, WL_DN = 113 * MiB, WL_BYTES = 145 * MiB;
constexpr size_t WS_W = 1 * MiB;
constexpr size_t WS_H = 291 * MiB;
constexpr size_t WS_QKVA = 323 * MiB;
constexpr size_t WS_QKVOB = 371 * MiB;
constexpr size_t WS_ZUV = 435 * MiB;
constexpr size_t WS_U = WS_QKVA;
constexpr size_t WS_G = 467 * MiB;
constexpr size_t WS_GATES = 563 * MiB;
constexpr size_t WS_SGR = WS_GATES + MiB / 2;
constexpr size_t WS_QC = 564 * MiB, WS_KC = 580 * MiB;
constexpr size_t WS_Y = 596 * MiB;
constexpr size_t WS_HF = 644 * MiB, WS_HB = 676 * MiB;
constexpr size_t WS_MRG = 708 * MiB;
constexpr size_t WS_MRGB = 772 * MiB;
constexpr size_t WS_T = 804 * MiB;
constexpr size_t WS_GS = 868 * MiB;
constexpr size_t WS_GD = 870 * MiB;
constexpr size_t WS_LST = 871 * MiB;
constexpr size_t WS_NLOC = 887 * MiB;
constexpr size_t WS_END = 888 * MiB;
static_assert(WS_W + 2 * WL_BYTES <= WS_H && WS_U + (size_t)MS * DFF * 2 <= WS_G && WS_SGR + (size_t)MS * 4 <= WS_QC, "d_ws map");
constexpr int CW_BAR = 4096;

constexpr int RING_OFF = 0, RING_BYTES = 131072;
constexpr int LDSCTL_OFF = 153600, MISC_OFF = LDSCTL_OFF + 320;
constexpr int LDS_BYTES = 155648;

#define GAS __attribute__((address_space(1)))
#define LAS __attribute__((address_space(3)))
typedef unsigned short bf16;
typedef unsigned v4u __attribute__((ext_vector_type(4)));
typedef float f32x4 __attribute__((ext_vector_type(4)));
typedef short bf16x8 __attribute__((ext_vector_type(8)));
typedef GAS unsigned gu32;
typedef GAS unsigned long long gu64;
#define RLX_AGENT __ATOMIC_RELAXED, __HIP_MEMORY_SCOPE_AGENT
#define LDS_WAIT() asm volatile("s_waitcnt lgkmcnt(0)" ::: "memory")
#define VM_WAIT() asm volatile("s_waitcnt vmcnt(0)" ::: "memory")
__device__ __forceinline__ unsigned long long rt() { return __builtin_amdgcn_s_memrealtime(); }
__device__ __forceinline__ unsigned f2bf(float f) { unsigned u = __builtin_bit_cast(unsigned, f); return (u + 0x7fffu + ((u >> 16) & 1u)) >> 16; }
__device__ __forceinline__ unsigned pk2(float lo, float hi) { return f2bf(lo) | (f2bf(hi) << 16); }

#define XB_TMO      128
#define XB_XCNT(j)  (256  + 64 * (j))
#define XB_XSUB(j)  (1280 + 64 * (j))
#define XB_XGEN(j)  (2304 + 64 * (j))
#define XB_TOP      3328
#define XB_TOPGEN   3392
#define XCD_BAR_WORDS 3456
#define XB_SPIN_CAP (1u << 18)

__device__ __forceinline__ unsigned xb_ld(unsigned* p)              { return __hip_atomic_load(p, __ATOMIC_RELAXED, __HIP_MEMORY_SCOPE_AGENT); }
__device__ __forceinline__ unsigned xb_add(unsigned* p, unsigned v) { return __hip_atomic_fetch_add(p, v, __ATOMIC_RELAXED, __HIP_MEMORY_SCOPE_AGENT); }
__device__ __forceinline__ unsigned xb_xcc_id() { return (unsigned)__builtin_amdgcn_s_getreg((3 << 11) | 20) & 0xFu; }
#define XB_SPIN(cond, bar) do { unsigned _sp = 0; while (cond) { __builtin_amdgcn_s_sleep(1); \
    if ((++_sp & 255u) == 0u) { if (xb_ld(&(bar)[XB_TMO])) break; if (_sp > XB_SPIN_CAP) { atomicAdd(&(bar)[XB_TMO], 1u); break; } } } } while (0)

struct XcdBarrier {
    unsigned* bar; unsigned x;
    volatile LAS unsigned* st;
};

__device__ __forceinline__ XcdBarrier xcd_barrier_post(unsigned* bar, volatile LAS unsigned* st) {
    XcdBarrier b; b.bar = bar; b.x = xb_xcc_id(); b.st = st;
    if (threadIdx.x == 0) (void)xb_add(&bar[XB_XCNT(b.x)], 1u);
    return b;
}
__device__ __forceinline__ void xcd_barrier_complete(unsigned* bar, unsigned x, unsigned& nloc, unsigned& nx) {
    const unsigned G = gridDim.x * gridDim.y * gridDim.z;
    unsigned sum, cnt, mine, sp = 0u;
    for (;;) {
        sum = 0u; cnt = 0u; mine = 0u;
#pragma unroll
        for (unsigned j = 0; j < 16; ++j) { const unsigned c = xb_ld(&bar[XB_XCNT(j)]); sum += c; cnt += (c > 0u) ? 1u : 0u; mine = (j == x) ? c : mine; }
        if (sum == G) break;
        __builtin_amdgcn_s_sleep(1);
        if ((++sp & 255u) == 0u) { if (xb_ld(&bar[XB_TMO])) break; if (sp > XB_SPIN_CAP) { atomicAdd(&bar[XB_TMO], 1u); break; } }
    }
    nloc = mine > 0u ? mine : 1u; nx = cnt > 0u ? cnt : 1u;
}

__device__ __forceinline__ void xcd_barrier(const XcdBarrier& b) {
    asm volatile("s_waitcnt vmcnt(0)" ::: "memory");
    __syncthreads();
    if (threadIdx.x == 0) {
        unsigned* bar = b.bar;
        __builtin_amdgcn_s_waitcnt(0);
        unsigned nloc = b.st[0], nx = b.st[1];
        if (nloc == 0u) { xcd_barrier_complete(bar, b.x, nloc, nx); b.st[0] = nloc; b.st[1] = nx; }
        const unsigned old = xb_add(&bar[XB_XSUB(b.x)], 1u);
        const unsigned gen = old / nloc;
        if (old + 1u == (gen + 1u) * nloc) {
            __builtin_amdgcn_fence(__ATOMIC_RELEASE, "agent");
            asm volatile("s_waitcnt vmcnt(0)" ::: "memory");
            const unsigned og = xb_add(&bar[XB_TOP], 1u);
            const unsigned tg = og / nx;
            if (og + 1u == (tg + 1u) * nx) xb_add(&bar[XB_TOPGEN], 1u);
            else XB_SPIN(xb_ld(&bar[XB_TOPGEN]) == tg, bar);
            __builtin_amdgcn_fence(__ATOMIC_ACQUIRE, "agent");
            xb_add(&bar[XB_XGEN(b.x)], 1u);
            asm volatile("s_waitcnt vmcnt(0)" ::: "memory");
        } else {
            XB_SPIN(xb_ld(&bar[XB_XGEN(b.x)]) == gen, bar);
            __builtin_amdgcn_fence(__ATOMIC_ACQUIRE, "agent");
            asm volatile("s_waitcnt vmcnt(0)" ::: "memory");
        }
    }
    __syncthreads();
}

struct Frame {
    LAS unsigned char* lds;
    int tid, lane, wave;
    int vcu, G;
};
struct Args {
    const float* x_prompt; const float* x_sample; const float* pre_mix_g; const float* post_mix_g; const float* pre_mlp_g; const float* post_mlp_g;
    const float* w_in; const float* b_gate; const float* conv_w; const float* na_rpb; const float* ml_norm_g; const float* sg_norm_g; const float* w_s; const float* b_s;
    const float* w_a; const float* w_b; const float* w_c; const float* w_out; const float* w_up; const float* w_down;
    float* out; unsigned char* ws;
    int ph_lo, ph_hi;
};

__device__ __forceinline__ float wave_sum(float v) {
#pragma unroll
    for (int o = 1; o < 64; o <<= 1) v += __shfl_xor(v, o);
    return v;
}
__device__ __forceinline__ float wave_max(float v) {
#pragma unroll
    for (int o = 1; o < 64; o <<= 1) v = fmaxf(v, __shfl_xor(v, o));
    return v;
}
__device__ __forceinline__ float bf_lo(unsigned u) { return __uint_as_float(u << 16); }
__device__ __forceinline__ float bf_hi(unsigned u) { return __uint_as_float(u & 0xffff0000u); }
__device__ __forceinline__ float sigmoid_f(float x) { return __builtin_amdgcn_rcpf(1.0f + __builtin_amdgcn_exp2f(-1.4426950408889634f * x)); }

__device__ __forceinline__ void p0_transpose_item(const float* W, int K, int N, bf16* WT, int k0, int n0, int ncols, int drow0, float sc, LAS float* scr, int lane) {
    const int cl = lane & 31;
#pragma unroll 8
    for (int i = 0; i < 32; ++i) { const int kk = 2 * i + (lane >> 5); scr[kk * 33 + cl] = (cl < ncols) ? W[(size_t)(k0 + kk) * N + n0 + cl] * sc : 0.f; }
    LDS_WAIT(); asm volatile("" ::: "memory");
    const int c = lane & 7;
#pragma unroll
    for (int j = 0; j < 4; ++j) { const int n = (lane >> 3) + 8 * j; const LAS float* s = scr + (8 * c) * 33 + n;
        v4u o; o.x = pk2(s[0 * 33], s[1 * 33]); o.y = pk2(s[2 * 33], s[3 * 33]); o.z = pk2(s[4 * 33], s[5 * 33]); o.w = pk2(s[6 * 33], s[7 * 33]);
        if (n < ncols) *(GAS v4u*)(WT + (size_t)(drow0 + n) * K + k0 + 8 * c) = o; }
    LDS_WAIT(); asm volatile("" ::: "memory");
}
__device__ __forceinline__ void p0_matrix(Frame& F, const float* W, int K, int N, bf16* WT, LAS float* scr) {
    const int gw = F.vcu * NWAVES + F.wave, NGW = F.G * NWAVES, nblk = N / 32, nit = (K / 64) * nblk;
    for (int it = gw; it < nit; it += NGW) { const int kb = it / nblk, nb = it % nblk; p0_transpose_item(W, K, N, WT, 64 * kb, 32 * nb, 32, 32 * nb, 1.f, scr, F.lane); }
}
__device__ __forceinline__ void p0_win(Frame& F, const float* W, bf16* WT, LAS float* scr) {
    const int gw = F.vcu * NWAVES + F.wave, NGW = F.G * NWAVES;
    constexpr int NB1 = 7168 / 32, NB2 = 8192 / 32, NBLK = NB1 + 1 + NB2, NIT = (D / 64) * NBLK;
    for (int it = gw; it < NIT; it += NGW) { const int kb = it / NBLK, nb = it % NBLK; int n0, ncols, drow0; float sc = 1.f;
        if (nb < NB1) { n0 = 32 * nb; ncols = 32; drow0 = n0; if (n0 < 1024) sc = 0.08838834764831845f; }
        else if (nb == NB1) { n0 = 7168; ncols = 16; drow0 = 15360; }
        else { n0 = 7184 + 32 * (nb - NB1 - 1); ncols = 32; drow0 = n0 - 16; }
        p0_transpose_item(W, D, D_IN, WT, 64 * kb, n0, ncols, drow0, sc, scr, F.lane); }
    const int gt = (F.vcu * NWAVES + F.wave) * 64 + F.lane, NGT = F.G * NWAVES * 64; constexpr int NZ16 = (N_IN_PAD - D_IN) * D / 8;
    GAS v4u* z = (GAS v4u*)(WT + (size_t)D_IN * D);
    for (int i = gt; i < NZ16; i += NGT) z[i] = (v4u){0u, 0u, 0u, 0u};
}

__device__ __forceinline__ void row_phase(Frame& F, const float* xin, const float* add, const float* g_add, float* xout, const float* g_next, bf16* hout) {
    const int gw = F.vcu * NWAVES + F.wave, NGW = F.G * NWAVES;
    for (int m = gw; m < MS; m += NGW) {
        const GAS f32x4* xr = (const GAS f32x4*)(xin + (size_t)m * D) + F.lane;
        f32x4 v[8];
#pragma unroll
        for (int j = 0; j < 8; ++j) v[j] = xr[64 * j];
        if (add) {
            const GAS f32x4* ar = (const GAS f32x4*)(add + (size_t)m * D) + F.lane; f32x4 a[8]; float s = 0.f;
#pragma unroll
            for (int j = 0; j < 8; ++j) { a[j] = ar[64 * j]; s += (a[j].x * a[j].x + a[j].y * a[j].y) + (a[j].z * a[j].z + a[j].w * a[j].w); }
            const float rs = 1.0f / sqrtf(wave_sum(s) * (1.f / D) + EPS);
#pragma unroll
            for (int j = 0; j < 8; ++j) { const f32x4 gv = ((const GAS f32x4*)g_add)[F.lane + 64 * j]; v[j] = v[j] + (a[j] * rs) * gv; }
        }
        if (xout) { GAS f32x4* o = (GAS f32x4*)(xout + (size_t)m * D) + F.lane;
#pragma unroll
            for (int j = 0; j < 8; ++j) o[64 * j] = v[j]; }
        if (hout) {
            float s = 0.f;
#pragma unroll
            for (int j = 0; j < 8; ++j) s += (v[j].x * v[j].x + v[j].y * v[j].y) + (v[j].z * v[j].z + v[j].w * v[j].w);
            const float rs = 1.0f / sqrtf(wave_sum(s) * (1.f / D) + EPS);
            GAS unsigned long long* o8 = (GAS unsigned long long*)(hout + (size_t)m * D) + F.lane;
#pragma unroll
            for (int j = 0; j < 8; ++j) { const f32x4 gv = ((const GAS f32x4*)g_next)[F.lane + 64 * j]; const f32x4 y = (v[j] * rs) * gv;
                o8[64 * j] = (unsigned long long)pk2(y.x, y.y) | ((unsigned long long)pk2(y.z, y.w) << 32); }
        }
    }
}

__device__ __forceinline__ void prep_phase(Frame& F, const bf16* qkvob, const float* convw, bf16* qc, bf16* kc, const bf16* zuv, float* sgr, int T) {
    const int gt = (F.vcu * NWAVES + F.wave) * 64 + F.lane, NGT = F.G * NWAVES * 64;
    {
        const int c8 = gt & 255; float w0[8], w1[8], w2[8];
#pragma unroll
        for (int j = 0; j < 8; ++j) { w0[j] = convw[c8 * 8 + j]; w1[j] = convw[2048 + c8 * 8 + j]; w2[j] = convw[4096 + c8 * 8 + j]; }
        const float osc = c8 < 128 ? 0.0625f : 1.0f;
        bf16* dst = c8 < 128 ? qc + c8 * 8 : kc + (c8 - 128) * 8;
        for (int t = gt >> 8; t < MS; t += NGT >> 8) {
            const int ts = t % T; const GAS v4u* src = (const GAS v4u*)(qkvob + (size_t)t * 4096 + c8 * 8);
            const v4u xc = src[0]; v4u xm = (v4u){0u, 0u, 0u, 0u}, xp = xm;
            if (ts > 0) xm = *(const GAS v4u*)(qkvob + (size_t)(t - 1) * 4096 + c8 * 8);
            if (ts < T - 1) xp = *(const GAS v4u*)(qkvob + (size_t)(t + 1) * 4096 + c8 * 8);
            float r[8];
#pragma unroll
            for (int j = 0; j < 4; ++j) {
                const float a0 = w0[2 * j] * bf_lo(xm[j]) + w1[2 * j] * bf_lo(xc[j]) + w2[2 * j] * bf_lo(xp[j]);
                const float a1 = w0[2 * j + 1] * bf_hi(xm[j]) + w1[2 * j + 1] * bf_hi(xc[j]) + w2[2 * j + 1] * bf_hi(xp[j]);
                r[2 * j] = a0 * sigmoid_f(a0) * osc; r[2 * j + 1] = a1 * sigmoid_f(a1) * osc; }
            v4u o; o.x = pk2(r[0], r[1]); o.y = pk2(r[2], r[3]); o.z = pk2(r[4], r[5]); o.w = pk2(r[6], r[7]);
            *(GAS v4u*)(dst + (size_t)t * 1024) = o;
        }
    }
    {
        const int gw = F.vcu * NWAVES + F.wave, NGW = F.G * NWAVES;
        for (int t = gw; t < MS; t += NGW) {
            const GAS v4u* src = (const GAS v4u*)(zuv + (size_t)t * 2048 + 1024) + 2 * F.lane; float s = 0.f;
#pragma unroll
            for (int i = 0; i < 2; ++i) { const v4u x = src[i];
#pragma unroll
                for (int j = 0; j < 4; ++j) { const float a = bf_lo(x[j]), b = bf_hi(x[j]); s += a * a + b * b; } }
            s = wave_sum(s);
            if (F.lane == 0) sgr[t] = 1.0f / sqrtf(s * (1.f / 1024.f) + EPS);
        }
    }
}

__device__ __forceinline__ void comb_phase(Frame& F, const float* hf, const float* hb, const bf16* qkvob, const float* mlg, bf16* yb) {
    const int gw = F.vcu * NWAVES + F.wave, NGW = F.G * NWAVES;
    for (int it = gw; it < MS * 4; it += NGW) { const int t = it >> 2, h = it & 3; const size_t o = (size_t)t * 1024 + h * 256 + 4 * F.lane;
        const f32x4 a = *(const GAS f32x4*)(hf + o), b = *(const GAS f32x4*)(hb + o); const f32x4 s = a + b;
        const float ss = wave_sum((s.x * s.x + s.y * s.y) + (s.z * s.z + s.w * s.w)); const float rs = 1.0f / sqrtf(ss * (1.f / 256.f) + EPS);
        const f32x4 gv = *(const GAS f32x4*)(mlg + h * 256 + 4 * F.lane);
        const unsigned long long ow = *(const GAS unsigned long long*)(qkvob + (size_t)t * 4096 + 3072 + h * 256 + 4 * F.lane);
        const unsigned o0 = (unsigned)ow, o1 = (unsigned)(ow >> 32);
        const float y0 = s.x * rs * gv.x * bf_lo(o0), y1 = s.y * rs * gv.y * bf_hi(o0), y2 = s.z * rs * gv.z * bf_lo(o1), y3 = s.w * rs * gv.w * bf_hi(o1);
        *(GAS unsigned long long*)(yb + o) = (unsigned long long)pk2(y0, y1) | ((unsigned long long)pk2(y2, y3) << 32);
    }
}

__device__ __forceinline__ void na_naive(Frame& F, const bf16* qkva, const float* rpb, bf16* ya, int T, int gw, int NGW) {
    const int rows = T / 64;
    for (int it = gw; it < MS * 8; it += NGW) {
        const int m = it >> 3, h = it & 7, seq = m / T, t = m % T, r = t >> 6, qc = t & 63;
        int rs = r - 4; rs = rs < 0 ? 0 : (rs > rows - 8 ? rows - 8 : rs);
        int cs = qc - 8; cs = cs < 0 ? 0 : (cs > 48 ? 48 : cs);
        const bf16* qrow = qkva + (size_t)m * 3072 + h * 128;
        float sc[2];
#pragma unroll
        for (int kk = 0; kk < 2; ++kk) { const int kap = F.lane + 64 * kk, j = kap >> 4, cc = kap & 15;
            const int ktok = seq * T + (rs + j) * 64 + cs + cc; const bf16* krow = qkva + (size_t)ktok * 3072 + 1024 + h * 128; float d = 0.f;
#pragma unroll 4
            for (int i = 0; i < 16; ++i) { const v4u qv = *(const GAS v4u*)(qrow + 8 * i), kv = *(const GAS v4u*)(krow + 8 * i);
#pragma unroll
                for (int e = 0; e < 4; ++e) d += bf_lo(qv[e]) * bf_lo(kv[e]) + bf_hi(qv[e]) * bf_hi(kv[e]); }
            sc[kk] = d + rpb[(h * 15 + (rs + j - r + 7)) * 31 + (cs + cc - qc + 15)]; }
        const float mx = wave_max(fmaxf(sc[0], sc[1]));
        const float e0 = __expf(sc[0] - mx), e1 = __expf(sc[1] - mx); const float inv = 1.0f / wave_sum(e0 + e1);
        const float p0 = e0 * inv, p1 = e1 * inv;
        float o0 = 0.f, o1 = 0.f;
        for (int kap = 0; kap < 128; ++kap) { const int j = kap >> 4, cc = kap & 15; const int ktok = seq * T + (rs + j) * 64 + cs + cc;
            const float p = __shfl(kap < 64 ? p0 : p1, kap & 63);
            const unsigned vv = *(const GAS unsigned*)(qkva + (size_t)ktok * 3072 + 2048 + h * 128 + 2 * F.lane);
            o0 += p * bf_lo(vv); o1 += p * bf_hi(vv); }
        *(GAS unsigned*)(ya + (size_t)m * 1024 + h * 128 + 2 * F.lane) = pk2(o0, o1);
    }
}
__device__ __forceinline__ void sg_naive(Frame& F, const bf16* zuv, const float* sgr, const float* sgn, const float* ws_, const float* bs, bf16* yc, int gw, int NGW) {
    for (int it = gw; it < MS * 8; it += NGW) {
        const int t = it >> 3, g = it & 7, p = t & 127, cb = t & ~127; const int c = g * 128 + 2 * F.lane;
        const float* wrow = ws_ + ((size_t)g * 128 + p) * 128; float a0 = 0.f, a1 = 0.f;
        for (int q = 0; q < 128; ++q) { const float wq = wrow[q] * sgr[cb + q]; const unsigned zz = *(const GAS unsigned*)(zuv + (size_t)(cb + q) * 2048 + 1024 + c);
            a0 += wq * bf_lo(zz); a1 += wq * bf_hi(zz); }
        const float b = bs[g * 128 + p]; const unsigned uu = *(const GAS unsigned*)(zuv + (size_t)t * 2048 + c);
        const float y0 = bf_lo(uu) * (a0 * sgn[c] + b), y1 = bf_hi(uu) * (a1 * sgn[c + 1] + b);
        *(GAS unsigned*)(yc + (size_t)t * 1024 + c) = pk2(y0, y1);
    }
}
__device__ __forceinline__ void mlstm_naive(Frame& F, int unit, const bf16* qc, const bf16* kc, const bf16* qkvob, const float* gates, float* hf, float* hb, int T) {
    const int es = unit & 3, dir = (unit >> 2) & 1, h = (unit >> 3) & 3, seq = unit >> 5, nc = T / 64, tid = F.tid;
    LAS unsigned char* L = F.lds;
    LAS bf16* Qs = (LAS bf16*)(L);
    LAS bf16* Ks = (LAS bf16*)(L + 33792);
    LAS float* Vs = (LAS float*)(L + 67584);
    LAS float* Ss = (LAS float*)(L + 83968);
    LAS float* NUM = (LAS float*)(L + 100608);
    LAS float* vb = (LAS float*)(L + 116992);
    LAS float* va = vb + 64;
    LAS float* vmr = vb + 128;
    LAS float* vw = vb + 192;
    LAS float* vwi = vb + 256;
    LAS float* NQ = vb + 320;
    LAS float* nst = vb + 384;
    LAS float* scal = vb + 640;
    float* hout = dir ? hb : hf;
    float Creg[32];
#pragma unroll
    for (int i = 0; i < 32; ++i) Creg[i] = 0.f;
    if (tid < 256) nst[tid] = 0.f;
    float m_prev = 0.f;
    const int e = tid & 63, dg = tid >> 6;
    for (int ci = 0; ci < nc; ++ci) {
        __syncthreads();
#pragma unroll
        for (int i = 0; i < 4; ++i) { const int p = tid + 512 * i, tau = p >> 5, c8 = p & 31; const int pos = ci * 64 + tau; const int tok = seq * T + (dir ? T - 1 - pos : pos);
            *(LAS v4u*)(Qs + tau * 264 + c8 * 8) = *(const GAS v4u*)(qc + (size_t)tok * 1024 + h * 256 + c8 * 8);
            *(LAS v4u*)(Ks + tau * 264 + c8 * 8) = *(const GAS v4u*)(kc + (size_t)tok * 1024 + h * 256 + c8 * 8); }
        { const int tau = tid >> 3, c8 = tid & 7; const int pos = ci * 64 + tau; const int tok = seq * T + (dir ? T - 1 - pos : pos);
            const v4u vv = *(const GAS v4u*)(qkvob + (size_t)tok * 4096 + 2048 + h * 256 + es * 64 + c8 * 8);
#pragma unroll
            for (int j = 0; j < 4; ++j) { Vs[tau * 64 + c8 * 8 + 2 * j] = bf_lo(vv[j]); Vs[tau * 64 + c8 * 8 + 2 * j + 1] = bf_hi(vv[j]); } }
        if (tid < 64) {
            const int pos = ci * 64 + tid; const int tok = seq * T + (dir ? T - 1 - pos : pos);
            const float ipre = gates[(size_t)tok * 16 + dir * 8 + h], fpre = gates[(size_t)tok * 16 + dir * 8 + 4 + h];
            const float logf = fminf(fpre, 0.f) - log1pf(__expf(-fabsf(fpre)));
            float b = logf;
#pragma unroll
            for (int o = 1; o < 64; o <<= 1) { const float y = __shfl_up(b, o); if (tid >= o) b += y; }
            const float a = ipre - b; float pm = a;
#pragma unroll
            for (int o = 1; o < 64; o <<= 1) { const float y = __shfl_up(pm, o); if (tid >= o) pm = fmaxf(pm, y); }
            const float mrow = fmaxf(b + m_prev, b + pm);
            const float blast = __shfl(b, 63), amax = __shfl(pm, 63);
            const float mnew = fmaxf(blast + m_prev, blast + amax);
            vb[tid] = b; va[tid] = a; vmr[tid] = mrow; vw[tid] = __expf(blast + a - mnew); vwi[tid] = __expf(b + m_prev - mrow);
            if (tid == 0) { scal[0] = __expf(blast + m_prev - mnew); scal[1] = mnew; }
        }
#pragma unroll
        for (int i = 0; i < 8; ++i) NUM[tid + 512 * i] = 0.f;
        __syncthreads();
        const float decay = scal[0]; m_prev = scal[1];
        {
            const int tau = tid >> 3, sg = tid & 7; float rowpart = 0.f; const float bt = vb[tau], mr = vmr[tau];
#pragma unroll 1
            for (int j = 0; j < 8; ++j) { const int s = sg * 8 + j; float val = 0.f;
                if (s <= tau) { float d = 0.f;
#pragma unroll 4
                    for (int c8 = 0; c8 < 32; ++c8) { const v4u qv = *(const LAS v4u*)(Qs + tau * 264 + c8 * 8), kv = *(const LAS v4u*)(Ks + s * 264 + c8 * 8);
#pragma unroll
                        for (int x = 0; x < 4; ++x) d += bf_lo(qv[x]) * bf_lo(kv[x]) + bf_hi(qv[x]) * bf_hi(kv[x]); }
                    val = d * __expf(bt + va[s] - mr); }
                Ss[tau * 65 + s] = val; rowpart += val; }
            float qn = 0.f;
#pragma unroll 4
            for (int c8 = 0; c8 < 4; ++c8) { const v4u qv = *(const LAS v4u*)(Qs + tau * 264 + sg * 32 + c8 * 8);
#pragma unroll
                for (int x = 0; x < 4; ++x) qn += bf_lo(qv[x]) * nst[sg * 32 + c8 * 8 + 2 * x] + bf_hi(qv[x]) * nst[sg * 32 + c8 * 8 + 2 * x + 1]; }
            float tot = rowpart + vwi[tau] * qn;
            tot += __shfl_xor(tot, 1); tot += __shfl_xor(tot, 2); tot += __shfl_xor(tot, 4);
            if (sg == 0) NQ[tau] = tot;
        }
        {
#pragma unroll 1
            for (int tau = 0; tau < 64; ++tau) { float part = 0.f;
#pragma unroll
                for (int c8 = 0; c8 < 4; ++c8) { const v4u qv = *(const LAS v4u*)(Qs + tau * 264 + dg * 32 + c8 * 8);
#pragma unroll
                    for (int x = 0; x < 4; ++x) part += bf_lo(qv[x]) * Creg[c8 * 8 + 2 * x] + bf_hi(qv[x]) * Creg[c8 * 8 + 2 * x + 1]; }
                __hip_atomic_fetch_add(&NUM[tau * 64 + e], vwi[tau] * part, __ATOMIC_RELAXED, __HIP_MEMORY_SCOPE_WORKGROUP); }
        }
        __syncthreads();
        {
#pragma unroll 1
            for (int j = 0; j < 8; ++j) { const int tau = dg * 8 + j; float acc = 0.f;
#pragma unroll 8
                for (int s = 0; s < 64; ++s) acc += Ss[tau * 65 + s] * Vs[s * 64 + e];
                __hip_atomic_fetch_add(&NUM[tau * 64 + e], acc, __ATOMIC_RELAXED, __HIP_MEMORY_SCOPE_WORKGROUP); }
        }
        __syncthreads();
#pragma unroll
        for (int i = 0; i < 8; ++i) { const int idx = tid + 512 * i, tau = idx >> 6, ee = idx & 63; const int pos = ci * 64 + tau; const int tok = seq * T + (dir ? T - 1 - pos : pos);
            const float den = fmaxf(fabsf(NQ[tau]), __expf(-vmr[tau]));
            hout[(size_t)tok * 1024 + h * 256 + es * 64 + ee] = NUM[idx] / den; }
#pragma unroll
        for (int i = 0; i < 32; ++i) Creg[i] *= decay;
#pragma unroll 1
        for (int s = 0; s < 64; ++s) { const float wv = vw[s] * Vs[s * 64 + e];
#pragma unroll
            for (int c8 = 0; c8 < 4; ++c8) { const v4u kv = *(const LAS v4u*)(Ks + s * 264 + dg * 32 + c8 * 8);
#pragma unroll
                for (int x = 0; x < 4; ++x) { Creg[c8 * 8 + 2 * x] += bf_lo(kv[x]) * wv; Creg[c8 * 8 + 2 * x + 1] += bf_hi(kv[x]) * wv; } } }
        if (tid < 256) { float a = decay * nst[tid];
#pragma unroll 8
            for (int s = 0; s < 64; ++s) a += vw[s] * __uint_as_float(((unsigned)Ks[s * 264 + tid]) << 16);
            nst[tid] = a; }
    }
    __syncthreads();
}

typedef short s16x4 __attribute__((ext_vector_type(4)));
__device__ __forceinline__ bf16x8 tr_pair(const LAS bf16* p0, const LAS bf16* p1) {
    const s16x4 a = __builtin_amdgcn_ds_read_tr16_b64_v4i16((LAS s16x4*)p0), b = __builtin_amdgcn_ds_read_tr16_b64_v4i16((LAS s16x4*)p1);
    return __builtin_shufflevector(a, b, 0, 1, 2, 3, 4, 5, 6, 7);
}
#define MFMA16(a, b, c) __builtin_amdgcn_mfma_f32_16x16x32_bf16((a), (b), (c), 0, 0, 0)

__device__ __forceinline__ void sg_fast(Frame& F, const bf16* zuv, const float* sgr, const float* sgn, const float* ws_, const float* bs, bf16* yc, int u0, int ustride) {
    LAS bf16* Z = (LAS bf16*)F.lds;
    const int lane = F.lane, kg = lane >> 4, li = lane & 15, qq = li >> 2, pp = li & 3;
    for (int unit = u0; unit < (MS / 128) * 8; unit += ustride) {
        const int c = unit >> 3, g = unit & 7, t0 = c * 128;
        __syncthreads();
#pragma unroll
        for (int i = 0; i < 4; ++i) { const int idx = F.tid + 512 * i, row = idx >> 4, ch = idx & 15;
            *(LAS v4u*)(Z + row * 136 + ch * 8) = *(const GAS v4u*)(zuv + (size_t)(t0 + row) * 2048 + 1024 + g * 128 + ch * 8); }
        const int p = F.wave * 16 + li;
        bf16x8 bw[4];
#pragma unroll
        for (int ks = 0; ks < 4; ++ks) { const int q0 = ks * 32 + 8 * kg;
            const f32x4 w0 = *(const GAS f32x4*)(ws_ + ((size_t)g * 128 + p) * 128 + q0), w1 = *(const GAS f32x4*)(ws_ + ((size_t)g * 128 + p) * 128 + q0 + 4);
            const f32x4 r0 = *(const GAS f32x4*)(sgr + t0 + q0), r1 = *(const GAS f32x4*)(sgr + t0 + q0 + 4);
            v4u pk; pk.x = pk2(w0.x * r0.x, w0.y * r0.y); pk.y = pk2(w0.z * r0.z, w0.w * r0.w); pk.z = pk2(w1.x * r1.x, w1.y * r1.y); pk.w = pk2(w1.z * r1.z, w1.w * r1.w);
            bw[ks] = __builtin_bit_cast(bf16x8, pk); }
        __syncthreads();
        const float bsv = bs[g * 128 + p];
#pragma unroll 2
        for (int dt = 0; dt < 8; ++dt) {
            f32x4 acc = (f32x4){0.f, 0.f, 0.f, 0.f};
#pragma unroll
            for (int ks = 0; ks < 4; ++ks) { const LAS bf16* a0 = Z + (ks * 32 + 8 * kg + qq) * 136 + dt * 16 + 4 * pp;
                acc = MFMA16(tr_pair(a0, a0 + 4 * 136), bw[ks], acc); }
            const int d0 = g * 128 + dt * 16 + 4 * kg;
            const f32x4 sg = *(const GAS f32x4*)(sgn + d0);
            const unsigned long long uw = *(const GAS unsigned long long*)(zuv + (size_t)(t0 + p) * 2048 + d0); const unsigned u0w = (unsigned)uw, u1w = (unsigned)(uw >> 32);
            const float y0 = bf_lo(u0w) * (sg.x * acc[0] + bsv), y1 = bf_hi(u0w) * (sg.y * acc[1] + bsv), y2 = bf_lo(u1w) * (sg.z * acc[2] + bsv), y3 = bf_hi(u1w) * (sg.w * acc[3] + bsv);
            *(GAS unsigned long long*)(yc + (size_t)(t0 + p) * 1024 + d0) = (unsigned long long)pk2(y0, y1) | ((unsigned long long)pk2(y2, y3) << 32);
        }
    }
    __syncthreads();
}

__device__ __forceinline__ void na_fast(Frame& F, const bf16* qkva, const float* rpb, bf16* ya, int T, int gw, int NGW) {
    const int rows = T / 64, lane = F.lane, kg = lane >> 4, li = lane & 15, qq = li >> 2, pp = li & 3;
    LAS bf16* Vt = (LAS bf16*)(F.lds + F.wave * 8192);
    for (int it = gw; it < (MS / 16) * 8; it += NGW) {
        const int h = it & 7, blk = it >> 3, n = blk & 3, rowg = blk >> 2, seq = rowg / rows, r = rowg % rows;
        int rs = r - 4; rs = rs < 0 ? 0 : (rs > rows - 8 ? rows - 8 : rs);
        int kc0 = 16 * n - 8; kc0 = kc0 < 0 ? 0 : (kc0 > 32 ? 32 : kc0);
        const int qc = 16 * n + li; const size_t qtok = (size_t)seq * T + r * 64 + qc;
        bf16x8 bq[4];
#pragma unroll
        for (int ks = 0; ks < 4; ++ks) bq[ks] = __builtin_bit_cast(bf16x8, *(const GAS v4u*)(qkva + qtok * 3072 + h * 128 + ks * 32 + 8 * kg));
        f32x4 s[8][2];
#pragma unroll
        for (int j = 0; j < 8; ++j)
#pragma unroll
            for (int ct = 0; ct < 2; ++ct) { const size_t ktok = (size_t)seq * T + (rs + j) * 64 + kc0 + 16 * ct + li; f32x4 a = (f32x4){0.f, 0.f, 0.f, 0.f};
#pragma unroll
                for (int ks = 0; ks < 4; ++ks) a = MFMA16(__builtin_bit_cast(bf16x8, *(const GAS v4u*)(qkva + ktok * 3072 + 1024 + h * 128 + ks * 32 + 8 * kg)), bq[ks], a);
                s[j][ct] = a; }
        int cs = qc - 8; cs = cs < 0 ? 0 : (cs > 48 ? 48 : cs);
        float mx = -3.0e38f;
#pragma unroll
        for (int j = 0; j < 8; ++j)
#pragma unroll
            for (int ct = 0; ct < 2; ++ct)
#pragma unroll
                for (int e = 0; e < 4; ++e) { const int kc = kc0 + 16 * ct + 4 * kg + e; const bool ok = kc >= cs && kc < cs + 16;
                    const int bi = (h * 15 + (rs + j - r + 7)) * 31 + (ok ? kc - qc + 15 : 15);
                    const float v = ok ? s[j][ct][e] + rpb[bi] : -3.0e38f; s[j][ct][e] = v; mx = fmaxf(mx, v); }
        mx = fmaxf(mx, __shfl_xor(mx, 16)); mx = fmaxf(mx, __shfl_xor(mx, 32));
        float sum = 0.f;
#pragma unroll
        for (int j = 0; j < 8; ++j)
#pragma unroll
            for (int ct = 0; ct < 2; ++ct)
#pragma unroll
                for (int e = 0; e < 4; ++e) { const float pv = s[j][ct][e] > -1.0e38f ? __expf(s[j][ct][e] - mx) : 0.f; s[j][ct][e] = pv; sum += pv; }
        sum += __shfl_xor(sum, 16); sum += __shfl_xor(sum, 32);
        const float inv = 1.0f / sum;
        f32x4 o[8];
#pragma unroll
        for (int dt = 0; dt < 8; ++dt) o[dt] = (f32x4){0.f, 0.f, 0.f, 0.f};
#pragma unroll 1
        for (int j = 0; j < 8; ++j) {
            asm volatile("" ::: "memory");
#pragma unroll
            for (int i = 0; i < 8; ++i) { const int key = 4 * i + kg; const size_t vtok = (size_t)seq * T + (rs + j) * 64 + kc0 + key;
                *(LAS v4u*)(Vt + key * 128 + li * 8) = *(const GAS v4u*)(qkva + vtok * 3072 + 2048 + h * 128 + li * 8); }
            asm volatile("" ::: "memory");
            f32x4 p0, p1;
            p0 = s[0][0]; p1 = s[0][1];
#pragma unroll
            for (int jj = 1; jj < 8; ++jj) if (j == jj) { p0 = s[jj][0]; p1 = s[jj][1]; }
            v4u pk; pk.x = pk2(p0[0], p0[1]); pk.y = pk2(p0[2], p0[3]); pk.z = pk2(p1[0], p1[1]); pk.w = pk2(p1[2], p1[3]);
            const bf16x8 bp = __builtin_bit_cast(bf16x8, pk);
#pragma unroll
            for (int dt = 0; dt < 8; ++dt) { const LAS bf16* a0 = Vt + (4 * kg + qq) * 128 + dt * 16 + 4 * pp;
                o[dt] = MFMA16(tr_pair(a0, a0 + 16 * 128), bp, o[dt]); }
            asm volatile("" ::: "memory");
        }
#pragma unroll
        for (int dt = 0; dt < 8; ++dt) { const f32x4 v = o[dt] * inv;
            *(GAS unsigned long long*)(ya + qtok * 1024 + h * 128 + dt * 16 + 4 * kg) = (unsigned long long)pk2(v[0], v[1]) | ((unsigned long long)pk2(v[2], v[3]) << 32); }
    }
}

constexpr int GS_STRIDE = 65536;
constexpr int ML_QS = 264, ML_VS = 72;
constexpr int ML_OFF_Q = 0, ML_OFF_K = 33792, ML_OFF_CT = 67584, ML_OFF_V = 101376, ML_OFF_WV = 110592, ML_OFF_ST = 119808, ML_OFF_VEC = 129024, ML_OFF_N = 130560, ML_OFF_CM = 131584, ML_LDS_END = 133120;
static_assert(ML_LDS_END <= LDSCTL_OFF, "mLSTM LDS map");

__device__ __forceinline__ void ml_gate_local(Frame& F, const float* gates, float* gs, float* gd, int T, int nchains) {
    const int gw = F.vcu * NWAVES + F.wave, NGW = F.G * NWAVES, lane = F.lane, nc = T / 64;
    for (int it = gw; it < nchains * nc; it += NGW) {
        const int chain = it / nc, ci = it % nc, seq = chain >> 3, h = (chain >> 1) & 3, dir = chain & 1;
        const int pos = ci * 64 + lane; const size_t tok = (size_t)seq * T + (dir ? T - 1 - pos : pos);
        const float ipre = gates[tok * 16 + dir * 8 + h], fpre = gates[tok * 16 + dir * 8 + 4 + h];
        const float logf = fminf(fpre, 0.f) - log1pf(__expf(-fabsf(fpre)));
        float b = logf;
#pragma unroll
        for (int o = 1; o < 64; o <<= 1) { const float y = __shfl_up(b, o); if (lane >= o) b += y; }
        const float a = ipre - b; float pm = a;
#pragma unroll
        for (int o = 1; o < 64; o <<= 1) { const float y = __shfl_up(pm, o); if (lane >= o) pm = fmaxf(pm, y); }
        const size_t o = (size_t)chain * T + pos;
        gs[o] = b; gs[GS_STRIDE + o] = a; gs[2 * GS_STRIDE + o] = pm;
        if (lane == 63) { gd[chain * 128 + ci] = b; gd[2048 + chain * 128 + ci] = b + pm; }
    }
}
__device__ __forceinline__ void ml_chain_m(Frame& F, const float* gd, int chain, int nc, LAS float* cm) {
    if (F.wave == 0) {
        const int lane = F.lane, cpl = nc >> 6;
        float sB0, sD0, sB1 = 0.f, sD1 = -3.0e38f;
        if (cpl == 2) { sB0 = gd[chain * 128 + 2 * lane]; sD0 = gd[2048 + chain * 128 + 2 * lane]; sB1 = gd[chain * 128 + 2 * lane + 1]; sD1 = gd[2048 + chain * 128 + 2 * lane + 1]; }
        else { sB0 = gd[chain * 128 + lane]; sD0 = gd[2048 + chain * 128 + lane]; }
        float B = sB0, Dm = sD0;
        if (cpl == 2) { Dm = fmaxf(sD0 + sB1, sD1); B = sB0 + sB1; }
#pragma unroll
        for (int o = 1; o < 64; o <<= 1) { const float Bp = __shfl_up(B, o), Dp = __shfl_up(Dm, o); if (lane >= o) { Dm = fmaxf(Dp + B, Dm); B = Bp + B; } }
        const float mend = fmaxf(B, Dm);
        float mp0 = __shfl_up(mend, 1); if (lane == 0) mp0 = 0.f;
        const float mn0 = fmaxf(mp0 + sB0, sD0);
        if (cpl == 2) { const float mn1 = fmaxf(mn0 + sB1, sD1);
            cm[2 * lane] = sB0; cm[2 * lane + 1] = sB1; cm[128 + 2 * lane] = mp0; cm[128 + 2 * lane + 1] = mn0; cm[256 + 2 * lane] = mn0; cm[256 + 2 * lane + 1] = mn1; }
        else { cm[lane] = sB0; cm[128 + lane] = mp0; cm[256 + lane] = mn0; }
    }
    __syncthreads();
}

__device__ __forceinline__ void ml_cupdate(f32x4 (&cst)[2][4], const LAS bf16* Ks, const LAS bf16* WV, float decay, int wave, int kg, int qq, int pp) {
#pragma unroll
    for (int dd = 0; dd < 2; ++dd)
#pragma unroll
        for (int et = 0; et < 4; ++et) cst[dd][et] = cst[dd][et] * decay;
#pragma unroll
    for (int ks = 0; ks < 2; ++ks) {
        bf16x8 af[2], bfv[4];
#pragma unroll
        for (int dd = 0; dd < 2; ++dd) { const LAS bf16* p = Ks + (ks * 32 + 8 * kg + qq) * ML_QS + (2 * wave + dd) * 16 + 4 * pp; af[dd] = tr_pair(p, p + 4 * ML_QS); }
#pragma unroll
        for (int et = 0; et < 4; ++et) { const LAS bf16* p = WV + (ks * 32 + 8 * kg + qq) * ML_VS + et * 16 + 4 * pp; bfv[et] = tr_pair(p, p + 4 * ML_VS); }
#pragma unroll
        for (int dd = 0; dd < 2; ++dd)
#pragma unroll
            for (int et = 0; et < 4; ++et) cst[dd][et] = MFMA16(af[dd], bfv[et], cst[dd][et]);
    }
}

__device__ __forceinline__ void ml_phaseA(Frame& F, int unit, const bf16* kc, const bf16* qkvob, const float* gs, const float* gd, float* lst, float* nloc, int T) {
    const int nseg = T / 1024, es = unit & 3, cs_ = unit >> 2, seg = cs_ % nseg, chain = cs_ / nseg, seq = chain >> 3, h = (chain >> 1) & 3, dir = chain & 1;
    if (seg == nseg - 1) return;
    const int tid = F.tid, lane = F.lane, kg = lane >> 4, li = lane & 15, qq = li >> 2, pp = li & 3, wave = F.wave;
    LAS bf16* Ks = (LAS bf16*)(F.lds + ML_OFF_K); LAS bf16* WV = (LAS bf16*)(F.lds + ML_OFF_WV); LAS float* wvec = (LAS float*)(F.lds + ML_OFF_VEC); LAS float* cm = (LAS float*)(F.lds + ML_OFF_CM);
    __syncthreads();
    ml_chain_m(F, gd, chain, T / 64, cm);
    f32x4 cst[2][4];
#pragma unroll
    for (int dd = 0; dd < 2; ++dd)
#pragma unroll
        for (int et = 0; et < 4; ++et) cst[dd][et] = (f32x4){0.f, 0.f, 0.f, 0.f};
    float nacc = 0.f;
    v4u pk[4], pv; float pw, pwv;
#define MLA_LOAD(ci_) do { const int ci__ = (ci_); \
        _Pragma("unroll") for (int i = 0; i < 4; ++i) { const int idx = tid + 512 * i, tau = idx >> 5, c8 = idx & 31; const int pos = ci__ * 64 + tau; const size_t tok = (size_t)seq * T + (dir ? T - 1 - pos : pos); \
            pk[i] = *(const GAS v4u*)(kc + tok * 1024 + h * 256 + c8 * 8); } \
        { const int tau = tid >> 3, c8 = tid & 7; const int pos = ci__ * 64 + tau; const size_t tok = (size_t)seq * T + (dir ? T - 1 - pos : pos); \
            pv = *(const GAS v4u*)(qkvob + tok * 4096 + 2048 + h * 256 + es * 64 + c8 * 8); pw = gs[GS_STRIDE + (size_t)chain * T + pos]; } \
        pwv = gs[GS_STRIDE + (size_t)chain * T + ci__ * 64 + (tid & 63)]; } while (0)
    MLA_LOAD(seg * 16);
    for (int cc = 0; cc < 16; ++cc) {
        const int ci = seg * 16 + cc;
        __syncthreads();
#pragma unroll
        for (int i = 0; i < 4; ++i) { const int idx = tid + 512 * i, tau = idx >> 5, c8 = idx & 31; *(LAS v4u*)(Ks + tau * ML_QS + c8 * 8) = pk[i]; }
        const float cB = cm[ci], cmp = cm[128 + ci], cmn = cm[256 + ci];
        { const int tau = tid >> 3, c8 = tid & 7; const float w = __expf(cB + pw - cmn);
            v4u o; o.x = pk2(bf_lo(pv.x) * w, bf_hi(pv.x) * w); o.y = pk2(bf_lo(pv.y) * w, bf_hi(pv.y) * w); o.z = pk2(bf_lo(pv.z) * w, bf_hi(pv.z) * w); o.w = pk2(bf_lo(pv.w) * w, bf_hi(pv.w) * w);
            *(LAS v4u*)(WV + tau * ML_VS + c8 * 8) = o; }
        if (tid < 64) wvec[tid] = __expf(cB + pwv - cmn);
        const float decay = __expf(cB + cmp - cmn);
        __syncthreads();
        if (cc + 1 < 16) MLA_LOAD(ci + 1);
        ml_cupdate(cst, Ks, WV, decay, wave, kg, qq, pp);
        if (tid < 64) { float a = decay * nacc;
#pragma unroll 8
            for (int s = 0; s < 64; ++s) a += wvec[s] * __uint_as_float(((unsigned)Ks[s * ML_QS + es * 64 + tid]) << 16);
            nacc = a; }
    }
#undef MLA_LOAD
    float* dst = lst + (size_t)unit * 32 * 512 + tid;
#pragma unroll
    for (int dd = 0; dd < 2; ++dd)
#pragma unroll
        for (int et = 0; et < 4; ++et)
#pragma unroll
            for (int r = 0; r < 4; ++r) dst[(dd * 16 + et * 4 + r) * 512] = cst[dd][et][r];
    if (tid < 64) nloc[(size_t)(chain * nseg + seg) * 256 + es * 64 + tid] = nacc;
    __syncthreads();
}

__device__ __forceinline__ void ml_phaseC(Frame& F, int unit, const bf16* qc, const bf16* kc, const bf16* qkvob, const float* gs, const float* gd, const float* lst, const float* nloc, float* hf, float* hb, int T) {
    const int nseg = T / 1024, es = unit & 3, cs_ = unit >> 2, seg = cs_ % nseg, chain = cs_ / nseg, seq = chain >> 3, h = (chain >> 1) & 3, dir = chain & 1;
    const int tid = F.tid, lane = F.lane, kg = lane >> 4, li = lane & 15, qq = li >> 2, pp = li & 3, wave = F.wave;
    LAS bf16* Qs = (LAS bf16*)(F.lds + ML_OFF_Q); LAS bf16* Ks = (LAS bf16*)(F.lds + ML_OFF_K); LAS bf16* CT = (LAS bf16*)(F.lds + ML_OFF_CT);
    LAS bf16* Vs = (LAS bf16*)(F.lds + ML_OFF_V); LAS bf16* WV = (LAS bf16*)(F.lds + ML_OFF_WV); LAS bf16* ST = (LAS bf16*)(F.lds + ML_OFF_ST);
    LAS float* vec = (LAS float*)(F.lds + ML_OFF_VEC);
    LAS float* nst = (LAS float*)(F.lds + ML_OFF_N);
    LAS float* cm = (LAS float*)(F.lds + ML_OFF_CM);
    float* hout = dir ? hb : hf;
    __syncthreads();
    ml_chain_m(F, gd, chain, T / 64, cm);
    f32x4 cst[2][4];
#pragma unroll
    for (int dd = 0; dd < 2; ++dd)
#pragma unroll
        for (int et = 0; et < 4; ++et) cst[dd][et] = (f32x4){0.f, 0.f, 0.f, 0.f};
    float nreg = 0.f;
    for (int i = 0; i < seg; ++i) {
        float sb = 0.f;
        for (int c = 0; c < 16; ++c) sb += cm[i * 16 + c];
        const float P = __expf(sb + cm[128 + i * 16] - cm[256 + i * 16 + 15]);
        const float* src = lst + (size_t)(((chain * nseg + i) << 2) + es) * 32 * 512 + tid;
#pragma unroll
        for (int dd = 0; dd < 2; ++dd)
#pragma unroll
            for (int et = 0; et < 4; ++et)
#pragma unroll
                for (int r = 0; r < 4; ++r) cst[dd][et][r] = P * cst[dd][et][r] + src[(dd * 16 + et * 4 + r) * 512];
        if (tid < 256) nreg = P * nreg + nloc[(size_t)(chain * nseg + i) * 256 + tid];
    }
    if (tid < 256) nst[tid] = nreg;
#pragma unroll
    for (int dd = 0; dd < 2; ++dd)
#pragma unroll
        for (int et = 0; et < 4; ++et) { const int e = et * 16 + li, d = (2 * wave + dd) * 16 + 4 * kg;
            *(LAS unsigned long long*)(CT + e * ML_QS + d) = (unsigned long long)pk2(cst[dd][et][0], cst[dd][et][1]) | ((unsigned long long)pk2(cst[dd][et][2], cst[dd][et][3]) << 32); }
    const int tt = wave >> 1, x0 = 2 * (wave & 1);
    v4u pq[4], pk[4], pv; float pw, pgb = 0.f, pga = 0.f, pgm = 0.f;
#define ML_LOAD(ci_) do { const int ci__ = (ci_); \
        _Pragma("unroll") for (int i = 0; i < 4; ++i) { const int idx = tid + 512 * i, tau = idx >> 5, c8 = idx & 31; const int pos = ci__ * 64 + tau; const size_t tok = (size_t)seq * T + (dir ? T - 1 - pos : pos); \
            pq[i] = *(const GAS v4u*)(qc + tok * 1024 + h * 256 + c8 * 8); pk[i] = *(const GAS v4u*)(kc + tok * 1024 + h * 256 + c8 * 8); } \
        { const int tau = tid >> 3, c8 = tid & 7; const int pos = ci__ * 64 + tau; const size_t tok = (size_t)seq * T + (dir ? T - 1 - pos : pos); \
            pv = *(const GAS v4u*)(qkvob + tok * 4096 + 2048 + h * 256 + es * 64 + c8 * 8); pw = gs[GS_STRIDE + (size_t)chain * T + pos]; } \
        if (tid < 64) { const size_t o_ = (size_t)chain * T + ci__ * 64 + tid; pgb = gs[o_]; pga = gs[GS_STRIDE + o_]; pgm = gs[2 * GS_STRIDE + o_]; } } while (0)
    ML_LOAD(seg * 16);
    for (int cc = 0; cc < 16; ++cc) {
        const int ci = seg * 16 + cc;
#pragma unroll
        for (int i = 0; i < 4; ++i) { const int idx = tid + 512 * i, tau = idx >> 5, c8 = idx & 31; *(LAS v4u*)(Qs + tau * ML_QS + c8 * 8) = pq[i]; *(LAS v4u*)(Ks + tau * ML_QS + c8 * 8) = pk[i]; }
        const float cB = cm[ci], cmp = cm[128 + ci], cmn = cm[256 + ci];
        { const int tau = tid >> 3, c8 = tid & 7; *(LAS v4u*)(Vs + tau * ML_VS + c8 * 8) = pv; const float w = __expf(cB + pw - cmn);
            v4u o; o.x = pk2(bf_lo(pv.x) * w, bf_hi(pv.x) * w); o.y = pk2(bf_lo(pv.y) * w, bf_hi(pv.y) * w); o.z = pk2(bf_lo(pv.z) * w, bf_hi(pv.z) * w); o.w = pk2(bf_lo(pv.w) * w, bf_hi(pv.w) * w);
            *(LAS v4u*)(WV + tau * ML_VS + c8 * 8) = o; }
        if (tid < 64) { const float mrow = fmaxf(pgb + cmp, pgb + pgm);
            vec[tid] = pgb; vec[64 + tid] = pga; vec[128 + tid] = mrow; vec[192 + tid] = __expf(cB + pga - cmn); vec[256 + tid] = __expf(pgb + cmp - mrow); vec[320 + tid] = 0.f; }
        const float decay = __expf(cB + cmp - cmn);
        __syncthreads();
        if (cc + 1 < 16) ML_LOAD(ci + 1);
        { const int t = tid >> 3, part = tid & 7; float qn = 0.f;
#pragma unroll
            for (int c8 = 0; c8 < 4; ++c8) { const v4u qv = *(const LAS v4u*)(Qs + t * ML_QS + part * 32 + c8 * 8);
#pragma unroll
                for (int x = 0; x < 4; ++x) qn += bf_lo(qv[x]) * nst[part * 32 + c8 * 8 + 2 * x] + bf_hi(qv[x]) * nst[part * 32 + c8 * 8 + 2 * x + 1]; }
            qn += __shfl_xor(qn, 1); qn += __shfl_xor(qn, 2); qn += __shfl_xor(qn, 4);
            if (part == 0) __hip_atomic_fetch_add(&vec[320 + t], vec[256 + t] * qn, __ATOMIC_RELAXED, __HIP_MEMORY_SCOPE_WORKGROUP); }
        bf16x8 qf[8];
#pragma unroll
        for (int ks = 0; ks < 8; ++ks) qf[ks] = __builtin_bit_cast(bf16x8, *(const LAS v4u*)(Qs + (tt * 16 + li) * ML_QS + ks * 32 + 8 * kg));
        { const int t = tt * 16 + li; const float bt = vec[t], mrt = vec[128 + t]; float rsum = 0.f;
#pragma unroll
            for (int x = 0; x < 2; ++x) { const int st = x0 + x; f32x4 a = (f32x4){0.f, 0.f, 0.f, 0.f};
#pragma unroll
                for (int ks = 0; ks < 8; ++ks) a = MFMA16(__builtin_bit_cast(bf16x8, *(const LAS v4u*)(Ks + (st * 16 + li) * ML_QS + ks * 32 + 8 * kg)), qf[ks], a);
                float v[4];
#pragma unroll
                for (int r = 0; r < 4; ++r) { const int s = st * 16 + 4 * kg + r; v[r] = (s <= t) ? a[r] * __expf(bt + vec[64 + s] - mrt) : 0.f; rsum += v[r]; }
                *(LAS unsigned long long*)(ST + t * ML_VS + st * 16 + 4 * kg) = (unsigned long long)pk2(v[0], v[1]) | ((unsigned long long)pk2(v[2], v[3]) << 32); }
            rsum += __shfl_xor(rsum, 16); rsum += __shfl_xor(rsum, 32);
            if (kg == 0) __hip_atomic_fetch_add(&vec[320 + t], rsum, __ATOMIC_RELAXED, __HIP_MEMORY_SCOPE_WORKGROUP); }
        f32x4 accn[2];
#pragma unroll
        for (int x = 0; x < 2; ++x) { const int et = x0 + x; f32x4 a = (f32x4){0.f, 0.f, 0.f, 0.f};
#pragma unroll
            for (int ks = 0; ks < 8; ++ks) a = MFMA16(qf[ks], __builtin_bit_cast(bf16x8, *(const LAS v4u*)(CT + (et * 16 + li) * ML_QS + ks * 32 + 8 * kg)), a);
#pragma unroll
            for (int r = 0; r < 4; ++r) a[r] *= vec[256 + tt * 16 + 4 * kg + r];
            accn[x] = a; }
        __syncthreads();
#pragma unroll
        for (int ks = 0; ks < 2; ++ks) { const bf16x8 sa = __builtin_bit_cast(bf16x8, *(const LAS v4u*)(ST + (tt * 16 + li) * ML_VS + ks * 32 + 8 * kg));
#pragma unroll
            for (int x = 0; x < 2; ++x) { const LAS bf16* p = Vs + (ks * 32 + 8 * kg + qq) * ML_VS + (x0 + x) * 16 + 4 * pp; accn[x] = MFMA16(sa, tr_pair(p, p + 4 * ML_VS), accn[x]); } }
#pragma unroll
        for (int r = 0; r < 4; ++r) { const int t = tt * 16 + 4 * kg + r; const float den = fmaxf(fabsf(vec[320 + t]), __expf(-vec[128 + t])); const float inv = 1.0f / den;
            const int pos = ci * 64 + t; const size_t tok = (size_t)seq * T + (dir ? T - 1 - pos : pos);
#pragma unroll
            for (int x = 0; x < 2; ++x) hout[tok * 1024 + h * 256 + es * 64 + (x0 + x) * 16 + li] = accn[x][r] * inv; }
        ml_cupdate(cst, Ks, WV, decay, wave, kg, qq, pp);
#pragma unroll
        for (int dd = 0; dd < 2; ++dd)
#pragma unroll
            for (int et = 0; et < 4; ++et) { const int e = et * 16 + li, d = (2 * wave + dd) * 16 + 4 * kg;
                *(LAS unsigned long long*)(CT + e * ML_QS + d) = (unsigned long long)pk2(cst[dd][et][0], cst[dd][et][1]) | ((unsigned long long)pk2(cst[dd][et][2], cst[dd][et][3]) << 32); }
        if (tid < 256) { float a = decay * nst[tid];
#pragma unroll 8
            for (int s = 0; s < 64; ++s) a += vec[192 + s] * __uint_as_float(((unsigned)Ks[s * ML_QS + tid]) << 16);
            nst[tid] = a; }
        __syncthreads();
    }
#undef ML_LOAD
}

#ifndef KNOB_NO_ROW
#define KNOB_NO_ROW 0
#endif
#ifndef KNOB_NO_WIN
#define KNOB_NO_WIN 0
#endif
#ifndef KNOB_NO_PREP
#define KNOB_NO_PREP 0
#endif
#ifndef KNOB_NO_ML
#define KNOB_NO_ML 0
#endif
#ifndef KNOB_NO_NA
#define KNOB_NO_NA 0
#endif
#ifndef KNOB_NO_SG
#define KNOB_NO_SG 0
#endif
#ifndef KNOB_NO_COMB
#define KNOB_NO_COMB 0
#endif
#ifndef KNOB_NO_MERGE
#define KNOB_NO_MERGE 0
#endif
#ifndef KNOB_NO_WOUT
#define KNOB_NO_WOUT 0
#endif
#ifndef KNOB_NO_UP
#define KNOB_NO_UP 0
#endif
#ifndef KNOB_NO_DOWN
#define KNOB_NO_DOWN 0
#endif
#ifndef KNOB_NO_P0
#define KNOB_NO_P0 0
#endif
#ifndef USE_NA_FAST
#define USE_NA_FAST 1
#endif
#ifndef USE_SG_FAST
#define USE_SG_FAST 1
#endif
#ifndef REP_P0
#define REP_P0 1
#endif
#ifndef REP_ROW
#define REP_ROW 1
#endif
#ifndef REP_WIN
#define REP_WIN 1
#endif
#ifndef REP_MERGE
#define REP_MERGE 1
#endif
#ifndef REP_WOUT
#define REP_WOUT 1
#endif
#ifndef REP_UP
#define REP_UP 1
#endif
#ifndef REP_DOWN
#define REP_DOWN 1
#endif
#ifndef REP_MIX1
#define REP_MIX1 1
#endif
#ifndef REP_MIX2
#define REP_MIX2 1
#endif
#ifndef REP_PREP
#define REP_PREP 1
#endif
#ifndef REP_COMB
#define REP_COMB 1
#endif
#ifndef REP_BAR
#define REP_BAR 1
#endif
#ifndef USE_ML_FAST
#define USE_ML_FAST 1
#endif
constexpr int STEPS_PER = 12, N_STEPS = 1 + NSLAB * DEPTH * STEPS_PER;
__global__ void __launch_bounds__(NWAVES * 64, 2) trunk_fwd(Args args) {
    extern __shared__ __attribute__((aligned(16))) unsigned char lds[];
#define MKF() Frame F; { int t_ = threadIdx.x; asm volatile("" : "+v"(t_)); F.lds = (LAS unsigned char*)lds; F.tid = t_; F.lane = t_ & 63; F.wave = __builtin_amdgcn_readfirstlane(t_ >> 6); \
        F.G = gridDim.x; const int bx_ = blockIdx.x; F.vcu = (F.G % 8 == 0) ? (bx_ % 8) * (F.G / 8) + bx_ / 8 : bx_; }
#define ARGS() ({ const __attribute__((address_space(4))) Args* _p = (const __attribute__((address_space(4))) Args*)__builtin_amdgcn_kernarg_segment_ptr(); asm volatile("" : "+s"(_p)); _p; })
    gu32* ctl = (gu32*)(ARGS()->ws + WS_CTL);
    for (int u = threadIdx.x; u < (LDS_BYTES - LDSCTL_OFF) / 4; u += NWAVES * 64) ((LAS unsigned*)((LAS unsigned char*)lds + LDSCTL_OFF))[u] = 0u;
    __syncthreads();
    volatile LAS unsigned* MISC = (volatile LAS unsigned*)((LAS unsigned char*)lds + MISC_OFF);
    XcdBarrier bar = xcd_barrier_post((unsigned*)ctl + CW_BAR, MISC + 8);
    const int lo = ARGS()->ph_lo, hi = ARGS()->ph_hi;
#define IN(k) (lo <= (k) && (k) < hi)
#define SEAM(k) do { if (IN(k) && IN((k) + 1)) { _Pragma("unroll") for (int rb_ = 0; rb_ < REP_BAR; ++rb_) xcd_barrier(bar); } } while (0)

#define WSB(T_, off) ((T_*)(A->ws + (off)))
#define Hb WSB(bf16, WS_H)
#define QKVA WSB(bf16, WS_QKVA)
#define QKVOB WSB(bf16, WS_QKVOB)
#define ZUV WSB(bf16, WS_ZUV)
#define Ub WSB(bf16, WS_U)
#define Gb WSB(bf16, WS_G)
#define GATES WSB(float, WS_GATES)
#define SGR WSB(float, WS_SGR)
#define QC WSB(bf16, WS_QC)
#define KC WSB(bf16, WS_KC)
#define Yb WSB(bf16, WS_Y)
#define HF WSB(float, WS_HF)
#define HB WSB(float, WS_HB)
#define MRG WSB(float, WS_MRG)
#define MRGB WSB(bf16, WS_MRGB)
#define Tb WSB(float, WS_T)
#define GSb WSB(float, WS_GS)
#define GDb WSB(float, WS_GD)
#define LSTb WSB(float, WS_LST)
#define NLOCb WSB(float, WS_NLOC)

    if (IN(0) && !KNOB_NO_P0) { MKF();
        LAS float* scr = (LAS float*)(F.lds + RING_OFF + F.wave * 16384);
        _Pragma("unroll") for (int rep_ = 0; rep_ < REP_P0; ++rep_) for (int l = 0; l < DEPTH; ++l) {
            const auto* A = ARGS(); unsigned char* wl = A->ws + WS_W + (size_t)l * WL_BYTES;
            p0_win(F, A->w_in + (size_t)l * D * D_IN, (bf16*)(wl + WL_IN), scr);
            p0_matrix(F, A->w_a + (size_t)l * NA_W * D, NA_W, D, (bf16*)(wl + WL_ABC), scr);
            p0_matrix(F, A->w_b + (size_t)l * ML_W * D, ML_W, D, (bf16*)(wl + WL_ABC) + (size_t)D * 1024, scr);
            p0_matrix(F, A->w_c + (size_t)l * SG_W * D, SG_W, D, (bf16*)(wl + WL_ABC) + (size_t)2 * D * 1024, scr);
            p0_matrix(F, A->w_out + (size_t)l * D * D, D, D, (bf16*)(wl + WL_OUT), scr);
            p0_matrix(F, A->w_up + (size_t)l * D * DFF, D, DFF, (bf16*)(wl + WL_UP), scr);
            p0_matrix(F, A->w_down + (size_t)l * DFF * D, DFF, D, (bf16*)(wl + WL_DN), scr);
        }
    }
    SEAM(0);

    for (int s = 0; s < NSLAB; ++s) {
        const int T = s < 4 ? 4096 : 8192, nseq = MS / T;
        for (int l = 0; l < DEPTH; ++l) {
            const int sb = 1 + (s * DEPTH + l) * STEPS_PER;
            if (sb + STEPS_PER <= lo || sb >= hi) continue;
#define XIN0 (s < 4 ? A->x_prompt + (size_t)s * MS * D : A->x_sample + (size_t)(s - 4) * MS * D)
#define XO (A->out + (size_t)s * MS * D)
#define WL (A->ws + WS_W + (size_t)l * WL_BYTES)
            if (IN(sb + 0) && l == 0 && !KNOB_NO_ROW) { MKF(); const auto* A = ARGS(); row_phase(F, XIN0, nullptr, nullptr, nullptr, A->pre_mix_g, Hb); }
            SEAM(sb + 0);
            if (IN(sb + 1) && !KNOB_NO_WIN) { MKF(); const auto* A = ARGS();
                pg8::Gemm g{Hb, (const bf16*)(WL + WL_IN), MS, N_IN_PAD, D, 0, 0}; pg8::StaticOrder S; S.init(MS, N_IN_PAD, (int)gridDim.x, (int)blockIdx.x);
                pg8::EpiIn E{QKVA, QKVOB, ZUV, Gb, GATES, A->b_gate + l * 16};
                _Pragma("unroll") for (int rep_ = 0; rep_ < REP_WIN; ++rep_) pg8::gemm_phase<pg8::EpiIn, pg8::StaticOrder, true, true>((PG8_LAS unsigned char*)lds + RING_OFF, g, S, E);
            }
            SEAM(sb + 1);
            if (IN(sb + 2) && !KNOB_NO_PREP) { MKF(); const auto* A = ARGS(); _Pragma("unroll") for (int rep_ = 0; rep_ < REP_PREP; ++rep_) { prep_phase(F, QKVOB, A->conv_w + (size_t)l * 3 * 2048, QC, KC, ZUV, SGR, T); if (USE_ML_FAST) ml_gate_local(F, GATES, GSb, GDb, T, nseq * 8); } }
            SEAM(sb + 2);
            if (IN(sb + 3)) { MKF(); const auto* A = ARGS();
                if (USE_ML_FAST) {
                  _Pragma("unroll") for (int rep_ = 0; rep_ < REP_MIX1; ++rep_) {
                    for (int unit = F.vcu; unit < 256; unit += F.G) ml_phaseA(F, unit, KC, QKVOB, GSb, GDb, LSTb, NLOCb, T);
                    const int gw = F.vcu * NWAVES + F.wave, NGW = F.G * NWAVES;
                    na_fast(F, QKVA, A->na_rpb + (size_t)l * 8 * 15 * 31, Yb, T, gw, NGW);
                    sg_fast(F, ZUV, SGR, A->sg_norm_g + l * 1024, A->w_s + (size_t)l * 8 * 128 * 128, A->b_s + l * 1024, Yb + (size_t)2 * MS * 1024, F.vcu, F.G);
                  }
                } else {
                    const int nml = nseq * 32;
                    if (F.vcu < nml) mlstm_naive(F, F.vcu, QC, KC, QKVOB, GATES, HF, HB, T);
                    else { const int gw = (F.vcu - nml) * NWAVES + F.wave, NGW = (F.G - nml) * NWAVES;
                        na_fast(F, QKVA, A->na_rpb + (size_t)l * 8 * 15 * 31, Yb, T, gw, NGW);
                        sg_fast(F, ZUV, SGR, A->sg_norm_g + l * 1024, A->w_s + (size_t)l * 8 * 128 * 128, A->b_s + l * 1024, Yb + (size_t)2 * MS * 1024, F.vcu - nml, F.G - nml); }
                }
            }
            SEAM(sb + 3);
            if (IN(sb + 4) && USE_ML_FAST) { MKF(); const auto* A = ARGS();
                _Pragma("unroll") for (int rep_ = 0; rep_ < REP_MIX2; ++rep_) for (int unit = F.vcu; unit < 256; unit += F.G) ml_phaseC(F, unit, QC, KC, QKVOB, GSb, GDb, LSTb, NLOCb, HF, HB, T);
            }
            SEAM(sb + 4);
            if (IN(sb + 5) && !KNOB_NO_COMB) { MKF(); const auto* A = ARGS(); _Pragma("unroll") for (int rep_ = 0; rep_ < REP_COMB; ++rep_) comb_phase(F, HF, HB, QKVOB, A->ml_norm_g + l * 1024, Yb + (size_t)MS * 1024); }
            SEAM(sb + 5);
            if (IN(sb + 6) && !KNOB_NO_MERGE) { MKF(); const auto* A = ARGS();
                pg8::Gemm g{Yb, (const bf16*)(WL + WL_ABC), MS, D, 1024, (size_t)MS * 1024 * 2, (size_t)D * 1024 * 2}; pg8::ZOrder<3> S; S.init(MS, D, (int)gridDim.x, (int)blockIdx.x);
                pg8::EpiMergeH E{Gb, MRGB};
                _Pragma("unroll") for (int rep_ = 0; rep_ < REP_MERGE; ++rep_) pg8::gemm_phase<pg8::EpiMergeH, pg8::ZOrder<3>, true, true>((PG8_LAS unsigned char*)lds + RING_OFF, g, S, E);
            }
            SEAM(sb + 6);
            if (IN(sb + 7) && !KNOB_NO_WOUT) { MKF(); const auto* A = ARGS();
                pg8::Gemm g{MRGB, (const bf16*)(WL + WL_OUT), MS, D, D, 0, 0}; pg8::StaticOrder S; S.init(MS, D, (int)gridDim.x, (int)blockIdx.x);
                pg8::EpiF32 E{Tb, D};
                _Pragma("unroll") for (int rep_ = 0; rep_ < REP_WOUT; ++rep_) pg8::gemm_phase<pg8::EpiF32, pg8::StaticOrder, true, true>((PG8_LAS unsigned char*)lds + RING_OFF, g, S, E);
            }
            SEAM(sb + 7);
            if (IN(sb + 8) && !KNOB_NO_ROW) { MKF(); const auto* A = ARGS(); _Pragma("unroll") for (int rep_ = 1; rep_ < REP_ROW; ++rep_) row_phase(F, l == 0 ? XIN0 : XO, Tb, A->post_mix_g + l * D, WSB(float, WS_MRG), A->pre_mlp_g + l * D, WSB(bf16, WS_HF)); row_phase(F, l == 0 ? XIN0 : XO, Tb, A->post_mix_g + l * D, XO, A->pre_mlp_g + l * D, Hb); }
            SEAM(sb + 8);
            if (IN(sb + 9) && !KNOB_NO_UP) { MKF(); const auto* A = ARGS();
                pg8::Gemm g{Hb, (const bf16*)(WL + WL_UP), MS, DFF, D, 0, 0}; pg8::StaticOrder S; S.init(MS, DFF, (int)gridDim.x, (int)blockIdx.x);
                pg8::EpiRelu2 E{Ub, DFF};
                _Pragma("unroll") for (int rep_ = 0; rep_ < REP_UP; ++rep_) pg8::gemm_phase<pg8::EpiRelu2, pg8::StaticOrder, true, true>((PG8_LAS unsigned char*)lds + RING_OFF, g, S, E);
            }
            SEAM(sb + 9);
            if (IN(sb + 10) && !KNOB_NO_DOWN) { MKF(); const auto* A = ARGS();
                pg8::Gemm g{Ub, (const bf16*)(WL + WL_DN), MS, D, DFF, 0, 0}; pg8::StaticOrder S; S.init(MS, D, (int)gridDim.x, (int)blockIdx.x);
                pg8::EpiF32 E{Tb, D};
                _Pragma("unroll") for (int rep_ = 0; rep_ < REP_DOWN; ++rep_) pg8::gemm_phase<pg8::EpiF32, pg8::StaticOrder, true, true>((PG8_LAS unsigned char*)lds + RING_OFF, g, S, E);
            }
            SEAM(sb + 10);
            if (IN(sb + 11) && !KNOB_NO_ROW) { MKF(); const auto* A = ARGS(); _Pragma("unroll") for (int rep_ = 1; rep_ < REP_ROW; ++rep_) row_phase(F, XO, Tb, A->post_mlp_g + l * D, WSB(float, WS_MRG), l + 1 < DEPTH ? A->pre_mix_g + (l + 1) * D : nullptr, l + 1 < DEPTH ? WSB(bf16, WS_HF) : nullptr); row_phase(F, XO, Tb, A->post_mlp_g + l * D, XO, l + 1 < DEPTH ? A->pre_mix_g + (l + 1) * D : nullptr, l + 1 < DEPTH ? Hb : nullptr); }
            SEAM(sb + 11);
        }
    }
#undef IN
#undef SEAM
}

#ifndef MK_LAUNCH_PER_STEP
#define MK_LAUNCH_PER_STEP 0
#endif
extern "C" void kernel_launch(void* const* d_in, const int* in_sizes, int n_in, void* d_out, int out_size, void* d_ws, size_t ws_size, hipStream_t stream) {
    static int grid = 0;
    if (grid == 0) {
        if (n_in != 20 || in_sizes[0] != M_PROMPT * D || in_sizes[1] != M_SAMPLE * D || out_size != M_ALL * D || ws_size < WS_END) {
            fprintf(stderr, "kernel_launch: unexpected shapes (n_in %d, in0 %d, in1 %d, out %d, ws %zu); nothing launched\n", n_in, n_in > 0 ? in_sizes[0] : -1, n_in > 1 ? in_sizes[1] : -1, out_size, ws_size); grid = -1; return; }
        int dev = 0, cus = 0;
        if (hipGetDevice(&dev) != hipSuccess || hipDeviceGetAttribute(&cus, hipDeviceAttributeMultiprocessorCount, dev) != hipSuccess) { grid = -1; return; }
        if (hipFuncSetAttribute((const void*)trunk_fwd, hipFuncAttributeMaxDynamicSharedMemorySize, LDS_BYTES) != hipSuccess) { fprintf(stderr, "kernel_launch: hipFuncSetAttribute failed\n"); grid = -1; return; }
        int per_cu = 0;
        if (hipOccupancyMaxActiveBlocksPerMultiprocessor(&per_cu, (const void*)trunk_fwd, NWAVES * 64, LDS_BYTES) != hipSuccess || per_cu < 1)
            fprintf(stderr, "kernel_launch: note: occupancy query reports %d workgroups per CU\n", per_cu);
        (void)hipGetLastError();
        grid = cus;
    }
    if (grid < 0) return;
    if (hipMemsetAsync((char*)d_ws + WS_CTL, 0, CTL_ZERO_BYTES, stream) != hipSuccess) return;
    Args a{};
    a.x_prompt = (const float*)d_in[0]; a.x_sample = (const float*)d_in[1]; a.pre_mix_g = (const float*)d_in[2]; a.post_mix_g = (const float*)d_in[3];
    a.pre_mlp_g = (const float*)d_in[4]; a.post_mlp_g = (const float*)d_in[5]; a.w_in = (const float*)d_in[6]; a.b_gate = (const float*)d_in[7];
    a.conv_w = (const float*)d_in[8]; a.na_rpb = (const float*)d_in[9]; a.ml_norm_g = (const float*)d_in[10]; a.sg_norm_g = (const float*)d_in[11];
    a.w_s = (const float*)d_in[12]; a.b_s = (const float*)d_in[13]; a.w_a = (const float*)d_in[14]; a.w_b = (const float*)d_in[15]; a.w_c = (const float*)d_in[16];
    a.w_out = (const float*)d_in[17]; a.w_up = (const float*)d_in[18]; a.w_down = (const float*)d_in[19];
    a.out = (float*)d_out; a.ws = (unsigned char*)d_ws;
#if MK_LAUNCH_PER_STEP
    for (int k = 0; k < N_STEPS; ++k) { a.ph_lo = k; a.ph_hi = k + 1; hipLaunchKernelGGL(trunk_fwd, dim3(grid), dim3(NWAVES * 64), LDS_BYTES, stream, a); }
#else
    a.ph_lo = 0; a.ph_hi = N_STEPS;
    hipLaunchKernelGGL(trunk_fwd, dim3(grid), dim3(NWAVES * 64), LDS_BYTES, stream, a);
#endif
}
```

```cpp
#include <hip/hip_runtime.h>
#include <cstdio>
#include <cstdint>
namespace pg8 {
#define PG8_LAS __attribute__((address_space(3)))
typedef unsigned short bf16_t;
typedef short bf16x8 __attribute__((ext_vector_type(8)));
typedef float f32x4 __attribute__((ext_vector_type(4)));
typedef unsigned u32x4 __attribute__((ext_vector_type(4)));
typedef unsigned u32x2 __attribute__((ext_vector_type(2)));
constexpr int BM = 256, BK = 64, HALF = 128, HTB = HALF * BK * 2  , STAGE_BYTES = 8 * HTB, NXCD = 8, WGM = 8;

__host__ __device__ __forceinline__ int lds_byte(int r, int c) { const int st = (r >> 4) * 2 + (c >> 5), rr = r & 15, cc = c & 31, ob = rr * 64 + cc * 2; return st * 1024 + (ob ^ (((ob >> 9) & 1) << 5)); }
__host__ __device__ __forceinline__ void stage_rc(int b, int& R, int& C) { const int st = b / 1024, sb = b % 1024, swz = sb ^ (((sb >> 9) & 1) << 5); R = (st >> 1) * 16 + swz / 64; C = (st & 1) * 32 + (swz % 64) / 2; }
__host__ __device__ __forceinline__ int perm32(int rho) { const int n = rho >> 4, i = rho & 15; return 8 * (i >> 2) + 4 * n + (i & 3); }

struct Unit { int pm, pn, z; };
struct Gemm { const bf16_t* A; const bf16_t* Bt; int M, N, K; size_t zA, zB; };

struct StaticOrder {
    int nM, nN, nwg, G, c;
    __host__ __device__ void init(int M, int N, int G_, int c_) { nM = M / BM; nN = N / BM; nwg = nM * nN; G = G_; c = c_; }
    __host__ __device__ bool tile(long L, Unit& u) const {
        if (L >= nwg) return false;
        int wgid = (int)L; { const int q = nwg / NXCD, r = nwg % NXCD, xcd = wgid % NXCD, off = wgid / NXCD; wgid = (xcd < r ? xcd * (q + 1) : r * (q + 1) + (xcd - r) * q) + off; }
        const int nig = WGM * nN, gid = wgid / nig, fm = gid * WGM, gsz = (nM - fm) < WGM ? (nM - fm) : WGM;
        u.pm = fm + ((wgid % nig) % gsz); u.pn = (wgid % nig) / gsz; return true;
    }
    __host__ __device__ bool next(int i, Unit& u) const { u.z = 0; return tile((long)i * G + c, u); }
    __device__ __forceinline__ void a_ready(const Unit&) const {}
    __device__ __forceinline__ void done(const Unit&) const {}
};
template <int NZ> struct ZOrder : StaticOrder {
    __host__ __device__ bool next(int i, Unit& u) const { const int k = i / NZ; u.z = i - k * NZ; return tile((long)k * G + c, u); }
};

__device__ __forceinline__ unsigned cvt_pk_bf16(float lo, float hi) { unsigned r; asm volatile("v_cvt_pk_bf16_f32 %0, %1, %2" : "=v"(r) : "v"(lo), "v"(hi)); return r; }
__device__ __forceinline__ float sigm(float x) { return __builtin_amdgcn_rcpf(1.0f + __builtin_amdgcn_exp2f(-1.4426950408889634f * x)); }
__device__ __forceinline__ float gelu_tanh(float x) { return x * sigm(1.5957691216057308f * x * (1.0f + 0.044715f * x * x)); }
__device__ __forceinline__ float act_apply(int act, float x) { return act == 1 ? sigm(x) : (act == 2 ? gelu_tanh(x) : x); }

struct EpiIn {
    static constexpr bool PERM = true, AFTER_DRAIN = false;
    __device__ static __forceinline__ bool keep(const Unit&) { return false; }
    bf16_t *qkva, *qkvob, *zuv, *g; float* gates; const float* bgate;
    __device__ __forceinline__ void operator()(const f32x4 (&acc)[2][2][4][2], const Unit& u, int wr, int wc, int fr, int fq) const {
        const int pn = u.pn, row0 = u.pm * BM + wr * 64 + fr;
        if (pn == 60) {
            if (wc == 0 && fq < 2) {
#pragma unroll
                for (int ai = 0; ai < 2; ++ai)
#pragma unroll
                    for (int m = 0; m < 4; ++m)
#pragma unroll
                        for (int n = 0; n < 2; ++n) { const int col = 8 * fq + 4 * n; *(f32x4*)(gates + (size_t)(row0 + ai * HALF + m * 16) * 16 + col) = acc[ai][0][m][n] + *(const f32x4*)(bgate + col); }
            }
            return;
        }
        bf16_t* base; int ldc, colt, act;
        if (pn < 12) { base = qkva; ldc = 3072; colt = pn * BM; act = 0; }
        else if (pn < 28) { base = qkvob; ldc = 4096; colt = (pn - 12) * BM; act = pn >= 24 ? 1 : 0; }
        else if (pn < 36) { base = zuv; ldc = 2048; colt = (pn - 28) * BM; act = 2; }
        else { base = g; ldc = 6144; colt = (pn - 36) * BM; act = 1; }
        const int col0 = colt + wc * 32 + 8 * fq;
#pragma unroll
        for (int ai = 0; ai < 2; ++ai)
#pragma unroll
            for (int m = 0; m < 4; ++m) { bf16_t* rowp = base + (size_t)(row0 + ai * HALF + m * 16) * ldc + col0;
#pragma unroll
                for (int bj = 0; bj < 2; ++bj) { f32x4 v0 = acc[ai][bj][m][0], v1 = acc[ai][bj][m][1];
                    if (act != 0) {
#pragma unroll
                        for (int j = 0; j < 4; ++j) { v0[j] = act_apply(act, v0[j]); v1[j] = act_apply(act, v1[j]); } }
                    u32x4 w; w.x = cvt_pk_bf16(v0[0], v0[1]); w.y = cvt_pk_bf16(v0[2], v0[3]); w.z = cvt_pk_bf16(v1[0], v1[1]); w.w = cvt_pk_bf16(v1[2], v1[3]);
                    *(u32x4*)(rowp + bj * HALF) = w; } }
    }
};
struct EpiMerge {
    static constexpr bool PERM = false, AFTER_DRAIN = false;
    __device__ static __forceinline__ bool keep(const Unit&) { return false; }
    const bf16_t* g; float* mrg; bf16_t* mrgb;
    __device__ __forceinline__ void operator()(const f32x4 (&acc)[2][2][4][2], const Unit& u, int wr, int wc, int fr, int fq) const {
        const int z = u.z, row0 = u.pm * BM + wr * 64 + fr, col0 = u.pn * BM + wc * 32 + 4 * fq;
#pragma unroll
        for (int ai = 0; ai < 2; ++ai)
#pragma unroll
            for (int m = 0; m < 4; ++m) { const size_t row = (size_t)(row0 + ai * HALF + m * 16);
#pragma unroll
                for (int bj = 0; bj < 2; ++bj)
#pragma unroll
                    for (int n = 0; n < 2; ++n) { const int col = col0 + bj * HALF + n * 16;
                        const u32x2 gw = *(const u32x2*)(g + row * 6144 + (size_t)z * 2048 + col);
                        f32x4 gv; gv[0] = __uint_as_float(gw.x << 16); gv[1] = __uint_as_float(gw.x & 0xffff0000u); gv[2] = __uint_as_float(gw.y << 16); gv[3] = __uint_as_float(gw.y & 0xffff0000u);
                        f32x4 v = acc[ai][bj][m][n] * gv;
                        if (z > 0) v += *(const f32x4*)(mrg + row * 2048 + col);
                        if (z < 2) *(f32x4*)(mrg + row * 2048 + col) = v;
                        else { u32x2 w; w.x = cvt_pk_bf16(v[0], v[1]); w.y = cvt_pk_bf16(v[2], v[3]); *(u32x2*)(mrgb + row * 2048 + col) = w; } }
                asm volatile("" ::: "memory"); }
    }
};
struct EpiMergeH {
    static constexpr bool PERM = true, AFTER_DRAIN = false;
    const bf16_t* g; bf16_t* mrgb;
    __device__ static __forceinline__ bool keep(const Unit& u) { return u.z < 2; }
    __device__ __forceinline__ void operator()(f32x4 (&acc)[2][2][4][2], const Unit& u, int wr, int wc, int fr, int fq) const {
        const int z = u.z, row0 = u.pm * BM + wr * 64 + fr, col0 = u.pn * BM + wc * 32 + 8 * fq;
#pragma unroll
        for (int ai = 0; ai < 2; ++ai)
#pragma unroll
            for (int m = 0; m < 4; ++m) { const size_t row = (size_t)(row0 + ai * HALF + m * 16);
#pragma unroll
                for (int bj = 0; bj < 2; ++bj) { const int col = col0 + bj * HALF;
                    const u32x4 gz = *(const u32x4*)(g + row * 6144 + (size_t)z * 2048 + col);
                    float f[8];
                    if (z < 2) { const u32x4 gn = *(const u32x4*)(g + row * 6144 + (size_t)(z + 1) * 2048 + col);
#pragma unroll
                        for (int j = 0; j < 4; ++j) { f[2 * j] = __uint_as_float(gz[j] << 16) * __builtin_amdgcn_rcpf(fmaxf(__uint_as_float(gn[j] << 16), 1e-30f));
                            f[2 * j + 1] = __uint_as_float(gz[j] & 0xffff0000u) * __builtin_amdgcn_rcpf(fmaxf(__uint_as_float(gn[j] & 0xffff0000u), 1e-30f)); }
                    } else {
#pragma unroll
                        for (int j = 0; j < 4; ++j) { f[2 * j] = __uint_as_float(gz[j] << 16); f[2 * j + 1] = __uint_as_float(gz[j] & 0xffff0000u); } }
#pragma unroll
                    for (int j = 0; j < 4; ++j) { acc[ai][bj][m][0][j] *= f[j]; acc[ai][bj][m][1][j] *= f[4 + j]; }
                    if (z == 2) { const f32x4 v0 = acc[ai][bj][m][0], v1 = acc[ai][bj][m][1];
                        u32x4 w; w.x = cvt_pk_bf16(v0[0], v0[1]); w.y = cvt_pk_bf16(v0[2], v0[3]); w.z = cvt_pk_bf16(v1[0], v1[1]); w.w = cvt_pk_bf16(v1[2], v1[3]);
                        *(u32x4*)(mrgb + row * 2048 + col) = w; } }
                asm volatile("" ::: "memory"); }
    }
};
struct EpiF32 {
    static constexpr bool PERM = false, AFTER_DRAIN = false;
    __device__ static __forceinline__ bool keep(const Unit&) { return false; }
    float* C; int ldc;
    __device__ __forceinline__ void operator()(const f32x4 (&acc)[2][2][4][2], const Unit& u, int wr, int wc, int fr, int fq) const {
        const int row0 = u.pm * BM + wr * 64 + fr, col0 = u.pn * BM + wc * 32 + 4 * fq;
#pragma unroll
        for (int ai = 0; ai < 2; ++ai)
#pragma unroll
            for (int m = 0; m < 4; ++m) { float* rowp = C + (size_t)(row0 + ai * HALF + m * 16) * ldc + col0;
#pragma unroll
                for (int bj = 0; bj < 2; ++bj)
#pragma unroll
                    for (int n = 0; n < 2; ++n) *(f32x4*)(rowp + bj * HALF + n * 16) = acc[ai][bj][m][n]; }
    }
};
struct EpiRelu2 {
    static constexpr bool PERM = true, AFTER_DRAIN = false;
    __device__ static __forceinline__ bool keep(const Unit&) { return false; }
    bf16_t* O; int ldc;
    __device__ __forceinline__ void operator()(const f32x4 (&acc)[2][2][4][2], const Unit& u, int wr, int wc, int fr, int fq) const {
        const int row0 = u.pm * BM + wr * 64 + fr, col0 = u.pn * BM + wc * 32 + 8 * fq;
#pragma unroll
        for (int ai = 0; ai < 2; ++ai)
#pragma unroll
            for (int m = 0; m < 4; ++m) { bf16_t* rowp = O + (size_t)(row0 + ai * HALF + m * 16) * ldc + col0;
#pragma unroll
                for (int bj = 0; bj < 2; ++bj) { f32x4 v0 = acc[ai][bj][m][0], v1 = acc[ai][bj][m][1];
#pragma unroll
                    for (int j = 0; j < 4; ++j) { const float a = fmaxf(v0[j], 0.f), b = fmaxf(v1[j], 0.f); v0[j] = a * a; v1[j] = b * b; }
                    u32x4 w; w.x = cvt_pk_bf16(v0[0], v0[1]); w.y = cvt_pk_bf16(v0[2], v0[3]); w.z = cvt_pk_bf16(v1[0], v1[1]); w.w = cvt_pk_bf16(v1[2], v1[3]);
                    *(u32x4*)(rowp + bj * HALF) = w; } }
    }
};

template <class Epi, class Sched, bool ALIGN_EPI = false, bool SP2 = false>
__device__ __forceinline__ void gemm_phase(PG8_LAS unsigned char* lds, const Gemm g, const Sched& S, const Epi& E) {
    int tid_l = threadIdx.x; asm volatile("" : "+v"(tid_l));
    const int tid = tid_l, wid = __builtin_amdgcn_readfirstlane(tid >> 6), lane = tid & 63, wr = wid >> 2, wc = wid & 3, fr = lane & 15, fq = lane >> 4;
    const int K = g.K, nt = K / BK;
    unsigned voffA[2], voffB[2];
#pragma unroll
    for (int i = 0; i < 2; ++i) { int R, C; stage_rc(tid * 16 + i * 8192, R, C); const int Rb = Epi::PERM ? ((R & ~31) + perm32(R & 31)) : R;
        voffA[i] = (unsigned)(R * K + C) * 2u; voffB[i] = (unsigned)(Rb * K + C) * 2u; }
    const size_t kstep = (size_t)(BK * 2);
    const size_t hstep = (size_t)HALF * K * 2;
    const size_t tstep = 2 * hstep;
    const unsigned ldsw = (unsigned)wid * 1024u;
    const int aoff = lds_byte(wr * 64 + fr, fq * 8), boff = lds_byte(wc * 32 + fr, fq * 8);
#define PG8_SA(b, h) (((b) * 2 + (h)) * HTB)
#define PG8_SB(b, h) ((4 + (b) * 2 + (h)) * HTB)
#define PG8_STAGE(bufoff, gbase, voff) do { _Pragma("unroll") for (int _i = 0; _i < 2; ++_i) \
        __builtin_amdgcn_global_load_lds((const unsigned*)((const char*)(gbase) + (voff)[_i]), (PG8_LAS unsigned*)(lds + (bufoff) + ldsw + _i * 8192), 16, 0, 0); } while (0)
#define PG8_LDA(dst, b, h) do { _Pragma("unroll") for (int m = 0; m < 4; ++m) _Pragma("unroll") for (int k = 0; k < 2; ++k) dst[m][k] = *(const PG8_LAS bf16x8*)(lds + PG8_SA(b, h) + aoff + m * 2048 + k * 1024); } while (0)
#define PG8_LDB(dst, b, h) do { _Pragma("unroll") for (int n = 0; n < 2; ++n) _Pragma("unroll") for (int k = 0; k < 2; ++k) dst[n][k] = *(const PG8_LAS bf16x8*)(lds + PG8_SB(b, h) + boff + n * 2048 + k * 1024); } while (0)
#define PG8_MMA(ai, bj, At, Bt) do { __builtin_amdgcn_s_setprio(1); _Pragma("unroll") for (int m = 0; m < 4; ++m) _Pragma("unroll") for (int n = 0; n < 2; ++n) _Pragma("unroll") for (int k = 0; k < 2; ++k) \
        acc[ai][bj][m][n] = __builtin_amdgcn_mfma_f32_16x16x32_bf16(Bt[n][k], At[m][k], acc[ai][bj][m][n], 0, 0, 0); __builtin_amdgcn_s_setprio(0); } while (0)
#define PG8_WAIT_V(n) asm volatile("s_waitcnt vmcnt(" #n ")" ::: "memory")
#define PG8_WAIT_L(n) asm volatile("s_waitcnt lgkmcnt(" #n ")" ::: "memory")
#define PG8_BAR __builtin_amdgcn_s_barrier()
#define PG8_SCHED __builtin_amdgcn_sched_barrier(0)
    Unit cur, nxt; int ui = 0;
    if (!S.next(0, cur)) return;
    f32x4 acc[2][2][4][2];
#pragma unroll
    for (int a = 0; a < 2; ++a)
#pragma unroll
        for (int b = 0; b < 2; ++b)
#pragma unroll
            for (int m = 0; m < 4; ++m)
#pragma unroll
                for (int n = 0; n < 2; ++n) acc[a][b][m][n] = (f32x4){0.f, 0.f, 0.f, 0.f};
    bf16x8 At[4][2], B0[2][2], B1[2][2];
    const char* cA = (const char*)g.A + (size_t)cur.pm * tstep + (size_t)cur.z * g.zA; const char* cB = (const char*)g.Bt + (size_t)cur.pn * tstep + (size_t)cur.z * g.zB;
    S.a_ready(cur);
    if constexpr (SP2) {
        PG8_STAGE(PG8_SB(0, 0), cB, voffB); PG8_STAGE(PG8_SB(0, 1), cB + hstep, voffB); PG8_STAGE(PG8_SA(0, 0), cA, voffA); PG8_STAGE(PG8_SA(0, 1), cA + hstep, voffA);
        if (wr == 1) PG8_BAR;
        PG8_WAIT_V(2); PG8_BAR;
        PG8_STAGE(PG8_SB(1, 0), cB + kstep, voffB); PG8_STAGE(PG8_SA(1, 0), cA + kstep, voffA); PG8_STAGE(PG8_SB(1, 1), cB + hstep + kstep, voffB);
        PG8_WAIT_V(6); PG8_BAR;
    } else {
        PG8_STAGE(PG8_SB(0, 0), cB, voffB); PG8_STAGE(PG8_SA(0, 0), cA, voffA); PG8_STAGE(PG8_SB(0, 1), cB + hstep, voffB); PG8_STAGE(PG8_SA(0, 1), cA + hstep, voffA);
        if (wr == 1) PG8_BAR;
        PG8_WAIT_V(4); PG8_BAR;
        PG8_STAGE(PG8_SB(1, 0), cB + kstep, voffB); PG8_STAGE(PG8_SA(1, 0), cA + kstep, voffA); PG8_STAGE(PG8_SB(1, 1), cB + hstep + kstep, voffB);
        PG8_WAIT_V(6); PG8_BAR;
    }
    for (;;) {
        const bool has_next = S.next(ui + 1, nxt);
        const char* nA = has_next ? (const char*)g.A + (size_t)nxt.pm * tstep + (size_t)nxt.z * g.zA : cA; const char* nB = has_next ? (const char*)g.Bt + (size_t)nxt.pn * tstep + (size_t)nxt.z * g.zB : cB;
        for (int t = 0; t < nt; t += 2) {
            const bool last = (t == nt - 2);
            const char* a1 = cA + (size_t)(t + 1) * kstep;
            const char* a2 = last ? nA : cA + (size_t)(t + 2) * kstep; const char* b2 = last ? nB : cB + (size_t)(t + 2) * kstep;
            const char* a3 = a2 + kstep; const char* b3 = b2 + kstep;
            if (last && has_next) S.a_ready(nxt);
            if constexpr (SP2) {
            PG8_LDB(B0, 0, 0); PG8_LDB(B1, 0, 1); PG8_SCHED; PG8_LDA(At, 0, 0); PG8_STAGE(PG8_SA(1, 1), a1 + hstep, voffA);
            PG8_WAIT_V(8); PG8_WAIT_L(0); PG8_BAR; PG8_MMA(0, 0, At, B0); PG8_MMA(0, 1, At, B1); PG8_BAR; PG8_SCHED;
            PG8_LDA(At, 0, 1); PG8_STAGE(PG8_SB(0, 0), b2, voffB); PG8_STAGE(PG8_SB(0, 1), b2 + hstep, voffB); PG8_STAGE(PG8_SA(0, 0), a2, voffA);
            PG8_WAIT_V(8); PG8_WAIT_L(0); PG8_BAR; PG8_MMA(1, 0, At, B0); PG8_MMA(1, 1, At, B1); PG8_BAR; PG8_SCHED;
            PG8_LDB(B0, 1, 0); PG8_LDB(B1, 1, 1); PG8_SCHED; PG8_LDA(At, 1, 0); PG8_STAGE(PG8_SA(0, 1), a2 + hstep, voffA);
            PG8_WAIT_V(8); PG8_WAIT_L(0); PG8_BAR; PG8_MMA(0, 0, At, B0); PG8_MMA(0, 1, At, B1); PG8_BAR; PG8_SCHED;
            PG8_LDA(At, 1, 1); PG8_STAGE(PG8_SB(1, 0), b3, voffB); PG8_STAGE(PG8_SB(1, 1), b3 + hstep, voffB); PG8_STAGE(PG8_SA(1, 0), a3, voffA);
            PG8_WAIT_V(8); PG8_WAIT_L(0); PG8_BAR; PG8_MMA(1, 0, At, B0); PG8_MMA(1, 1, At, B1); PG8_BAR; PG8_SCHED;
            } else {
            PG8_LDB(B0, 0, 0); PG8_SCHED; PG8_LDA(At, 0, 0); PG8_STAGE(PG8_SA(1, 1), a1 + hstep, voffA);
            PG8_WAIT_L(8); PG8_BAR; PG8_WAIT_L(0); PG8_MMA(0, 0, At, B0); PG8_BAR; PG8_SCHED;
            PG8_LDB(B1, 0, 1); PG8_STAGE(PG8_SB(0, 0), b2, voffB);
            PG8_BAR; PG8_WAIT_L(0); PG8_MMA(0, 1, At, B1); PG8_BAR;
            PG8_LDA(At, 0, 1); PG8_STAGE(PG8_SA(0, 0), a2, voffA);
            PG8_BAR; PG8_WAIT_L(0); PG8_MMA(1, 0, At, B0); PG8_BAR; PG8_SCHED;
            PG8_STAGE(PG8_SB(0, 1), b2 + hstep, voffB);
            PG8_WAIT_V(6); PG8_BAR; PG8_MMA(1, 1, At, B1); PG8_BAR;
            PG8_LDB(B0, 1, 0); PG8_SCHED; PG8_LDA(At, 1, 0); PG8_STAGE(PG8_SA(0, 1), a2 + hstep, voffA);
            PG8_WAIT_L(8); PG8_BAR; PG8_WAIT_L(0); PG8_MMA(0, 0, At, B0); PG8_BAR; PG8_SCHED;
            PG8_LDB(B1, 1, 1); PG8_STAGE(PG8_SB(1, 0), b3, voffB);
            PG8_BAR; PG8_WAIT_L(0); PG8_MMA(0, 1, At, B1); PG8_BAR;
            PG8_LDA(At, 1, 1); PG8_STAGE(PG8_SA(1, 0), a3, voffA);
            PG8_BAR; PG8_WAIT_L(0); PG8_MMA(1, 0, At, B0); PG8_BAR; PG8_SCHED;
            PG8_STAGE(PG8_SB(1, 1), b3 + hstep, voffB);
            PG8_WAIT_V(6); PG8_BAR; PG8_MMA(1, 1, At, B1); PG8_BAR;
            }
        }
        if constexpr (ALIGN_EPI) { if (wr == 0) PG8_BAR; }
        if constexpr (!Epi::AFTER_DRAIN) { E(acc, cur, wr, wc, fr, fq); S.done(cur); }
        if (!has_next) break;
        if (!Epi::keep(cur)) {
#pragma unroll
        for (int a = 0; a < 2; ++a)
#pragma unroll
            for (int b = 0; b < 2; ++b)
#pragma unroll
                for (int m = 0; m < 4; ++m)
#pragma unroll
                    for (int n = 0; n < 2; ++n) acc[a][b][m][n] = (f32x4){0.f, 0.f, 0.f, 0.f};
        }
        cur = nxt; cA = nA; cB = nB; ++ui;
        if constexpr (ALIGN_EPI) { if (wr == 1) PG8_BAR; }
    }
    PG8_WAIT_V(0);
    if constexpr (!ALIGN_EPI) { if (wr == 0) PG8_BAR; }
    PG8_BAR;
    if constexpr (Epi::AFTER_DRAIN) { E.fused(acc, cur, wr, wc, fr, fq, lds, wid, lane); S.done(cur); }
#undef PG8_SA
#undef PG8_SB
#undef PG8_STAGE
#undef PG8_LDA
#undef PG8_LDB
#undef PG8_MMA
#undef PG8_WAIT_V
#undef PG8_WAIT_L
#undef PG8_BAR
#undef PG8_SCHED
}
}

constexpr int NWAVES = 8;
constexpr int D = 2048, DEPTH = 2, DFF = 8192;
constexpr int NA_W = 1024, ML_W = 1024, SG_W = 1024;
constexpr int D_IN = 15376, N_IN_PAD = 15616;
constexpr int M_PROMPT = 8 * 4096, M_SAMPLE = 2 * 8192, M_ALL = M_PROMPT + M_SAMPLE;
constexpr int MS = 8192, NSLAB = M_ALL / MS;
constexpr float EPS = 1e-6f;

constexpr size_t MiB = 1u << 20;
constexpr size_t WS_CTL = 0, CTL_ZERO_BYTES = 1 * MiB;
constexpr size_t WL_IN = 0, WL_ABC = 61 * MiB, WL_OUT = 73 * MiB, WL_UP = 81 * MiB, WL_DN = 113 * MiB, WL_BYTES = 145 * MiB;
constexpr size_t WS_W = 1 * MiB;
constexpr size_t WS_H = 291 * MiB;
constexpr size_t WS_QKVA = 323 * MiB;
constexpr size_t WS_QKVOB = 371 * MiB;
constexpr size_t WS_ZUV = 435 * MiB;
constexpr size_t WS_U = WS_QKVA;
constexpr size_t WS_G = 467 * MiB;
constexpr size_t WS_GATES = 563 * MiB;
constexpr size_t WS_SGR = WS_GATES + MiB / 2;
constexpr size_t WS_QC = 564 * MiB, WS_KC = 580 * MiB;
constexpr size_t WS_Y = 596 * MiB;
constexpr size_t WS_HF = 644 * MiB, WS_HB = 676 * MiB;
constexpr size_t WS_MRG = 708 * MiB;
constexpr size_t WS_MRGB = 772 * MiB;
constexpr size_t WS_T = 804 * MiB;
constexpr size_t WS_GS = 868 * MiB;
constexpr size_t WS_GD = 870 * MiB;
constexpr size_t WS_LST = 871 * MiB;
constexpr size_t WS_NLOC = 887 * MiB;
constexpr size_t WS_END = 888 * MiB;
static_assert(WS_W + 2 * WL_BYTES <= WS_H && WS_U + (size_t)MS * DFF * 2 <= WS_G && WS_SGR + (size_t)MS * 4 <= WS_QC, "d_ws map");
constexpr int CW_BAR = 4096;

constexpr int RING_OFF = 0, RING_BYTES = 131072;
constexpr int LDSCTL_OFF = 153600, MISC_OFF = LDSCTL_OFF + 320;
constexpr int LDS_BYTES = 155648;

#define GAS __attribute__((address_space(1)))
#define LAS __attribute__((address_space(3)))
typedef unsigned short bf16;
typedef unsigned v4u __attribute__((ext_vector_type(4)));
typedef float f32x4 __attribute__((ext_vector_type(4)));
typedef short bf16x8 __attribute__((ext_vector_type(8)));
typedef GAS unsigned gu32;
typedef GAS unsigned long long gu64;
#define RLX_AGENT __ATOMIC_RELAXED, __HIP_MEMORY_SCOPE_AGENT
#define LDS_WAIT() asm volatile("s_waitcnt lgkmcnt(0)" ::: "memory")
#define VM_WAIT() asm volatile("s_waitcnt vmcnt(0)" ::: "memory")
__device__ __forceinline__ unsigned long long rt() { return __builtin_amdgcn_s_memrealtime(); }
__device__ __forceinline__ unsigned f2bf(float f) { unsigned u = __builtin_bit_cast(unsigned, f); return (u + 0x7fffu + ((u >> 16) & 1u)) >> 16; }
__device__ __forceinline__ unsigned pk2(float lo, float hi) { return f2bf(lo) | (f2bf(hi) << 16); }

#define XB_TMO      128
#define XB_XCNT(j)  (256  + 64 * (j))
#define XB_XSUB(j)  (1280 + 64 * (j))
#define XB_XGEN(j)  (2304 + 64 * (j))
#define XB_TOP      3328
#define XB_TOPGEN   3392
#define XCD_BAR_WORDS 3456
#define XB_SPIN_CAP (1u << 18)

__device__ __forceinline__ unsigned xb_ld(unsigned* p)              { return __hip_atomic_load(p, __ATOMIC_RELAXED, __HIP_MEMORY_SCOPE_AGENT); }
__device__ __forceinline__ unsigned xb_add(unsigned* p, unsigned v) { return __hip_atomic_fetch_add(p, v, __ATOMIC_RELAXED, __HIP_MEMORY_SCOPE_AGENT); }
__device__ __forceinline__ unsigned xb_xcc_id() { return (unsigned)__builtin_amdgcn_s_getreg((3 << 11) | 20) & 0xFu; }
#define XB_SPIN(cond, bar) do { unsigned _sp = 0; while (cond) { __builtin_amdgcn_s_sleep(1); \
    if ((++_sp & 255u) == 0u) { if (xb_ld(&(bar)[XB_TMO])) break; if (_sp > XB_SPIN_CAP) { atomicAdd(&(bar)[XB_TMO], 1u); break; } } } } while (0)

struct XcdBarrier {
    unsigned* bar; unsigned x;
    volatile LAS unsigned* st;
};

__device__ __forceinline__ XcdBarrier xcd_barrier_post(unsigned* bar, volatile LAS unsigned* st) {
    XcdBarrier b; b.bar = bar; b.x = xb_xcc_id(); b.st = st;
    if (threadIdx.x == 0) (void)xb_add(&bar[XB_XCNT(b.x)], 1u);
    return b;
}
__device__ __forceinline__ void xcd_barrier_complete(unsigned* bar, unsigned x, unsigned& nloc, unsigned& nx) {
    const unsigned G = gridDim.x * gridDim.y * gridDim.z;
    unsigned sum, cnt, mine, sp = 0u;
    for (;;) {
        sum = 0u; cnt = 0u; mine = 0u;
#pragma unroll
        for (unsigned j = 0; j < 16; ++j) { const unsigned c = xb_ld(&bar[XB_XCNT(j)]); sum += c; cnt += (c > 0u) ? 1u : 0u; mine = (j == x) ? c : mine; }
        if (sum == G) break;
        __builtin_amdgcn_s_sleep(1);
        if ((++sp & 255u) == 0u) { if (xb_ld(&bar[XB_TMO])) break; if (sp > XB_SPIN_CAP) { atomicAdd(&bar[XB_TMO], 1u); break; } }
    }
    nloc = mine > 0u ? mine : 1u; nx = cnt > 0u ? cnt : 1u;
}

__device__ __forceinline__ void xcd_barrier(const XcdBarrier& b) {
    asm volatile("s_waitcnt vmcnt(0)" ::: "memory");
    __syncthreads();
    if (threadIdx.x == 0) {
        unsigned* bar = b.bar;
        __builtin_amdgcn_s_waitcnt(0);
        unsigned nloc = b.st[0], nx = b.st[1];
        if (nloc == 0u) { xcd_barrier_complete(bar, b.x, nloc, nx); b.st[0] = nloc; b.st[1] = nx; }
        const unsigned old = xb_add(&bar[XB_XSUB(b.x)], 1u);
        const unsigned gen = old / nloc;
        if (old + 1u == (gen + 1u) * nloc) {
            __builtin_amdgcn_fence(__ATOMIC_RELEASE, "agent");
            asm volatile("s_waitcnt vmcnt(0)" ::: "memory");
            const unsigned og = xb_add(&bar[XB_TOP], 1u);
            const unsigned tg = og / nx;
            if (og + 1u == (tg + 1u) * nx) xb_add(&bar[XB_TOPGEN], 1u);
            else XB_SPIN(xb_ld(&bar[XB_TOPGEN]) == tg, bar);
            __builtin_amdgcn_fence(__ATOMIC_ACQUIRE, "agent");
            xb_add(&bar[XB_XGEN(b.x)], 1u);
            asm volatile("s_waitcnt vmcnt(0)" ::: "memory");
        } else {
            XB_SPIN(xb_ld(&bar[XB_XGEN(b.x)]) == gen, bar);
            __builtin_amdgcn_fence(__ATOMIC_ACQUIRE, "agent");
            asm volatile("s_waitcnt vmcnt(0)" ::: "memory");
        }
    }
    __syncthreads();
}

struct Frame {
    LAS unsigned char* lds;
    int tid, lane, wave;
    int vcu, G;
};
struct Args {
    const float* x_prompt; const float* x_sample; const float* pre_mix_g; const float* post_mix_g; const float* pre_mlp_g; const float* post_mlp_g;
    const float* w_in; const float* b_gate; const float* conv_w; const float* na_rpb; const float* ml_norm_g; const float* sg_norm_g; const float* w_s; const float* b_s;
    const float* w_a; const float* w_b; const float* w_c; const float* w_out; const float* w_up; const float* w_down;
    float* out; unsigned char* ws;
    int ph_lo, ph_hi;
};

__device__ __forceinline__ float wave_sum(float v) {
#pragma unroll
    for (int o = 1; o < 64; o <<= 1) v += __shfl_xor(v, o);
    return v;
}
__device__ __forceinline__ float wave_max(float v) {
#pragma unroll
    for (int o = 1; o < 64; o <<= 1) v = fmaxf(v, __shfl_xor(v, o));
    return v;
}
__device__ __forceinline__ float bf_lo(unsigned u) { return __uint_as_float(u << 16); }
__device__ __forceinline__ float bf_hi(unsigned u) { return __uint_as_float(u & 0xffff0000u); }
__device__ __forceinline__ float sigmoid_f(float x) { return __builtin_amdgcn_rcpf(1.0f + __builtin_amdgcn_exp2f(-1.4426950408889634f * x)); }

__device__ __forceinline__ void p0_transpose_item(const float* W, int K, int N, bf16* WT, int k0, int n0, int ncols, int drow0, float sc, LAS float* scr, int lane) {
    const int cl = lane & 31;
#pragma unroll 8
    for (int i = 0; i < 32; ++i) { const int kk = 2 * i + (lane >> 5); scr[kk * 33 + cl] = (cl < ncols) ? W[(size_t)(k0 + kk) * N + n0 + cl] * sc : 0.f; }
    LDS_WAIT(); asm volatile("" ::: "memory");
    const int c = lane & 7;
#pragma unroll
    for (int j = 0; j < 4; ++j) { const int n = (lane >> 3) + 8 * j; const LAS float* s = scr + (8 * c) * 33 + n;
        v4u o; o.x = pk2(s[0 * 33], s[1 * 33]); o.y = pk2(s[2 * 33], s[3 * 33]); o.z = pk2(s[4 * 33], s[5 * 33]); o.w = pk2(s[6 * 33], s[7 * 33]);
        if (n < ncols) *(GAS v4u*)(WT + (size_t)(drow0 + n) * K + k0 + 8 * c) = o; }
    LDS_WAIT(); asm volatile("" ::: "memory");
}
__device__ __forceinline__ void p0_matrix(Frame& F, const float* W, int K, int N, bf16* WT, LAS float* scr) {
    const int gw = F.vcu * NWAVES + F.wave, NGW = F.G * NWAVES, nblk = N / 32, nit = (K / 64) * nblk;
    for (int it = gw; it < nit; it += NGW) { const int kb = it / nblk, nb = it % nblk; p0_transpose_item(W, K, N, WT, 64 * kb, 32 * nb, 32, 32 * nb, 1.f, scr, F.lane); }
}
__device__ __forceinline__ void p0_win(Frame& F, const float* W, bf16* WT, LAS float* scr) {
    const int gw = F.vcu * NWAVES + F.wave, NGW = F.G * NWAVES;
    constexpr int NB1 = 7168 / 32, NB2 = 8192 / 32, NBLK = NB1 + 1 + NB2, NIT = (D / 64) * NBLK;
    for (int it = gw; it < NIT; it += NGW) { const int kb = it / NBLK, nb = it % NBLK; int n0, ncols, drow0; float sc = 1.f;
        if (nb < NB1) { n0 = 32 * nb; ncols = 32; drow0 = n0; if (n0 < 1024) sc = 0.08838834764831845f; }
        else if (nb == NB1) { n0 = 7168; ncols = 16; drow0 = 15360; }
        else { n0 = 7184 + 32 * (nb - NB1 - 1); ncols = 32; drow0 = n0 - 16; }
        p0_transpose_item(W, D, D_IN, WT, 64 * kb, n0, ncols, drow0, sc, scr, F.lane); }
    const int gt = (F.vcu * NWAVES + F.wave) * 64 + F.lane, NGT = F.G * NWAVES * 64; constexpr int NZ16 = (N_IN_PAD - D_IN) * D / 8;
    GAS v4u* z = (GAS v4u*)(WT + (size_t)D_IN * D);
    for (int i = gt; i < NZ16; i += NGT) z[i] = (v4u){0u, 0u, 0u, 0u};
}

__device__ __forceinline__ void row_phase(Frame& F, const float* xin, const float* add, const float* g_add, float* xout, const float* g_next, bf16* hout) {
    const int gw = F.vcu * NWAVES + F.wave, NGW = F.G * NWAVES;
    for (int m = gw; m < MS; m += NGW) {
        const GAS f32x4* xr = (const GAS f32x4*)(xin + (size_t)m * D) + F.lane;
        f32x4 v[8];
#pragma unroll
        for (int j = 0; j < 8; ++j) v[j] = xr[64 * j];
        if (add) {
            const GAS f32x4* ar = (const GAS f32x4*)(add + (size_t)m * D) + F.lane; f32x4 a[8]; float s = 0.f;
#pragma unroll
            for (int j = 0; j < 8; ++j) { a[j] = ar[64 * j]; s += (a[j].x * a[j].x + a[j].y * a[j].y) + (a[j].z * a[j].z + a[j].w * a[j].w); }
            const float rs = 1.0f / sqrtf(wave_sum(s) * (1.f / D) + EPS);
#pragma unroll
            for (int j = 0; j < 8; ++j) { const f32x4 gv = ((const GAS f32x4*)g_add)[F.lane + 64 * j]; v[j] = v[j] + (a[j] * rs) * gv; }
        }
        if (xout) { GAS f32x4* o = (GAS f32x4*)(xout + (size_t)m * D) + F.lane;
#pragma unroll
            for (int j = 0; j < 8; ++j) o[64 * j] = v[j]; }
        if (hout) {
            float s = 0.f;
#pragma unroll
            for (int j = 0; j < 8; ++j) s += (v[j].x * v[j].x + v[j].y * v[j].y) + (v[j].z * v[j].z + v[j].w * v[j].w);
            const float rs = 1.0f / sqrtf(wave_sum(s) * (1.f / D) + EPS);
            GAS unsigned long long* o8 = (GAS unsigned long long*)(hout + (size_t)m * D) + F.lane;
#pragma unroll
            for (int j = 0; j < 8; ++j) { const f32x4 gv = ((const GAS f32x4*)g_next)[F.lane + 64 * j]; const f32x4 y = (v[j] * rs) * gv;
                o8[64 * j] = (unsigned long long)pk2(y.x, y.y) | ((unsigned long long)pk2(y.z, y.w) << 32); }
        }
    }
}

__device__ __forceinline__ void prep_phase(Frame& F, const bf16* qkvob, const float* convw, bf16* qc, bf16* kc, const bf16* zuv, float* sgr, int T) {
    const int gt = (F.vcu * NWAVES + F.wave) * 64 + F.lane, NGT = F.G * NWAVES * 64;
    {
        const int c8 = gt & 255; float w0[8], w1[8], w2[8];
#pragma unroll
        for (int j = 0; j < 8; ++j) { w0[j] = convw[c8 * 8 + j]; w1[j] = convw[2048 + c8 * 8 + j]; w2[j] = convw[4096 + c8 * 8 + j]; }
        const float osc = c8 < 128 ? 0.0625f : 1.0f;
        bf16* dst = c8 < 128 ? qc + c8 * 8 : kc + (c8 - 128) * 8;
        for (int t = gt >> 8; t < MS; t += NGT >> 8) {
            const int ts = t % T; const GAS v4u* src = (const GAS v4u*)(qkvob + (size_t)t * 4096 + c8 * 8);
            const v4u xc = src[0]; v4u xm = (v4u){0u, 0u, 0u, 0u}, xp = xm;
            if (ts > 0) xm = *(const GAS v4u*)(qkvob + (size_t)(t - 1) * 4096 + c8 * 8);
            if (ts < T - 1) xp = *(const GAS v4u*)(qkvob + (size_t)(t + 1) * 4096 + c8 * 8);
            float r[8];
#pragma unroll
            for (int j = 0; j < 4; ++j) {
                const float a0 = w0[2 * j] * bf_lo(xm[j]) + w1[2 * j] * bf_lo(xc[j]) + w2[2 * j] * bf_lo(xp[j]);
                const float a1 = w0[2 * j + 1] * bf_hi(xm[j]) + w1[2 * j + 1] * bf_hi(xc[j]) + w2[2 * j + 1] * bf_hi(xp[j]);
                r[2 * j] = a0 * sigmoid_f(a0) * osc; r[2 * j + 1] = a1 * sigmoid_f(a1) * osc; }
            v4u o; o.x = pk2(r[0], r[1]); o.y = pk2(r[2], r[3]); o.z = pk2(r[4], r[5]); o.w = pk2(r[6], r[7]);
            *(GAS v4u*)(dst + (size_t)t * 1024) = o;
        }
    }
    {
        const int gw = F.vcu * NWAVES + F.wave, NGW = F.G * NWAVES;
        for (int t = gw; t < MS; t += NGW) {
            const GAS v4u* src = (const GAS v4u*)(zuv + (size_t)t * 2048 + 1024) + 2 * F.lane; float s = 0.f;
#pragma unroll
            for (int i = 0; i < 2; ++i) { const v4u x = src[i];
#pragma unroll
                for (int j = 0; j < 4; ++j) { const float a = bf_lo(x[j]), b = bf_hi(x[j]); s += a * a + b * b; } }
            s = wave_sum(s);
            if (F.lane == 0) sgr[t] = 1.0f / sqrtf(s * (1.f / 1024.f) + EPS);
        }
    }
}

__device__ __forceinline__ void comb_phase(Frame& F, const float* hf, const float* hb, const bf16* qkvob, const float* mlg, bf16* yb) {
    const int gw = F.vcu * NWAVES + F.wave, NGW = F.G * NWAVES;
    for (int it = gw; it < MS * 4; it += NGW) { const int t = it >> 2, h = it & 3; const size_t o = (size_t)t * 1024 + h * 256 + 4 * F.lane;
        const f32x4 a = *(const GAS f32x4*)(hf + o), b = *(const GAS f32x4*)(hb + o); const f32x4 s = a + b;
        const float ss = wave_sum((s.x * s.x + s.y * s.y) + (s.z * s.z + s.w * s.w)); const float rs = 1.0f / sqrtf(ss * (1.f / 256.f) + EPS);
        const f32x4 gv = *(const GAS f32x4*)(mlg + h * 256 + 4 * F.lane);
        const unsigned long long ow = *(const GAS unsigned long long*)(qkvob + (size_t)t * 4096 + 3072 + h * 256 + 4 * F.lane);
        const unsigned o0 = (unsigned)ow, o1 = (unsigned)(ow >> 32);
        const float y0 = s.x * rs * gv.x * bf_lo(o0), y1 = s.y * rs * gv.y * bf_hi(o0), y2 = s.z * rs * gv.z * bf_lo(o1), y3 = s.w * rs * gv.w * bf_hi(o1);
        *(GAS unsigned long long*)(yb + o) = (unsigned long long)pk2(y0, y1) | ((unsigned long long)pk2(y2, y3) << 32);
    }
}

__device__ __forceinline__ void na_naive(Frame& F, const bf16* qkva, const float* rpb, bf16* ya, int T, int gw, int NGW) {
    const int rows = T / 64;
    for (int it = gw; it < MS * 8; it += NGW) {
        const int m = it >> 3, h = it & 7, seq = m / T, t = m % T, r = t >> 6, qc = t & 63;
        int rs = r - 4; rs = rs < 0 ? 0 : (rs > rows - 8 ? rows - 8 : rs);
        int cs = qc - 8; cs = cs < 0 ? 0 : (cs > 48 ? 48 : cs);
        const bf16* qrow = qkva + (size_t)m * 3072 + h * 128;
        float sc[2];
#pragma unroll
        for (int kk = 0; kk < 2; ++kk) { const int kap = F.lane + 64 * kk, j = kap >> 4, cc = kap & 15;
            const int ktok = seq * T + (rs + j) * 64 + cs + cc; const bf16* krow = qkva + (size_t)ktok * 3072 + 1024 + h * 128; float d = 0.f;
#pragma unroll 4
            for (int i = 0; i < 16; ++i) { const v4u qv = *(const GAS v4u*)(qrow + 8 * i), kv = *(const GAS v4u*)(krow + 8 * i);
#pragma unroll
                for (int e = 0; e < 4; ++e) d += bf_lo(qv[e]) * bf_lo(kv[e]) + bf_hi(qv[e]) * bf_hi(kv[e]); }
            sc[kk] = d + rpb[(h * 15 + (rs + j - r + 7)) * 31 + (cs + cc - qc + 15)]; }
        const float mx = wave_max(fmaxf(sc[0], sc[1]));
        const float e0 = __expf(sc[0] - mx), e1 = __expf(sc[1] - mx); const float inv = 1.0f / wave_sum(e0 + e1);
        const float p0 = e0 * inv, p1 = e1 * inv;
        float o0 = 0.f, o1 = 0.f;
        for (int kap = 0; kap < 128; ++kap) { const int j = kap >> 4, cc = kap & 15; const int ktok = seq * T + (rs + j) * 64 + cs + cc;
            const float p = __shfl(kap < 64 ? p0 : p1, kap & 63);
            const unsigned vv = *(const GAS unsigned*)(qkva + (size_t)ktok * 3072 + 2048 + h * 128 + 2 * F.lane);
            o0 += p * bf_lo(vv); o1 += p * bf_hi(vv); }
        *(GAS unsigned*)(ya + (size_t)m * 1024 + h * 128 + 2 * F.lane) = pk2(o0, o1);
    }
}
__device__ __forceinline__ void sg_naive(Frame& F, const bf16* zuv, const float* sgr, const float* sgn, const float* ws_, const float* bs, bf16* yc, int gw, int NGW) {
    for (int it = gw; it < MS * 8; it += NGW) {
        const int t = it >> 3, g = it & 7, p = t & 127, cb = t & ~127; const int c = g * 128 + 2 * F.lane;
        const float* wrow = ws_ + ((size_t)g * 128 + p) * 128; float a0 = 0.f, a1 = 0.f;
        for (int q = 0; q < 128; ++q) { const float wq = wrow[q] * sgr[cb + q]; const unsigned zz = *(const GAS unsigned*)(zuv + (size_t)(cb + q) * 2048 + 1024 + c);
            a0 += wq * bf_lo(zz); a1 += wq * bf_hi(zz); }
        const float b = bs[g * 128 + p]; const unsigned uu = *(const GAS unsigned*)(zuv + (size_t)t * 2048 + c);
        const float y0 = bf_lo(uu) * (a0 * sgn[c] + b), y1 = bf_hi(uu) * (a1 * sgn[c + 1] + b);
        *(GAS unsigned*)(yc + (size_t)t * 1024 + c) = pk2(y0, y1);
    }
}
__device__ __forceinline__ void mlstm_naive(Frame& F, int unit, const bf16* qc, const bf16* kc, const bf16* qkvob, const float* gates, float* hf, float* hb, int T) {
    const int es = unit & 3, dir = (unit >> 2) & 1, h = (unit >> 3) & 3, seq = unit >> 5, nc = T / 64, tid = F.tid;
    LAS unsigned char* L = F.lds;
    LAS bf16* Qs = (LAS bf16*)(L);
    LAS bf16* Ks = (LAS bf16*)(L + 33792);
    LAS float* Vs = (LAS float*)(L + 67584);
    LAS float* Ss = (LAS float*)(L + 83968);
    LAS float* NUM = (LAS float*)(L + 100608);
    LAS float* vb = (LAS float*)(L + 116992);
    LAS float* va = vb + 64;
    LAS float* vmr = vb + 128;
    LAS float* vw = vb + 192;
    LAS float* vwi = vb + 256;
    LAS float* NQ = vb + 320;
    LAS float* nst = vb + 384;
    LAS float* scal = vb + 640;
    float* hout = dir ? hb : hf;
    float Creg[32];
#pragma unroll
    for (int i = 0; i < 32; ++i) Creg[i] = 0.f;
    if (tid < 256) nst[tid] = 0.f;
    float m_prev = 0.f;
    const int e = tid & 63, dg = tid >> 6;
    for (int ci = 0; ci < nc; ++ci) {
        __syncthreads();
#pragma unroll
        for (int i = 0; i < 4; ++i) { const int p = tid + 512 * i, tau = p >> 5, c8 = p & 31; const int pos = ci * 64 + tau; const int tok = seq * T + (dir ? T - 1 - pos : pos);
            *(LAS v4u*)(Qs + tau * 264 + c8 * 8) = *(const GAS v4u*)(qc + (size_t)tok * 1024 + h * 256 + c8 * 8);
            *(LAS v4u*)(Ks + tau * 264 + c8 * 8) = *(const GAS v4u*)(kc + (size_t)tok * 1024 + h * 256 + c8 * 8); }
        { const int tau = tid >> 3, c8 = tid & 7; const int pos = ci * 64 + tau; const int tok = seq * T + (dir ? T - 1 - pos : pos);
            const v4u vv = *(const GAS v4u*)(qkvob + (size_t)tok * 4096 + 2048 + h * 256 + es * 64 + c8 * 8);
#pragma unroll
            for (int j = 0; j < 4; ++j) { Vs[tau * 64 + c8 * 8 + 2 * j] = bf_lo(vv[j]); Vs[tau * 64 + c8 * 8 + 2 * j + 1] = bf_hi(vv[j]); } }
        if (tid < 64) {
            const int pos = ci * 64 + tid; const int tok = seq * T + (dir ? T - 1 - pos : pos);
            const float ipre = gates[(size_t)tok * 16 + dir * 8 + h], fpre = gates[(size_t)tok * 16 + dir * 8 + 4 + h];
            const float logf = fminf(fpre, 0.f) - log1pf(__expf(-fabsf(fpre)));
            float b = logf;
#pragma unroll
            for (int o = 1; o < 64; o <<= 1) { const float y = __shfl_up(b, o); if (tid >= o) b += y; }
            const float a = ipre - b; float pm = a;
#pragma unroll
            for (int o = 1; o < 64; o <<= 1) { const float y = __shfl_up(pm, o); if (tid >= o) pm = fmaxf(pm, y); }
            const float mrow = fmaxf(b + m_prev, b + pm);
            const float blast = __shfl(b, 63), amax = __shfl(pm, 63);
            const float mnew = fmaxf(blast + m_prev, blast + amax);
            vb[tid] = b; va[tid] = a; vmr[tid] = mrow; vw[tid] = __expf(blast + a - mnew); vwi[tid] = __expf(b + m_prev - mrow);
            if (tid == 0) { scal[0] = __expf(blast + m_prev - mnew); scal[1] = mnew; }
        }
#pragma unroll
        for (int i = 0; i < 8; ++i) NUM[tid + 512 * i] = 0.f;
        __syncthreads();
        const float decay = scal[0]; m_prev = scal[1];
        {
            const int tau = tid >> 3, sg = tid & 7; float rowpart = 0.f; const float bt = vb[tau], mr = vmr[tau];
#pragma unroll 1
            for (int j = 0; j < 8; ++j) { const int s = sg * 8 + j; float val = 0.f;
                if (s <= tau) { float d = 0.f;
#pragma unroll 4
                    for (int c8 = 0; c8 < 32; ++c8) { const v4u qv = *(const LAS v4u*)(Qs + tau * 264 + c8 * 8), kv = *(const LAS v4u*)(Ks + s * 264 + c8 * 8);
#pragma unroll
                        for (int x = 0; x < 4; ++x) d += bf_lo(qv[x]) * bf_lo(kv[x]) + bf_hi(qv[x]) * bf_hi(kv[x]); }
                    val = d * __expf(bt + va[s] - mr); }
                Ss[tau * 65 + s] = val; rowpart += val; }
            float qn = 0.f;
#pragma unroll 4
            for (int c8 = 0; c8 < 4; ++c8) { const v4u qv = *(const LAS v4u*)(Qs + tau * 264 + sg * 32 + c8 * 8);
#pragma unroll
                for (int x = 0; x < 4; ++x) qn += bf_lo(qv[x]) * nst[sg * 32 + c8 * 8 + 2 * x] + bf_hi(qv[x]) * nst[sg * 32 + c8 * 8 + 2 * x + 1]; }
            float tot = rowpart + vwi[tau] * qn;
            tot += __shfl_xor(tot, 1); tot += __shfl_xor(tot, 2); tot += __shfl_xor(tot, 4);
            if (sg == 0) NQ[tau] = tot;
        }
        {
#pragma unroll 1
            for (int tau = 0; tau < 64; ++tau) { float part = 0.f;
#pragma unroll
                for (int c8 = 0; c8 < 4; ++c8) { const v4u qv = *(const LAS v4u*)(Qs + tau * 264 + dg * 32 + c8 * 8);
#pragma unroll
                    for (int x = 0; x < 4; ++x) part += bf_lo(qv[x]) * Creg[c8 * 8 + 2 * x] + bf_hi(qv[x]) * Creg[c8 * 8 + 2 * x + 1]; }
                __hip_atomic_fetch_add(&NUM[tau * 64 + e], vwi[tau] * part, __ATOMIC_RELAXED, __HIP_MEMORY_SCOPE_WORKGROUP); }
        }
        __syncthreads();
        {
#pragma unroll 1
            for (int j = 0; j < 8; ++j) { const int tau = dg * 8 + j; float acc = 0.f;
#pragma unroll 8
                for (int s = 0; s < 64; ++s) acc += Ss[tau * 65 + s] * Vs[s * 64 + e];
                __hip_atomic_fetch_add(&NUM[tau * 64 + e], acc, __ATOMIC_RELAXED, __HIP_MEMORY_SCOPE_WORKGROUP); }
        }
        __syncthreads();
#pragma unroll
        for (int i = 0; i < 8; ++i) { const int idx = tid + 512 * i, tau = idx >> 6, ee = idx & 63; const int pos = ci * 64 + tau; const int tok = seq * T + (dir ? T - 1 - pos : pos);
            const float den = fmaxf(fabsf(NQ[tau]), __expf(-vmr[tau]));
            hout[(size_t)tok * 1024 + h * 256 + es * 64 + ee] = NUM[idx] / den; }
#pragma unroll
        for (int i = 0; i < 32; ++i) Creg[i] *= decay;
#pragma unroll 1
        for (int s = 0; s < 64; ++s) { const float wv = vw[s] * Vs[s * 64 + e];
#pragma unroll
            for (int c8 = 0; c8 < 4; ++c8) { const v4u kv = *(const LAS v4u*)(Ks + s * 264 + dg * 32 + c8 * 8);
#pragma unroll
                for (int x = 0; x < 4; ++x) { Creg[c8 * 8 + 2 * x] += bf_lo(kv[x]) * wv; Creg[c8 * 8 + 2 * x + 1] += bf_hi(kv[x]) * wv; } } }
        if (tid < 256) { float a = decay * nst[tid];
#pragma unroll 8
            for (int s = 0; s < 64; ++s) a += vw[s] * __uint_as_float(((unsigned)Ks[s * 264 + tid]) << 16);
            nst[tid] = a; }
    }
    __syncthreads();
}

typedef short s16x4 __attribute__((ext_vector_type(4)));
__device__ __forceinline__ bf16x8 tr_pair(const LAS bf16* p0, const LAS bf16* p1) {
    const s16x4 a = __builtin_amdgcn_ds_read_tr16_b64_v4i16((LAS s16x4*)p0), b = __builtin_amdgcn_ds_read_tr16_b64_v4i16((LAS s16x4*)p1);
    return __builtin_shufflevector(a, b, 0, 1, 2, 3, 4, 5, 6, 7);
}
#define MFMA16(a, b, c) __builtin_amdgcn_mfma_f32_16x16x32_bf16((a), (b), (c), 0, 0, 0)

__device__ __forceinline__ void sg_fast(Frame& F, const bf16* zuv, const float* sgr, const float* sgn, const float* ws_, const float* bs, bf16* yc, int u0, int ustride) {
    LAS bf16* Z = (LAS bf16*)F.lds;
    const int lane = F.lane, kg = lane >> 4, li = lane & 15, qq = li >> 2, pp = li & 3;
    for (int unit = u0; unit < (MS / 128) * 8; unit += ustride) {
        const int c = unit >> 3, g = unit & 7, t0 = c * 128;
        __syncthreads();
#pragma unroll
        for (int i = 0; i < 4; ++i) { const int idx = F.tid + 512 * i, row = idx >> 4, ch = idx & 15;
            *(LAS v4u*)(Z + row * 136 + ch * 8) = *(const GAS v4u*)(zuv + (size_t)(t0 + row) * 2048 + 1024 + g * 128 + ch * 8); }
        const int p = F.wave * 16 + li;
        bf16x8 bw[4];
#pragma unroll
        for (int ks = 0; ks < 4; ++ks) { const int q0 = ks * 32 + 8 * kg;
            const f32x4 w0 = *(const GAS f32x4*)(ws_ + ((size_t)g * 128 + p) * 128 + q0), w1 = *(const GAS f32x4*)(ws_ + ((size_t)g * 128 + p) * 128 + q0 + 4);
            const f32x4 r0 = *(const GAS f32x4*)(sgr + t0 + q0), r1 = *(const GAS f32x4*)(sgr + t0 + q0 + 4);
            v4u pk; pk.x = pk2(w0.x * r0.x, w0.y * r0.y); pk.y = pk2(w0.z * r0.z, w0.w * r0.w); pk.z = pk2(w1.x * r1.x, w1.y * r1.y); pk.w = pk2(w1.z * r1.z, w1.w * r1.w);
            bw[ks] = __builtin_bit_cast(bf16x8, pk); }
        __syncthreads();
        const float bsv = bs[g * 128 + p];
#pragma unroll 2
        for (int dt = 0; dt < 8; ++dt) {
            f32x4 acc = (f32x4){0.f, 0.f, 0.f, 0.f};
#pragma unroll
            for (int ks = 0; ks < 4; ++ks) { const LAS bf16* a0 = Z + (ks * 32 + 8 * kg + qq) * 136 + dt * 16 + 4 * pp;
                acc = MFMA16(tr_pair(a0, a0 + 4 * 136), bw[ks], acc); }
            const int d0 = g * 128 + dt * 16 + 4 * kg;
            const f32x4 sg = *(const GAS f32x4*)(sgn + d0);
            const unsigned long long uw = *(const GAS unsigned long long*)(zuv + (size_t)(t0 + p) * 2048 + d0); const unsigned u0w = (unsigned)uw, u1w = (unsigned)(uw >> 32);
            const float y0 = bf_lo(u0w) * (sg.x * acc[0] + bsv), y1 = bf_hi(u0w) * (sg.y * acc[1] + bsv), y2 = bf_lo(u1w) * (sg.z * acc[2] + bsv), y3 = bf_hi(u1w) * (sg.w * acc[3] + bsv);
            *(GAS unsigned long long*)(yc + (size_t)(t0 + p) * 1024 + d0) = (unsigned long long)pk2(y0, y1) | ((unsigned long long)pk2(y2, y3) << 32);
        }
    }
    __syncthreads();
}

__device__ __forceinline__ void na_fast(Frame& F, const bf16* qkva, const float* rpb, bf16* ya, int T, int gw, int NGW) {
    const int rows = T / 64, lane = F.lane, kg = lane >> 4, li = lane & 15, qq = li >> 2, pp = li & 3;
    LAS bf16* Vt = (LAS bf16*)(F.lds + F.wave * 8192);
    for (int it = gw; it < (MS / 16) * 8; it += NGW) {
        const int h = it & 7, blk = it >> 3, n = blk & 3, rowg = blk >> 2, seq = rowg / rows, r = rowg % rows;
        int rs = r - 4; rs = rs < 0 ? 0 : (rs > rows - 8 ? rows - 8 : rs);
        int kc0 = 16 * n - 8; kc0 = kc0 < 0 ? 0 : (kc0 > 32 ? 32 : kc0);
        const int qc = 16 * n + li; const size_t qtok = (size_t)seq * T + r * 64 + qc;
        bf16x8 bq[4];
#pragma unroll
        for (int ks = 0; ks < 4; ++ks) bq[ks] = __builtin_bit_cast(bf16x8, *(const GAS v4u*)(qkva + qtok * 3072 + h * 128 + ks * 32 + 8 * kg));
        f32x4 s[8][2];
#pragma unroll
        for (int j = 0; j < 8; ++j)
#pragma unroll
            for (int ct = 0; ct < 2; ++ct) { const size_t ktok = (size_t)seq * T + (rs + j) * 64 + kc0 + 16 * ct + li; f32x4 a = (f32x4){0.f, 0.f, 0.f, 0.f};
#pragma unroll
                for (int ks = 0; ks < 4; ++ks) a = MFMA16(__builtin_bit_cast(bf16x8, *(const GAS v4u*)(qkva + ktok * 3072 + 1024 + h * 128 + ks * 32 + 8 * kg)), bq[ks], a);
                s[j][ct] = a; }
        int cs = qc - 8; cs = cs < 0 ? 0 : (cs > 48 ? 48 : cs);
        float mx = -3.0e38f;
#pragma unroll
        for (int j = 0; j < 8; ++j)
#pragma unroll
            for (int ct = 0; ct < 2; ++ct)
#pragma unroll
                for (int e = 0; e < 4; ++e) { const int kc = kc0 + 16 * ct + 4 * kg + e; const bool ok = kc >= cs && kc < cs + 16;
                    const int bi = (h * 15 + (rs + j - r + 7)) * 31 + (ok ? kc - qc + 15 : 15);
                    const float v = ok ? s[j][ct][e] + rpb[bi] : -3.0e38f; s[j][ct][e] = v; mx = fmaxf(mx, v); }
        mx = fmaxf(mx, __shfl_xor(mx, 16)); mx = fmaxf(mx, __shfl_xor(mx, 32));
        float sum = 0.f;
#pragma unroll
        for (int j = 0; j < 8; ++j)
#pragma unroll
            for (int ct = 0; ct < 2; ++ct)
#pragma unroll
                for (int e = 0; e < 4; ++e) { const float pv = s[j][ct][e] > -1.0e38f ? __expf(s[j][ct][e] - mx) : 0.f; s[j][ct][e] = pv; sum += pv; }
        sum += __shfl_xor(sum, 16); sum += __shfl_xor(sum, 32);
        const float inv = 1.0f / sum;
        f32x4 o[8];
#pragma unroll
        for (int dt = 0; dt < 8; ++dt) o[dt] = (f32x4){0.f, 0.f, 0.f, 0.f};
#pragma unroll 1
        for (int j = 0; j < 8; ++j) {
            asm volatile("" ::: "memory");
#pragma unroll
            for (int i = 0; i < 8; ++i) { const int key = 4 * i + kg; const size_t vtok = (size_t)seq * T + (rs + j) * 64 + kc0 + key;
                *(LAS v4u*)(Vt + key * 128 + li * 8) = *(const GAS v4u*)(qkva + vtok * 3072 + 2048 + h * 128 + li * 8); }
            asm volatile("" ::: "memory");
            f32x4 p0, p1;
            p0 = s[0][0]; p1 = s[0][1];
#pragma unroll
            for (int jj = 1; jj < 8; ++jj) if (j == jj) { p0 = s[jj][0]; p1 = s[jj][1]; }
            v4u pk; pk.x = pk2(p0[0], p0[1]); pk.y = pk2(p0[2], p0[3]); pk.z = pk2(p1[0], p1[1]); pk.w = pk2(p1[2], p1[3]);
            const bf16x8 bp = __builtin_bit_cast(bf16x8, pk);
#pragma unroll
            for (int dt = 0; dt < 8; ++dt) { const LAS bf16* a0 = Vt + (4 * kg + qq) * 128 + dt * 16 + 4 * pp;
                o[dt] = MFMA16(tr_pair(a0, a0 + 16 * 128), bp, o[dt]); }
            asm volatile("" ::: "memory");
        }
#pragma unroll
        for (int dt = 0; dt < 8; ++dt) { const f32x4 v = o[dt] * inv;
            *(GAS unsigned long long*)(ya + qtok * 1024 + h * 128 + dt * 16 + 4 * kg) = (unsigned long long)pk2(v[0], v[1]) | ((unsigned long long)pk2(v[2], v[3]) << 32); }
    }
}

constexpr int NA_KS = 136;
__device__ __forceinline__ void na_wg(Frame& F, const bf16* qkva, const float* rpb, bf16* ya, int T, int u0, int ustride) {
    const int rows = T / 64, nrb = rows / 8, lane = F.lane, kg = lane >> 4, li = lane & 15, qq = li >> 2, pp = li & 3, tid = F.tid;
    LAS bf16* KV = (LAS bf16*)F.lds;
    for (int unit = u0; unit < (MS / 512) * 32; unit += ustride) {
        const int h = unit & 7, n = (unit >> 3) & 3, rb = unit >> 5, seq = rb / nrb, r0 = (rb % nrb) * 8, r = r0 + F.wave;
        int rs = r - 4; rs = rs < 0 ? 0 : (rs > rows - 8 ? rows - 8 : rs);
        int rs0 = r0 - 4; rs0 = rs0 < 0 ? 0 : (rs0 > rows - 8 ? rows - 8 : rs0);
        int rsl = r0 + 3; rsl = rsl > rows - 8 ? rows - 8 : rsl;
        const int nkr = rsl + 8 - rs0;
        int kc0 = 16 * n - 8; kc0 = kc0 < 0 ? 0 : (kc0 > 32 ? 32 : kc0);
        const int qc = 16 * n + li; const size_t qtok = (size_t)seq * T + r * 64 + qc;
        const size_t tok0 = (size_t)seq * T + rs0 * 64 + kc0;
        __syncthreads();
        v4u pv[15];
#pragma unroll
        for (int i = 0; i < 15; ++i) { const int idx = tid + 512 * i, key = idx >> 4, ch = idx & 15; pv[i] = (v4u){0u, 0u, 0u, 0u};
            if (i < nkr) { const size_t tok = tok0 + (key >> 5) * 64 + (key & 31);
                *(LAS v4u*)(KV + key * NA_KS + ch * 8) = *(const GAS v4u*)(qkva + tok * 3072 + 1024 + h * 128 + ch * 8);
                pv[i] = *(const GAS v4u*)(qkva + tok * 3072 + 2048 + h * 128 + ch * 8); } }
        bf16x8 bq[4];
#pragma unroll
        for (int ks = 0; ks < 4; ++ks) bq[ks] = __builtin_bit_cast(bf16x8, *(const GAS v4u*)(qkva + qtok * 3072 + h * 128 + ks * 32 + 8 * kg));
        __syncthreads();
        const int lr0 = rs - rs0;
        f32x4 s[8][2];
#pragma unroll
        for (int j = 0; j < 8; ++j)
#pragma unroll
            for (int ct = 0; ct < 2; ++ct) { const LAS bf16* kp = KV + ((lr0 + j) * 32 + ct * 16 + li) * NA_KS + 8 * kg; f32x4 a = (f32x4){0.f, 0.f, 0.f, 0.f};
#pragma unroll
                for (int ks = 0; ks < 4; ++ks) a = MFMA16(__builtin_bit_cast(bf16x8, *(const LAS v4u*)(kp + ks * 32)), bq[ks], a);
                s[j][ct] = a; }
        int cs = qc - 8; cs = cs < 0 ? 0 : (cs > 48 ? 48 : cs);
        float mx = -3.0e38f;
#pragma unroll
        for (int j = 0; j < 8; ++j)
#pragma unroll
            for (int ct = 0; ct < 2; ++ct)
#pragma unroll
                for (int e = 0; e < 4; ++e) { const int kc = kc0 + 16 * ct + 4 * kg + e; const bool ok = kc >= cs && kc < cs + 16;
                    const int bi = (h * 15 + (rs + j - r + 7)) * 31 + (ok ? kc - qc + 15 : 15);
                    const float v = ok ? s[j][ct][e] + rpb[bi] : -3.0e38f; s[j][ct][e] = v; mx = fmaxf(mx, v); }
        mx = fmaxf(mx, __shfl_xor(mx, 16)); mx = fmaxf(mx, __shfl_xor(mx, 32));
        float sum = 0.f;
#pragma unroll
        for (int j = 0; j < 8; ++j)
#pragma unroll
            for (int ct = 0; ct < 2; ++ct)
#pragma unroll
                for (int e = 0; e < 4; ++e) { const float pvv = s[j][ct][e] > -1.0e38f ? __expf(s[j][ct][e] - mx) : 0.f; s[j][ct][e] = pvv; sum += pvv; }
        sum += __shfl_xor(sum, 16); sum += __shfl_xor(sum, 32);
        const float inv = 1.0f / sum;
        __syncthreads();
#pragma unroll
        for (int i = 0; i < 15; ++i) { const int idx = tid + 512 * i, key = idx >> 4, ch = idx & 15; if (i < nkr) *(LAS v4u*)(KV + key * NA_KS + ch * 8) = pv[i]; }
        __syncthreads();
        f32x4 o[8];
#pragma unroll
        for (int dt = 0; dt < 8; ++dt) o[dt] = (f32x4){0.f, 0.f, 0.f, 0.f};
#pragma unroll
        for (int j = 0; j < 8; ++j) {
            v4u pk; pk.x = pk2(s[j][0][0], s[j][0][1]); pk.y = pk2(s[j][0][2], s[j][0][3]); pk.z = pk2(s[j][1][0], s[j][1][1]); pk.w = pk2(s[j][1][2], s[j][1][3]);
            const bf16x8 bp = __builtin_bit_cast(bf16x8, pk);
#pragma unroll
            for (int dt = 0; dt < 8; ++dt) { const LAS bf16* a0 = KV + ((lr0 + j) * 32 + 4 * kg + qq) * NA_KS + dt * 16 + 4 * pp;
                o[dt] = MFMA16(tr_pair(a0, a0 + 16 * NA_KS), bp, o[dt]); }
        }
#pragma unroll
        for (int dt = 0; dt < 8; ++dt) { const f32x4 v = o[dt] * inv;
            *(GAS unsigned long long*)(ya + qtok * 1024 + h * 128 + dt * 16 + 4 * kg) = (unsigned long long)pk2(v[0], v[1]) | ((unsigned long long)pk2(v[2], v[3]) << 32); }
    }
    __syncthreads();
}

constexpr int GS_STRIDE = 65536;
constexpr int ML_QS = 264, ML_VS = 72;
constexpr int ML_OFF_Q = 0, ML_OFF_K = 33792, ML_OFF_CT = 67584, ML_OFF_V = 101376, ML_OFF_WV = 110592, ML_OFF_ST = 119808, ML_OFF_VEC = 129024, ML_OFF_N = 130560, ML_OFF_CM = 131584, ML_LDS_END = 133120;
static_assert(ML_LDS_END <= LDSCTL_OFF, "mLSTM LDS map");

__device__ __forceinline__ void ml_gate_local(Frame& F, const float* gates, float* gs, float* gd, int T, int nchains) {
    const int gw = F.vcu * NWAVES + F.wave, NGW = F.G * NWAVES, lane = F.lane, nc = T / 64;
    for (int it = gw; it < nchains * nc; it += NGW) {
        const int chain = it / nc, ci = it % nc, seq = chain >> 3, h = (chain >> 1) & 3, dir = chain & 1;
        const int pos = ci * 64 + lane; const size_t tok = (size_t)seq * T + (dir ? T - 1 - pos : pos);
        const float ipre = gates[tok * 16 + dir * 8 + h], fpre = gates[tok * 16 + dir * 8 + 4 + h];
        const float logf = fminf(fpre, 0.f) - log1pf(__expf(-fabsf(fpre)));
        float b = logf;
#pragma unroll
        for (int o = 1; o < 64; o <<= 1) { const float y = __shfl_up(b, o); if (lane >= o) b += y; }
        const float a = ipre - b; float pm = a;
#pragma unroll
        for (int o = 1; o < 64; o <<= 1) { const float y = __shfl_up(pm, o); if (lane >= o) pm = fmaxf(pm, y); }
        const size_t o = (size_t)chain * T + pos;
        gs[o] = b; gs[GS_STRIDE + o] = a; gs[2 * GS_STRIDE + o] = pm;
        if (lane == 63) { gd[chain * 128 + ci] = b; gd[2048 + chain * 128 + ci] = b + pm; }
    }
}
__device__ __forceinline__ void ml_chain_m(Frame& F, const float* gd, int chain, int nc, LAS float* cm) {
    if (F.wave == 0) {
        const int lane = F.lane, cpl = nc >> 6;
        float sB0, sD0, sB1 = 0.f, sD1 = -3.0e38f;
        if (cpl == 2) { sB0 = gd[chain * 128 + 2 * lane]; sD0 = gd[2048 + chain * 128 + 2 * lane]; sB1 = gd[chain * 128 + 2 * lane + 1]; sD1 = gd[2048 + chain * 128 + 2 * lane + 1]; }
        else { sB0 = gd[chain * 128 + lane]; sD0 = gd[2048 + chain * 128 + lane]; }
        float B = sB0, Dm = sD0;
        if (cpl == 2) { Dm = fmaxf(sD0 + sB1, sD1); B = sB0 + sB1; }
#pragma unroll
        for (int o = 1; o < 64; o <<= 1) { const float Bp = __shfl_up(B, o), Dp = __shfl_up(Dm, o); if (lane >= o) { Dm = fmaxf(Dp + B, Dm); B = Bp + B; } }
        const float mend = fmaxf(B, Dm);
        float mp0 = __shfl_up(mend, 1); if (lane == 0) mp0 = 0.f;
        const float mn0 = fmaxf(mp0 + sB0, sD0);
        if (cpl == 2) { const float mn1 = fmaxf(mn0 + sB1, sD1);
            cm[2 * lane] = sB0; cm[2 * lane + 1] = sB1; cm[128 + 2 * lane] = mp0; cm[128 + 2 * lane + 1] = mn0; cm[256 + 2 * lane] = mn0; cm[256 + 2 * lane + 1] = mn1; }
        else { cm[lane] = sB0; cm[128 + lane] = mp0; cm[256 + lane] = mn0; }
    }
    __syncthreads();
}

__device__ __forceinline__ void ml_cupdate(f32x4 (&cst)[2][4], const LAS bf16* Ks, const LAS bf16* WV, float decay, int wave, int kg, int qq, int pp) {
#pragma unroll
    for (int dd = 0; dd < 2; ++dd)
#pragma unroll
        for (int et = 0; et < 4; ++et) cst[dd][et] = cst[dd][et] * decay;
#pragma unroll
    for (int ks = 0; ks < 2; ++ks) {
        bf16x8 af[2], bfv[4];
#pragma unroll
        for (int dd = 0; dd < 2; ++dd) { const LAS bf16* p = Ks + (ks * 32 + 8 * kg + qq) * ML_QS + (2 * wave + dd) * 16 + 4 * pp; af[dd] = tr_pair(p, p + 4 * ML_QS); }
#pragma unroll
        for (int et = 0; et < 4; ++et) { const LAS bf16* p = WV + (ks * 32 + 8 * kg + qq) * ML_VS + et * 16 + 4 * pp; bfv[et] = tr_pair(p, p + 4 * ML_VS); }
#pragma unroll
        for (int dd = 0; dd < 2; ++dd)
#pragma unroll
            for (int et = 0; et < 4; ++et) cst[dd][et] = MFMA16(af[dd], bfv[et], cst[dd][et]);
    }
}

__device__ __forceinline__ void ml_phaseA(Frame& F, int unit, const bf16* kc, const bf16* qkvob, const float* gs, const float* gd, float* lst, float* nloc, int T) {
    const int nseg = T / 1024, es = unit & 3, cs_ = unit >> 2, seg = cs_ % nseg, chain = cs_ / nseg, seq = chain >> 3, h = (chain >> 1) & 3, dir = chain & 1;
    if (seg == nseg - 1) return;
    const int tid = F.tid, lane = F.lane, kg = lane >> 4, li = lane & 15, qq = li >> 2, pp = li & 3, wave = F.wave;
    LAS bf16* Ks = (LAS bf16*)(F.lds + ML_OFF_K); LAS bf16* WV = (LAS bf16*)(F.lds + ML_OFF_WV); LAS float* wvec = (LAS float*)(F.lds + ML_OFF_VEC); LAS float* cm = (LAS float*)(F.lds + ML_OFF_CM);
    __syncthreads();
    ml_chain_m(F, gd, chain, T / 64, cm);
    f32x4 cst[2][4];
#pragma unroll
    for (int dd = 0; dd < 2; ++dd)
#pragma unroll
        for (int et = 0; et < 4; ++et) cst[dd][et] = (f32x4){0.f, 0.f, 0.f, 0.f};
    float nacc = 0.f;
    v4u pk[4], pv; float pw, pwv;
#define MLA_LOAD(ci_) do { const int ci__ = (ci_); \
        _Pragma("unroll") for (int i = 0; i < 4; ++i) { const int idx = tid + 512 * i, tau = idx >> 5, c8 = idx & 31; const int pos = ci__ * 64 + tau; const size_t tok = (size_t)seq * T + (dir ? T - 1 - pos : pos); \
            pk[i] = *(const GAS v4u*)(kc + tok * 1024 + h * 256 + c8 * 8); } \
        { const int tau = tid >> 3, c8 = tid & 7; const int pos = ci__ * 64 + tau; const size_t tok = (size_t)seq * T + (dir ? T - 1 - pos : pos); \
            pv = *(const GAS v4u*)(qkvob + tok * 4096 + 2048 + h * 256 + es * 64 + c8 * 8); pw = gs[GS_STRIDE + (size_t)chain * T + pos]; } \
        pwv = gs[GS_STRIDE + (size_t)chain * T + ci__ * 64 + (tid & 63)]; } while (0)
    MLA_LOAD(seg * 16);
    for (int cc = 0; cc < 16; ++cc) {
        const int ci = seg * 16 + cc;
        __syncthreads();
#pragma unroll
        for (int i = 0; i < 4; ++i) { const int idx = tid + 512 * i, tau = idx >> 5, c8 = idx & 31; *(LAS v4u*)(Ks + tau * ML_QS + c8 * 8) = pk[i]; }
        const float cB = cm[ci], cmp = cm[128 + ci], cmn = cm[256 + ci];
        { const int tau = tid >> 3, c8 = tid & 7; const float w = __expf(cB + pw - cmn);
            v4u o; o.x = pk2(bf_lo(pv.x) * w, bf_hi(pv.x) * w); o.y = pk2(bf_lo(pv.y) * w, bf_hi(pv.y) * w); o.z = pk2(bf_lo(pv.z) * w, bf_hi(pv.z) * w); o.w = pk2(bf_lo(pv.w) * w, bf_hi(pv.w) * w);
            *(LAS v4u*)(WV + tau * ML_VS + c8 * 8) = o; }
        if (tid < 64) wvec[tid] = __expf(cB + pwv - cmn);
        const float decay = __expf(cB + cmp - cmn);
        __syncthreads();
        if (cc + 1 < 16) MLA_LOAD(ci + 1);
        ml_cupdate(cst, Ks, WV, decay, wave, kg, qq, pp);
        if (tid < 64) { float a = decay * nacc;
#pragma unroll 8
            for (int s = 0; s < 64; ++s) a += wvec[s] * __uint_as_float(((unsigned)Ks[s * ML_QS + es * 64 + tid]) << 16);
            nacc = a; }
    }
#undef MLA_LOAD
    float* dst = lst + (size_t)unit * 32 * 512 + tid;
#pragma unroll
    for (int dd = 0; dd < 2; ++dd)
#pragma unroll
        for (int et = 0; et < 4; ++et)
#pragma unroll
            for (int r = 0; r < 4; ++r) dst[(dd * 16 + et * 4 + r) * 512] = cst[dd][et][r];
    if (tid < 64) nloc[(size_t)(chain * nseg + seg) * 256 + es * 64 + tid] = nacc;
    __syncthreads();
}

__device__ __forceinline__ void ml_phaseC(Frame& F, int unit, const bf16* qc, const bf16* kc, const bf16* qkvob, const float* gs, const float* gd, const float* lst, const float* nloc, float* hf, float* hb, int T) {
    const int nseg = T / 1024, es = unit & 3, cs_ = unit >> 2, seg = cs_ % nseg, chain = cs_ / nseg, seq = chain >> 3, h = (chain >> 1) & 3, dir = chain & 1;
    const int tid = F.tid, lane = F.lane, kg = lane >> 4, li = lane & 15, qq = li >> 2, pp = li & 3, wave = F.wave;
    LAS bf16* Qs = (LAS bf16*)(F.lds + ML_OFF_Q); LAS bf16* Ks = (LAS bf16*)(F.lds + ML_OFF_K); LAS bf16* CT = (LAS bf16*)(F.lds + ML_OFF_CT);
    LAS bf16* Vs = (LAS bf16*)(F.lds + ML_OFF_V); LAS bf16* WV = (LAS bf16*)(F.lds + ML_OFF_WV); LAS bf16* ST = (LAS bf16*)(F.lds + ML_OFF_ST);
    LAS float* vec = (LAS float*)(F.lds + ML_OFF_VEC);
    LAS float* nst = (LAS float*)(F.lds + ML_OFF_N);
    LAS float* cm = (LAS float*)(F.lds + ML_OFF_CM);
    float* hout = dir ? hb : hf;
    __syncthreads();
    ml_chain_m(F, gd, chain, T / 64, cm);
    f32x4 cst[2][4];
#pragma unroll
    for (int dd = 0; dd < 2; ++dd)
#pragma unroll
        for (int et = 0; et < 4; ++et) cst[dd][et] = (f32x4){0.f, 0.f, 0.f, 0.f};
    float nreg = 0.f;
    for (int i = 0; i < seg; ++i) {
        float sb = 0.f;
        for (int c = 0; c < 16; ++c) sb += cm[i * 16 + c];
        const float P = __expf(sb + cm[128 + i * 16] - cm[256 + i * 16 + 15]);
        const float* src = lst + (size_t)(((chain * nseg + i) << 2) + es) * 32 * 512 + tid;
#pragma unroll
        for (int dd = 0; dd < 2; ++dd)
#pragma unroll
            for (int et = 0; et < 4; ++et)
#pragma unroll
                for (int r = 0; r < 4; ++r) cst[dd][et][r] = P * cst[dd][et][r] + src[(dd * 16 + et * 4 + r) * 512];
        if (tid < 256) nreg = P * nreg + nloc[(size_t)(chain * nseg + i) * 256 + tid];
    }
    if (tid < 256) nst[tid] = nreg;
#pragma unroll
    for (int dd = 0; dd < 2; ++dd)
#pragma unroll
        for (int et = 0; et < 4; ++et) { const int e = et * 16 + li, d = (2 * wave + dd) * 16 + 4 * kg;
            *(LAS unsigned long long*)(CT + e * ML_QS + d) = (unsigned long long)pk2(cst[dd][et][0], cst[dd][et][1]) | ((unsigned long long)pk2(cst[dd][et][2], cst[dd][et][3]) << 32); }
    const int tt = wave >> 1, x0 = 2 * (wave & 1);
    v4u pq[4], pk[4], pv; float pw, pgb = 0.f, pga = 0.f, pgm = 0.f;
#define ML_LOAD(ci_) do { const int ci__ = (ci_); \
        _Pragma("unroll") for (int i = 0; i < 4; ++i) { const int idx = tid + 512 * i, tau = idx >> 5, c8 = idx & 31; const int pos = ci__ * 64 + tau; const size_t tok = (size_t)seq * T + (dir ? T - 1 - pos : pos); \
            pq[i] = *(const GAS v4u*)(qc + tok * 1024 + h * 256 + c8 * 8); pk[i] = *(const GAS v4u*)(kc + tok * 1024 + h * 256 + c8 * 8); } \
        { const int tau = tid >> 3, c8 = tid & 7; const int pos = ci__ * 64 + tau; const size_t tok = (size_t)seq * T + (dir ? T - 1 - pos : pos); \
            pv = *(const GAS v4u*)(qkvob + tok * 4096 + 2048 + h * 256 + es * 64 + c8 * 8); pw = gs[GS_STRIDE + (size_t)chain * T + pos]; } \
        if (tid < 64) { const size_t o_ = (size_t)chain * T + ci__ * 64 + tid; pgb = gs[o_]; pga = gs[GS_STRIDE + o_]; pgm = gs[2 * GS_STRIDE + o_]; } } while (0)
    ML_LOAD(seg * 16);
    for (int cc = 0; cc < 16; ++cc) {
        const int ci = seg * 16 + cc;
#pragma unroll
        for (int i = 0; i < 4; ++i) { const int idx = tid + 512 * i, tau = idx >> 5, c8 = idx & 31; *(LAS v4u*)(Qs + tau * ML_QS + c8 * 8) = pq[i]; *(LAS v4u*)(Ks + tau * ML_QS + c8 * 8) = pk[i]; }
        const float cB = cm[ci], cmp = cm[128 + ci], cmn = cm[256 + ci];
        { const int tau = tid >> 3, c8 = tid & 7; *(LAS v4u*)(Vs + tau * ML_VS + c8 * 8) = pv; const float w = __expf(cB + pw - cmn);
            v4u o; o.x = pk2(bf_lo(pv.x) * w, bf_hi(pv.x) * w); o.y = pk2(bf_lo(pv.y) * w, bf_hi(pv.y) * w); o.z = pk2(bf_lo(pv.z) * w, bf_hi(pv.z) * w); o.w = pk2(bf_lo(pv.w) * w, bf_hi(pv.w) * w);
            *(LAS v4u*)(WV + tau * ML_VS + c8 * 8) = o; }
        if (tid < 64) { const float mrow = fmaxf(pgb + cmp, pgb + pgm);
            vec[tid] = pgb; vec[64 + tid] = pga; vec[128 + tid] = mrow; vec[192 + tid] = __expf(cB + pga - cmn); vec[256 + tid] = __expf(pgb + cmp - mrow); vec[320 + tid] = 0.f; }
        const float decay = __expf(cB + cmp - cmn);
        __syncthreads();
        if (cc + 1 < 16) ML_LOAD(ci + 1);
        { const int t = tid >> 3, part = tid & 7; float qn = 0.f;
#pragma unroll
            for (int c8 = 0; c8 < 4; ++c8) { const v4u qv = *(const LAS v4u*)(Qs + t * ML_QS + part * 32 + c8 * 8);
#pragma unroll
                for (int x = 0; x < 4; ++x) qn += bf_lo(qv[x]) * nst[part * 32 + c8 * 8 + 2 * x] + bf_hi(qv[x]) * nst[part * 32 + c8 * 8 + 2 * x + 1]; }
            qn += __shfl_xor(qn, 1); qn += __shfl_xor(qn, 2); qn += __shfl_xor(qn, 4);
            if (part == 0) __hip_atomic_fetch_add(&vec[320 + t], vec[256 + t] * qn, __ATOMIC_RELAXED, __HIP_MEMORY_SCOPE_WORKGROUP); }
        bf16x8 qf[8];
#pragma unroll
        for (int ks = 0; ks < 8; ++ks) qf[ks] = __builtin_bit_cast(bf16x8, *(const LAS v4u*)(Qs + (tt * 16 + li) * ML_QS + ks * 32 + 8 * kg));
        { const int t = tt * 16 + li; const float bt = vec[t], mrt = vec[128 + t]; float rsum = 0.f;
#pragma unroll
            for (int x = 0; x < 2; ++x) { const int st = x0 + x; f32x4 a = (f32x4){0.f, 0.f, 0.f, 0.f};
#pragma unroll
                for (int ks = 0; ks < 8; ++ks) a = MFMA16(__builtin_bit_cast(bf16x8, *(const LAS v4u*)(Ks + (st * 16 + li) * ML_QS + ks * 32 + 8 * kg)), qf[ks], a);
                float v[4];
#pragma unroll
                for (int r = 0; r < 4; ++r) { const int s = st * 16 + 4 * kg + r; v[r] = (s <= t) ? a[r] * __expf(bt + vec[64 + s] - mrt) : 0.f; rsum += v[r]; }
                *(LAS unsigned long long*)(ST + t * ML_VS + st * 16 + 4 * kg) = (unsigned long long)pk2(v[0], v[1]) | ((unsigned long long)pk2(v[2], v[3]) << 32); }
            rsum += __shfl_xor(rsum, 16); rsum += __shfl_xor(rsum, 32);
            if (kg == 0) __hip_atomic_fetch_add(&vec[320 + t], rsum, __ATOMIC_RELAXED, __HIP_MEMORY_SCOPE_WORKGROUP); }
        f32x4 accn[2];
#pragma unroll
        for (int x = 0; x < 2; ++x) { const int et = x0 + x; f32x4 a = (f32x4){0.f, 0.f, 0.f, 0.f};
#pragma unroll
            for (int ks = 0; ks < 8; ++ks) a = MFMA16(qf[ks], __builtin_bit_cast(bf16x8, *(const LAS v4u*)(CT + (et * 16 + li) * ML_QS + ks * 32 + 8 * kg)), a);
#pragma unroll
            for (int r = 0; r < 4; ++r) a[r] *= vec[256 + tt * 16 + 4 * kg + r];
            accn[x] = a; }
        __syncthreads();
#pragma unroll
        for (int ks = 0; ks < 2; ++ks) { const bf16x8 sa = __builtin_bit_cast(bf16x8, *(const LAS v4u*)(ST + (tt * 16 + li) * ML_VS + ks * 32 + 8 * kg));
#pragma unroll
            for (int x = 0; x < 2; ++x) { const LAS bf16* p = Vs + (ks * 32 + 8 * kg + qq) * ML_VS + (x0 + x) * 16 + 4 * pp; accn[x] = MFMA16(sa, tr_pair(p, p + 4 * ML_VS), accn[x]); } }
#pragma unroll
        for (int r = 0; r < 4; ++r) { const int t = tt * 16 + 4 * kg + r; const float den = fmaxf(fabsf(vec[320 + t]), __expf(-vec[128 + t])); const float inv = 1.0f / den;
            const int pos = ci * 64 + t; const size_t tok = (size_t)seq * T + (dir ? T - 1 - pos : pos);
#pragma unroll
            for (int x = 0; x < 2; ++x) hout[tok * 1024 + h * 256 + es * 64 + (x0 + x) * 16 + li] = accn[x][r] * inv; }
        ml_cupdate(cst, Ks, WV, decay, wave, kg, qq, pp);
#pragma unroll
        for (int dd = 0; dd < 2; ++dd)
#pragma unroll
            for (int et = 0; et < 4; ++et) { const int e = et * 16 + li, d = (2 * wave + dd) * 16 + 4 * kg;
                *(LAS unsigned long long*)(CT + e * ML_QS + d) = (unsigned long long)pk2(cst[dd][et][0], cst[dd][et][1]) | ((unsigned long long)pk2(cst[dd][et][2], cst[dd][et][3]) << 32); }
        if (tid < 256) { float a = decay * nst[tid];
#pragma unroll 8
            for (int s = 0; s < 64; ++s) a += vec[192 + s] * __uint_as_float(((unsigned)Ks[s * ML_QS + tid]) << 16);
            nst[tid] = a; }
        __syncthreads();
    }
#undef ML_LOAD
}

#ifndef KNOB_NO_ROW
#define KNOB_NO_ROW 0
#endif
#ifndef KNOB_NO_WIN
#define KNOB_NO_WIN 0
#endif
#ifndef KNOB_NO_PREP
#define KNOB_NO_PREP 0
#endif
#ifndef KNOB_NO_ML
#define KNOB_NO_ML 0
#endif
#ifndef KNOB_NO_NA
#define KNOB_NO_NA 0
#endif
#ifndef KNOB_NO_SG
#define KNOB_NO_SG 0
#endif
#ifndef KNOB_NO_COMB
#define KNOB_NO_COMB 0
#endif
#ifndef KNOB_NO_MERGE
#define KNOB_NO_MERGE 0
#endif
#ifndef KNOB_NO_WOUT
#define KNOB_NO_WOUT 0
#endif
#ifndef KNOB_NO_UP
#define KNOB_NO_UP 0
#endif
#ifndef KNOB_NO_DOWN
#define KNOB_NO_DOWN 0
#endif
#ifndef KNOB_NO_P0
#define KNOB_NO_P0 0
#endif
#ifndef USE_NA_WG
#define USE_NA_WG 1
#endif
#ifndef USE_NA_FAST
#define USE_NA_FAST 1
#endif
#ifndef USE_SG_FAST
#define USE_SG_FAST 1
#endif
#ifndef REP_P0
#define REP_P0 1
#endif
#ifndef REP_ROW
#define REP_ROW 1
#endif
#ifndef REP_PA
#define REP_PA 1
#endif
#ifndef REP_NA
#define REP_NA 1
#endif
#ifndef REP_SG
#define REP_SG 1
#endif
#ifndef REP_WIN
#define REP_WIN 1
#endif
#ifndef REP_MERGE
#define REP_MERGE 1
#endif
#ifndef REP_WOUT
#define REP_WOUT 1
#endif
#ifndef REP_UP
#define REP_UP 1
#endif
#ifndef REP_DOWN
#define REP_DOWN 1
#endif
#ifndef REP_MIX1
#define REP_MIX1 1
#endif
#ifndef REP_MIX2
#define REP_MIX2 1
#endif
#ifndef REP_PREP
#define REP_PREP 1
#endif
#ifndef REP_COMB
#define REP_COMB 1
#endif
#ifndef REP_BAR
#define REP_BAR 1
#endif
#ifndef USE_ML_FAST
#define USE_ML_FAST 1
#endif
constexpr int STEPS_PER = 12, N_STEPS = 1 + NSLAB * DEPTH * STEPS_PER;
__global__ void __launch_bounds__(NWAVES * 64, 2) trunk_fwd(Args args) {
    extern __shared__ __attribute__((aligned(16))) unsigned char lds[];
#define MKF() Frame F; { int t_ = threadIdx.x; asm volatile("" : "+v"(t_)); F.lds = (LAS unsigned char*)lds; F.tid = t_; F.lane = t_ & 63; F.wave = __builtin_amdgcn_readfirstlane(t_ >> 6); \
        F.G = gridDim.x; const int bx_ = blockIdx.x; F.vcu = (F.G % 8 == 0) ? (bx_ % 8) * (F.G / 8) + bx_ / 8 : bx_; }
#define ARGS() ({ const __attribute__((address_space(4))) Args* _p = (const __attribute__((address_space(4))) Args*)__builtin_amdgcn_kernarg_segment_ptr(); asm volatile("" : "+s"(_p)); _p; })
    gu32* ctl = (gu32*)(ARGS()->ws + WS_CTL);
    for (int u = threadIdx.x; u < (LDS_BYTES - LDSCTL_OFF) / 4; u += NWAVES * 64) ((LAS unsigned*)((LAS unsigned char*)lds + LDSCTL_OFF))[u] = 0u;
    __syncthreads();
    volatile LAS unsigned* MISC = (volatile LAS unsigned*)((LAS unsigned char*)lds + MISC_OFF);
    XcdBarrier bar = xcd_barrier_post((unsigned*)ctl + CW_BAR, MISC + 8);
    const int lo = ARGS()->ph_lo, hi = ARGS()->ph_hi;
#define IN(k) (lo <= (k) && (k) < hi)
#define SEAM(k) do { if (IN(k) && IN((k) + 1)) { _Pragma("unroll") for (int rb_ = 0; rb_ < REP_BAR; ++rb_) xcd_barrier(bar); } } while (0)

#define WSB(T_, off) ((T_*)(A->ws + (off)))
#define Hb WSB(bf16, WS_H)
#define QKVA WSB(bf16, WS_QKVA)
#define QKVOB WSB(bf16, WS_QKVOB)
#define ZUV WSB(bf16, WS_ZUV)
#define Ub WSB(bf16, WS_U)
#define Gb WSB(bf16, WS_G)
#define GATES WSB(float, WS_GATES)
#define SGR WSB(float, WS_SGR)
#define QC WSB(bf16, WS_QC)
#define KC WSB(bf16, WS_KC)
#define Yb WSB(bf16, WS_Y)
#define HF WSB(float, WS_HF)
#define HB WSB(float, WS_HB)
#define MRG WSB(float, WS_MRG)
#define MRGB WSB(bf16, WS_MRGB)
#define Tb WSB(float, WS_T)
#define GSb WSB(float, WS_GS)
#define GDb WSB(float, WS_GD)
#define LSTb WSB(float, WS_LST)
#define NLOCb WSB(float, WS_NLOC)

    if (IN(0) && !KNOB_NO_P0) { MKF();
        LAS float* scr = (LAS float*)(F.lds + RING_OFF + F.wave * 16384);
        _Pragma("unroll") for (int rep_ = 0; rep_ < REP_P0; ++rep_) for (int l = 0; l < DEPTH; ++l) {
            const auto* A = ARGS(); unsigned char* wl = A->ws + WS_W + (size_t)l * WL_BYTES;
            p0_win(F, A->w_in + (size_t)l * D * D_IN, (bf16*)(wl + WL_IN), scr);
            p0_matrix(F, A->w_a + (size_t)l * NA_W * D, NA_W, D, (bf16*)(wl + WL_ABC), scr);
            p0_matrix(F, A->w_b + (size_t)l * ML_W * D, ML_W, D, (bf16*)(wl + WL_ABC) + (size_t)D * 1024, scr);
            p0_matrix(F, A->w_c + (size_t)l * SG_W * D, SG_W, D, (bf16*)(wl + WL_ABC) + (size_t)2 * D * 1024, scr);
            p0_matrix(F, A->w_out + (size_t)l * D * D, D, D, (bf16*)(wl + WL_OUT), scr);
            p0_matrix(F, A->w_up + (size_t)l * D * DFF, D, DFF, (bf16*)(wl + WL_UP), scr);
            p0_matrix(F, A->w_down + (size_t)l * DFF * D, DFF, D, (bf16*)(wl + WL_DN), scr);
        }
    }
    SEAM(0);

    for (int s = 0; s < NSLAB; ++s) {
        const int T = s < 4 ? 4096 : 8192, nseq = MS / T;
        for (int l = 0; l < DEPTH; ++l) {
            const int sb = 1 + (s * DEPTH + l) * STEPS_PER;
            if (sb + STEPS_PER <= lo || sb >= hi) continue;
#define XIN0 (s < 4 ? A->x_prompt + (size_t)s * MS * D : A->x_sample + (size_t)(s - 4) * MS * D)
#define XO (A->out + (size_t)s * MS * D)
#define WL (A->ws + WS_W + (size_t)l * WL_BYTES)
            if (IN(sb + 0) && l == 0 && !KNOB_NO_ROW) { MKF(); const auto* A = ARGS(); row_phase(F, XIN0, nullptr, nullptr, nullptr, A->pre_mix_g, Hb); }
            SEAM(sb + 0);
            if (IN(sb + 1) && !KNOB_NO_WIN) { MKF(); const auto* A = ARGS();
                pg8::Gemm g{Hb, (const bf16*)(WL + WL_IN), MS, N_IN_PAD, D, 0, 0}; pg8::StaticOrder S; S.init(MS, N_IN_PAD, (int)gridDim.x, (int)blockIdx.x);
                pg8::EpiIn E{QKVA, QKVOB, ZUV, Gb, GATES, A->b_gate + l * 16};
                _Pragma("unroll") for (int rep_ = 0; rep_ < REP_WIN; ++rep_) pg8::gemm_phase<pg8::EpiIn, pg8::StaticOrder, true, true>((PG8_LAS unsigned char*)lds + RING_OFF, g, S, E);
            }
            SEAM(sb + 1);
            if (IN(sb + 2) && !KNOB_NO_PREP) { MKF(); const auto* A = ARGS(); _Pragma("unroll") for (int rep_ = 0; rep_ < REP_PREP; ++rep_) { prep_phase(F, QKVOB, A->conv_w + (size_t)l * 3 * 2048, QC, KC, ZUV, SGR, T); if (USE_ML_FAST) ml_gate_local(F, GATES, GSb, GDb, T, nseq * 8); } }
            SEAM(sb + 2);
            if (IN(sb + 3)) { MKF(); const auto* A = ARGS();
                if (USE_ML_FAST) {
                  _Pragma("unroll") for (int rep_ = 0; rep_ < REP_MIX1; ++rep_) {
                    _Pragma("unroll") for (int r2_ = 0; r2_ < REP_PA; ++r2_) for (int unit = F.vcu; unit < 256; unit += F.G) ml_phaseA(F, unit, KC, QKVOB, GSb, GDb, LSTb, NLOCb, T);
                    const int gw = F.vcu * NWAVES + F.wave, NGW = F.G * NWAVES;
                    _Pragma("unroll") for (int r2_ = 0; r2_ < REP_NA; ++r2_) { if (USE_NA_WG) na_wg(F, QKVA, A->na_rpb + (size_t)l * 8 * 15 * 31, Yb, T, F.vcu, F.G); else na_fast(F, QKVA, A->na_rpb + (size_t)l * 8 * 15 * 31, Yb, T, gw, NGW); }
                    _Pragma("unroll") for (int r2_ = 0; r2_ < REP_SG; ++r2_) sg_fast(F, ZUV, SGR, A->sg_norm_g + l * 1024, A->w_s + (size_t)l * 8 * 128 * 128, A->b_s + l * 1024, Yb + (size_t)2 * MS * 1024, F.vcu, F.G);
                  }
                } else {
                    const int nml = nseq * 32;
                    if (F.vcu < nml) mlstm_naive(F, F.vcu, QC, KC, QKVOB, GATES, HF, HB, T);
                    else { const int gw = (F.vcu - nml) * NWAVES + F.wave, NGW = (F.G - nml) * NWAVES;
                        na_fast(F, QKVA, A->na_rpb + (size_t)l * 8 * 15 * 31, Yb, T, gw, NGW);
                        sg_fast(F, ZUV, SGR, A->sg_norm_g + l * 1024, A->w_s + (size_t)l * 8 * 128 * 128, A->b_s + l * 1024, Yb + (size_t)2 * MS * 1024, F.vcu - nml, F.G - nml); }
                }
            }
            SEAM(sb + 3);
            if (IN(sb + 4) && USE_ML_FAST) { MKF(); const auto* A = ARGS();
                _Pragma("unroll") for (int rep_ = 0; rep_ < REP_MIX2; ++rep_) for (int unit = F.vcu; unit < 256; unit += F.G) ml_phaseC(F, unit, QC, KC, QKVOB, GSb, GDb, LSTb, NLOCb, HF, HB, T);
            }
            SEAM(sb + 4);
            if (IN(sb + 5) && !KNOB_NO_COMB) { MKF(); const auto* A = ARGS(); _Pragma("unroll") for (int rep_ = 0; rep_ < REP_COMB; ++rep_) comb_phase(F, HF, HB, QKVOB, A->ml_norm_g + l * 1024, Yb + (size_t)MS * 1024); }
            SEAM(sb + 5);
            if (IN(sb + 6) && !KNOB_NO_MERGE) { MKF(); const auto* A = ARGS();
                pg8::Gemm g{Yb, (const bf16*)(WL + WL_ABC), MS, D, 1024, (size_t)MS * 1024 * 2, (size_t)D * 1024 * 2}; pg8::ZOrder<3> S; S.init(MS, D, (int)gridDim.x, (int)blockIdx.x);
                pg8::EpiMergeH E{Gb, MRGB};
                _Pragma("unroll") for (int rep_ = 0; rep_ < REP_MERGE; ++rep_) pg8::gemm_phase<pg8::EpiMergeH, pg8::ZOrder<3>, true, true>((PG8_LAS unsigned char*)lds + RING_OFF, g, S, E);
            }
            SEAM(sb + 6);
            if (IN(sb + 7) && !KNOB_NO_WOUT) { MKF(); const auto* A = ARGS();
                pg8::Gemm g{MRGB, (const bf16*)(WL + WL_OUT), MS, D, D, 0, 0}; pg8::StaticOrder S; S.init(MS, D, (int)gridDim.x, (int)blockIdx.x);
                pg8::EpiF32 E{Tb, D};
                _Pragma("unroll") for (int rep_ = 0; rep_ < REP_WOUT; ++rep_) pg8::gemm_phase<pg8::EpiF32, pg8::StaticOrder, true, true>((PG8_LAS unsigned char*)lds + RING_OFF, g, S, E);
            }
            SEAM(sb + 7);
            if (IN(sb + 8) && !KNOB_NO_ROW) { MKF(); const auto* A = ARGS(); _Pragma("unroll") for (int rep_ = 1; rep_ < REP_ROW; ++rep_) row_phase(F, l == 0 ? XIN0 : XO, Tb, A->post_mix_g + l * D, WSB(float, WS_MRG), A->pre_mlp_g + l * D, WSB(bf16, WS_HF)); row_phase(F, l == 0 ? XIN0 : XO, Tb, A->post_mix_g + l * D, XO, A->pre_mlp_g + l * D, Hb); }
            SEAM(sb + 8);
            if (IN(sb + 9) && !KNOB_NO_UP) { MKF(); const auto* A = ARGS();
                pg8::Gemm g{Hb, (const bf16*)(WL + WL_UP), MS, DFF, D, 0, 0}; pg8::StaticOrder S; S.init(MS, DFF, (int)gridDim.x, (int)blockIdx.x);
                pg8::EpiRelu2 E{Ub, DFF};
                _Pragma("unroll") for (int rep_ = 0; rep_ < REP_UP; ++rep_) pg8::gemm_phase<pg8::EpiRelu2, pg8::StaticOrder, true, true>((PG8_LAS unsigned char*)lds + RING_OFF, g, S, E);
            }
            SEAM(sb + 9);
            if (IN(sb + 10) && !KNOB_NO_DOWN) { MKF(); const auto* A = ARGS();
                pg8::Gemm g{Ub, (const bf16*)(WL + WL_DN), MS, D, DFF, 0, 0}; pg8::StaticOrder S; S.init(MS, D, (int)gridDim.x, (int)blockIdx.x);
                pg8::EpiF32 E{Tb, D};
                _Pragma("unroll") for (int rep_ = 0; rep_ < REP_DOWN; ++rep_) pg8::gemm_phase<pg8::EpiF32, pg8::StaticOrder, true, true>((PG8_LAS unsigned char*)lds + RING_OFF, g, S, E);
            }
            SEAM(sb + 10);
            if (IN(sb + 11) && !KNOB_NO_ROW) { MKF(); const auto* A = ARGS(); _Pragma("unroll") for (int rep_ = 1; rep_ < REP_ROW; ++rep_) row_phase(F, XO, Tb, A->post_mlp_g + l * D, WSB(float, WS_MRG), l + 1 < DEPTH ? A->pre_mix_g + (l + 1) * D : nullptr, l + 1 < DEPTH ? WSB(bf16, WS_HF) : nullptr); row_phase(F, XO, Tb, A->post_mlp_g + l * D, XO, l + 1 < DEPTH ? A->pre_mix_g + (l + 1) * D : nullptr, l + 1 < DEPTH ? Hb : nullptr); }
            SEAM(sb + 11);
        }
    }
#undef IN
#undef SEAM
}

#ifndef MK_LAUNCH_PER_STEP
#define MK_LAUNCH_PER_STEP 0
#endif
extern "C" void kernel_launch(void* const* d_in, const int* in_sizes, int n_in, void* d_out, int out_size, void* d_ws, size_t ws_size, hipStream_t stream) {
    static int grid = 0;
    if (grid == 0) {
        if (n_in != 20 || in_sizes[0] != M_PROMPT * D || in_sizes[1] != M_SAMPLE * D || out_size != M_ALL * D || ws_size < WS_END) {
            fprintf(stderr, "kernel_launch: unexpected shapes (n_in %d, in0 %d, in1 %d, out %d, ws %zu); nothing launched\n", n_in, n_in > 0 ? in_sizes[0] : -1, n_in > 1 ? in_sizes[1] : -1, out_size, ws_size); grid = -1; return; }
        int dev = 0, cus = 0;
        if (hipGetDevice(&dev) != hipSuccess || hipDeviceGetAttribute(&cus, hipDeviceAttributeMultiprocessorCount, dev) != hipSuccess) { grid = -1; return; }
        if (hipFuncSetAttribute((const void*)trunk_fwd, hipFuncAttributeMaxDynamicSharedMemorySize, LDS_BYTES) != hipSuccess) { fprintf(stderr, "kernel_launch: hipFuncSetAttribute failed\n"); grid = -1; return; }
        int per_cu = 0;
        if (hipOccupancyMaxActiveBlocksPerMultiprocessor(&per_cu, (const void*)trunk_fwd, NWAVES * 64, LDS_BYTES) != hipSuccess || per_cu < 1)
            fprintf(stderr, "kernel_launch: note: occupancy query reports %d workgroups per CU\n", per_cu);
        (void)hipGetLastError();
        grid = cus;
    }
    if (grid < 0) return;
    if (hipMemsetAsync((char*)d_ws + WS_CTL, 0, CTL_ZERO_BYTES, stream) != hipSuccess) return;
    Args a{};
    a.x_prompt = (const float*)d_in[0]; a.x_sample = (const float*)d_in[1]; a.pre_mix_g = (const float*)d_in[2]; a.post_mix_g = (const float*)d_in[3];
    a.pre_mlp_g = (const float*)d_in[4]; a.post_mlp_g = (const float*)d_in[5]; a.w_in = (const float*)d_in[6]; a.b_gate = (const float*)d_in[7];
    a.conv_w = (const float*)d_in[8]; a.na_rpb = (const float*)d_in[9]; a.ml_norm_g = (const float*)d_in[10]; a.sg_norm_g = (const float*)d_in[11];
    a.w_s = (const float*)d_in[12]; a.b_s = (const float*)d_in[13]; a.w_a = (const float*)d_in[14]; a.w_b = (const float*)d_in[15]; a.w_c = (const float*)d_in[16];
    a.w_out = (const float*)d_in[17]; a.w_up = (const float*)d_in[18]; a.w_down = (const float*)d_in[19];
    a.out = (float*)d_out; a.ws = (unsigned char*)d_ws;
#if MK_LAUNCH_PER_STEP
    for (int k = 0; k < N_STEPS; ++k) { a.ph_lo = k; a.ph_hi = k + 1; hipLaunchKernelGGL(trunk_fwd, dim3(grid), dim3(NWAVES * 64), LDS_BYTES, stream, a); }
#else
    a.ph_lo = 0; a.ph_hi = N_STEPS;
    hipLaunchKernelGGL(trunk_fwd, dim3(grid), dim3(NWAVES * 64), LDS_BYTES, stream, a);
#endif
}
```

```cpp
#include <hip/hip_runtime.h>
#include <cstdio>
#include <cstdint>
namespace pg8 {
#define PG8_LAS __attribute__((address_space(3)))
typedef unsigned short bf16_t;
typedef short bf16x8 __attribute__((ext_vector_type(8)));
typedef float f32x4 __attribute__((ext_vector_type(4)));
typedef unsigned u32x4 __attribute__((ext_vector_type(4)));
typedef unsigned u32x2 __attribute__((ext_vector_type(2)));
constexpr int BM = 256, BK = 64, HALF = 128, HTB = HALF * BK * 2  , STAGE_BYTES = 8 * HTB, NXCD = 8, WGM = 8;

__host__ __device__ __forceinline__ int lds_byte(int r, int c) { const int st = (r >> 4) * 2 + (c >> 5), rr = r & 15, cc = c & 31, ob = rr * 64 + cc * 2; return st * 1024 + (ob ^ (((ob >> 9) & 1) << 5)); }
__host__ __device__ __forceinline__ void stage_rc(int b, int& R, int& C) { const int st = b / 1024, sb = b % 1024, swz = sb ^ (((sb >> 9) & 1) << 5); R = (st >> 1) * 16 + swz / 64; C = (st & 1) * 32 + (swz % 64) / 2; }
__host__ __device__ __forceinline__ int perm32(int rho) { const int n = rho >> 4, i = rho & 15; return 8 * (i >> 2) + 4 * n + (i & 3); }

struct Unit { int pm, pn, z; };
struct Gemm { const bf16_t* A; const bf16_t* Bt; int M, N, K; size_t zA, zB; };

struct StaticOrder {
    int nM, nN, nwg, G, c;
    __host__ __device__ void init(int M, int N, int G_, int c_) { nM = M / BM; nN = N / BM; nwg = nM * nN; G = G_; c = c_; }
    __host__ __device__ bool tile(long L, Unit& u) const {
        if (L >= nwg) return false;
        int wgid = (int)L; { const int q = nwg / NXCD, r = nwg % NXCD, xcd = wgid % NXCD, off = wgid / NXCD; wgid = (xcd < r ? xcd * (q + 1) : r * (q + 1) + (xcd - r) * q) + off; }
        const int nig = WGM * nN, gid = wgid / nig, fm = gid * WGM, gsz = (nM - fm) < WGM ? (nM - fm) : WGM;
        u.pm = fm + ((wgid % nig) % gsz); u.pn = (wgid % nig) / gsz; return true;
    }
    __host__ __device__ bool next(int i, Unit& u) const { u.z = 0; return tile((long)i * G + c, u); }
    __device__ __forceinline__ void a_ready(const Unit&) const {}
    __device__ __forceinline__ void done(const Unit&) const {}
};
template <int NZ> struct ZOrder : StaticOrder {
    __host__ __device__ bool next(int i, Unit& u) const { const int k = i / NZ; u.z = i - k * NZ; return tile((long)k * G + c, u); }
};

__device__ __forceinline__ unsigned cvt_pk_bf16(float lo, float hi) { unsigned r; asm volatile("v_cvt_pk_bf16_f32 %0, %1, %2" : "=v"(r) : "v"(lo), "v"(hi)); return r; }
__device__ __forceinline__ float sigm(float x) { return __builtin_amdgcn_rcpf(1.0f + __builtin_amdgcn_exp2f(-1.4426950408889634f * x)); }
__device__ __forceinline__ float gelu_tanh(float x) { return x * sigm(1.5957691216057308f * x * (1.0f + 0.044715f * x * x)); }
__device__ __forceinline__ float act_apply(int act, float x) { return act == 1 ? sigm(x) : (act == 2 ? gelu_tanh(x) : x); }

struct EpiIn {
    static constexpr bool PERM = true, AFTER_DRAIN = false;
    __device__ static __forceinline__ bool keep(const Unit&) { return false; }
    bf16_t *qkva, *qkvob, *zuv, *g; float* gates; const float* bgate;
    __device__ __forceinline__ void operator()(const f32x4 (&acc)[2][2][4][2], const Unit& u, int wr, int wc, int fr, int fq) const {
        const int pn = u.pn, row0 = u.pm * BM + wr * 64 + fr;
        if (pn == 60) {
            if (wc == 0 && fq < 2) {
#pragma unroll
                for (int ai = 0; ai < 2; ++ai)
#pragma unroll
                    for (int m = 0; m < 4; ++m)
#pragma unroll
                        for (int n = 0; n < 2; ++n) { const int col = 8 * fq + 4 * n; *(f32x4*)(gates + (size_t)(row0 + ai * HALF + m * 16) * 16 + col) = acc[ai][0][m][n] + *(const f32x4*)(bgate + col); }
            }
            return;
        }
        bf16_t* base; int ldc, colt, act;
        if (pn < 12) { base = qkva; ldc = 3072; colt = pn * BM; act = 0; }
        else if (pn < 28) { base = qkvob; ldc = 4096; colt = (pn - 12) * BM; act = pn >= 24 ? 1 : 0; }
        else if (pn < 36) { base = zuv; ldc = 2048; colt = (pn - 28) * BM; act = 2; }
        else { base = g; ldc = 6144; colt = (pn - 36) * BM; act = 1; }
        const int col0 = colt + wc * 32 + 8 * fq;
#pragma unroll
        for (int ai = 0; ai < 2; ++ai)
#pragma unroll
            for (int m = 0; m < 4; ++m) { bf16_t* rowp = base + (size_t)(row0 + ai * HALF + m * 16) * ldc + col0;
#pragma unroll
                for (int bj = 0; bj < 2; ++bj) { f32x4 v0 = acc[ai][bj][m][0], v1 = acc[ai][bj][m][1];
                    if (act != 0) {
#pragma unroll
                        for (int j = 0; j < 4; ++j) { v0[j] = act_apply(act, v0[j]); v1[j] = act_apply(act, v1[j]); } }
                    u32x4 w; w.x = cvt_pk_bf16(v0[0], v0[1]); w.y = cvt_pk_bf16(v0[2], v0[3]); w.z = cvt_pk_bf16(v1[0], v1[1]); w.w = cvt_pk_bf16(v1[2], v1[3]);
                    *(u32x4*)(rowp + bj * HALF) = w; } }
    }
};
struct EpiMerge {
    static constexpr bool PERM = false, AFTER_DRAIN = false;
    __device__ static __forceinline__ bool keep(const Unit&) { return false; }
    const bf16_t* g; float* mrg; bf16_t* mrgb;
    __device__ __forceinline__ void operator()(const f32x4 (&acc)[2][2][4][2], const Unit& u, int wr, int wc, int fr, int fq) const {
        const int z = u.z, row0 = u.pm * BM + wr * 64 + fr, col0 = u.pn * BM + wc * 32 + 4 * fq;
#pragma unroll
        for (int ai = 0; ai < 2; ++ai)
#pragma unroll
            for (int m = 0; m < 4; ++m) { const size_t row = (size_t)(row0 + ai * HALF + m * 16);
#pragma unroll
                for (int bj = 0; bj < 2; ++bj)
#pragma unroll
                    for (int n = 0; n < 2; ++n) { const int col = col0 + bj * HALF + n * 16;
                        const u32x2 gw = *(const u32x2*)(g + row * 6144 + (size_t)z * 2048 + col);
                        f32x4 gv; gv[0] = __uint_as_float(gw.x << 16); gv[1] = __uint_as_float(gw.x & 0xffff0000u); gv[2] = __uint_as_float(gw.y << 16); gv[3] = __uint_as_float(gw.y & 0xffff0000u);
                        f32x4 v = acc[ai][bj][m][n] * gv;
                        if (z > 0) v += *(const f32x4*)(mrg + row * 2048 + col);
                        if (z < 2) *(f32x4*)(mrg + row * 2048 + col) = v;
                        else { u32x2 w; w.x = cvt_pk_bf16(v[0], v[1]); w.y = cvt_pk_bf16(v[2], v[3]); *(u32x2*)(mrgb + row * 2048 + col) = w; } }
                asm volatile("" ::: "memory"); }
    }
};
struct EpiMergeH {
    static constexpr bool PERM = true, AFTER_DRAIN = false;
    const bf16_t* g; bf16_t* mrgb;
    __device__ static __forceinline__ bool keep(const Unit& u) { return u.z < 2; }
    __device__ __forceinline__ void operator()(f32x4 (&acc)[2][2][4][2], const Unit& u, int wr, int wc, int fr, int fq) const {
        const int z = u.z, row0 = u.pm * BM + wr * 64 + fr, col0 = u.pn * BM + wc * 32 + 8 * fq;
#pragma unroll
        for (int ai = 0; ai < 2; ++ai)
#pragma unroll
            for (int m = 0; m < 4; ++m) { const size_t row = (size_t)(row0 + ai * HALF + m * 16);
#pragma unroll
                for (int bj = 0; bj < 2; ++bj) { const int col = col0 + bj * HALF;
                    const u32x4 gz = *(const u32x4*)(g + row * 6144 + (size_t)z * 2048 + col);
                    float f[8];
                    if (z < 2) { const u32x4 gn = *(const u32x4*)(g + row * 6144 + (size_t)(z + 1) * 2048 + col);
#pragma unroll
                        for (int j = 0; j < 4; ++j) { f[2 * j] = __uint_as_float(gz[j] << 16) * __builtin_amdgcn_rcpf(fmaxf(__uint_as_float(gn[j] << 16), 1e-30f));
                            f[2 * j + 1] = __uint_as_float(gz[j] & 0xffff0000u) * __builtin_amdgcn_rcpf(fmaxf(__uint_as_float(gn[j] & 0xffff0000u), 1e-30f)); }
                    } else {
#pragma unroll
                        for (int j = 0; j < 4; ++j) { f[2 * j] = __uint_as_float(gz[j] << 16); f[2 * j + 1] = __uint_as_float(gz[j] & 0xffff0000u); } }
#pragma unroll
                    for (int j = 0; j < 4; ++j) { acc[ai][bj][m][0][j] *= f[j]; acc[ai][bj][m][1][j] *= f[4 + j]; }
                    if (z == 2) { const f32x4 v0 = acc[ai][bj][m][0], v1 = acc[ai][bj][m][1];
                        u32x4 w; w.x = cvt_pk_bf16(v0[0], v0[1]); w.y = cvt_pk_bf16(v0[2], v0[3]); w.z = cvt_pk_bf16(v1[0], v1[1]); w.w = cvt_pk_bf16(v1[2], v1[3]);
                        *(u32x4*)(mrgb + row * 2048 + col) = w; } }
                asm volatile("" ::: "memory"); }
    }
};
struct EpiF32 {
    static constexpr bool PERM = false, AFTER_DRAIN = false;
    __device__ static __forceinline__ bool keep(const Unit&) { return false; }
    float* C; int ldc;
    __device__ __forceinline__ void operator()(const f32x4 (&acc)[2][2][4][2], const Unit& u, int wr, int wc, int fr, int fq) const {
        const int row0 = u.pm * BM + wr * 64 + fr, col0 = u.pn * BM + wc * 32 + 4 * fq;
#pragma unroll
        for (int ai = 0; ai < 2; ++ai)
#pragma unroll
            for (int m = 0; m < 4; ++m) { float* rowp = C + (size_t)(row0 + ai * HALF + m * 16) * ldc + col0;
#pragma unroll
                for (int bj = 0; bj < 2; ++bj)
#pragma unroll
                    for (int n = 0; n < 2; ++n) *(f32x4*)(rowp + bj * HALF + n * 16) = acc[ai][bj][m][n]; }
    }
};
struct EpiRelu2 {
    static constexpr bool PERM = true, AFTER_DRAIN = false;
    __device__ static __forceinline__ bool keep(const Unit&) { return false; }
    bf16_t* O; int ldc;
    __device__ __forceinline__ void operator()(const f32x4 (&acc)[2][2][4][2], const Unit& u, int wr, int wc, int fr, int fq) const {
        const int row0 = u.pm * BM + wr * 64 + fr, col0 = u.pn * BM + wc * 32 + 8 * fq;
#pragma unroll
        for (int ai = 0; ai < 2; ++ai)
#pragma unroll
            for (int m = 0; m < 4; ++m) { bf16_t* rowp = O + (size_t)(row0 + ai * HALF + m * 16) * ldc + col0;
#pragma unroll
                for (int bj = 0; bj < 2; ++bj) { f32x4 v0 = acc[ai][bj][m][0], v1 = acc[ai][bj][m][1];
#pragma unroll
                    for (int j = 0; j < 4; ++j) { const float a = fmaxf(v0[j], 0.f), b = fmaxf(v1[j], 0.f); v0[j] = a * a; v1[j] = b * b; }
                    u32x4 w; w.x = cvt_pk_bf16(v0[0], v0[1]); w.y = cvt_pk_bf16(v0[2], v0[3]); w.z = cvt_pk_bf16(v1[0], v1[1]); w.w = cvt_pk_bf16(v1[2], v1[3]);
                    *(u32x4*)(rowp + bj * HALF) = w; } }
    }
};

template <class Epi, class Sched, bool ALIGN_EPI = false, bool SP2 = false>
__device__ __forceinline__ void gemm_phase(PG8_LAS unsigned char* lds, const Gemm g, const Sched& S, const Epi& E) {
    int tid_l = threadIdx.x; asm volatile("" : "+v"(tid_l));
    const int tid = tid_l, wid = __builtin_amdgcn_readfirstlane(tid >> 6), lane = tid & 63, wr = wid >> 2, wc = wid & 3, fr = lane & 15, fq = lane >> 4;
    const int K = g.K, nt = K / BK;
    unsigned voffA[2], voffB[2];
#pragma unroll
    for (int i = 0; i < 2; ++i) { int R, C; stage_rc(tid * 16 + i * 8192, R, C); const int Rb = Epi::PERM ? ((R & ~31) + perm32(R & 31)) : R;
        voffA[i] = (unsigned)(R * K + C) * 2u; voffB[i] = (unsigned)(Rb * K + C) * 2u; }
    const size_t kstep = (size_t)(BK * 2);
    const size_t hstep = (size_t)HALF * K * 2;
    const size_t tstep = 2 * hstep;
    const unsigned ldsw = (unsigned)wid * 1024u;
    const int aoff = lds_byte(wr * 64 + fr, fq * 8), boff = lds_byte(wc * 32 + fr, fq * 8);
#define PG8_SA(b, h) (((b) * 2 + (h)) * HTB)
#define PG8_SB(b, h) ((4 + (b) * 2 + (h)) * HTB)
#define PG8_STAGE(bufoff, gbase, voff) do { _Pragma("unroll") for (int _i = 0; _i < 2; ++_i) \
        __builtin_amdgcn_global_load_lds((const unsigned*)((const char*)(gbase) + (voff)[_i]), (PG8_LAS unsigned*)(lds + (bufoff) + ldsw + _i * 8192), 16, 0, 0); } while (0)
#define PG8_LDA(dst, b, h) do { _Pragma("unroll") for (int m = 0; m < 4; ++m) _Pragma("unroll") for (int k = 0; k < 2; ++k) dst[m][k] = *(const PG8_LAS bf16x8*)(lds + PG8_SA(b, h) + aoff + m * 2048 + k * 1024); } while (0)
#define PG8_LDB(dst, b, h) do { _Pragma("unroll") for (int n = 0; n < 2; ++n) _Pragma("unroll") for (int k = 0; k < 2; ++k) dst[n][k] = *(const PG8_LAS bf16x8*)(lds + PG8_SB(b, h) + boff + n * 2048 + k * 1024); } while (0)
#define PG8_MMA(ai, bj, At, Bt) do { __builtin_amdgcn_s_setprio(1); _Pragma("unroll") for (int m = 0; m < 4; ++m) _Pragma("unroll") for (int n = 0; n < 2; ++n) _Pragma("unroll") for (int k = 0; k < 2; ++k) \
        acc[ai][bj][m][n] = __builtin_amdgcn_mfma_f32_16x16x32_bf16(Bt[n][k], At[m][k], acc[ai][bj][m][n], 0, 0, 0); __builtin_amdgcn_s_setprio(0); } while (0)
#define PG8_WAIT_V(n) asm volatile("s_waitcnt vmcnt(" #n ")" ::: "memory")
#define PG8_WAIT_L(n) asm volatile("s_waitcnt lgkmcnt(" #n ")" ::: "memory")
#define PG8_BAR __builtin_amdgcn_s_barrier()
#define PG8_SCHED __builtin_amdgcn_sched_barrier(0)
    Unit cur, nxt; int ui = 0;
    if (!S.next(0, cur)) return;
    f32x4 acc[2][2][4][2];
#pragma unroll
    for (int a = 0; a < 2; ++a)
#pragma unroll
        for (int b = 0; b < 2; ++b)
#pragma unroll
            for (int m = 0; m < 4; ++m)
#pragma unroll
                for (int n = 0; n < 2; ++n) acc[a][b][m][n] = (f32x4){0.f, 0.f, 0.f, 0.f};
    bf16x8 At[4][2], B0[2][2], B1[2][2];
    const char* cA = (const char*)g.A + (size_t)cur.pm * tstep + (size_t)cur.z * g.zA; const char* cB = (const char*)g.Bt + (size_t)cur.pn * tstep + (size_t)cur.z * g.zB;
    S.a_ready(cur);
    if constexpr (SP2) {
        PG8_STAGE(PG8_SB(0, 0), cB, voffB); PG8_STAGE(PG8_SB(0, 1), cB + hstep, voffB); PG8_STAGE(PG8_SA(0, 0), cA, voffA); PG8_STAGE(PG8_SA(0, 1), cA + hstep, voffA);
        if (wr == 1) PG8_BAR;
        PG8_WAIT_V(2); PG8_BAR;
        PG8_STAGE(PG8_SB(1, 0), cB + kstep, voffB); PG8_STAGE(PG8_SA(1, 0), cA + kstep, voffA); PG8_STAGE(PG8_SB(1, 1), cB + hstep + kstep, voffB);
        PG8_WAIT_V(6); PG8_BAR;
    } else {
        PG8_STAGE(PG8_SB(0, 0), cB, voffB); PG8_STAGE(PG8_SA(0, 0), cA, voffA); PG8_STAGE(PG8_SB(0, 1), cB + hstep, voffB); PG8_STAGE(PG8_SA(0, 1), cA + hstep, voffA);
        if (wr == 1) PG8_BAR;
        PG8_WAIT_V(4); PG8_BAR;
        PG8_STAGE(PG8_SB(1, 0), cB + kstep, voffB); PG8_STAGE(PG8_SA(1, 0), cA + kstep, voffA); PG8_STAGE(PG8_SB(1, 1), cB + hstep + kstep, voffB);
        PG8_WAIT_V(6); PG8_BAR;
    }
    for (;;) {
        const bool has_next = S.next(ui + 1, nxt);
        const char* nA = has_next ? (const char*)g.A + (size_t)nxt.pm * tstep + (size_t)nxt.z * g.zA : cA; const char* nB = has_next ? (const char*)g.Bt + (size_t)nxt.pn * tstep + (size_t)nxt.z * g.zB : cB;
        for (int t = 0; t < nt; t += 2) {
            const bool last = (t == nt - 2);
            const char* a1 = cA + (size_t)(t + 1) * kstep;
            const char* a2 = last ? nA : cA + (size_t)(t + 2) * kstep; const char* b2 = last ? nB : cB + (size_t)(t + 2) * kstep;
            const char* a3 = a2 + kstep; const char* b3 = b2 + kstep;
            if (last && has_next) S.a_ready(nxt);
            if constexpr (SP2) {
            PG8_LDB(B0, 0, 0); PG8_LDB(B1, 0, 1); PG8_SCHED; PG8_LDA(At, 0, 0); PG8_STAGE(PG8_SA(1, 1), a1 + hstep, voffA);
            PG8_WAIT_V(8); PG8_WAIT_L(0); PG8_BAR; PG8_MMA(0, 0, At, B0); PG8_MMA(0, 1, At, B1); PG8_BAR; PG8_SCHED;
            PG8_LDA(At, 0, 1); PG8_STAGE(PG8_SB(0, 0), b2, voffB); PG8_STAGE(PG8_SB(0, 1), b2 + hstep, voffB); PG8_STAGE(PG8_SA(0, 0), a2, voffA);
            PG8_WAIT_V(8); PG8_WAIT_L(0); PG8_BAR; PG8_MMA(1, 0, At, B0); PG8_MMA(1, 1, At, B1); PG8_BAR; PG8_SCHED;
            PG8_LDB(B0, 1, 0); PG8_LDB(B1, 1, 1); PG8_SCHED; PG8_LDA(At, 1, 0); PG8_STAGE(PG8_SA(0, 1), a2 + hstep, voffA);
            PG8_WAIT_V(8); PG8_WAIT_L(0); PG8_BAR; PG8_MMA(0, 0, At, B0); PG8_MMA(0, 1, At, B1); PG8_BAR; PG8_SCHED;
            PG8_LDA(At, 1, 1); PG8_STAGE(PG8_SB(1, 0), b3, voffB); PG8_STAGE(PG8_SB(1, 1), b3 + hstep, voffB); PG8_STAGE(PG8_SA(1, 0), a3, voffA);
            PG8_WAIT_V(8); PG8_WAIT_L(0); PG8_BAR; PG8_MMA(1, 0, At, B0); PG8_MMA(1, 1, At, B1); PG8_BAR; PG8_SCHED;
            } else {
            PG8_LDB(B0, 0, 0); PG8_SCHED; PG8_LDA(At, 0, 0); PG8_STAGE(PG8_SA(1, 1), a1 + hstep, voffA);
            PG8_WAIT_L(8); PG8_BAR; PG8_WAIT_L(0); PG8_MMA(0, 0, At, B0); PG8_BAR; PG8_SCHED;
            PG8_LDB(B1, 0, 1); PG8_STAGE(PG8_SB(0, 0), b2, voffB);
            PG8_BAR; PG8_WAIT_L(0); PG8_MMA(0, 1, At, B1); PG8_BAR;
            PG8_LDA(At, 0, 1); PG8_STAGE(PG8_SA(0, 0), a2, voffA);
            PG8_BAR; PG8_WAIT_L(0); PG8_MMA(1, 0, At, B0); PG8_BAR; PG8_SCHED;
            PG8_STAGE(PG8_SB(0, 1), b2 + hstep, voffB);
            PG8_WAIT_V(6); PG8_BAR; PG8_MMA(1, 1, At, B1); PG8_BAR;
            PG8_LDB(B0, 1, 0); PG8_SCHED; PG8_LDA(At, 1, 0); PG8_STAGE(PG8_SA(0, 1), a2 + hstep, voffA);
            PG8_WAIT_L(8); PG8_BAR; PG8_WAIT_L(0); PG8_MMA(0, 0, At, B0); PG8_BAR; PG8_SCHED;
            PG8_LDB(B1, 1, 1); PG8_STAGE(PG8_SB(1, 0), b3, voffB);
            PG8_BAR; PG8_WAIT_L(0); PG8_MMA(0, 1, At, B1); PG8_BAR;
            PG8_LDA(At, 1, 1); PG8_STAGE(PG8_SA(1, 0), a3, voffA);
            PG8_BAR; PG8_WAIT_L(0); PG8_MMA(1, 0, At, B0); PG8_BAR; PG8_SCHED;
            PG8_STAGE(PG8_SB(1, 1), b3 + hstep, voffB);
            PG8_WAIT_V(6); PG8_BAR; PG8_MMA(1, 1, At, B1); PG8_BAR;
            }
        }
        if constexpr (ALIGN_EPI) { if (wr == 0) PG8_BAR; }
        if constexpr (!Epi::AFTER_DRAIN) { E(acc, cur, wr, wc, fr, fq); S.done(cur); }
        if (!has_next) break;
        if (!Epi::keep(cur)) {
#pragma unroll
        for (int a = 0; a < 2; ++a)
#pragma unroll
            for (int b = 0; b < 2; ++b)
#pragma unroll
                for (int m = 0; m < 4; ++m)
#pragma unroll
                    for (int n = 0; n < 2; ++n) acc[a][b][m][n] = (f32x4){0.f, 0.f, 0.f, 0.f};
        }
        cur = nxt; cA = nA; cB = nB; ++ui;
        if constexpr (ALIGN_EPI) { if (wr == 1) PG8_BAR; }
    }
    PG8_WAIT_V(0);
    if constexpr (!ALIGN_EPI) { if (wr == 0) PG8_BAR; }
    PG8_BAR;
    if constexpr (Epi::AFTER_DRAIN) { E.fused(acc, cur, wr, wc, fr, fq, lds, wid, lane); S.done(cur); }
#undef PG8_SA
#undef PG8_SB
#undef PG8_STAGE
#undef PG8_LDA
#undef PG8_LDB
#undef PG8_MMA
#undef PG8_WAIT_V
#undef PG8_WAIT_L
#undef PG8_BAR
#undef PG8_SCHED
}
}

constexpr int NWAVES = 8;
constexpr int D = 2048, DEPTH = 2, DFF = 8192;
constexpr int NA_W = 1024, ML_W = 1024, SG_W = 1024;
constexpr int D_IN = 15376, N_IN_PAD = 15616;
constexpr int M_PROMPT = 8 * 4096, M_SAMPLE = 2 * 8192, M_ALL = M_PROMPT + M_SAMPLE;
constexpr int MS = 8192, NSLAB = M_ALL / MS;
constexpr float EPS = 1e-6f;

constexpr size_t MiB = 1u << 20;
constexpr size_t WS_CTL = 0, CTL_ZERO_BYTES = 1 * MiB;
constexpr size_t WL_IN = 0, WL_ABC = 61 * MiB, WL_OUT = 73 * MiB, WL_UP = 81 * MiB, WL_DN = 113 * MiB, WL_BYTES = 145 * MiB;
constexpr size_t WS_W = 1 * MiB;
constexpr size_t WS_H = 291 * MiB;
constexpr size_t WS_QKVA = 323 * MiB;
constexpr size_t WS_QKVOB = 371 * MiB;
constexpr size_t WS_ZUV = 435 * MiB;
constexpr size_t WS_U = WS_QKVA;
constexpr size_t WS_G = 467 * MiB;
constexpr size_t WS_GATES = 563 * MiB;
constexpr size_t WS_SGR = WS_GATES + MiB / 2;
constexpr size_t WS_QC = 564 * MiB, WS_KC = 580 * MiB;
constexpr size_t WS_Y = 596 * MiB;
constexpr size_t WS_HF = 644 * MiB, WS_HB = 676 * MiB;
constexpr size_t WS_MRG = 708 * MiB;
constexpr size_t WS_MRGB = 772 * MiB;
constexpr size_t WS_T = 804 * MiB;
constexpr size_t WS_GS = 868 * MiB;
constexpr size_t WS_GD = 870 * MiB;
constexpr size_t WS_LST = 871 * MiB;
constexpr size_t WS_NLOC = 887 * MiB;
constexpr size_t WS_LST2 = 888 * MiB;
constexpr size_t WS_STG = 908 * MiB;
constexpr size_t WS_END = 916 * MiB;
static_assert(WS_W + 2 * WL_BYTES <= WS_H && WS_U + (size_t)MS * DFF * 2 <= WS_G && WS_SGR + (size_t)MS * 4 <= WS_QC, "d_ws map");
constexpr int CW_BAR = 4096;

constexpr int RING_OFF = 0, RING_BYTES = 131072;
constexpr int LDSCTL_OFF = 153600, MISC_OFF = LDSCTL_OFF + 320;
constexpr int LDS_BYTES = 155648;

#define GAS __attribute__((address_space(1)))
#define LAS __attribute__((address_space(3)))
typedef unsigned short bf16;
typedef unsigned v4u __attribute__((ext_vector_type(4)));
typedef float f32x4 __attribute__((ext_vector_type(4)));
typedef short bf16x8 __attribute__((ext_vector_type(8)));
typedef GAS unsigned gu32;
typedef GAS unsigned long long gu64;
#define RLX_AGENT __ATOMIC_RELAXED, __HIP_MEMORY_SCOPE_AGENT
#define LDS_WAIT() asm volatile("s_waitcnt lgkmcnt(0)" ::: "memory")
#define VM_WAIT() asm volatile("s_waitcnt vmcnt(0)" ::: "memory")
__device__ __forceinline__ unsigned long long rt() { return __builtin_amdgcn_s_memrealtime(); }
__device__ __forceinline__ unsigned f2bf(float f) { unsigned u = __builtin_bit_cast(unsigned, f); return (u + 0x7fffu + ((u >> 16) & 1u)) >> 16; }
__device__ __forceinline__ unsigned pk2(float lo, float hi) { return f2bf(lo) | (f2bf(hi) << 16); }

#define XB_TMO      128
#define XB_XCNT(j)  (256  + 64 * (j))
#define XB_XSUB(j)  (1280 + 64 * (j))
#define XB_XGEN(j)  (2304 + 64 * (j))
#define XB_TOP      3328
#define XB_TOPGEN   3392
#define XCD_BAR_WORDS 3456
#define XB_SPIN_CAP (1u << 18)

__device__ __forceinline__ unsigned xb_ld(unsigned* p)              { return __hip_atomic_load(p, __ATOMIC_RELAXED, __HIP_MEMORY_SCOPE_AGENT); }
__device__ __forceinline__ unsigned xb_add(unsigned* p, unsigned v) { return __hip_atomic_fetch_add(p, v, __ATOMIC_RELAXED, __HIP_MEMORY_SCOPE_AGENT); }
__device__ __forceinline__ unsigned xb_xcc_id() { return (unsigned)__builtin_amdgcn_s_getreg((3 << 11) | 20) & 0xFu; }
#define XB_SPIN(cond, bar) do { unsigned _sp = 0; while (cond) { __builtin_amdgcn_s_sleep(1); \
    if ((++_sp & 255u) == 0u) { if (xb_ld(&(bar)[XB_TMO])) break; if (_sp > XB_SPIN_CAP) { atomicAdd(&(bar)[XB_TMO], 1u); break; } } } } while (0)

struct XcdBarrier {
    unsigned* bar; unsigned x;
    volatile LAS unsigned* st;
};

__device__ __forceinline__ XcdBarrier xcd_barrier_post(unsigned* bar, volatile LAS unsigned* st) {
    XcdBarrier b; b.bar = bar; b.x = xb_xcc_id(); b.st = st;
    if (threadIdx.x == 0) (void)xb_add(&bar[XB_XCNT(b.x)], 1u);
    return b;
}
__device__ __forceinline__ void xcd_barrier_complete(unsigned* bar, unsigned x, unsigned& nloc, unsigned& nx) {
    const unsigned G = gridDim.x * gridDim.y * gridDim.z;
    unsigned sum, cnt, mine, sp = 0u;
    for (;;) {
        sum = 0u; cnt = 0u; mine = 0u;
#pragma unroll
        for (unsigned j = 0; j < 16; ++j) { const unsigned c = xb_ld(&bar[XB_XCNT(j)]); sum += c; cnt += (c > 0u) ? 1u : 0u; mine = (j == x) ? c : mine; }
        if (sum == G) break;
        __builtin_amdgcn_s_sleep(1);
        if ((++sp & 255u) == 0u) { if (xb_ld(&bar[XB_TMO])) break; if (sp > XB_SPIN_CAP) { atomicAdd(&bar[XB_TMO], 1u); break; } }
    }
    nloc = mine > 0u ? mine : 1u; nx = cnt > 0u ? cnt : 1u;
}

__device__ __forceinline__ void xcd_barrier(const XcdBarrier& b) {
    asm volatile("s_waitcnt vmcnt(0)" ::: "memory");
    __syncthreads();
    if (threadIdx.x == 0) {
        unsigned* bar = b.bar;
        __builtin_amdgcn_s_waitcnt(0);
        unsigned nloc = b.st[0], nx = b.st[1];
        if (nloc == 0u) { xcd_barrier_complete(bar, b.x, nloc, nx); b.st[0] = nloc; b.st[1] = nx; }
        const unsigned old = xb_add(&bar[XB_XSUB(b.x)], 1u);
        const unsigned gen = old / nloc;
        if (old + 1u == (gen + 1u) * nloc) {
            __builtin_amdgcn_fence(__ATOMIC_RELEASE, "agent");
            asm volatile("s_waitcnt vmcnt(0)" ::: "memory");
            const unsigned og = xb_add(&bar[XB_TOP], 1u);
            const unsigned tg = og / nx;
            if (og + 1u == (tg + 1u) * nx) xb_add(&bar[XB_TOPGEN], 1u);
            else XB_SPIN(xb_ld(&bar[XB_TOPGEN]) == tg, bar);
            __builtin_amdgcn_fence(__ATOMIC_ACQUIRE, "agent");
            xb_add(&bar[XB_XGEN(b.x)], 1u);
            asm volatile("s_waitcnt vmcnt(0)" ::: "memory");
        } else {
            XB_SPIN(xb_ld(&bar[XB_XGEN(b.x)]) == gen, bar);
            __builtin_amdgcn_fence(__ATOMIC_ACQUIRE, "agent");
            asm volatile("s_waitcnt vmcnt(0)" ::: "memory");
        }
    }
    __syncthreads();
}

struct Frame {
    LAS unsigned char* lds;
    int tid, lane, wave;
    int vcu, G;
};
struct Args {
    const float* x_prompt; const float* x_sample; const float* pre_mix_g; const float* post_mix_g; const float* pre_mlp_g; const float* post_mlp_g;
    const float* w_in; const float* b_gate; const float* conv_w; const float* na_rpb; const float* ml_norm_g; const float* sg_norm_g; const float* w_s; const float* b_s;
    const float* w_a; const float* w_b; const float* w_c; const float* w_out; const float* w_up; const float* w_down;
    float* out; unsigned char* ws;
    int ph_lo, ph_hi;
};

__device__ __forceinline__ float wave_sum(float v) {
#pragma unroll
    for (int o = 1; o < 64; o <<= 1) v += __shfl_xor(v, o);
    return v;
}
__device__ __forceinline__ float wave_max(float v) {
#pragma unroll
    for (int o = 1; o < 64; o <<= 1) v = fmaxf(v, __shfl_xor(v, o));
    return v;
}
__device__ __forceinline__ float bf_lo(unsigned u) { return __uint_as_float(u << 16); }
__device__ __forceinline__ float bf_hi(unsigned u) { return __uint_as_float(u & 0xffff0000u); }
__device__ __forceinline__ float sigmoid_f(float x) { return __builtin_amdgcn_rcpf(1.0f + __builtin_amdgcn_exp2f(-1.4426950408889634f * x)); }

__device__ __forceinline__ void p0_transpose_item(const float* W, int K, int N, bf16* WT, int k0, int n0, int ncols, int drow0, float sc, LAS float* scr, int lane) {
    const int cl = lane & 31;
#pragma unroll 8
    for (int i = 0; i < 32; ++i) { const int kk = 2 * i + (lane >> 5); scr[kk * 33 + cl] = (cl < ncols) ? W[(size_t)(k0 + kk) * N + n0 + cl] * sc : 0.f; }
    LDS_WAIT(); asm volatile("" ::: "memory");
    const int c = lane & 7;
#pragma unroll
    for (int j = 0; j < 4; ++j) { const int n = (lane >> 3) + 8 * j; const LAS float* s = scr + (8 * c) * 33 + n;
        v4u o; o.x = pk2(s[0 * 33], s[1 * 33]); o.y = pk2(s[2 * 33], s[3 * 33]); o.z = pk2(s[4 * 33], s[5 * 33]); o.w = pk2(s[6 * 33], s[7 * 33]);
        if (n < ncols) *(GAS v4u*)(WT + (size_t)(drow0 + n) * K + k0 + 8 * c) = o; }
    LDS_WAIT(); asm volatile("" ::: "memory");
}
__device__ __forceinline__ void p0_matrix(Frame& F, const float* W, int K, int N, bf16* WT, LAS float* scr) {
    const int gw = F.vcu * NWAVES + F.wave, NGW = F.G * NWAVES, nblk = N / 32, nit = (K / 64) * nblk;
    for (int it = gw; it < nit; it += NGW) { const int kb = it / nblk, nb = it % nblk; p0_transpose_item(W, K, N, WT, 64 * kb, 32 * nb, 32, 32 * nb, 1.f, scr, F.lane); }
}
__device__ __forceinline__ void p0_win(Frame& F, const float* W, bf16* WT, LAS float* scr) {
    const int gw = F.vcu * NWAVES + F.wave, NGW = F.G * NWAVES;
    constexpr int NB1 = 7168 / 32, NB2 = 8192 / 32, NBLK = NB1 + 1 + NB2, NIT = (D / 64) * NBLK;
    for (int it = gw; it < NIT; it += NGW) { const int kb = it / NBLK, nb = it % NBLK; int n0, ncols, drow0; float sc = 1.f;
        if (nb < NB1) { n0 = 32 * nb; ncols = 32; drow0 = n0; if (n0 < 1024) sc = 0.08838834764831845f; }
        else if (nb == NB1) { n0 = 7168; ncols = 16; drow0 = 15360; }
        else { n0 = 7184 + 32 * (nb - NB1 - 1); ncols = 32; drow0 = n0 - 16; }
        p0_transpose_item(W, D, D_IN, WT, 64 * kb, n0, ncols, drow0, sc, scr, F.lane); }
    const int gt = (F.vcu * NWAVES + F.wave) * 64 + F.lane, NGT = F.G * NWAVES * 64; constexpr int NZ16 = (N_IN_PAD - D_IN) * D / 8;
    GAS v4u* z = (GAS v4u*)(WT + (size_t)D_IN * D);
    for (int i = gt; i < NZ16; i += NGT) z[i] = (v4u){0u, 0u, 0u, 0u};
}

__device__ __forceinline__ void row_phase(Frame& F, const float* xin, const float* add, const float* g_add, float* xout, const float* g_next, bf16* hout) {
    const int gw = F.vcu * NWAVES + F.wave, NGW = F.G * NWAVES;
    for (int m = gw; m < MS; m += NGW) {
        const GAS f32x4* xr = (const GAS f32x4*)(xin + (size_t)m * D) + F.lane;
        f32x4 v[8];
#pragma unroll
        for (int j = 0; j < 8; ++j) v[j] = xr[64 * j];
        if (add) {
            const GAS f32x4* ar = (const GAS f32x4*)(add + (size_t)m * D) + F.lane; f32x4 a[8]; float s = 0.f;
#pragma unroll
            for (int j = 0; j < 8; ++j) { a[j] = ar[64 * j]; s += (a[j].x * a[j].x + a[j].y * a[j].y) + (a[j].z * a[j].z + a[j].w * a[j].w); }
            const float rs = 1.0f / sqrtf(wave_sum(s) * (1.f / D) + EPS);
#pragma unroll
            for (int j = 0; j < 8; ++j) { const f32x4 gv = ((const GAS f32x4*)g_add)[F.lane + 64 * j]; v[j] = v[j] + (a[j] * rs) * gv; }
        }
        if (xout) { GAS f32x4* o = (GAS f32x4*)(xout + (size_t)m * D) + F.lane;
#pragma unroll
            for (int j = 0; j < 8; ++j) o[64 * j] = v[j]; }
        if (hout) {
            float s = 0.f;
#pragma unroll
            for (int j = 0; j < 8; ++j) s += (v[j].x * v[j].x + v[j].y * v[j].y) + (v[j].z * v[j].z + v[j].w * v[j].w);
            const float rs = 1.0f / sqrtf(wave_sum(s) * (1.f / D) + EPS);
            GAS unsigned long long* o8 = (GAS unsigned long long*)(hout + (size_t)m * D) + F.lane;
#pragma unroll
            for (int j = 0; j < 8; ++j) { const f32x4 gv = ((const GAS f32x4*)g_next)[F.lane + 64 * j]; const f32x4 y = (v[j] * rs) * gv;
                o8[64 * j] = (unsigned long long)pk2(y.x, y.y) | ((unsigned long long)pk2(y.z, y.w) << 32); }
        }
    }
}

__device__ __forceinline__ void prep_phase(Frame& F, const bf16* qkvob, const float* convw, bf16* qc, bf16* kc, const bf16* zuv, float* sgr, int T) {
    const int gt = (F.vcu * NWAVES + F.wave) * 64 + F.lane, NGT = F.G * NWAVES * 64;
    {
        const int c8 = gt & 255; float w0[8], w1[8], w2[8];
#pragma unroll
        for (int j = 0; j < 8; ++j) { w0[j] = convw[c8 * 8 + j]; w1[j] = convw[2048 + c8 * 8 + j]; w2[j] = convw[4096 + c8 * 8 + j]; }
        const float osc = c8 < 128 ? 0.0625f : 1.0f;
        bf16* dst = c8 < 128 ? qc + c8 * 8 : kc + (c8 - 128) * 8;
        for (int t = gt >> 8; t < MS; t += NGT >> 8) {
            const int ts = t % T; const GAS v4u* src = (const GAS v4u*)(qkvob + (size_t)t * 4096 + c8 * 8);
            const v4u xc = src[0]; v4u xm = (v4u){0u, 0u, 0u, 0u}, xp = xm;
            if (ts > 0) xm = *(const GAS v4u*)(qkvob + (size_t)(t - 1) * 4096 + c8 * 8);
            if (ts < T - 1) xp = *(const GAS v4u*)(qkvob + (size_t)(t + 1) * 4096 + c8 * 8);
            float r[8];
#pragma unroll
            for (int j = 0; j < 4; ++j) {
                const float a0 = w0[2 * j] * bf_lo(xm[j]) + w1[2 * j] * bf_lo(xc[j]) + w2[2 * j] * bf_lo(xp[j]);
                const float a1 = w0[2 * j + 1] * bf_hi(xm[j]) + w1[2 * j + 1] * bf_hi(xc[j]) + w2[2 * j + 1] * bf_hi(xp[j]);
                r[2 * j] = a0 * sigmoid_f(a0) * osc; r[2 * j + 1] = a1 * sigmoid_f(a1) * osc; }
            v4u o; o.x = pk2(r[0], r[1]); o.y = pk2(r[2], r[3]); o.z = pk2(r[4], r[5]); o.w = pk2(r[6], r[7]);
            *(GAS v4u*)(dst + (size_t)t * 1024) = o;
        }
    }
    {
        const int gw = F.vcu * NWAVES + F.wave, NGW = F.G * NWAVES;
        for (int t = gw; t < MS; t += NGW) {
            const GAS v4u* src = (const GAS v4u*)(zuv + (size_t)t * 2048 + 1024) + 2 * F.lane; float s = 0.f;
#pragma unroll
            for (int i = 0; i < 2; ++i) { const v4u x = src[i];
#pragma unroll
                for (int j = 0; j < 4; ++j) { const float a = bf_lo(x[j]), b = bf_hi(x[j]); s += a * a + b * b; } }
            s = wave_sum(s);
            if (F.lane == 0) sgr[t] = 1.0f / sqrtf(s * (1.f / 1024.f) + EPS);
        }
    }
}

__device__ __forceinline__ void comb_phase(Frame& F, const float* hf, const float* hb, const bf16* qkvob, const float* mlg, bf16* yb) {
    const int gw = F.vcu * NWAVES + F.wave, NGW = F.G * NWAVES;
    for (int it = gw; it < MS * 4; it += NGW) { const int t = it >> 2, h = it & 3; const size_t o = (size_t)t * 1024 + h * 256 + 4 * F.lane;
        const f32x4 a = *(const GAS f32x4*)(hf + o), b = *(const GAS f32x4*)(hb + o); const f32x4 s = a + b;
        const float ss = wave_sum((s.x * s.x + s.y * s.y) + (s.z * s.z + s.w * s.w)); const float rs = 1.0f / sqrtf(ss * (1.f / 256.f) + EPS);
        const f32x4 gv = *(const GAS f32x4*)(mlg + h * 256 + 4 * F.lane);
        const unsigned long long ow = *(const GAS unsigned long long*)(qkvob + (size_t)t * 4096 + 3072 + h * 256 + 4 * F.lane);
        const unsigned o0 = (unsigned)ow, o1 = (unsigned)(ow >> 32);
        const float y0 = s.x * rs * gv.x * bf_lo(o0), y1 = s.y * rs * gv.y * bf_hi(o0), y2 = s.z * rs * gv.z * bf_lo(o1), y3 = s.w * rs * gv.w * bf_hi(o1);
        *(GAS unsigned long long*)(yb + o) = (unsigned long long)pk2(y0, y1) | ((unsigned long long)pk2(y2, y3) << 32);
    }
}

__device__ __forceinline__ void na_naive(Frame& F, const bf16* qkva, const float* rpb, bf16* ya, int T, int gw, int NGW) {
    const int rows = T / 64;
    for (int it = gw; it < MS * 8; it += NGW) {
        const int m = it >> 3, h = it & 7, seq = m / T, t = m % T, r = t >> 6, qc = t & 63;
        int rs = r - 4; rs = rs < 0 ? 0 : (rs > rows - 8 ? rows - 8 : rs);
        int cs = qc - 8; cs = cs < 0 ? 0 : (cs > 48 ? 48 : cs);
        const bf16* qrow = qkva + (size_t)m * 3072 + h * 128;
        float sc[2];
#pragma unroll
        for (int kk = 0; kk < 2; ++kk) { const int kap = F.lane + 64 * kk, j = kap >> 4, cc = kap & 15;
            const int ktok = seq * T + (rs + j) * 64 + cs + cc; const bf16* krow = qkva + (size_t)ktok * 3072 + 1024 + h * 128; float d = 0.f;
#pragma unroll 4
            for (int i = 0; i < 16; ++i) { const v4u qv = *(const GAS v4u*)(qrow + 8 * i), kv = *(const GAS v4u*)(krow + 8 * i);
#pragma unroll
                for (int e = 0; e < 4; ++e) d += bf_lo(qv[e]) * bf_lo(kv[e]) + bf_hi(qv[e]) * bf_hi(kv[e]); }
            sc[kk] = d + rpb[(h * 15 + (rs + j - r + 7)) * 31 + (cs + cc - qc + 15)]; }
        const float mx = wave_max(fmaxf(sc[0], sc[1]));
        const float e0 = __expf(sc[0] - mx), e1 = __expf(sc[1] - mx); const float inv = 1.0f / wave_sum(e0 + e1);
        const float p0 = e0 * inv, p1 = e1 * inv;
        float o0 = 0.f, o1 = 0.f;
        for (int kap = 0; kap < 128; ++kap) { const int j = kap >> 4, cc = kap & 15; const int ktok = seq * T + (rs + j) * 64 + cs + cc;
            const float p = __shfl(kap < 64 ? p0 : p1, kap & 63);
            const unsigned vv = *(const GAS unsigned*)(qkva + (size_t)ktok * 3072 + 2048 + h * 128 + 2 * F.lane);
            o0 += p * bf_lo(vv); o1 += p * bf_hi(vv); }
        *(GAS unsigned*)(ya + (size_t)m * 1024 + h * 128 + 2 * F.lane) = pk2(o0, o1);
    }
}
__device__ __forceinline__ void sg_naive(Frame& F, const bf16* zuv, const float* sgr, const float* sgn, const float* ws_, const float* bs, bf16* yc, int gw, int NGW) {
    for (int it = gw; it < MS * 8; it += NGW) {
        const int t = it >> 3, g = it & 7, p = t & 127, cb = t & ~127; const int c = g * 128 + 2 * F.lane;
        const float* wrow = ws_ + ((size_t)g * 128 + p) * 128; float a0 = 0.f, a1 = 0.f;
        for (int q = 0; q < 128; ++q) { const float wq = wrow[q] * sgr[cb + q]; const unsigned zz = *(const GAS unsigned*)(zuv + (size_t)(cb + q) * 2048 + 1024 + c);
            a0 += wq * bf_lo(zz); a1 += wq * bf_hi(zz); }
        const float b = bs[g * 128 + p]; const unsigned uu = *(const GAS unsigned*)(zuv + (size_t)t * 2048 + c);
        const float y0 = bf_lo(uu) * (a0 * sgn[c] + b), y1 = bf_hi(uu) * (a1 * sgn[c + 1] + b);
        *(GAS unsigned*)(yc + (size_t)t * 1024 + c) = pk2(y0, y1);
    }
}
__device__ __forceinline__ void mlstm_naive(Frame& F, int unit, const bf16* qc, const bf16* kc, const bf16* qkvob, const float* gates, float* hf, float* hb, int T) {
    const int es = unit & 3, dir = (unit >> 2) & 1, h = (unit >> 3) & 3, seq = unit >> 5, nc = T / 64, tid = F.tid;
    LAS unsigned char* L = F.lds;
    LAS bf16* Qs = (LAS bf16*)(L);
    LAS bf16* Ks = (LAS bf16*)(L + 33792);
    LAS float* Vs = (LAS float*)(L + 67584);
    LAS float* Ss = (LAS float*)(L + 83968);
    LAS float* NUM = (LAS float*)(L + 100608);
    LAS float* vb = (LAS float*)(L + 116992);
    LAS float* va = vb + 64;
    LAS float* vmr = vb + 128;
    LAS float* vw = vb + 192;
    LAS float* vwi = vb + 256;
    LAS float* NQ = vb + 320;
    LAS float* nst = vb + 384;
    LAS float* scal = vb + 640;
    float* hout = dir ? hb : hf;
    float Creg[32];
#pragma unroll
    for (int i = 0; i < 32; ++i) Creg[i] = 0.f;
    if (tid < 256) nst[tid] = 0.f;
    float m_prev = 0.f;
    const int e = tid & 63, dg = tid >> 6;
    for (int ci = 0; ci < nc; ++ci) {
        __syncthreads();
#pragma unroll
        for (int i = 0; i < 4; ++i) { const int p = tid + 512 * i, tau = p >> 5, c8 = p & 31; const int pos = ci * 64 + tau; const int tok = seq * T + (dir ? T - 1 - pos : pos);
            *(LAS v4u*)(Qs + tau * 264 + c8 * 8) = *(const GAS v4u*)(qc + (size_t)tok * 1024 + h * 256 + c8 * 8);
            *(LAS v4u*)(Ks + tau * 264 + c8 * 8) = *(const GAS v4u*)(kc + (size_t)tok * 1024 + h * 256 + c8 * 8); }
        { const int tau = tid >> 3, c8 = tid & 7; const int pos = ci * 64 + tau; const int tok = seq * T + (dir ? T - 1 - pos : pos);
            const v4u vv = *(const GAS v4u*)(qkvob + (size_t)tok * 4096 + 2048 + h * 256 + es * 64 + c8 * 8);
#pragma unroll
            for (int j = 0; j < 4; ++j) { Vs[tau * 64 + c8 * 8 + 2 * j] = bf_lo(vv[j]); Vs[tau * 64 + c8 * 8 + 2 * j + 1] = bf_hi(vv[j]); } }
        if (tid < 64) {
            const int pos = ci * 64 + tid; const int tok = seq * T + (dir ? T - 1 - pos : pos);
            const float ipre = gates[(size_t)tok * 16 + dir * 8 + h], fpre = gates[(size_t)tok * 16 + dir * 8 + 4 + h];
            const float logf = fminf(fpre, 0.f) - log1pf(__expf(-fabsf(fpre)));
            float b = logf;
#pragma unroll
            for (int o = 1; o < 64; o <<= 1) { const float y = __shfl_up(b, o); if (tid >= o) b += y; }
            const float a = ipre - b; float pm = a;
#pragma unroll
            for (int o = 1; o < 64; o <<= 1) { const float y = __shfl_up(pm, o); if (tid >= o) pm = fmaxf(pm, y); }
            const float mrow = fmaxf(b + m_prev, b + pm);
            const float blast = __shfl(b, 63), amax = __shfl(pm, 63);
            const float mnew = fmaxf(blast + m_prev, blast + amax);
            vb[tid] = b; va[tid] = a; vmr[tid] = mrow; vw[tid] = __expf(blast + a - mnew); vwi[tid] = __expf(b + m_prev - mrow);
            if (tid == 0) { scal[0] = __expf(blast + m_prev - mnew); scal[1] = mnew; }
        }
#pragma unroll
        for (int i = 0; i < 8; ++i) NUM[tid + 512 * i] = 0.f;
        __syncthreads();
        const float decay = scal[0]; m_prev = scal[1];
        {
            const int tau = tid >> 3, sg = tid & 7; float rowpart = 0.f; const float bt = vb[tau], mr = vmr[tau];
#pragma unroll 1
            for (int j = 0; j < 8; ++j) { const int s = sg * 8 + j; float val = 0.f;
                if (s <= tau) { float d = 0.f;
#pragma unroll 4
                    for (int c8 = 0; c8 < 32; ++c8) { const v4u qv = *(const LAS v4u*)(Qs + tau * 264 + c8 * 8), kv = *(const LAS v4u*)(Ks + s * 264 + c8 * 8);
#pragma unroll
                        for (int x = 0; x < 4; ++x) d += bf_lo(qv[x]) * bf_lo(kv[x]) + bf_hi(qv[x]) * bf_hi(kv[x]); }
                    val = d * __expf(bt + va[s] - mr); }
                Ss[tau * 65 + s] = val; rowpart += val; }
            float qn = 0.f;
#pragma unroll 4
            for (int c8 = 0; c8 < 4; ++c8) { const v4u qv = *(const LAS v4u*)(Qs + tau * 264 + sg * 32 + c8 * 8);
#pragma unroll
                for (int x = 0; x < 4; ++x) qn += bf_lo(qv[x]) * nst[sg * 32 + c8 * 8 + 2 * x] + bf_hi(qv[x]) * nst[sg * 32 + c8 * 8 + 2 * x + 1]; }
            float tot = rowpart + vwi[tau] * qn;
            tot += __shfl_xor(tot, 1); tot += __shfl_xor(tot, 2); tot += __shfl_xor(tot, 4);
            if (sg == 0) NQ[tau] = tot;
        }
        {
#pragma unroll 1
            for (int tau = 0; tau < 64; ++tau) { float part = 0.f;
#pragma unroll
                for (int c8 = 0; c8 < 4; ++c8) { const v4u qv = *(const LAS v4u*)(Qs + tau * 264 + dg * 32 + c8 * 8);
#pragma unroll
                    for (int x = 0; x < 4; ++x) part += bf_lo(qv[x]) * Creg[c8 * 8 + 2 * x] + bf_hi(qv[x]) * Creg[c8 * 8 + 2 * x + 1]; }
                __hip_atomic_fetch_add(&NUM[tau * 64 + e], vwi[tau] * part, __ATOMIC_RELAXED, __HIP_MEMORY_SCOPE_WORKGROUP); }
        }
        __syncthreads();
        {
#pragma unroll 1
            for (int j = 0; j < 8; ++j) { const int tau = dg * 8 + j; float acc = 0.f;
#pragma unroll 8
                for (int s = 0; s < 64; ++s) acc += Ss[tau * 65 + s] * Vs[s * 64 + e];
                __hip_atomic_fetch_add(&NUM[tau * 64 + e], acc, __ATOMIC_RELAXED, __HIP_MEMORY_SCOPE_WORKGROUP); }
        }
        __syncthreads();
#pragma unroll
        for (int i = 0; i < 8; ++i) { const int idx = tid + 512 * i, tau = idx >> 6, ee = idx & 63; const int pos = ci * 64 + tau; const int tok = seq * T + (dir ? T - 1 - pos : pos);
            const float den = fmaxf(fabsf(NQ[tau]), __expf(-vmr[tau]));
            hout[(size_t)tok * 1024 + h * 256 + es * 64 + ee] = NUM[idx] / den; }
#pragma unroll
        for (int i = 0; i < 32; ++i) Creg[i] *= decay;
#pragma unroll 1
        for (int s = 0; s < 64; ++s) { const float wv = vw[s] * Vs[s * 64 + e];
#pragma unroll
            for (int c8 = 0; c8 < 4; ++c8) { const v4u kv = *(const LAS v4u*)(Ks + s * 264 + dg * 32 + c8 * 8);
#pragma unroll
                for (int x = 0; x < 4; ++x) { Creg[c8 * 8 + 2 * x] += bf_lo(kv[x]) * wv; Creg[c8 * 8 + 2 * x + 1] += bf_hi(kv[x]) * wv; } } }
        if (tid < 256) { float a = decay * nst[tid];
#pragma unroll 8
            for (int s = 0; s < 64; ++s) a += vw[s] * __uint_as_float(((unsigned)Ks[s * 264 + tid]) << 16);
            nst[tid] = a; }
    }
    __syncthreads();
}

typedef short s16x4 __attribute__((ext_vector_type(4)));
__device__ __forceinline__ bf16x8 tr_pair(const LAS bf16* p0, const LAS bf16* p1) {
    const s16x4 a = __builtin_amdgcn_ds_read_tr16_b64_v4i16((LAS s16x4*)p0), b = __builtin_amdgcn_ds_read_tr16_b64_v4i16((LAS s16x4*)p1);
    return __builtin_shufflevector(a, b, 0, 1, 2, 3, 4, 5, 6, 7);
}
#define MFMA16(a, b, c) __builtin_amdgcn_mfma_f32_16x16x32_bf16((a), (b), (c), 0, 0, 0)

__device__ __forceinline__ void sg_fast(Frame& F, const bf16* zuv, const float* sgr, const float* sgn, const float* ws_, const float* bs, bf16* yc, int u0, int ustride) {
    LAS bf16* Z = (LAS bf16*)F.lds;
    const int lane = F.lane, kg = lane >> 4, li = lane & 15, qq = li >> 2, pp = li & 3;
    for (int unit = u0; unit < (MS / 128) * 8; unit += ustride) {
        const int c = unit >> 3, g = unit & 7, t0 = c * 128;
        __syncthreads();
#pragma unroll
        for (int i = 0; i < 4; ++i) { const int idx = F.tid + 512 * i, row = idx >> 4, ch = idx & 15;
            *(LAS v4u*)(Z + row * 136 + ch * 8) = *(const GAS v4u*)(zuv + (size_t)(t0 + row) * 2048 + 1024 + g * 128 + ch * 8); }
        const int p = F.wave * 16 + li;
        bf16x8 bw[4];
#pragma unroll
        for (int ks = 0; ks < 4; ++ks) { const int q0 = ks * 32 + 8 * kg;
            const f32x4 w0 = *(const GAS f32x4*)(ws_ + ((size_t)g * 128 + p) * 128 + q0), w1 = *(const GAS f32x4*)(ws_ + ((size_t)g * 128 + p) * 128 + q0 + 4);
            const f32x4 r0 = *(const GAS f32x4*)(sgr + t0 + q0), r1 = *(const GAS f32x4*)(sgr + t0 + q0 + 4);
            v4u pk; pk.x = pk2(w0.x * r0.x, w0.y * r0.y); pk.y = pk2(w0.z * r0.z, w0.w * r0.w); pk.z = pk2(w1.x * r1.x, w1.y * r1.y); pk.w = pk2(w1.z * r1.z, w1.w * r1.w);
            bw[ks] = __builtin_bit_cast(bf16x8, pk); }
        __syncthreads();
        const float bsv = bs[g * 128 + p];
#pragma unroll 2
        for (int dt = 0; dt < 8; ++dt) {
            f32x4 acc = (f32x4){0.f, 0.f, 0.f, 0.f};
#pragma unroll
            for (int ks = 0; ks < 4; ++ks) { const LAS bf16* a0 = Z + (ks * 32 + 8 * kg + qq) * 136 + dt * 16 + 4 * pp;
                acc = MFMA16(tr_pair(a0, a0 + 4 * 136), bw[ks], acc); }
            const int d0 = g * 128 + dt * 16 + 4 * kg;
            const f32x4 sg = *(const GAS f32x4*)(sgn + d0);
            const unsigned long long uw = *(const GAS unsigned long long*)(zuv + (size_t)(t0 + p) * 2048 + d0); const unsigned u0w = (unsigned)uw, u1w = (unsigned)(uw >> 32);
            const float y0 = bf_lo(u0w) * (sg.x * acc[0] + bsv), y1 = bf_hi(u0w) * (sg.y * acc[1] + bsv), y2 = bf_lo(u1w) * (sg.z * acc[2] + bsv), y3 = bf_hi(u1w) * (sg.w * acc[3] + bsv);
            *(GAS unsigned long long*)(yc + (size_t)(t0 + p) * 1024 + d0) = (unsigned long long)pk2(y0, y1) | ((unsigned long long)pk2(y2, y3) << 32);
        }
    }
    __syncthreads();
}

__device__ __forceinline__ void na_fast(Frame& F, const bf16* qkva, const float* rpb, bf16* ya, int T, int gw, int NGW) {
    const int rows = T / 64, lane = F.lane, kg = lane >> 4, li = lane & 15, qq = li >> 2, pp = li & 3;
    LAS bf16* Vt = (LAS bf16*)(F.lds + F.wave * 8192);
    for (int it = gw; it < (MS / 16) * 8; it += NGW) {
        const int h = it & 7, blk = it >> 3, n = blk & 3, rowg = blk >> 2, seq = rowg / rows, r = rowg % rows;
        int rs = r - 4; rs = rs < 0 ? 0 : (rs > rows - 8 ? rows - 8 : rs);
        int kc0 = 16 * n - 8; kc0 = kc0 < 0 ? 0 : (kc0 > 32 ? 32 : kc0);
        const int qc = 16 * n + li; const size_t qtok = (size_t)seq * T + r * 64 + qc;
        bf16x8 bq[4];
#pragma unroll
        for (int ks = 0; ks < 4; ++ks) bq[ks] = __builtin_bit_cast(bf16x8, *(const GAS v4u*)(qkva + qtok * 3072 + h * 128 + ks * 32 + 8 * kg));
        f32x4 s[8][2];
#pragma unroll
        for (int j = 0; j < 8; ++j)
#pragma unroll
            for (int ct = 0; ct < 2; ++ct) { const size_t ktok = (size_t)seq * T + (rs + j) * 64 + kc0 + 16 * ct + li; f32x4 a = (f32x4){0.f, 0.f, 0.f, 0.f};
#pragma unroll
                for (int ks = 0; ks < 4; ++ks) a = MFMA16(__builtin_bit_cast(bf16x8, *(const GAS v4u*)(qkva + ktok * 3072 + 1024 + h * 128 + ks * 32 + 8 * kg)), bq[ks], a);
                s[j][ct] = a; }
        int cs = qc - 8; cs = cs < 0 ? 0 : (cs > 48 ? 48 : cs);
        float mx = -3.0e38f;
#pragma unroll
        for (int j = 0; j < 8; ++j)
#pragma unroll
            for (int ct = 0; ct < 2; ++ct)
#pragma unroll
                for (int e = 0; e < 4; ++e) { const int kc = kc0 + 16 * ct + 4 * kg + e; const bool ok = kc >= cs && kc < cs + 16;
                    const int bi = (h * 15 + (rs + j - r + 7)) * 31 + (ok ? kc - qc + 15 : 15);
                    const float v = ok ? s[j][ct][e] + rpb[bi] : -3.0e38f; s[j][ct][e] = v; mx = fmaxf(mx, v); }
        mx = fmaxf(mx, __shfl_xor(mx, 16)); mx = fmaxf(mx, __shfl_xor(mx, 32));
        float sum = 0.f;
#pragma unroll
        for (int j = 0; j < 8; ++j)
#pragma unroll
            for (int ct = 0; ct < 2; ++ct)
#pragma unroll
                for (int e = 0; e < 4; ++e) { const float pv = s[j][ct][e] > -1.0e38f ? __expf(s[j][ct][e] - mx) : 0.f; s[j][ct][e] = pv; sum += pv; }
        sum += __shfl_xor(sum, 16); sum += __shfl_xor(sum, 32);
        const float inv = 1.0f / sum;
        f32x4 o[8];
#pragma unroll
        for (int dt = 0; dt < 8; ++dt) o[dt] = (f32x4){0.f, 0.f, 0.f, 0.f};
#pragma unroll 1
        for (int j = 0; j < 8; ++j) {
            asm volatile("" ::: "memory");
#pragma unroll
            for (int i = 0; i < 8; ++i) { const int key = 4 * i + kg; const size_t vtok = (size_t)seq * T + (rs + j) * 64 + kc0 + key;
                *(LAS v4u*)(Vt + key * 128 + li * 8) = *(const GAS v4u*)(qkva + vtok * 3072 + 2048 + h * 128 + li * 8); }
            asm volatile("" ::: "memory");
            f32x4 p0, p1;
            p0 = s[0][0]; p1 = s[0][1];
#pragma unroll
            for (int jj = 1; jj < 8; ++jj) if (j == jj) { p0 = s[jj][0]; p1 = s[jj][1]; }
            v4u pk; pk.x = pk2(p0[0], p0[1]); pk.y = pk2(p0[2], p0[3]); pk.z = pk2(p1[0], p1[1]); pk.w = pk2(p1[2], p1[3]);
            const bf16x8 bp = __builtin_bit_cast(bf16x8, pk);
#pragma unroll
            for (int dt = 0; dt < 8; ++dt) { const LAS bf16* a0 = Vt + (4 * kg + qq) * 128 + dt * 16 + 4 * pp;
                o[dt] = MFMA16(tr_pair(a0, a0 + 16 * 128), bp, o[dt]); }
            asm volatile("" ::: "memory");
        }
#pragma unroll
        for (int dt = 0; dt < 8; ++dt) { const f32x4 v = o[dt] * inv;
            *(GAS unsigned long long*)(ya + qtok * 1024 + h * 128 + dt * 16 + 4 * kg) = (unsigned long long)pk2(v[0], v[1]) | ((unsigned long long)pk2(v[2], v[3]) << 32); }
    }
}

constexpr int NA_KS = 136;
__device__ __forceinline__ void na_wg(Frame& F, const bf16* qkva, const float* rpb, bf16* ya, int T, int u0, int ustride) {
    const int rows = T / 64, nrb = rows / 8, lane = F.lane, kg = lane >> 4, li = lane & 15, qq = li >> 2, pp = li & 3, tid = F.tid;
    LAS bf16* KV = (LAS bf16*)F.lds;
    for (int unit = u0; unit < (MS / 512) * 32; unit += ustride) {
        const int h = unit & 7, n = (unit >> 3) & 3, rb = unit >> 5, seq = rb / nrb, r0 = (rb % nrb) * 8, r = r0 + F.wave;
        int rs = r - 4; rs = rs < 0 ? 0 : (rs > rows - 8 ? rows - 8 : rs);
        int rs0 = r0 - 4; rs0 = rs0 < 0 ? 0 : (rs0 > rows - 8 ? rows - 8 : rs0);
        int rsl = r0 + 3; rsl = rsl > rows - 8 ? rows - 8 : rsl;
        const int nkr = rsl + 8 - rs0;
        int kc0 = 16 * n - 8; kc0 = kc0 < 0 ? 0 : (kc0 > 32 ? 32 : kc0);
        const int qc = 16 * n + li; const size_t qtok = (size_t)seq * T + r * 64 + qc;
        const size_t tok0 = (size_t)seq * T + rs0 * 64 + kc0;
        __syncthreads();
        v4u pv[15];
#pragma unroll
        for (int i = 0; i < 15; ++i) { const int idx = tid + 512 * i, key = idx >> 4, ch = idx & 15; pv[i] = (v4u){0u, 0u, 0u, 0u};
            if (i < nkr) { const size_t tok = tok0 + (key >> 5) * 64 + (key & 31);
                *(LAS v4u*)(KV + key * NA_KS + ch * 8) = *(const GAS v4u*)(qkva + tok * 3072 + 1024 + h * 128 + ch * 8);
                pv[i] = *(const GAS v4u*)(qkva + tok * 3072 + 2048 + h * 128 + ch * 8); } }
        bf16x8 bq[4];
#pragma unroll
        for (int ks = 0; ks < 4; ++ks) bq[ks] = __builtin_bit_cast(bf16x8, *(const GAS v4u*)(qkva + qtok * 3072 + h * 128 + ks * 32 + 8 * kg));
        __syncthreads();
        const int lr0 = rs - rs0;
        f32x4 s[8][2];
#pragma unroll
        for (int j = 0; j < 8; ++j)
#pragma unroll
            for (int ct = 0; ct < 2; ++ct) { const LAS bf16* kp = KV + ((lr0 + j) * 32 + ct * 16 + li) * NA_KS + 8 * kg; f32x4 a = (f32x4){0.f, 0.f, 0.f, 0.f};
#pragma unroll
                for (int ks = 0; ks < 4; ++ks) a = MFMA16(__builtin_bit_cast(bf16x8, *(const LAS v4u*)(kp + ks * 32)), bq[ks], a);
                s[j][ct] = a; }
        int cs = qc - 8; cs = cs < 0 ? 0 : (cs > 48 ? 48 : cs);
        float mx = -3.0e38f;
#pragma unroll
        for (int j = 0; j < 8; ++j)
#pragma unroll
            for (int ct = 0; ct < 2; ++ct)
#pragma unroll
                for (int e = 0; e < 4; ++e) { const int kc = kc0 + 16 * ct + 4 * kg + e; const bool ok = kc >= cs && kc < cs + 16;
                    const int bi = (h * 15 + (rs + j - r + 7)) * 31 + (ok ? kc - qc + 15 : 15);
                    const float v = ok ? s[j][ct][e] + rpb[bi] : -3.0e38f; s[j][ct][e] = v; mx = fmaxf(mx, v); }
        mx = fmaxf(mx, __shfl_xor(mx, 16)); mx = fmaxf(mx, __shfl_xor(mx, 32));
        float sum = 0.f;
#pragma unroll
        for (int j = 0; j < 8; ++j)
#pragma unroll
            for (int ct = 0; ct < 2; ++ct)
#pragma unroll
                for (int e = 0; e < 4; ++e) { const float pvv = s[j][ct][e] > -1.0e38f ? __expf(s[j][ct][e] - mx) : 0.f; s[j][ct][e] = pvv; sum += pvv; }
        sum += __shfl_xor(sum, 16); sum += __shfl_xor(sum, 32);
        const float inv = 1.0f / sum;
        __syncthreads();
#pragma unroll
        for (int i = 0; i < 15; ++i) { const int idx = tid + 512 * i, key = idx >> 4, ch = idx & 15; if (i < nkr) *(LAS v4u*)(KV + key * NA_KS + ch * 8) = pv[i]; }
        __syncthreads();
        f32x4 o[8];
#pragma unroll
        for (int dt = 0; dt < 8; ++dt) o[dt] = (f32x4){0.f, 0.f, 0.f, 0.f};
#pragma unroll
        for (int j = 0; j < 8; ++j) {
            v4u pk; pk.x = pk2(s[j][0][0], s[j][0][1]); pk.y = pk2(s[j][0][2], s[j][0][3]); pk.z = pk2(s[j][1][0], s[j][1][1]); pk.w = pk2(s[j][1][2], s[j][1][3]);
            const bf16x8 bp = __builtin_bit_cast(bf16x8, pk);
#pragma unroll
            for (int dt = 0; dt < 8; ++dt) { const LAS bf16* a0 = KV + ((lr0 + j) * 32 + 4 * kg + qq) * NA_KS + dt * 16 + 4 * pp;
                o[dt] = MFMA16(tr_pair(a0, a0 + 16 * NA_KS), bp, o[dt]); }
        }
#pragma unroll
        for (int dt = 0; dt < 8; ++dt) { const f32x4 v = o[dt] * inv;
            *(GAS unsigned long long*)(ya + qtok * 1024 + h * 128 + dt * 16 + 4 * kg) = (unsigned long long)pk2(v[0], v[1]) | ((unsigned long long)pk2(v[2], v[3]) << 32); }
    }
    __syncthreads();
}

constexpr int GS_STRIDE = 65536;
constexpr int ML_QS = 264, ML_VS = 72;
constexpr int ML_OFF_Q = 0, ML_OFF_K = 33792, ML_OFF_CT = 67584, ML_OFF_V = 101376, ML_OFF_WV = 110592, ML_OFF_ST = 119808, ML_OFF_VEC = 129024, ML_OFF_N = 130560, ML_OFF_CM = 131584, ML_LDS_END = 133120;
static_assert(ML_LDS_END <= LDSCTL_OFF, "mLSTM LDS map");

__device__ __forceinline__ void ml_gate_local(Frame& F, const float* gates, float* gs, float* gd, int T, int nchains) {
    const int gw = F.vcu * NWAVES + F.wave, NGW = F.G * NWAVES, lane = F.lane, nc = T / 64;
    for (int it = gw; it < nchains * nc; it += NGW) {
        const int chain = it / nc, ci = it % nc, seq = chain >> 3, h = (chain >> 1) & 3, dir = chain & 1;
        const int pos = ci * 64 + lane; const size_t tok = (size_t)seq * T + (dir ? T - 1 - pos : pos);
        const float ipre = gates[tok * 16 + dir * 8 + h], fpre = gates[tok * 16 + dir * 8 + 4 + h];
        const float logf = fminf(fpre, 0.f) - log1pf(__expf(-fabsf(fpre)));
        float b = logf;
#pragma unroll
        for (int o = 1; o < 64; o <<= 1) { const float y = __shfl_up(b, o); if (lane >= o) b += y; }
        const float a = ipre - b; float pm = a;
#pragma unroll
        for (int o = 1; o < 64; o <<= 1) { const float y = __shfl_up(pm, o); if (lane >= o) pm = fmaxf(pm, y); }
        const size_t o = (size_t)chain * T + pos;
        gs[o] = b; gs[GS_STRIDE + o] = a; gs[2 * GS_STRIDE + o] = pm;
        if (lane == 63) { gd[chain * 128 + ci] = b; gd[2048 + chain * 128 + ci] = b + pm; }
    }
}
__device__ __forceinline__ void ml_chain_m(Frame& F, const float* gd, int chain, int nc, LAS float* cm) {
    if (F.wave == 0) {
        const int lane = F.lane, cpl = nc >> 6;
        float sB0, sD0, sB1 = 0.f, sD1 = -3.0e38f;
        if (cpl == 2) { sB0 = gd[chain * 128 + 2 * lane]; sD0 = gd[2048 + chain * 128 + 2 * lane]; sB1 = gd[chain * 128 + 2 * lane + 1]; sD1 = gd[2048 + chain * 128 + 2 * lane + 1]; }
        else { sB0 = gd[chain * 128 + lane]; sD0 = gd[2048 + chain * 128 + lane]; }
        float B = sB0, Dm = sD0;
        if (cpl == 2) { Dm = fmaxf(sD0 + sB1, sD1); B = sB0 + sB1; }
#pragma unroll
        for (int o = 1; o < 64; o <<= 1) { const float Bp = __shfl_up(B, o), Dp = __shfl_up(Dm, o); if (lane >= o) { Dm = fmaxf(Dp + B, Dm); B = Bp + B; } }
        const float mend = fmaxf(B, Dm);
        float mp0 = __shfl_up(mend, 1); if (lane == 0) mp0 = 0.f;
        const float mn0 = fmaxf(mp0 + sB0, sD0);
        if (cpl == 2) { const float mn1 = fmaxf(mn0 + sB1, sD1);
            cm[2 * lane] = sB0; cm[2 * lane + 1] = sB1; cm[128 + 2 * lane] = mp0; cm[128 + 2 * lane + 1] = mn0; cm[256 + 2 * lane] = mn0; cm[256 + 2 * lane + 1] = mn1; }
        else { cm[lane] = sB0; cm[128 + lane] = mp0; cm[256 + lane] = mn0; }
    }
    __syncthreads();
}

__device__ __forceinline__ void ml_cupdate(f32x4 (&cst)[2][4], const LAS bf16* Ks, const LAS bf16* WV, float decay, int wave, int kg, int qq, int pp) {
#pragma unroll
    for (int dd = 0; dd < 2; ++dd)
#pragma unroll
        for (int et = 0; et < 4; ++et) cst[dd][et] = cst[dd][et] * decay;
#pragma unroll
    for (int ks = 0; ks < 2; ++ks) {
        bf16x8 af[2], bfv[4];
#pragma unroll
        for (int dd = 0; dd < 2; ++dd) { const LAS bf16* p = Ks + (ks * 32 + 8 * kg + qq) * ML_QS + (2 * wave + dd) * 16 + 4 * pp; af[dd] = tr_pair(p, p + 4 * ML_QS); }
#pragma unroll
        for (int et = 0; et < 4; ++et) { const LAS bf16* p = WV + (ks * 32 + 8 * kg + qq) * ML_VS + et * 16 + 4 * pp; bfv[et] = tr_pair(p, p + 4 * ML_VS); }
#pragma unroll
        for (int dd = 0; dd < 2; ++dd)
#pragma unroll
            for (int et = 0; et < 4; ++et) cst[dd][et] = MFMA16(af[dd], bfv[et], cst[dd][et]);
    }
}

__device__ __forceinline__ void ml_phaseA(Frame& F, int unit, const bf16* kc, const bf16* qkvob, const float* gs, const float* gd, float* lst, float* nloc, int T) {
    const int nseg = T / 1024, es = unit & 3, cs_ = unit >> 2, seg = cs_ % nseg, chain = cs_ / nseg, seq = chain >> 3, h = (chain >> 1) & 3, dir = chain & 1;
    if (seg == nseg - 1) return;
    const int tid = F.tid, lane = F.lane, kg = lane >> 4, li = lane & 15, qq = li >> 2, pp = li & 3, wave = F.wave;
    LAS bf16* Ks = (LAS bf16*)(F.lds + ML_OFF_K); LAS bf16* WV = (LAS bf16*)(F.lds + ML_OFF_WV); LAS float* wvec = (LAS float*)(F.lds + ML_OFF_VEC); LAS float* cm = (LAS float*)(F.lds + ML_OFF_CM);
    __syncthreads();
    ml_chain_m(F, gd, chain, T / 64, cm);
    f32x4 cst[2][4];
#pragma unroll
    for (int dd = 0; dd < 2; ++dd)
#pragma unroll
        for (int et = 0; et < 4; ++et) cst[dd][et] = (f32x4){0.f, 0.f, 0.f, 0.f};
    float nacc = 0.f;
    v4u pk[4], pv; float pw, pwv;
#define MLA_LOAD(ci_) do { const int ci__ = (ci_); \
        _Pragma("unroll") for (int i = 0; i < 4; ++i) { const int idx = tid + 512 * i, tau = idx >> 5, c8 = idx & 31; const int pos = ci__ * 64 + tau; const size_t tok = (size_t)seq * T + (dir ? T - 1 - pos : pos); \
            pk[i] = *(const GAS v4u*)(kc + tok * 1024 + h * 256 + c8 * 8); } \
        { const int tau = tid >> 3, c8 = tid & 7; const int pos = ci__ * 64 + tau; const size_t tok = (size_t)seq * T + (dir ? T - 1 - pos : pos); \
            pv = *(const GAS v4u*)(qkvob + tok * 4096 + 2048 + h * 256 + es * 64 + c8 * 8); pw = gs[GS_STRIDE + (size_t)chain * T + pos]; } \
        pwv = gs[GS_STRIDE + (size_t)chain * T + ci__ * 64 + (tid & 63)]; } while (0)
    MLA_LOAD(seg * 16);
    for (int cc = 0; cc < 16; ++cc) {
        const int ci = seg * 16 + cc;
        __syncthreads();
#pragma unroll
        for (int i = 0; i < 4; ++i) { const int idx = tid + 512 * i, tau = idx >> 5, c8 = idx & 31; *(LAS v4u*)(Ks + tau * ML_QS + c8 * 8) = pk[i]; }
        const float cB = cm[ci], cmp = cm[128 + ci], cmn = cm[256 + ci];
        { const int tau = tid >> 3, c8 = tid & 7; const float w = __expf(cB + pw - cmn);
            v4u o; o.x = pk2(bf_lo(pv.x) * w, bf_hi(pv.x) * w); o.y = pk2(bf_lo(pv.y) * w, bf_hi(pv.y) * w); o.z = pk2(bf_lo(pv.z) * w, bf_hi(pv.z) * w); o.w = pk2(bf_lo(pv.w) * w, bf_hi(pv.w) * w);
            *(LAS v4u*)(WV + tau * ML_VS + c8 * 8) = o; }
        if (tid < 64) wvec[tid] = __expf(cB + pwv - cmn);
        const float decay = __expf(cB + cmp - cmn);
        __syncthreads();
        if (cc + 1 < 16) MLA_LOAD(ci + 1);
        ml_cupdate(cst, Ks, WV, decay, wave, kg, qq, pp);
        if (tid < 64) { float a = decay * nacc;
#pragma unroll 8
            for (int s = 0; s < 64; ++s) a += wvec[s] * __uint_as_float(((unsigned)Ks[s * ML_QS + es * 64 + tid]) << 16);
            nacc = a; }
    }
#undef MLA_LOAD
    float* dst = lst + (size_t)unit * 32 * 512 + tid;
#pragma unroll
    for (int dd = 0; dd < 2; ++dd)
#pragma unroll
        for (int et = 0; et < 4; ++et)
#pragma unroll
            for (int r = 0; r < 4; ++r) dst[(dd * 16 + et * 4 + r) * 512] = cst[dd][et][r];
    if (tid < 64) nloc[(size_t)(chain * nseg + seg) * 256 + es * 64 + tid] = nacc;
    __syncthreads();
}

__device__ __forceinline__ void ml_phaseC(Frame& F, int unit, const bf16* qc, const bf16* kc, const bf16* qkvob, const float* gs, const float* gd, const float* lst, const float* nloc, float* hf, float* hb, int T) {
    const int nseg = T / 1024, es = unit & 3, cs_ = unit >> 2, seg = cs_ % nseg, chain = cs_ / nseg, seq = chain >> 3, h = (chain >> 1) & 3, dir = chain & 1;
    const int tid = F.tid, lane = F.lane, kg = lane >> 4, li = lane & 15, qq = li >> 2, pp = li & 3, wave = F.wave;
    LAS bf16* Qs = (LAS bf16*)(F.lds + ML_OFF_Q); LAS bf16* Ks = (LAS bf16*)(F.lds + ML_OFF_K); LAS bf16* CT = (LAS bf16*)(F.lds + ML_OFF_CT);
    LAS bf16* Vs = (LAS bf16*)(F.lds + ML_OFF_V); LAS bf16* WV = (LAS bf16*)(F.lds + ML_OFF_WV); LAS bf16* ST = (LAS bf16*)(F.lds + ML_OFF_ST);
    LAS float* vec = (LAS float*)(F.lds + ML_OFF_VEC);
    LAS float* nst = (LAS float*)(F.lds + ML_OFF_N);
    LAS float* cm = (LAS float*)(F.lds + ML_OFF_CM);
    float* hout = dir ? hb : hf;
    __syncthreads();
    ml_chain_m(F, gd, chain, T / 64, cm);
    f32x4 cst[2][4];
#pragma unroll
    for (int dd = 0; dd < 2; ++dd)
#pragma unroll
        for (int et = 0; et < 4; ++et) cst[dd][et] = (f32x4){0.f, 0.f, 0.f, 0.f};
    float nreg = 0.f;
    for (int i = 0; i < seg; ++i) {
        float sb = 0.f;
        for (int c = 0; c < 16; ++c) sb += cm[i * 16 + c];
        const float P = __expf(sb + cm[128 + i * 16] - cm[256 + i * 16 + 15]);
        const float* src = lst + (size_t)(((chain * nseg + i) << 2) + es) * 32 * 512 + tid;
#pragma unroll
        for (int dd = 0; dd < 2; ++dd)
#pragma unroll
            for (int et = 0; et < 4; ++et)
#pragma unroll
                for (int r = 0; r < 4; ++r) cst[dd][et][r] = P * cst[dd][et][r] + src[(dd * 16 + et * 4 + r) * 512];
        if (tid < 256) nreg = P * nreg + nloc[(size_t)(chain * nseg + i) * 256 + tid];
    }
    if (tid < 256) nst[tid] = nreg;
#pragma unroll
    for (int dd = 0; dd < 2; ++dd)
#pragma unroll
        for (int et = 0; et < 4; ++et) { const int e = et * 16 + li, d = (2 * wave + dd) * 16 + 4 * kg;
            *(LAS unsigned long long*)(CT + e * ML_QS + d) = (unsigned long long)pk2(cst[dd][et][0], cst[dd][et][1]) | ((unsigned long long)pk2(cst[dd][et][2], cst[dd][et][3]) << 32); }
    const int tt = wave >> 1, x0 = 2 * (wave & 1);
    v4u pq[4], pk[4], pv; float pw, pgb = 0.f, pga = 0.f, pgm = 0.f;
#define ML_LOAD(ci_) do { const int ci__ = (ci_); \
        _Pragma("unroll") for (int i = 0; i < 4; ++i) { const int idx = tid + 512 * i, tau = idx >> 5, c8 = idx & 31; const int pos = ci__ * 64 + tau; const size_t tok = (size_t)seq * T + (dir ? T - 1 - pos : pos); \
            pq[i] = *(const GAS v4u*)(qc + tok * 1024 + h * 256 + c8 * 8); pk[i] = *(const GAS v4u*)(kc + tok * 1024 + h * 256 + c8 * 8); } \
        { const int tau = tid >> 3, c8 = tid & 7; const int pos = ci__ * 64 + tau; const size_t tok = (size_t)seq * T + (dir ? T - 1 - pos : pos); \
            pv = *(const GAS v4u*)(qkvob + tok * 4096 + 2048 + h * 256 + es * 64 + c8 * 8); pw = gs[GS_STRIDE + (size_t)chain * T + pos]; } \
        if (tid < 64) { const size_t o_ = (size_t)chain * T + ci__ * 64 + tid; pgb = gs[o_]; pga = gs[GS_STRIDE + o_]; pgm = gs[2 * GS_STRIDE + o_]; } } while (0)
    ML_LOAD(seg * 16);
    for (int cc = 0; cc < 16; ++cc) {
        const int ci = seg * 16 + cc;
#pragma unroll
        for (int i = 0; i < 4; ++i) { const int idx = tid + 512 * i, tau = idx >> 5, c8 = idx & 31; *(LAS v4u*)(Qs + tau * ML_QS + c8 * 8) = pq[i]; *(LAS v4u*)(Ks + tau * ML_QS + c8 * 8) = pk[i]; }
        const float cB = cm[ci], cmp = cm[128 + ci], cmn = cm[256 + ci];
        { const int tau = tid >> 3, c8 = tid & 7; *(LAS v4u*)(Vs + tau * ML_VS + c8 * 8) = pv; const float w = __expf(cB + pw - cmn);
            v4u o; o.x = pk2(bf_lo(pv.x) * w, bf_hi(pv.x) * w); o.y = pk2(bf_lo(pv.y) * w, bf_hi(pv.y) * w); o.z = pk2(bf_lo(pv.z) * w, bf_hi(pv.z) * w); o.w = pk2(bf_lo(pv.w) * w, bf_hi(pv.w) * w);
            *(LAS v4u*)(WV + tau * ML_VS + c8 * 8) = o; }
        if (tid < 64) { const float mrow = fmaxf(pgb + cmp, pgb + pgm);
            vec[tid] = pgb; vec[64 + tid] = pga; vec[128 + tid] = mrow; vec[192 + tid] = __expf(cB + pga - cmn); vec[256 + tid] = __expf(pgb + cmp - mrow); vec[320 + tid] = 0.f; }
        const float decay = __expf(cB + cmp - cmn);
        __syncthreads();
        if (cc + 1 < 16) ML_LOAD(ci + 1);
        { const int t = tid >> 3, part = tid & 7; float qn = 0.f;
#pragma unroll
            for (int c8 = 0; c8 < 4; ++c8) { const v4u qv = *(const LAS v4u*)(Qs + t * ML_QS + part * 32 + c8 * 8);
#pragma unroll
                for (int x = 0; x < 4; ++x) qn += bf_lo(qv[x]) * nst[part * 32 + c8 * 8 + 2 * x] + bf_hi(qv[x]) * nst[part * 32 + c8 * 8 + 2 * x + 1]; }
            qn += __shfl_xor(qn, 1); qn += __shfl_xor(qn, 2); qn += __shfl_xor(qn, 4);
            if (part == 0) __hip_atomic_fetch_add(&vec[320 + t], vec[256 + t] * qn, __ATOMIC_RELAXED, __HIP_MEMORY_SCOPE_WORKGROUP); }
        bf16x8 qf[8];
#pragma unroll
        for (int ks = 0; ks < 8; ++ks) qf[ks] = __builtin_bit_cast(bf16x8, *(const LAS v4u*)(Qs + (tt * 16 + li) * ML_QS + ks * 32 + 8 * kg));
        { const int t = tt * 16 + li; const float bt = vec[t], mrt = vec[128 + t]; float rsum = 0.f;
#pragma unroll
            for (int x = 0; x < 2; ++x) { const int st = x0 + x; f32x4 a = (f32x4){0.f, 0.f, 0.f, 0.f};
#pragma unroll
                for (int ks = 0; ks < 8; ++ks) a = MFMA16(__builtin_bit_cast(bf16x8, *(const LAS v4u*)(Ks + (st * 16 + li) * ML_QS + ks * 32 + 8 * kg)), qf[ks], a);
                float v[4];
#pragma unroll
                for (int r = 0; r < 4; ++r) { const int s = st * 16 + 4 * kg + r; v[r] = (s <= t) ? a[r] * __expf(bt + vec[64 + s] - mrt) : 0.f; rsum += v[r]; }
                *(LAS unsigned long long*)(ST + t * ML_VS + st * 16 + 4 * kg) = (unsigned long long)pk2(v[0], v[1]) | ((unsigned long long)pk2(v[2], v[3]) << 32); }
            rsum += __shfl_xor(rsum, 16); rsum += __shfl_xor(rsum, 32);
            if (kg == 0) __hip_atomic_fetch_add(&vec[320 + t], rsum, __ATOMIC_RELAXED, __HIP_MEMORY_SCOPE_WORKGROUP); }
        f32x4 accn[2];
#pragma unroll
        for (int x = 0; x < 2; ++x) { const int et = x0 + x; f32x4 a = (f32x4){0.f, 0.f, 0.f, 0.f};
#pragma unroll
            for (int ks = 0; ks < 8; ++ks) a = MFMA16(qf[ks], __builtin_bit_cast(bf16x8, *(const LAS v4u*)(CT + (et * 16 + li) * ML_QS + ks * 32 + 8 * kg)), a);
#pragma unroll
            for (int r = 0; r < 4; ++r) a[r] *= vec[256 + tt * 16 + 4 * kg + r];
            accn[x] = a; }
        __syncthreads();
#pragma unroll
        for (int ks = 0; ks < 2; ++ks) { const bf16x8 sa = __builtin_bit_cast(bf16x8, *(const LAS v4u*)(ST + (tt * 16 + li) * ML_VS + ks * 32 + 8 * kg));
#pragma unroll
            for (int x = 0; x < 2; ++x) { const LAS bf16* p = Vs + (ks * 32 + 8 * kg + qq) * ML_VS + (x0 + x) * 16 + 4 * pp; accn[x] = MFMA16(sa, tr_pair(p, p + 4 * ML_VS), accn[x]); } }
#pragma unroll
        for (int r = 0; r < 4; ++r) { const int t = tt * 16 + 4 * kg + r; const float den = fmaxf(fabsf(vec[320 + t]), __expf(-vec[128 + t])); const float inv = 1.0f / den;
            const int pos = ci * 64 + t; const size_t tok = (size_t)seq * T + (dir ? T - 1 - pos : pos);
#pragma unroll
            for (int x = 0; x < 2; ++x) hout[tok * 1024 + h * 256 + es * 64 + (x0 + x) * 16 + li] = accn[x][r] * inv; }
        ml_cupdate(cst, Ks, WV, decay, wave, kg, qq, pp);
#pragma unroll
        for (int dd = 0; dd < 2; ++dd)
#pragma unroll
            for (int et = 0; et < 4; ++et) { const int e = et * 16 + li, d = (2 * wave + dd) * 16 + 4 * kg;
                *(LAS unsigned long long*)(CT + e * ML_QS + d) = (unsigned long long)pk2(cst[dd][et][0], cst[dd][et][1]) | ((unsigned long long)pk2(cst[dd][et][2], cst[dd][et][3]) << 32); }
        if (tid < 256) { float a = decay * nst[tid];
#pragma unroll 8
            for (int s = 0; s < 64; ++s) a += vec[192 + s] * __uint_as_float(((unsigned)Ks[s * ML_QS + tid]) << 16);
            nst[tid] = a; }
        __syncthreads();
    }
#undef ML_LOAD
}

constexpr int ML2_WS = 88;
constexpr int ML2_OFF_Q = 0, ML2_OFF_K = 33792, ML2_OFF_CT = 67584, ML2_OFF_V = 109824, ML2_OFF_WV = 119040, ML2_OFF_ST = 130304, ML2_OFF_VEC = 139520, ML2_OFF_CM = 140288, ML2_LDS_END = 141824;
static_assert(ML2_LDS_END <= LDSCTL_OFF, "mLSTM v2 LDS map");
constexpr int ML2_NREG = 40;

__device__ __forceinline__ void ml2_cupdate(f32x4 (&cst)[2][5], const LAS bf16* Ks, const LAS bf16* WV, float decay, int wave, int kg, int qq, int pp) {
#pragma unroll
    for (int dd = 0; dd < 2; ++dd)
#pragma unroll
        for (int et = 0; et < 5; ++et) cst[dd][et] = cst[dd][et] * decay;
#pragma unroll
    for (int ks = 0; ks < 2; ++ks) {
        bf16x8 af[2], bfv[5];
#pragma unroll
        for (int dd = 0; dd < 2; ++dd) { const LAS bf16* p = Ks + (ks * 32 + 8 * kg + qq) * ML_QS + (2 * wave + dd) * 16 + 4 * pp; af[dd] = tr_pair(p, p + 4 * ML_QS); }
#pragma unroll
        for (int et = 0; et < 5; ++et) { const LAS bf16* p = WV + (ks * 32 + 8 * kg + qq) * ML2_WS + et * 16 + 4 * pp; bfv[et] = tr_pair(p, p + 4 * ML2_WS); }
#pragma unroll
        for (int dd = 0; dd < 2; ++dd)
#pragma unroll
            for (int et = 0; et < 5; ++et) cst[dd][et] = MFMA16(af[dd], bfv[et], cst[dd][et]);
    }
}
__device__ __forceinline__ void ml2_stage_wv(LAS bf16* WV, int tau, int c8, const v4u& pv, float w) {
    v4u o; o.x = pk2(bf_lo(pv.x) * w, bf_hi(pv.x) * w); o.y = pk2(bf_lo(pv.y) * w, bf_hi(pv.y) * w); o.z = pk2(bf_lo(pv.z) * w, bf_hi(pv.z) * w); o.w = pk2(bf_lo(pv.w) * w, bf_hi(pv.w) * w);
    *(LAS v4u*)(WV + tau * ML2_WS + c8 * 8) = o;
    if (c8 == 0) { v4u e; e.x = pk2(w, 0.f); e.y = 0u; e.z = 0u; e.w = 0u; *(LAS v4u*)(WV + tau * ML2_WS + 64) = e; *(LAS v4u*)(WV + tau * ML2_WS + 72) = (v4u){0u, 0u, 0u, 0u}; }
}

__device__ __forceinline__ void ml2_phaseS(Frame& F, const bf16* qc, const bf16* kc, float* gs, const float* gd, bf16* stg, int T, int u0, int ustride) {
    const int nc = T / 64, gpc = nc / 4, tid = F.tid, lane = F.lane, kg = lane >> 4, li = lane & 15, wave = F.wave;
    LAS bf16* Qs = (LAS bf16*)(F.lds + ML2_OFF_Q); LAS bf16* Ks = (LAS bf16*)(F.lds + ML2_OFF_K);
    LAS float* vec = (LAS float*)(F.lds + ML2_OFF_VEC);
    LAS float* nqs = (LAS float*)(F.lds + ML2_OFF_ST);
    LAS float* cm = (LAS float*)(F.lds + ML2_OFF_CM);
    const int tt = wave >> 1, x0 = 2 * (wave & 1);
    for (int grp = u0; grp < 256; grp += ustride) {
        const int chain = grp / gpc, c0 = (grp % gpc) * 4, seq = chain >> 3, h = (chain >> 1) & 3, dir = chain & 1;
        __syncthreads();
        ml_chain_m(F, gd, chain, nc, cm);
        v4u pq[4], pk[4]; float pgb = 0.f, pga = 0.f, pgm = 0.f;
#define MLS_LOAD(ci_) do { const int ci__ = (ci_); \
        _Pragma("unroll") for (int i = 0; i < 4; ++i) { const int idx = tid + 512 * i, tau = idx >> 5, c8 = idx & 31; const int pos = ci__ * 64 + tau; const size_t tok = (size_t)seq * T + (dir ? T - 1 - pos : pos); \
            pq[i] = *(const GAS v4u*)(qc + tok * 1024 + h * 256 + c8 * 8); pk[i] = *(const GAS v4u*)(kc + tok * 1024 + h * 256 + c8 * 8); } \
        if (tid < 64) { const size_t o_ = (size_t)chain * T + ci__ * 64 + tid; pgb = gs[o_]; pga = gs[GS_STRIDE + o_]; pgm = gs[2 * GS_STRIDE + o_]; } } while (0)
        MLS_LOAD(c0);
        for (int cc = 0; cc < 4; ++cc) {
            const int ci = c0 + cc; const float cmp = cm[128 + ci];
#pragma unroll
            for (int i = 0; i < 4; ++i) { const int idx = tid + 512 * i, tau = idx >> 5, c8 = idx & 31; *(LAS v4u*)(Qs + tau * ML_QS + c8 * 8) = pq[i]; *(LAS v4u*)(Ks + tau * ML_QS + c8 * 8) = pk[i]; }
            float my_b = 0.f, my_mr = 0.f;
            if (tid < 64) { my_b = pgb; my_mr = fmaxf(pgb + cmp, pgb + pgm); vec[tid] = pgb; vec[64 + tid] = pga; vec[128 + tid] = my_mr; nqs[tid] = 0.f; }
            __syncthreads();
            if (cc + 1 < 4) MLS_LOAD(ci + 1);
            { const int t = tt * 16 + li; const float bt = vec[t], mrt = vec[128 + t]; float rsum = 0.f;
                bf16* dst = stg + ((size_t)chain * nc + ci) * 4096 + t * 64;
#pragma unroll
                for (int x = 0; x < 2; ++x) { const int st = x0 + x; f32x4 a = (f32x4){0.f, 0.f, 0.f, 0.f};
#pragma unroll
                    for (int ks = 0; ks < 8; ++ks) a = MFMA16(__builtin_bit_cast(bf16x8, *(const LAS v4u*)(Ks + (st * 16 + li) * ML_QS + ks * 32 + 8 * kg)),
                                                             __builtin_bit_cast(bf16x8, *(const LAS v4u*)(Qs + (tt * 16 + li) * ML_QS + ks * 32 + 8 * kg)), a);
                    float v[4];
#pragma unroll
                    for (int r = 0; r < 4; ++r) { const int s = st * 16 + 4 * kg + r; v[r] = (s <= t) ? a[r] * __expf(bt + vec[64 + s] - mrt) : 0.f; rsum += v[r]; }
                    *(GAS unsigned long long*)(dst + st * 16 + 4 * kg) = (unsigned long long)pk2(v[0], v[1]) | ((unsigned long long)pk2(v[2], v[3]) << 32); }
                rsum += __shfl_xor(rsum, 16); rsum += __shfl_xor(rsum, 32);
                if (kg == 0) __hip_atomic_fetch_add(&nqs[t], rsum, __ATOMIC_RELAXED, __HIP_MEMORY_SCOPE_WORKGROUP); }
            __syncthreads();
            if (tid < 64) { const size_t o = (size_t)chain * T + ci * 64 + tid;
                gs[3 * GS_STRIDE + o] = __expf(my_b + cmp - my_mr); gs[4 * GS_STRIDE + o] = nqs[tid]; gs[5 * GS_STRIDE + o] = __expf(-my_mr); }
            __syncthreads();
        }
#undef MLS_LOAD
    }
}

__device__ __forceinline__ void ml2_phaseA(Frame& F, int unit, const bf16* kc, const bf16* qkvob, const float* gs, const float* gd, float* lst, int T) {
    const int nseg = T / 1024, es = unit & 3, cs_ = unit >> 2, seg = cs_ % nseg, chain = cs_ / nseg, seq = chain >> 3, h = (chain >> 1) & 3, dir = chain & 1;
    if (seg == nseg - 1) return;
    const int tid = F.tid, lane = F.lane, kg = lane >> 4, li = lane & 15, qq = li >> 2, pp = li & 3, wave = F.wave;
    LAS bf16* Ks = (LAS bf16*)(F.lds + ML2_OFF_K); LAS bf16* WV = (LAS bf16*)(F.lds + ML2_OFF_WV); LAS float* cm = (LAS float*)(F.lds + ML2_OFF_CM);
    __syncthreads();
    ml_chain_m(F, gd, chain, T / 64, cm);
    f32x4 cst[2][5];
#pragma unroll
    for (int dd = 0; dd < 2; ++dd)
#pragma unroll
        for (int et = 0; et < 5; ++et) cst[dd][et] = (f32x4){0.f, 0.f, 0.f, 0.f};
    v4u pk[4], pv; float pw;
#define MLA_LOAD(ci_) do { const int ci__ = (ci_); \
        _Pragma("unroll") for (int i = 0; i < 4; ++i) { const int idx = tid + 512 * i, tau = idx >> 5, c8 = idx & 31; const int pos = ci__ * 64 + tau; const size_t tok = (size_t)seq * T + (dir ? T - 1 - pos : pos); \
            pk[i] = *(const GAS v4u*)(kc + tok * 1024 + h * 256 + c8 * 8); } \
        { const int tau = tid >> 3, c8 = tid & 7; const int pos = ci__ * 64 + tau; const size_t tok = (size_t)seq * T + (dir ? T - 1 - pos : pos); \
            pv = *(const GAS v4u*)(qkvob + tok * 4096 + 2048 + h * 256 + es * 64 + c8 * 8); pw = gs[GS_STRIDE + (size_t)chain * T + pos]; } } while (0)
    MLA_LOAD(seg * 16);
    for (int cc = 0; cc < 16; ++cc) {
        const int ci = seg * 16 + cc;
        __syncthreads();
#pragma unroll
        for (int i = 0; i < 4; ++i) { const int idx = tid + 512 * i, tau = idx >> 5, c8 = idx & 31; *(LAS v4u*)(Ks + tau * ML_QS + c8 * 8) = pk[i]; }
        const float cB = cm[ci], cmp = cm[128 + ci], cmn = cm[256 + ci];
        ml2_stage_wv(WV, tid >> 3, tid & 7, pv, __expf(cB + pw - cmn));
        const float decay = __expf(cB + cmp - cmn);
        __syncthreads();
        if (cc + 1 < 16) MLA_LOAD(ci + 1);
        ml2_cupdate(cst, Ks, WV, decay, wave, kg, qq, pp);
    }
#undef MLA_LOAD
    float* dst = lst + (size_t)unit * ML2_NREG * 512 + tid;
#pragma unroll
    for (int dd = 0; dd < 2; ++dd)
#pragma unroll
        for (int et = 0; et < 5; ++et)
#pragma unroll
            for (int r = 0; r < 4; ++r) dst[(dd * 20 + et * 4 + r) * 512] = cst[dd][et][r];
    __syncthreads();
}

__device__ __forceinline__ void ml2_write_ct(LAS bf16* CT, const f32x4 (&cst)[2][5], int wave, int kg, int li) {
#pragma unroll
    for (int dd = 0; dd < 2; ++dd) { const int d = (2 * wave + dd) * 16 + 4 * kg;
#pragma unroll
        for (int et = 0; et < 4; ++et) *(LAS unsigned long long*)(CT + (et * 16 + li) * ML_QS + d) = (unsigned long long)pk2(cst[dd][et][0], cst[dd][et][1]) | ((unsigned long long)pk2(cst[dd][et][2], cst[dd][et][3]) << 32);
        if (li == 0) *(LAS unsigned long long*)(CT + 64 * ML_QS + d) = (unsigned long long)pk2(cst[dd][4][0], cst[dd][4][1]) | ((unsigned long long)pk2(cst[dd][4][2], cst[dd][4][3]) << 32); }
}

__device__ __forceinline__ void ml2_phaseC(Frame& F, int unit, const bf16* qc, const bf16* kc, const bf16* qkvob, const float* gs, const float* gd, const float* lst, const bf16* stg, float* hf, float* hb, int T) {
    const int nseg = T / 1024, nc = T / 64, es = unit & 3, cs_ = unit >> 2, seg = cs_ % nseg, chain = cs_ / nseg, seq = chain >> 3, h = (chain >> 1) & 3, dir = chain & 1;
    const int tid = F.tid, lane = F.lane, kg = lane >> 4, li = lane & 15, qq = li >> 2, pp = li & 3, wave = F.wave;
    LAS bf16* Qs = (LAS bf16*)(F.lds + ML2_OFF_Q); LAS bf16* Ks = (LAS bf16*)(F.lds + ML2_OFF_K); LAS bf16* CT = (LAS bf16*)(F.lds + ML2_OFF_CT);
    LAS bf16* Vs = (LAS bf16*)(F.lds + ML2_OFF_V); LAS bf16* WV = (LAS bf16*)(F.lds + ML2_OFF_WV); LAS bf16* ST = (LAS bf16*)(F.lds + ML2_OFF_ST);
    LAS float* vec = (LAS float*)(F.lds + ML2_OFF_VEC);
    LAS float* cm = (LAS float*)(F.lds + ML2_OFF_CM);
    float* hout = dir ? hb : hf;
    __syncthreads();
    ml_chain_m(F, gd, chain, nc, cm);
    f32x4 cst[2][5];
#pragma unroll
    for (int dd = 0; dd < 2; ++dd)
#pragma unroll
        for (int et = 0; et < 5; ++et) cst[dd][et] = (f32x4){0.f, 0.f, 0.f, 0.f};
    for (int i = 0; i < seg; ++i) {
        float sb = 0.f;
        for (int c = 0; c < 16; ++c) sb += cm[i * 16 + c];
        const float P = __expf(sb + cm[128 + i * 16] - cm[256 + i * 16 + 15]);
        const float* src = lst + (size_t)(((chain * nseg + i) << 2) + es) * ML2_NREG * 512 + tid;
#pragma unroll
        for (int dd = 0; dd < 2; ++dd)
#pragma unroll
            for (int et = 0; et < 5; ++et)
#pragma unroll
                for (int r = 0; r < 4; ++r) cst[dd][et][r] = P * cst[dd][et][r] + src[(dd * 20 + et * 4 + r) * 512];
    }
    for (int i = tid; i < 15 * ML_QS / 2; i += 512) ((LAS unsigned*)(CT + 65 * ML_QS))[i] = 0u;
    const int tt = wave >> 1, x0 = 2 * (wave & 1);
    v4u pq[4], pk[4], pv, pst; float pw, pg0 = 0.f, pg1 = 0.f, pg2 = 0.f;
#define MLC_LOAD(ci_) do { const int ci__ = (ci_); \
        _Pragma("unroll") for (int i = 0; i < 4; ++i) { const int idx = tid + 512 * i, tau = idx >> 5, c8 = idx & 31; const int pos = ci__ * 64 + tau; const size_t tok = (size_t)seq * T + (dir ? T - 1 - pos : pos); \
            pq[i] = *(const GAS v4u*)(qc + tok * 1024 + h * 256 + c8 * 8); pk[i] = *(const GAS v4u*)(kc + tok * 1024 + h * 256 + c8 * 8); } \
        { const int tau = tid >> 3, c8 = tid & 7; const int pos = ci__ * 64 + tau; const size_t tok = (size_t)seq * T + (dir ? T - 1 - pos : pos); \
            pv = *(const GAS v4u*)(qkvob + tok * 4096 + 2048 + h * 256 + es * 64 + c8 * 8); pw = gs[GS_STRIDE + (size_t)chain * T + pos]; \
            pst = *(const GAS v4u*)(stg + ((size_t)chain * nc + ci__) * 4096 + tau * 64 + c8 * 8); } \
        if (tid < 64) { const size_t o_ = (size_t)chain * T + ci__ * 64 + tid; pg0 = gs[3 * GS_STRIDE + o_]; pg1 = gs[4 * GS_STRIDE + o_]; pg2 = gs[5 * GS_STRIDE + o_]; } } while (0)
    MLC_LOAD(seg * 16);
    for (int cc = 0; cc < 16; ++cc) {
        const int ci = seg * 16 + cc;
        ml2_write_ct(CT, cst, wave, kg, li);
#pragma unroll
        for (int i = 0; i < 4; ++i) { const int idx = tid + 512 * i, tau = idx >> 5, c8 = idx & 31; *(LAS v4u*)(Qs + tau * ML_QS + c8 * 8) = pq[i]; *(LAS v4u*)(Ks + tau * ML_QS + c8 * 8) = pk[i]; }
        const float cB = cm[ci], cmp = cm[128 + ci], cmn = cm[256 + ci];
        { const int tau = tid >> 3, c8 = tid & 7; *(LAS v4u*)(Vs + tau * ML_VS + c8 * 8) = pv; *(LAS v4u*)(ST + tau * ML_VS + c8 * 8) = pst;
            ml2_stage_wv(WV, tau, c8, pv, __expf(cB + pw - cmn)); }
        if (tid < 64) { vec[tid] = pg0; vec[64 + tid] = pg1; vec[128 + tid] = pg2; }
        const float decay = __expf(cB + cmp - cmn);
        __syncthreads();
        if (cc + 1 < 16) MLC_LOAD(ci + 1);
        f32x4 accn[3];
        { bf16x8 qf[8];
#pragma unroll
            for (int ks = 0; ks < 8; ++ks) qf[ks] = __builtin_bit_cast(bf16x8, *(const LAS v4u*)(Qs + (tt * 16 + li) * ML_QS + ks * 32 + 8 * kg));
#pragma unroll
            for (int x = 0; x < 3; ++x) { const int et = x < 2 ? x0 + x : 4; f32x4 a = (f32x4){0.f, 0.f, 0.f, 0.f};
#pragma unroll
                for (int ks = 0; ks < 8; ++ks) a = MFMA16(qf[ks], __builtin_bit_cast(bf16x8, *(const LAS v4u*)(CT + (et * 16 + li) * ML_QS + ks * 32 + 8 * kg)), a);
                accn[x] = a; } }
        float wi[4], inv[4];
#pragma unroll
        for (int r = 0; r < 4; ++r) { const int t = tt * 16 + 4 * kg + r; wi[r] = vec[t]; const float qn = __shfl(accn[2][r], lane & 48);
            const float nq = vec[64 + t] + wi[r] * qn; inv[r] = 1.0f / fmaxf(fabsf(nq), vec[128 + t]); }
#pragma unroll
        for (int x = 0; x < 2; ++x)
#pragma unroll
            for (int r = 0; r < 4; ++r) accn[x][r] *= wi[r];
#pragma unroll
        for (int ks = 0; ks < 2; ++ks) { const bf16x8 sa = __builtin_bit_cast(bf16x8, *(const LAS v4u*)(ST + (tt * 16 + li) * ML_VS + ks * 32 + 8 * kg));
#pragma unroll
            for (int x = 0; x < 2; ++x) { const LAS bf16* p = Vs + (ks * 32 + 8 * kg + qq) * ML_VS + (x0 + x) * 16 + 4 * pp; accn[x] = MFMA16(sa, tr_pair(p, p + 4 * ML_VS), accn[x]); } }
#pragma unroll
        for (int r = 0; r < 4; ++r) { const int t = tt * 16 + 4 * kg + r; const int pos = ci * 64 + t; const size_t tok = (size_t)seq * T + (dir ? T - 1 - pos : pos);
#pragma unroll
            for (int x = 0; x < 2; ++x) hout[tok * 1024 + h * 256 + es * 64 + (x0 + x) * 16 + li] = accn[x][r] * inv[r]; }
        ml2_cupdate(cst, Ks, WV, decay, wave, kg, qq, pp);
        __syncthreads();
    }
#undef MLC_LOAD
}

#ifndef KNOB_NO_ROW
#define KNOB_NO_ROW 0
#endif
#ifndef KNOB_NO_WIN
#define KNOB_NO_WIN 0
#endif
#ifndef KNOB_NO_PREP
#define KNOB_NO_PREP 0
#endif
#ifndef KNOB_NO_ML
#define KNOB_NO_ML 0
#endif
#ifndef KNOB_NO_NA
#define KNOB_NO_NA 0
#endif
#ifndef KNOB_NO_SG
#define KNOB_NO_SG 0
#endif
#ifndef KNOB_NO_COMB
#define KNOB_NO_COMB 0
#endif
#ifndef KNOB_NO_MERGE
#define KNOB_NO_MERGE 0
#endif
#ifndef KNOB_NO_WOUT
#define KNOB_NO_WOUT 0
#endif
#ifndef KNOB_NO_UP
#define KNOB_NO_UP 0
#endif
#ifndef KNOB_NO_DOWN
#define KNOB_NO_DOWN 0
#endif
#ifndef KNOB_NO_P0
#define KNOB_NO_P0 0
#endif
#ifndef USE_ML_V2
#define USE_ML_V2 1
#endif
#ifndef USE_NA_WG
#define USE_NA_WG 1
#endif
#ifndef USE_NA_FAST
#define USE_NA_FAST 1
#endif
#ifndef USE_SG_FAST
#define USE_SG_FAST 1
#endif
#ifndef REP_P0
#define REP_P0 1
#endif
#ifndef REP_ROW
#define REP_ROW 1
#endif
#ifndef REP_PA
#define REP_PA 1
#endif
#ifndef REP_NA
#define REP_NA 1
#endif
#ifndef REP_SG
#define REP_SG 1
#endif
#ifndef REP_WIN
#define REP_WIN 1
#endif
#ifndef REP_MERGE
#define REP_MERGE 1
#endif
#ifndef REP_WOUT
#define REP_WOUT 1
#endif
#ifndef REP_UP
#define REP_UP 1
#endif
#ifndef REP_DOWN
#define REP_DOWN 1
#endif
#ifndef REP_MIX1
#define REP_MIX1 1
#endif
#ifndef REP_MIX2
#define REP_MIX2 1
#endif
#ifndef REP_PREP
#define REP_PREP 1
#endif
#ifndef REP_COMB
#define REP_COMB 1
#endif
#ifndef REP_BAR
#define REP_BAR 1
#endif
#ifndef USE_ML_FAST
#define USE_ML_FAST 1
#endif
constexpr int STEPS_PER = 12, N_STEPS = 1 + NSLAB * DEPTH * STEPS_PER;
__global__ void __launch_bounds__(NWAVES * 64, 2) trunk_fwd(Args args) {
    extern __shared__ __attribute__((aligned(16))) unsigned char lds[];
#define MKF() Frame F; { int t_ = threadIdx.x; asm volatile("" : "+v"(t_)); F.lds = (LAS unsigned char*)lds; F.tid = t_; F.lane = t_ & 63; F.wave = __builtin_amdgcn_readfirstlane(t_ >> 6); \
        F.G = gridDim.x; const int bx_ = blockIdx.x; F.vcu = (F.G % 8 == 0) ? (bx_ % 8) * (F.G / 8) + bx_ / 8 : bx_; }
#define ARGS() ({ const __attribute__((address_space(4))) Args* _p = (const __attribute__((address_space(4))) Args*)__builtin_amdgcn_kernarg_segment_ptr(); asm volatile("" : "+s"(_p)); _p; })
    gu32* ctl = (gu32*)(ARGS()->ws + WS_CTL);
    for (int u = threadIdx.x; u < (LDS_BYTES - LDSCTL_OFF) / 4; u += NWAVES * 64) ((LAS unsigned*)((LAS unsigned char*)lds + LDSCTL_OFF))[u] = 0u;
    __syncthreads();
    volatile LAS unsigned* MISC = (volatile LAS unsigned*)((LAS unsigned char*)lds + MISC_OFF);
    XcdBarrier bar = xcd_barrier_post((unsigned*)ctl + CW_BAR, MISC + 8);
    const int lo = ARGS()->ph_lo, hi = ARGS()->ph_hi;
#define IN(k) (lo <= (k) && (k) < hi)
#define SEAM(k) do { if (IN(k) && IN((k) + 1)) { _Pragma("unroll") for (int rb_ = 0; rb_ < REP_BAR; ++rb_) xcd_barrier(bar); } } while (0)

#define WSB(T_, off) ((T_*)(A->ws + (off)))
#define Hb WSB(bf16, WS_H)
#define QKVA WSB(bf16, WS_QKVA)
#define QKVOB WSB(bf16, WS_QKVOB)
#define ZUV WSB(bf16, WS_ZUV)
#define Ub WSB(bf16, WS_U)
#define Gb WSB(bf16, WS_G)
#define GATES WSB(float, WS_GATES)
#define SGR WSB(float, WS_SGR)
#define QC WSB(bf16, WS_QC)
#define KC WSB(bf16, WS_KC)
#define Yb WSB(bf16, WS_Y)
#define HF WSB(float, WS_HF)
#define HB WSB(float, WS_HB)
#define MRG WSB(float, WS_MRG)
#define MRGB WSB(bf16, WS_MRGB)
#define Tb WSB(float, WS_T)
#define GSb WSB(float, WS_GS)
#define GDb WSB(float, WS_GD)
#define LSTb WSB(float, WS_LST)
#define NLOCb WSB(float, WS_NLOC)
#define LST2b WSB(float, WS_LST2)
#define STGb WSB(bf16, WS_STG)

    if (IN(0) && !KNOB_NO_P0) { MKF();
        LAS float* scr = (LAS float*)(F.lds + RING_OFF + F.wave * 16384);
        _Pragma("unroll") for (int rep_ = 0; rep_ < REP_P0; ++rep_) for (int l = 0; l < DEPTH; ++l) {
            const auto* A = ARGS(); unsigned char* wl = A->ws + WS_W + (size_t)l * WL_BYTES;
            p0_win(F, A->w_in + (size_t)l * D * D_IN, (bf16*)(wl + WL_IN), scr);
            p0_matrix(F, A->w_a + (size_t)l * NA_W * D, NA_W, D, (bf16*)(wl + WL_ABC), scr);
            p0_matrix(F, A->w_b + (size_t)l * ML_W * D, ML_W, D, (bf16*)(wl + WL_ABC) + (size_t)D * 1024, scr);
            p0_matrix(F, A->w_c + (size_t)l * SG_W * D, SG_W, D, (bf16*)(wl + WL_ABC) + (size_t)2 * D * 1024, scr);
            p0_matrix(F, A->w_out + (size_t)l * D * D, D, D, (bf16*)(wl + WL_OUT), scr);
            p0_matrix(F, A->w_up + (size_t)l * D * DFF, D, DFF, (bf16*)(wl + WL_UP), scr);
            p0_matrix(F, A->w_down + (size_t)l * DFF * D, DFF, D, (bf16*)(wl + WL_DN), scr);
        }
    }
    SEAM(0);

    for (int s = 0; s < NSLAB; ++s) {
        const int T = s < 4 ? 4096 : 8192, nseq = MS / T;
        for (int l = 0; l < DEPTH; ++l) {
            const int sb = 1 + (s * DEPTH + l) * STEPS_PER;
            if (sb + STEPS_PER <= lo || sb >= hi) continue;
#define XIN0 (s < 4 ? A->x_prompt + (size_t)s * MS * D : A->x_sample + (size_t)(s - 4) * MS * D)
#define XO (A->out + (size_t)s * MS * D)
#define WL (A->ws + WS_W + (size_t)l * WL_BYTES)
            if (IN(sb + 0) && l == 0 && !KNOB_NO_ROW) { MKF(); const auto* A = ARGS(); row_phase(F, XIN0, nullptr, nullptr, nullptr, A->pre_mix_g, Hb); }
            SEAM(sb + 0);
            if (IN(sb + 1) && !KNOB_NO_WIN) { MKF(); const auto* A = ARGS();
                pg8::Gemm g{Hb, (const bf16*)(WL + WL_IN), MS, N_IN_PAD, D, 0, 0}; pg8::StaticOrder S; S.init(MS, N_IN_PAD, (int)gridDim.x, (int)blockIdx.x);
                pg8::EpiIn E{QKVA, QKVOB, ZUV, Gb, GATES, A->b_gate + l * 16};
                _Pragma("unroll") for (int rep_ = 0; rep_ < REP_WIN; ++rep_) pg8::gemm_phase<pg8::EpiIn, pg8::StaticOrder, true, true>((PG8_LAS unsigned char*)lds + RING_OFF, g, S, E);
            }
            SEAM(sb + 1);
            if (IN(sb + 2) && !KNOB_NO_PREP) { MKF(); const auto* A = ARGS(); _Pragma("unroll") for (int rep_ = 0; rep_ < REP_PREP; ++rep_) { prep_phase(F, QKVOB, A->conv_w + (size_t)l * 3 * 2048, QC, KC, ZUV, SGR, T); if (USE_ML_FAST) ml_gate_local(F, GATES, GSb, GDb, T, nseq * 8); } }
            SEAM(sb + 2);
            if (IN(sb + 3)) { MKF(); const auto* A = ARGS();
                if (USE_ML_FAST) {
                  _Pragma("unroll") for (int rep_ = 0; rep_ < REP_MIX1; ++rep_) {
                    _Pragma("unroll") for (int r2_ = 0; r2_ < REP_PA; ++r2_) { if (USE_ML_V2) { for (int unit = F.vcu; unit < 256; unit += F.G) ml2_phaseA(F, unit, KC, QKVOB, GSb, GDb, LST2b, T); ml2_phaseS(F, QC, KC, GSb, GDb, STGb, T, F.vcu, F.G); }
                        else for (int unit = F.vcu; unit < 256; unit += F.G) ml_phaseA(F, unit, KC, QKVOB, GSb, GDb, LSTb, NLOCb, T); }
                    const int gw = F.vcu * NWAVES + F.wave, NGW = F.G * NWAVES;
                    _Pragma("unroll") for (int r2_ = 0; r2_ < REP_NA; ++r2_) { if (USE_NA_WG) na_wg(F, QKVA, A->na_rpb + (size_t)l * 8 * 15 * 31, Yb, T, F.vcu, F.G); else na_fast(F, QKVA, A->na_rpb + (size_t)l * 8 * 15 * 31, Yb, T, gw, NGW); }
                    _Pragma("unroll") for (int r2_ = 0; r2_ < REP_SG; ++r2_) sg_fast(F, ZUV, SGR, A->sg_norm_g + l * 1024, A->w_s + (size_t)l * 8 * 128 * 128, A->b_s + l * 1024, Yb + (size_t)2 * MS * 1024, F.vcu, F.G);
                  }
                } else {
                    const int nml = nseq * 32;
                    if (F.vcu < nml) mlstm_naive(F, F.vcu, QC, KC, QKVOB, GATES, HF, HB, T);
                    else { const int gw = (F.vcu - nml) * NWAVES + F.wave, NGW = (F.G - nml) * NWAVES;
                        na_fast(F, QKVA, A->na_rpb + (size_t)l * 8 * 15 * 31, Yb, T, gw, NGW);
                        sg_fast(F, ZUV, SGR, A->sg_norm_g + l * 1024, A->w_s + (size_t)l * 8 * 128 * 128, A->b_s + l * 1024, Yb + (size_t)2 * MS * 1024, F.vcu - nml, F.G - nml); }
                }
            }
            SEAM(sb + 3);
            if (IN(sb + 4) && USE_ML_FAST) { MKF(); const auto* A = ARGS();
                _Pragma("unroll") for (int rep_ = 0; rep_ < REP_MIX2; ++rep_) { if (USE_ML_V2) { for (int unit = F.vcu; unit < 256; unit += F.G) ml2_phaseC(F, unit, QC, KC, QKVOB, GSb, GDb, LST2b, STGb, HF, HB, T); }
                    else for (int unit = F.vcu; unit < 256; unit += F.G) ml_phaseC(F, unit, QC, KC, QKVOB, GSb, GDb, LSTb, NLOCb, HF, HB, T); }
            }
            SEAM(sb + 4);
            if (IN(sb + 5) && !KNOB_NO_COMB) { MKF(); const auto* A = ARGS(); _Pragma("unroll") for (int rep_ = 0; rep_ < REP_COMB; ++rep_) comb_phase(F, HF, HB, QKVOB, A->ml_norm_g + l * 1024, Yb + (size_t)MS * 1024); }
            SEAM(sb + 5);
            if (IN(sb + 6) && !KNOB_NO_MERGE) { MKF(); const auto* A = ARGS();
                pg8::Gemm g{Yb, (const bf16*)(WL + WL_ABC), MS, D, 1024, (size_t)MS * 1024 * 2, (size_t)D * 1024 * 2}; pg8::ZOrder<3> S; S.init(MS, D, (int)gridDim.x, (int)blockIdx.x);
                pg8::EpiMergeH E{Gb, MRGB};
                _Pragma("unroll") for (int rep_ = 0; rep_ < REP_MERGE; ++rep_) pg8::gemm_phase<pg8::EpiMergeH, pg8::ZOrder<3>, true, true>((PG8_LAS unsigned char*)lds + RING_OFF, g, S, E);
            }
            SEAM(sb + 6);
            if (IN(sb + 7) && !KNOB_NO_WOUT) { MKF(); const auto* A = ARGS();
                pg8::Gemm g{MRGB, (const bf16*)(WL + WL_OUT), MS, D, D, 0, 0}; pg8::StaticOrder S; S.init(MS, D, (int)gridDim.x, (int)blockIdx.x);
                pg8::EpiF32 E{Tb, D};
                _Pragma("unroll") for (int rep_ = 0; rep_ < REP_WOUT; ++rep_) pg8::gemm_phase<pg8::EpiF32, pg8::StaticOrder, true, true>((PG8_LAS unsigned char*)lds + RING_OFF, g, S, E);
            }
            SEAM(sb + 7);
            if (IN(sb + 8) && !KNOB_NO_ROW) { MKF(); const auto* A = ARGS(); _Pragma("unroll") for (int rep_ = 1; rep_ < REP_ROW; ++rep_) row_phase(F, l == 0 ? XIN0 : XO, Tb, A->post_mix_g + l * D, WSB(float, WS_MRG), A->pre_mlp_g + l * D, WSB(bf16, WS_HF)); row_phase(F, l == 0 ? XIN0 : XO, Tb, A->post_mix_g + l * D, XO, A->pre_mlp_g + l * D, Hb); }
            SEAM(sb + 8);
            if (IN(sb + 9) && !KNOB_NO_UP) { MKF(); const auto* A = ARGS();
                pg8::Gemm g{Hb, (const bf16*)(WL + WL_UP), MS, DFF, D, 0, 0}; pg8::StaticOrder S; S.init(MS, DFF, (int)gridDim.x, (int)blockIdx.x);
                pg8::EpiRelu2 E{Ub, DFF};
                _Pragma("unroll") for (int rep_ = 0; rep_ < REP_UP; ++rep_) pg8::gemm_phase<pg8::EpiRelu2, pg8::StaticOrder, true, true>((PG8_LAS unsigned char*)lds + RING_OFF, g, S, E);
            }
            SEAM(sb + 9);
            if (IN(sb + 10) && !KNOB_NO_DOWN) { MKF(); const auto* A = ARGS();
                pg8::Gemm g{Ub, (const bf16*)(WL + WL_DN), MS, D, DFF, 0, 0}; pg8::StaticOrder S; S.init(MS, D, (int)gridDim.x, (int)blockIdx.x);
                pg8::EpiF32 E{Tb, D};
                _Pragma("unroll") for (int rep_ = 0; rep_ < REP_DOWN; ++rep_) pg8::gemm_phase<pg8::EpiF32, pg8::StaticOrder, true, true>((PG8_LAS unsigned char*)lds + RING_OFF, g, S, E);
            }
            SEAM(sb + 10);
            if (IN(sb + 11) && !KNOB_NO_ROW) { MKF(); const auto* A = ARGS(); _Pragma("unroll") for (int rep_ = 1; rep_ < REP_ROW; ++rep_) row_phase(F, XO, Tb, A->post_mlp_g + l * D, WSB(float, WS_MRG), l + 1 < DEPTH ? A->pre_mix_g + (l + 1) * D : nullptr, l + 1 < DEPTH ? WSB(bf16, WS_HF) : nullptr); row_phase(F, XO, Tb, A->post_mlp_g + l * D, XO, l + 1 < DEPTH ? A->pre_mix_g + (l + 1) * D : nullptr, l + 1 < DEPTH ? Hb : nullptr); }
            SEAM(sb + 11);
        }
    }
#undef IN
#undef SEAM
}

#ifndef MK_LAUNCH_PER_STEP
#define MK_LAUNCH_PER_STEP 0
#endif
extern "C" void kernel_launch(void* const* d_in, const int* in_sizes, int n_in, void* d_out, int out_size, void* d_ws, size_t ws_size, hipStream_t stream) {
    static int grid = 0;
    if (grid == 0) {
        if (n_in != 20 || in_sizes[0] != M_PROMPT * D || in_sizes[1] != M_SAMPLE * D || out_size != M_ALL * D || ws_size < WS_END) {
            fprintf(stderr, "kernel_launch: unexpected shapes (n_in %d, in0 %d, in1 %d, out %d, ws %zu); nothing launched\n", n_in, n_in > 0 ? in_sizes[0] : -1, n_in > 1 ? in_sizes[1] : -1, out_size, ws_size); grid = -1; return; }
        int dev = 0, cus = 0;
        if (hipGetDevice(&dev) != hipSuccess || hipDeviceGetAttribute(&cus, hipDeviceAttributeMultiprocessorCount, dev) != hipSuccess) { grid = -1; return; }
        if (hipFuncSetAttribute((const void*)trunk_fwd, hipFuncAttributeMaxDynamicSharedMemorySize, LDS_BYTES) != hipSuccess) { fprintf(stderr, "kernel_launch: hipFuncSetAttribute failed\n"); grid = -1; return; }
        int per_cu = 0;
        if (hipOccupancyMaxActiveBlocksPerMultiprocessor(&per_cu, (const void*)trunk_fwd, NWAVES * 64, LDS_BYTES) != hipSuccess || per_cu < 1)
            fprintf(stderr, "kernel_launch: note: occupancy query reports %d workgroups per CU\n", per_cu);
        (void)hipGetLastError();
        grid = cus;
    }
    if (grid < 0) return;
    if (hipMemsetAsync((char*)d_ws + WS_CTL, 0, CTL_ZERO_BYTES, stream) != hipSuccess) return;
    Args a{};
    a.x_prompt = (const float*)d_in[0]; a.x_sample = (const float*)d_in[1]; a.pre_mix_g = (const float*)d_in[2]; a.post_mix_g = (const float*)d_in[3];
    a.pre_mlp_g = (const float*)d_in[4]; a.post_mlp_g = (const float*)d_in[5]; a.w_in = (const float*)d_in[6]; a.b_gate = (const float*)d_in[7];
    a.conv_w = (const float*)d_in[8]; a.na_rpb = (const float*)d_in[9]; a.ml_norm_g = (const float*)d_in[10]; a.sg_norm_g = (const float*)d_in[11];
    a.w_s = (const float*)d_in[12]; a.b_s = (const float*)d_in[13]; a.w_a = (const float*)d_in[14]; a.w_b = (const float*)d_in[15]; a.w_c = (const float*)d_in[16];
    a.w_out = (const float*)d_in[17]; a.w_up = (const float*)d_in[18]; a.w_down = (const float*)d_in[19];
    a.out = (float*)d_out; a.ws = (unsigned char*)d_ws;
#if MK_LAUNCH_PER_STEP
    for (int k = 0; k < N_STEPS; ++k) { a.ph_lo = k; a.ph_hi = k + 1; hipLaunchKernelGGL(trunk_fwd, dim3(grid), dim3(NWAVES * 64), LDS_BYTES, stream, a); }
#else
    a.ph_lo = 0; a.ph_hi = N_STEPS;
    hipLaunchKernelGGL(trunk_fwd, dim3(grid), dim3(NWAVES * 64), LDS_BYTES, stream, a);
#endif
}
```

```cpp
#include <hip/hip_runtime.h>
#include <cstdio>
#include <cstdint>
namespace pg8 {
#define PG8_LAS __attribute__((address_space(3)))
typedef unsigned short bf16_t;
typedef short bf16x8 __attribute__((ext_vector_type(8)));
typedef float f32x4 __attribute__((ext_vector_type(4)));
typedef unsigned u32x4 __attribute__((ext_vector_type(4)));
typedef unsigned u32x2 __attribute__((ext_vector_type(2)));
constexpr int BM = 256, BK = 64, HALF = 128, HTB = HALF * BK * 2  , STAGE_BYTES = 8 * HTB, NXCD = 8, WGM = 8;

__host__ __device__ __forceinline__ int lds_byte(int r, int c) { const int st = (r >> 4) * 2 + (c >> 5), rr = r & 15, cc = c & 31, ob = rr * 64 + cc * 2; return st * 1024 + (ob ^ (((ob >> 9) & 1) << 5)); }
__host__ __device__ __forceinline__ void stage_rc(int b, int& R, int& C) { const int st = b / 1024, sb = b % 1024, swz = sb ^ (((sb >> 9) & 1) << 5); R = (st >> 1) * 16 + swz / 64; C = (st & 1) * 32 + (swz % 64) / 2; }
__host__ __device__ __forceinline__ int perm32(int rho) { const int n = rho >> 4, i = rho & 15; return 8 * (i >> 2) + 4 * n + (i & 3); }

struct Unit { int pm, pn, z; };
struct Gemm { const bf16_t* A; const bf16_t* Bt; int M, N, K; size_t zA, zB; };

struct StaticOrder {
    int nM, nN, nwg, G, c;
    __host__ __device__ void init(int M, int N, int G_, int c_) { nM = M / BM; nN = N / BM; nwg = nM * nN; G = G_; c = c_; }
    __host__ __device__ bool tile(long L, Unit& u) const {
        if (L >= nwg) return false;
        int wgid = (int)L; { const int q = nwg / NXCD, r = nwg % NXCD, xcd = wgid % NXCD, off = wgid / NXCD; wgid = (xcd < r ? xcd * (q + 1) : r * (q + 1) + (xcd - r) * q) + off; }
        const int nig = WGM * nN, gid = wgid / nig, fm = gid * WGM, gsz = (nM - fm) < WGM ? (nM - fm) : WGM;
        u.pm = fm + ((wgid % nig) % gsz); u.pn = (wgid % nig) / gsz; return true;
    }
    __host__ __device__ bool next(int i, Unit& u) const { u.z = 0; return tile((long)i * G + c, u); }
    __device__ __forceinline__ void a_ready(const Unit&) const {}
    __device__ __forceinline__ void done(const Unit&) const {}
};
template <int NZ> struct ZOrder : StaticOrder {
    __host__ __device__ bool next(int i, Unit& u) const { const int k = i / NZ; u.z = i - k * NZ; return tile((long)k * G + c, u); }
};

__device__ __forceinline__ unsigned cvt_pk_bf16(float lo, float hi) { unsigned r; asm volatile("v_cvt_pk_bf16_f32 %0, %1, %2" : "=v"(r) : "v"(lo), "v"(hi)); return r; }
__device__ __forceinline__ float sigm(float x) { return __builtin_amdgcn_rcpf(1.0f + __builtin_amdgcn_exp2f(-1.4426950408889634f * x)); }
__device__ __forceinline__ float gelu_tanh(float x) { return x * sigm(1.5957691216057308f * x * (1.0f + 0.044715f * x * x)); }
__device__ __forceinline__ float act_apply(int act, float x) { return act == 1 ? sigm(x) : (act == 2 ? gelu_tanh(x) : x); }

struct EpiIn {
    static constexpr bool PERM = true, AFTER_DRAIN = false;
    __device__ static __forceinline__ bool keep(const Unit&) { return false; }
    bf16_t *qkva, *qkvob, *zuv, *g; float* gates; const float* bgate;
    __device__ __forceinline__ void operator()(const f32x4 (&acc)[2][2][4][2], const Unit& u, int wr, int wc, int fr, int fq) const {
        const int pn = u.pn, row0 = u.pm * BM + wr * 64 + fr;
        if (pn == 60) {
            if (wc == 0 && fq < 2) {
#pragma unroll
                for (int ai = 0; ai < 2; ++ai)
#pragma unroll
                    for (int m = 0; m < 4; ++m)
#pragma unroll
                        for (int n = 0; n < 2; ++n) { const int col = 8 * fq + 4 * n; *(f32x4*)(gates + (size_t)(row0 + ai * HALF + m * 16) * 16 + col) = acc[ai][0][m][n] + *(const f32x4*)(bgate + col); }
            }
            return;
        }
        bf16_t* base; int ldc, colt, act;
        if (pn < 12) { base = qkva; ldc = 3072; colt = pn * BM; act = 0; }
        else if (pn < 28) { base = qkvob; ldc = 4096; colt = (pn - 12) * BM; act = pn >= 24 ? 1 : 0; }
        else if (pn < 36) { base = zuv; ldc = 2048; colt = (pn - 28) * BM; act = 2; }
        else { base = g; ldc = 6144; colt = (pn - 36) * BM; act = 1; }
        const int col0 = colt + wc * 32 + 8 * fq;
#pragma unroll
        for (int ai = 0; ai < 2; ++ai)
#pragma unroll
            for (int m = 0; m < 4; ++m) { bf16_t* rowp = base + (size_t)(row0 + ai * HALF + m * 16) * ldc + col0;
#pragma unroll
                for (int bj = 0; bj < 2; ++bj) { f32x4 v0 = acc[ai][bj][m][0], v1 = acc[ai][bj][m][1];
                    if (act != 0) {
#pragma unroll
                        for (int j = 0; j < 4; ++j) { v0[j] = act_apply(act, v0[j]); v1[j] = act_apply(act, v1[j]); } }
                    u32x4 w; w.x = cvt_pk_bf16(v0[0], v0[1]); w.y = cvt_pk_bf16(v0[2], v0[3]); w.z = cvt_pk_bf16(v1[0], v1[1]); w.w = cvt_pk_bf16(v1[2], v1[3]);
                    *(u32x4*)(rowp + bj * HALF) = w; } }
    }
};
struct EpiMerge {
    static constexpr bool PERM = false, AFTER_DRAIN = false;
    __device__ static __forceinline__ bool keep(const Unit&) { return false; }
    const bf16_t* g; float* mrg; bf16_t* mrgb;
    __device__ __forceinline__ void operator()(const f32x4 (&acc)[2][2][4][2], const Unit& u, int wr, int wc, int fr, int fq) const {
        const int z = u.z, row0 = u.pm * BM + wr * 64 + fr, col0 = u.pn * BM + wc * 32 + 4 * fq;
#pragma unroll
        for (int ai = 0; ai < 2; ++ai)
#pragma unroll
            for (int m = 0; m < 4; ++m) { const size_t row = (size_t)(row0 + ai * HALF + m * 16);
#pragma unroll
                for (int bj = 0; bj < 2; ++bj)
#pragma unroll
                    for (int n = 0; n < 2; ++n) { const int col = col0 + bj * HALF + n * 16;
                        const u32x2 gw = *(const u32x2*)(g + row * 6144 + (size_t)z * 2048 + col);
                        f32x4 gv; gv[0] = __uint_as_float(gw.x << 16); gv[1] = __uint_as_float(gw.x & 0xffff0000u); gv[2] = __uint_as_float(gw.y << 16); gv[3] = __uint_as_float(gw.y & 0xffff0000u);
                        f32x4 v = acc[ai][bj][m][n] * gv;
                        if (z > 0) v += *(const f32x4*)(mrg + row * 2048 + col);
                        if (z < 2) *(f32x4*)(mrg + row * 2048 + col) = v;
                        else { u32x2 w; w.x = cvt_pk_bf16(v[0], v[1]); w.y = cvt_pk_bf16(v[2], v[3]); *(u32x2*)(mrgb + row * 2048 + col) = w; } }
                asm volatile("" ::: "memory"); }
    }
};
struct EpiMergeH {
    static constexpr bool PERM = true, AFTER_DRAIN = false;
    const bf16_t* g; bf16_t* mrgb;
    __device__ static __forceinline__ bool keep(const Unit& u) { return u.z < 2; }
    __device__ __forceinline__ void operator()(f32x4 (&acc)[2][2][4][2], const Unit& u, int wr, int wc, int fr, int fq) const {
        const int z = u.z, row0 = u.pm * BM + wr * 64 + fr, col0 = u.pn * BM + wc * 32 + 8 * fq;
#pragma unroll
        for (int ai = 0; ai < 2; ++ai)
#pragma unroll
            for (int m = 0; m < 4; ++m) { const size_t row = (size_t)(row0 + ai * HALF + m * 16);
#pragma unroll
                for (int bj = 0; bj < 2; ++bj) { const int col = col0 + bj * HALF;
                    const u32x4 gz = *(const u32x4*)(g + row * 6144 + (size_t)z * 2048 + col);
                    float f[8];
                    if (z < 2) { const u32x4 gn = *(const u32x4*)(g + row * 6144 + (size_t)(z + 1) * 2048 + col);
#pragma unroll
                        for (int j = 0; j < 4; ++j) { f[2 * j] = __uint_as_float(gz[j] << 16) * __builtin_amdgcn_rcpf(fmaxf(__uint_as_float(gn[j] << 16), 1e-30f));
                            f[2 * j + 1] = __uint_as_float(gz[j] & 0xffff0000u) * __builtin_amdgcn_rcpf(fmaxf(__uint_as_float(gn[j] & 0xffff0000u), 1e-30f)); }
                    } else {
#pragma unroll
                        for (int j = 0; j < 4; ++j) { f[2 * j] = __uint_as_float(gz[j] << 16); f[2 * j + 1] = __uint_as_float(gz[j] & 0xffff0000u); } }
#pragma unroll
                    for (int j = 0; j < 4; ++j) { acc[ai][bj][m][0][j] *= f[j]; acc[ai][bj][m][1][j] *= f[4 + j]; }
                    if (z == 2) { const f32x4 v0 = acc[ai][bj][m][0], v1 = acc[ai][bj][m][1];
                        u32x4 w; w.x = cvt_pk_bf16(v0[0], v0[1]); w.y = cvt_pk_bf16(v0[2], v0[3]); w.z = cvt_pk_bf16(v1[0], v1[1]); w.w = cvt_pk_bf16(v1[2], v1[3]);
                        *(u32x4*)(mrgb + row * 2048 + col) = w; } }
                asm volatile("" ::: "memory"); }
    }
};
struct EpiF32 {
    static constexpr bool PERM = false, AFTER_DRAIN = false;
    __device__ static __forceinline__ bool keep(const Unit&) { return false; }
    float* C; int ldc;
    __device__ __forceinline__ void operator()(const f32x4 (&acc)[2][2][4][2], const Unit& u, int wr, int wc, int fr, int fq) const {
        const int row0 = u.pm * BM + wr * 64 + fr, col0 = u.pn * BM + wc * 32 + 4 * fq;
#pragma unroll
        for (int ai = 0; ai < 2; ++ai)
#pragma unroll
            for (int m = 0; m < 4; ++m) { float* rowp = C + (size_t)(row0 + ai * HALF + m * 16) * ldc + col0;
#pragma unroll
                for (int bj = 0; bj < 2; ++bj)
#pragma unroll
                    for (int n = 0; n < 2; ++n) *(f32x4*)(rowp + bj * HALF + n * 16) = acc[ai][bj][m][n]; }
    }
};
struct EpiRelu2 {
    static constexpr bool PERM = true, AFTER_DRAIN = false;
    __device__ static __forceinline__ bool keep(const Unit&) { return false; }
    bf16_t* O; int ldc;
    __device__ __forceinline__ void operator()(const f32x4 (&acc)[2][2][4][2], const Unit& u, int wr, int wc, int fr, int fq) const {
        const int row0 = u.pm * BM + wr * 64 + fr, col0 = u.pn * BM + wc * 32 + 8 * fq;
#pragma unroll
        for (int ai = 0; ai < 2; ++ai)
#pragma unroll
            for (int m = 0; m < 4; ++m) { bf16_t* rowp = O + (size_t)(row0 + ai * HALF + m * 16) * ldc + col0;
#pragma unroll
                for (int bj = 0; bj < 2; ++bj) { f32x4 v0 = acc[ai][bj][m][0], v1 = acc[ai][bj][m][1];
#pragma unroll
                    for (int j = 0; j < 4; ++j) { const float a = fmaxf(v0[j], 0.f), b = fmaxf(v1[j], 0.f); v0[j] = a * a; v1[j] = b * b; }
                    u32x4 w; w.x = cvt_pk_bf16(v0[0], v0[1]); w.y = cvt_pk_bf16(v0[2], v0[3]); w.z = cvt_pk_bf16(v1[0], v1[1]); w.w = cvt_pk_bf16(v1[2], v1[3]);
                    *(u32x4*)(rowp + bj * HALF) = w; } }
    }
};

template <class Epi, class Sched, bool ALIGN_EPI = false, bool SP2 = false>
__device__ __forceinline__ void gemm_phase(PG8_LAS unsigned char* lds, const Gemm g, const Sched& S, const Epi& E, const int wave_s) {
    unsigned ones_l; asm volatile("s_mov_b32 %0, -1" : "=s"(ones_l)); const int tid_l = wave_s * 64 + (int)__builtin_amdgcn_mbcnt_hi(ones_l, __builtin_amdgcn_mbcnt_lo(ones_l, 0u));
    const int tid = tid_l, wid = __builtin_amdgcn_readfirstlane(tid >> 6), lane = tid & 63, wr = wid >> 2, wc = wid & 3, fr = lane & 15, fq = lane >> 4;
    const int K = g.K, nt = K / BK;
    unsigned voffA[2], voffB[2];
#pragma unroll
    for (int i = 0; i < 2; ++i) { int R, C; stage_rc(tid * 16 + i * 8192, R, C); const int Rb = Epi::PERM ? ((R & ~31) + perm32(R & 31)) : R;
        voffA[i] = (unsigned)(R * K + C) * 2u; voffB[i] = (unsigned)(Rb * K + C) * 2u; }
    const size_t kstep = (size_t)(BK * 2);
    const size_t hstep = (size_t)HALF * K * 2;
    const size_t tstep = 2 * hstep;
    const unsigned ldsw = (unsigned)wid * 1024u;
    const int aoff = lds_byte(wr * 64 + fr, fq * 8), boff = lds_byte(wc * 32 + fr, fq * 8);
#define PG8_SA(b, h) (((b) * 2 + (h)) * HTB)
#define PG8_SB(b, h) ((4 + (b) * 2 + (h)) * HTB)
#define PG8_STAGE(bufoff, gbase, voff) do { _Pragma("unroll") for (int _i = 0; _i < 2; ++_i) \
        __builtin_amdgcn_global_load_lds((const unsigned*)((const char*)(gbase) + (voff)[_i]), (PG8_LAS unsigned*)(lds + (bufoff) + ldsw + _i * 8192), 16, 0, 0); } while (0)
#define PG8_LDA(dst, b, h) do { _Pragma("unroll") for (int m = 0; m < 4; ++m) _Pragma("unroll") for (int k = 0; k < 2; ++k) dst[m][k] = *(const PG8_LAS bf16x8*)(lds + PG8_SA(b, h) + aoff + m * 2048 + k * 1024); } while (0)
#define PG8_LDB(dst, b, h) do { _Pragma("unroll") for (int n = 0; n < 2; ++n) _Pragma("unroll") for (int k = 0; k < 2; ++k) dst[n][k] = *(const PG8_LAS bf16x8*)(lds + PG8_SB(b, h) + boff + n * 2048 + k * 1024); } while (0)
#define PG8_MMA(ai, bj, At, Bt) do { __builtin_amdgcn_s_setprio(1); _Pragma("unroll") for (int m = 0; m < 4; ++m) _Pragma("unroll") for (int n = 0; n < 2; ++n) _Pragma("unroll") for (int k = 0; k < 2; ++k) \
        acc[ai][bj][m][n] = __builtin_amdgcn_mfma_f32_16x16x32_bf16(Bt[n][k], At[m][k], acc[ai][bj][m][n], 0, 0, 0); __builtin_amdgcn_s_setprio(0); } while (0)
#define PG8_WAIT_V(n) asm volatile("s_waitcnt vmcnt(" #n ")" ::: "memory")
#define PG8_WAIT_L(n) asm volatile("s_waitcnt lgkmcnt(" #n ")" ::: "memory")
#define PG8_BAR __builtin_amdgcn_s_barrier()
#define PG8_SCHED __builtin_amdgcn_sched_barrier(0)
    Unit cur, nxt; int ui = 0;
    if (!S.next(0, cur)) return;
    f32x4 acc[2][2][4][2];
#pragma unroll
    for (int a = 0; a < 2; ++a)
#pragma unroll
        for (int b = 0; b < 2; ++b)
#pragma unroll
            for (int m = 0; m < 4; ++m)
#pragma unroll
                for (int n = 0; n < 2; ++n) acc[a][b][m][n] = (f32x4){0.f, 0.f, 0.f, 0.f};
    bf16x8 At[4][2], B0[2][2], B1[2][2];
    const char* cA = (const char*)g.A + (size_t)cur.pm * tstep + (size_t)cur.z * g.zA; const char* cB = (const char*)g.Bt + (size_t)cur.pn * tstep + (size_t)cur.z * g.zB;
    S.a_ready(cur);
    if constexpr (SP2) {
        PG8_STAGE(PG8_SB(0, 0), cB, voffB); PG8_STAGE(PG8_SB(0, 1), cB + hstep, voffB); PG8_STAGE(PG8_SA(0, 0), cA, voffA); PG8_STAGE(PG8_SA(0, 1), cA + hstep, voffA);
        if (wr == 1) PG8_BAR;
        PG8_WAIT_V(2); PG8_BAR;
        PG8_STAGE(PG8_SB(1, 0), cB + kstep, voffB); PG8_STAGE(PG8_SA(1, 0), cA + kstep, voffA); PG8_STAGE(PG8_SB(1, 1), cB + hstep + kstep, voffB);
        PG8_WAIT_V(6); PG8_BAR;
    } else {
        PG8_STAGE(PG8_SB(0, 0), cB, voffB); PG8_STAGE(PG8_SA(0, 0), cA, voffA); PG8_STAGE(PG8_SB(0, 1), cB + hstep, voffB); PG8_STAGE(PG8_SA(0, 1), cA + hstep, voffA);
        if (wr == 1) PG8_BAR;
        PG8_WAIT_V(4); PG8_BAR;
        PG8_STAGE(PG8_SB(1, 0), cB + kstep, voffB); PG8_STAGE(PG8_SA(1, 0), cA + kstep, voffA); PG8_STAGE(PG8_SB(1, 1), cB + hstep + kstep, voffB);
        PG8_WAIT_V(6); PG8_BAR;
    }
    for (;;) {
        const bool has_next = S.next(ui + 1, nxt);
        const char* nA = has_next ? (const char*)g.A + (size_t)nxt.pm * tstep + (size_t)nxt.z * g.zA : cA; const char* nB = has_next ? (const char*)g.Bt + (size_t)nxt.pn * tstep + (size_t)nxt.z * g.zB : cB;
        for (int t = 0; t < nt; t += 2) {
            const bool last = (t == nt - 2);
            const char* a1 = cA + (size_t)(t + 1) * kstep;
            const char* a2 = last ? nA : cA + (size_t)(t + 2) * kstep; const char* b2 = last ? nB : cB + (size_t)(t + 2) * kstep;
            const char* a3 = a2 + kstep; const char* b3 = b2 + kstep;
            if (last && has_next) S.a_ready(nxt);
            if constexpr (SP2) {
            PG8_LDB(B0, 0, 0); PG8_LDB(B1, 0, 1); PG8_SCHED; PG8_LDA(At, 0, 0); PG8_STAGE(PG8_SA(1, 1), a1 + hstep, voffA);
            PG8_WAIT_V(8); PG8_WAIT_L(0); PG8_BAR; PG8_MMA(0, 0, At, B0); PG8_MMA(0, 1, At, B1); PG8_BAR; PG8_SCHED;
            PG8_LDA(At, 0, 1); PG8_STAGE(PG8_SB(0, 0), b2, voffB); PG8_STAGE(PG8_SB(0, 1), b2 + hstep, voffB); PG8_STAGE(PG8_SA(0, 0), a2, voffA);
            PG8_WAIT_V(8); PG8_WAIT_L(0); PG8_BAR; PG8_MMA(1, 0, At, B0); PG8_MMA(1, 1, At, B1); PG8_BAR; PG8_SCHED;
            PG8_LDB(B0, 1, 0); PG8_LDB(B1, 1, 1); PG8_SCHED; PG8_LDA(At, 1, 0); PG8_STAGE(PG8_SA(0, 1), a2 + hstep, voffA);
            PG8_WAIT_V(8); PG8_WAIT_L(0); PG8_BAR; PG8_MMA(0, 0, At, B0); PG8_MMA(0, 1, At, B1); PG8_BAR; PG8_SCHED;
            PG8_LDA(At, 1, 1); PG8_STAGE(PG8_SB(1, 0), b3, voffB); PG8_STAGE(PG8_SB(1, 1), b3 + hstep, voffB); PG8_STAGE(PG8_SA(1, 0), a3, voffA);
            PG8_WAIT_V(8); PG8_WAIT_L(0); PG8_BAR; PG8_MMA(1, 0, At, B0); PG8_MMA(1, 1, At, B1); PG8_BAR; PG8_SCHED;
            } else {
            PG8_LDB(B0, 0, 0); PG8_SCHED; PG8_LDA(At, 0, 0); PG8_STAGE(PG8_SA(1, 1), a1 + hstep, voffA);
            PG8_WAIT_L(8); PG8_BAR; PG8_WAIT_L(0); PG8_MMA(0, 0, At, B0); PG8_BAR; PG8_SCHED;
            PG8_LDB(B1, 0, 1); PG8_STAGE(PG8_SB(0, 0), b2, voffB);
            PG8_BAR; PG8_WAIT_L(0); PG8_MMA(0, 1, At, B1); PG8_BAR;
            PG8_LDA(At, 0, 1); PG8_STAGE(PG8_SA(0, 0), a2, voffA);
            PG8_BAR; PG8_WAIT_L(0); PG8_MMA(1, 0, At, B0); PG8_BAR; PG8_SCHED;
            PG8_STAGE(PG8_SB(0, 1), b2 + hstep, voffB);
            PG8_WAIT_V(6); PG8_BAR; PG8_MMA(1, 1, At, B1); PG8_BAR;
            PG8_LDB(B0, 1, 0); PG8_SCHED; PG8_LDA(At, 1, 0); PG8_STAGE(PG8_SA(0, 1), a2 + hstep, voffA);
            PG8_WAIT_L(8); PG8_BAR; PG8_WAIT_L(0); PG8_MMA(0, 0, At, B0); PG8_BAR; PG8_SCHED;
            PG8_LDB(B1, 1, 1); PG8_STAGE(PG8_SB(1, 0), b3, voffB);
            PG8_BAR; PG8_WAIT_L(0); PG8_MMA(0, 1, At, B1); PG8_BAR;
            PG8_LDA(At, 1, 1); PG8_STAGE(PG8_SA(1, 0), a3, voffA);
            PG8_BAR; PG8_WAIT_L(0); PG8_MMA(1, 0, At, B0); PG8_BAR; PG8_SCHED;
            PG8_STAGE(PG8_SB(1, 1), b3 + hstep, voffB);
            PG8_WAIT_V(6); PG8_BAR; PG8_MMA(1, 1, At, B1); PG8_BAR;
            }
        }
        if constexpr (ALIGN_EPI) { if (wr == 0) PG8_BAR; }
        if constexpr (!Epi::AFTER_DRAIN) { E(acc, cur, wr, wc, fr, fq); S.done(cur); }
        if (!has_next) break;
        if (!Epi::keep(cur)) {
#pragma unroll
        for (int a = 0; a < 2; ++a)
#pragma unroll
            for (int b = 0; b < 2; ++b)
#pragma unroll
                for (int m = 0; m < 4; ++m)
#pragma unroll
                    for (int n = 0; n < 2; ++n) acc[a][b][m][n] = (f32x4){0.f, 0.f, 0.f, 0.f};
        }
        cur = nxt; cA = nA; cB = nB; ++ui;
        if constexpr (ALIGN_EPI) { if (wr == 1) PG8_BAR; }
    }
    PG8_WAIT_V(0);
    if constexpr (!ALIGN_EPI) { if (wr == 0) PG8_BAR; }
    PG8_BAR;
    if constexpr (Epi::AFTER_DRAIN) { E.fused(acc, cur, wr, wc, fr, fq, lds, wid, lane); S.done(cur); }
#undef PG8_SA
#undef PG8_SB
#undef PG8_STAGE
#undef PG8_LDA
#undef PG8_LDB
#undef PG8_MMA
#undef PG8_WAIT_V
#undef PG8_WAIT_L
#undef PG8_BAR
#undef PG8_SCHED
}
}

constexpr int NWAVES = 8;
constexpr int D = 2048, DEPTH = 2, DFF = 8192;
constexpr int NA_W = 1024, ML_W = 1024, SG_W = 1024;
constexpr int D_IN = 15376, N_IN_PAD = 15616;
constexpr int M_PROMPT = 8 * 4096, M_SAMPLE = 2 * 8192, M_ALL = M_PROMPT + M_SAMPLE;
constexpr int MS = 8192, NSLAB = M_ALL / MS;
constexpr float EPS = 1e-6f;

constexpr size_t MiB = 1u << 20;
constexpr size_t WS_CTL = 0, CTL_ZERO_BYTES = 1 * MiB;
constexpr size_t WL_IN = 0, WL_ABC = 61 * MiB, WL_OUT = 73 * MiB, WL_UP = 81 * MiB, WL_DN = 113 * MiB, WL_BYTES = 145 * MiB;
constexpr size_t WS_W = 1 * MiB;
constexpr size_t WS_H = 291 * MiB;
constexpr size_t WS_QKVA = 323 * MiB;
constexpr size_t WS_QKVOB = 371 * MiB;
constexpr size_t WS_ZUV = 435 * MiB;
constexpr size_t WS_U = WS_QKVA;
constexpr size_t WS_G = 467 * MiB;
constexpr size_t WS_GATES = 563 * MiB;
constexpr size_t WS_SGR = WS_GATES + MiB / 2;
constexpr size_t WS_QC = 564 * MiB, WS_KC = 580 * MiB;
constexpr size_t WS_Y = 596 * MiB;
constexpr size_t WS_HF = 644 * MiB, WS_HB = 676 * MiB;
constexpr size_t WS_MRG = 708 * MiB;
constexpr size_t WS_MRGB = 772 * MiB;
constexpr size_t WS_T = 804 * MiB;
constexpr size_t WS_GS = 868 * MiB;
constexpr size_t WS_GD = 870 * MiB;
constexpr size_t WS_LST = 871 * MiB;
constexpr size_t WS_NLOC = 887 * MiB;
constexpr size_t WS_LST2 = 888 * MiB;
constexpr size_t WS_STG = 908 * MiB;
constexpr size_t WS_END = 916 * MiB;
static_assert(WS_W + 2 * WL_BYTES <= WS_H && WS_U + (size_t)MS * DFF * 2 <= WS_G && WS_SGR + (size_t)MS * 4 <= WS_QC, "d_ws map");
constexpr int CW_BAR = 4096;

constexpr int RING_OFF = 0, RING_BYTES = 131072;
constexpr int LDSCTL_OFF = 153600, MISC_OFF = LDSCTL_OFF + 320;
constexpr int LDS_BYTES = 155648;

#define GAS __attribute__((address_space(1)))
#define LAS __attribute__((address_space(3)))
typedef unsigned short bf16;
typedef unsigned v4u __attribute__((ext_vector_type(4)));
typedef float f32x4 __attribute__((ext_vector_type(4)));
typedef short bf16x8 __attribute__((ext_vector_type(8)));
typedef GAS unsigned gu32;
typedef GAS unsigned long long gu64;
#define RLX_AGENT __ATOMIC_RELAXED, __HIP_MEMORY_SCOPE_AGENT
#define LDS_WAIT() asm volatile("s_waitcnt lgkmcnt(0)" ::: "memory")
#define VM_WAIT() asm volatile("s_waitcnt vmcnt(0)" ::: "memory")
__device__ __forceinline__ unsigned long long rt() { return __builtin_amdgcn_s_memrealtime(); }
__device__ __forceinline__ unsigned f2bf(float f) { unsigned u = __builtin_bit_cast(unsigned, f); return (u + 0x7fffu + ((u >> 16) & 1u)) >> 16; }
__device__ __forceinline__ unsigned pk2(float lo, float hi) { unsigned r; asm("v_cvt_pk_bf16_f32 %0, %1, %2" : "=v"(r) : "v"(lo), "v"(hi)); return r; }

#define XB_TMO      128
#define XB_XCNT(j)  (256  + 64 * (j))
#define XB_XSUB(j)  (1280 + 64 * (j))
#define XB_XGEN(j)  (2304 + 64 * (j))
#define XB_TOP      3328
#define XB_TOPGEN   3392
#define XCD_BAR_WORDS 3456
#define XB_SPIN_CAP (1u << 18)

__device__ __forceinline__ unsigned xb_ld(unsigned* p)              { return __hip_atomic_load(p, __ATOMIC_RELAXED, __HIP_MEMORY_SCOPE_AGENT); }
__device__ __forceinline__ unsigned xb_add(unsigned* p, unsigned v) { return __hip_atomic_fetch_add(p, v, __ATOMIC_RELAXED, __HIP_MEMORY_SCOPE_AGENT); }
__device__ __forceinline__ unsigned xb_xcc_id() { return (unsigned)__builtin_amdgcn_s_getreg((3 << 11) | 20) & 0xFu; }
#define XB_SPIN(cond, bar) do { unsigned _sp = 0; while (cond) { __builtin_amdgcn_s_sleep(1); \
    if ((++_sp & 255u) == 0u) { if (xb_ld(&(bar)[XB_TMO])) break; if (_sp > XB_SPIN_CAP) { atomicAdd(&(bar)[XB_TMO], 1u); break; } } } } while (0)

struct XcdBarrier {
    unsigned* bar; unsigned x;
    volatile LAS unsigned* st;
};

__device__ __forceinline__ XcdBarrier xcd_barrier_post(unsigned* bar, volatile LAS unsigned* st) {
    XcdBarrier b; b.bar = bar; b.x = xb_xcc_id(); b.st = st;
    if (threadIdx.x == 0) (void)xb_add(&bar[XB_XCNT(b.x)], 1u);
    return b;
}
__device__ __forceinline__ void xcd_barrier_complete(unsigned* bar, unsigned x, unsigned& nloc, unsigned& nx) {
    const unsigned G = gridDim.x * gridDim.y * gridDim.z;
    unsigned sum, cnt, mine, sp = 0u;
    for (;;) {
        sum = 0u; cnt = 0u; mine = 0u;
#pragma unroll
        for (unsigned j = 0; j < 16; ++j) { const unsigned c = xb_ld(&bar[XB_XCNT(j)]); sum += c; cnt += (c > 0u) ? 1u : 0u; mine = (j == x) ? c : mine; }
        if (sum == G) break;
        __builtin_amdgcn_s_sleep(1);
        if ((++sp & 255u) == 0u) { if (xb_ld(&bar[XB_TMO])) break; if (sp > XB_SPIN_CAP) { atomicAdd(&bar[XB_TMO], 1u); break; } }
    }
    nloc = mine > 0u ? mine : 1u; nx = cnt > 0u ? cnt : 1u;
}

__device__ __forceinline__ void xcd_barrier(const XcdBarrier& b) {
    asm volatile("s_waitcnt vmcnt(0)" ::: "memory");
    __syncthreads();
    if (threadIdx.x == 0) {
        unsigned* bar = b.bar;
        __builtin_amdgcn_s_waitcnt(0);
        unsigned nloc = b.st[0], nx = b.st[1];
        if (nloc == 0u) { xcd_barrier_complete(bar, b.x, nloc, nx); b.st[0] = nloc; b.st[1] = nx; }
        const unsigned old = xb_add(&bar[XB_XSUB(b.x)], 1u);
        const unsigned gen = old / nloc;
        if (old + 1u == (gen + 1u) * nloc) {
            __builtin_amdgcn_fence(__ATOMIC_RELEASE, "agent");
            asm volatile("s_waitcnt vmcnt(0)" ::: "memory");
            const unsigned og = xb_add(&bar[XB_TOP], 1u);
            const unsigned tg = og / nx;
            if (og + 1u == (tg + 1u) * nx) xb_add(&bar[XB_TOPGEN], 1u);
            else XB_SPIN(xb_ld(&bar[XB_TOPGEN]) == tg, bar);
            __builtin_amdgcn_fence(__ATOMIC_ACQUIRE, "agent");
            xb_add(&bar[XB_XGEN(b.x)], 1u);
            asm volatile("s_waitcnt vmcnt(0)" ::: "memory");
        } else {
            XB_SPIN(xb_ld(&bar[XB_XGEN(b.x)]) == gen, bar);
            __builtin_amdgcn_fence(__ATOMIC_ACQUIRE, "agent");
            asm volatile("s_waitcnt vmcnt(0)" ::: "memory");
        }
    }
    __syncthreads();
}

struct Frame {
    LAS unsigned char* lds;
    int tid, lane, wave;
    int vcu, G;
};
struct Args {
    const float* x_prompt; const float* x_sample; const float* pre_mix_g; const float* post_mix_g; const float* pre_mlp_g; const float* post_mlp_g;
    const float* w_in; const float* b_gate; const float* conv_w; const float* na_rpb; const float* ml_norm_g; const float* sg_norm_g; const float* w_s; const float* b_s;
    const float* w_a; const float* w_b; const float* w_c; const float* w_out; const float* w_up; const float* w_down;
    float* out; unsigned char* ws;
    int ph_lo, ph_hi;
};

__device__ __forceinline__ float sh_xor(float v, int m, int lane) { return __int_as_float(__builtin_amdgcn_ds_bpermute((lane ^ m) << 2, __float_as_int(v))); }
__device__ __forceinline__ float sh_up(float v, int o, int lane) { return __int_as_float(__builtin_amdgcn_ds_bpermute((lane - o) << 2, __float_as_int(v))); }
__device__ __forceinline__ float sh_idx(float v, int src) { return __int_as_float(__builtin_amdgcn_ds_bpermute(src << 2, __float_as_int(v))); }
__device__ __forceinline__ float wave_sum(float v, int lane) {
#pragma unroll
    for (int o = 1; o < 64; o <<= 1) v += sh_xor(v, o, lane);
    return v;
}
__device__ __forceinline__ float wave_max(float v, int lane) {
#pragma unroll
    for (int o = 1; o < 64; o <<= 1) v = fmaxf(v, sh_xor(v, o, lane));
    return v;
}
__device__ __forceinline__ float bf_lo(unsigned u) { return __uint_as_float(u << 16); }
__device__ __forceinline__ float bf_hi(unsigned u) { return __uint_as_float(u & 0xffff0000u); }
__device__ __forceinline__ float sigmoid_f(float x) { return __builtin_amdgcn_rcpf(1.0f + __builtin_amdgcn_exp2f(-1.4426950408889634f * x)); }

__device__ __forceinline__ void p0_transpose_item(const float* W, int K, int N, bf16* WT, int k0, int n0, int ncols, int drow0, float sc, LAS float* scr, int lane) {
    const int cl = lane & 31;
#pragma unroll 8
    for (int i = 0; i < 32; ++i) { const int kk = 2 * i + (lane >> 5); scr[kk * 33 + cl] = (cl < ncols) ? W[(size_t)(k0 + kk) * N + n0 + cl] * sc : 0.f; }
    LDS_WAIT(); asm volatile("" ::: "memory");
    const int c = lane & 7;
#pragma unroll
    for (int j = 0; j < 4; ++j) { const int n = (lane >> 3) + 8 * j; const LAS float* s = scr + (8 * c) * 33 + n;
        v4u o; o.x = pk2(s[0 * 33], s[1 * 33]); o.y = pk2(s[2 * 33], s[3 * 33]); o.z = pk2(s[4 * 33], s[5 * 33]); o.w = pk2(s[6 * 33], s[7 * 33]);
        if (n < ncols) *(GAS v4u*)(WT + (size_t)(drow0 + n) * K + k0 + 8 * c) = o; }
    LDS_WAIT(); asm volatile("" ::: "memory");
}
__device__ __forceinline__ void p0_matrix(Frame& F, const float* W, int K, int N, bf16* WT, LAS float* scr) {
    const int gw = F.vcu * NWAVES + F.wave, NGW = F.G * NWAVES, nblk = N / 32, nit = (K / 64) * nblk;
    for (int it = gw; it < nit; it += NGW) { const int kb = it / nblk, nb = it % nblk; p0_transpose_item(W, K, N, WT, 64 * kb, 32 * nb, 32, 32 * nb, 1.f, scr, F.lane); }
}
__device__ __forceinline__ void p0_win(Frame& F, const float* W, bf16* WT, LAS float* scr) {
    const int gw = F.vcu * NWAVES + F.wave, NGW = F.G * NWAVES;
    constexpr int NB1 = 7168 / 32, NB2 = 8192 / 32, NBLK = NB1 + 1 + NB2, NIT = (D / 64) * NBLK;
    for (int it = gw; it < NIT; it += NGW) { const int kb = it / NBLK, nb = it % NBLK; int n0, ncols, drow0; float sc = 1.f;
        if (nb < NB1) { n0 = 32 * nb; ncols = 32; drow0 = n0; if (n0 < 1024) sc = 0.08838834764831845f; }
        else if (nb == NB1) { n0 = 7168; ncols = 16; drow0 = 15360; }
        else { n0 = 7184 + 32 * (nb - NB1 - 1); ncols = 32; drow0 = n0 - 16; }
        p0_transpose_item(W, D, D_IN, WT, 64 * kb, n0, ncols, drow0, sc, scr, F.lane); }
    const int gt = (F.vcu * NWAVES + F.wave) * 64 + F.lane, NGT = F.G * NWAVES * 64; constexpr int NZ16 = (N_IN_PAD - D_IN) * D / 8;
    GAS v4u* z = (GAS v4u*)(WT + (size_t)D_IN * D);
    for (int i = gt; i < NZ16; i += NGT) z[i] = (v4u){0u, 0u, 0u, 0u};
}

__device__ __forceinline__ void row_phase(Frame& F, const float* xin, const float* add, const float* g_add, float* xout, const float* g_next, bf16* hout) {
    const int gw = F.vcu * NWAVES + F.wave, NGW = F.G * NWAVES;
    for (int m = gw; m < MS; m += NGW) {
        const GAS f32x4* xr = (const GAS f32x4*)(xin + (size_t)m * D) + F.lane;
        f32x4 v[8];
#pragma unroll
        for (int j = 0; j < 8; ++j) v[j] = xr[64 * j];
        if (add) {
            const GAS f32x4* ar = (const GAS f32x4*)(add + (size_t)m * D) + F.lane; f32x4 a[8]; float s = 0.f;
#pragma unroll
            for (int j = 0; j < 8; ++j) { a[j] = ar[64 * j]; s += (a[j].x * a[j].x + a[j].y * a[j].y) + (a[j].z * a[j].z + a[j].w * a[j].w); }
            const float rs = 1.0f / sqrtf(wave_sum(s, F.lane) * (1.f / D) + EPS);
#pragma unroll
            for (int j = 0; j < 8; ++j) { const f32x4 gv = ((const GAS f32x4*)g_add)[F.lane + 64 * j]; v[j] = v[j] + (a[j] * rs) * gv; }
        }
        if (xout) { GAS f32x4* o = (GAS f32x4*)(xout + (size_t)m * D) + F.lane;
#pragma unroll
            for (int j = 0; j < 8; ++j) o[64 * j] = v[j]; }
        if (hout) {
            float s = 0.f;
#pragma unroll
            for (int j = 0; j < 8; ++j) s += (v[j].x * v[j].x + v[j].y * v[j].y) + (v[j].z * v[j].z + v[j].w * v[j].w);
            const float rs = 1.0f / sqrtf(wave_sum(s, F.lane) * (1.f / D) + EPS);
            GAS unsigned long long* o8 = (GAS unsigned long long*)(hout + (size_t)m * D) + F.lane;
#pragma unroll
            for (int j = 0; j < 8; ++j) { const f32x4 gv = ((const GAS f32x4*)g_next)[F.lane + 64 * j]; const f32x4 y = (v[j] * rs) * gv;
                o8[64 * j] = (unsigned long long)pk2(y.x, y.y) | ((unsigned long long)pk2(y.z, y.w) << 32); }
        }
    }
}

__device__ __forceinline__ void prep_phase(Frame& F, const bf16* qkvob, const float* convw, bf16* qc, bf16* kc, const bf16* zuv, float* sgr, int T) {
    const int gt = (F.vcu * NWAVES + F.wave) * 64 + F.lane, NGT = F.G * NWAVES * 64;
    {
        const int c8 = gt & 255; float w0[8], w1[8], w2[8];
#pragma unroll
        for (int j = 0; j < 8; ++j) { w0[j] = convw[c8 * 8 + j]; w1[j] = convw[2048 + c8 * 8 + j]; w2[j] = convw[4096 + c8 * 8 + j]; }
        const float osc = c8 < 128 ? 0.0625f : 1.0f;
        bf16* dst = c8 < 128 ? qc + c8 * 8 : kc + (c8 - 128) * 8;
        for (int t = gt >> 8; t < MS; t += NGT >> 8) {
            const int ts = t % T; const GAS v4u* src = (const GAS v4u*)(qkvob + (size_t)t * 4096 + c8 * 8);
            const v4u xc = src[0]; v4u xm = (v4u){0u, 0u, 0u, 0u}, xp = xm;
            if (ts > 0) xm = *(const GAS v4u*)(qkvob + (size_t)(t - 1) * 4096 + c8 * 8);
            if (ts < T - 1) xp = *(const GAS v4u*)(qkvob + (size_t)(t + 1) * 4096 + c8 * 8);
            float r[8];
#pragma unroll
            for (int j = 0; j < 4; ++j) {
                const float a0 = w0[2 * j] * bf_lo(xm[j]) + w1[2 * j] * bf_lo(xc[j]) + w2[2 * j] * bf_lo(xp[j]);
                const float a1 = w0[2 * j + 1] * bf_hi(xm[j]) + w1[2 * j + 1] * bf_hi(xc[j]) + w2[2 * j + 1] * bf_hi(xp[j]);
                r[2 * j] = a0 * sigmoid_f(a0) * osc; r[2 * j + 1] = a1 * sigmoid_f(a1) * osc; }
            v4u o; o.x = pk2(r[0], r[1]); o.y = pk2(r[2], r[3]); o.z = pk2(r[4], r[5]); o.w = pk2(r[6], r[7]);
            *(GAS v4u*)(dst + (size_t)t * 1024) = o;
        }
    }
    {
        const int gw = F.vcu * NWAVES + F.wave, NGW = F.G * NWAVES;
        for (int t = gw; t < MS; t += NGW) {
            const GAS v4u* src = (const GAS v4u*)(zuv + (size_t)t * 2048 + 1024) + 2 * F.lane; float s = 0.f;
#pragma unroll
            for (int i = 0; i < 2; ++i) { const v4u x = src[i];
#pragma unroll
                for (int j = 0; j < 4; ++j) { const float a = bf_lo(x[j]), b = bf_hi(x[j]); s += a * a + b * b; } }
            s = wave_sum(s, F.lane);
            if (F.lane == 0) sgr[t] = 1.0f / sqrtf(s * (1.f / 1024.f) + EPS);
        }
    }
}

__device__ __forceinline__ void comb_phase(Frame& F, const float* hf, const float* hb, const bf16* qkvob, const float* mlg, bf16* yb) {
    const int gw = F.vcu * NWAVES + F.wave, NGW = F.G * NWAVES;
    for (int it = gw; it < MS * 4; it += NGW) { const int t = it >> 2, h = it & 3; const size_t o = (size_t)t * 1024 + h * 256 + 4 * F.lane;
        const f32x4 a = *(const GAS f32x4*)(hf + o), b = *(const GAS f32x4*)(hb + o); const f32x4 s = a + b;
        const float ss = wave_sum((s.x * s.x + s.y * s.y) + (s.z * s.z + s.w * s.w), F.lane); const float rs = 1.0f / sqrtf(ss * (1.f / 256.f) + EPS);
        const f32x4 gv = *(const GAS f32x4*)(mlg + h * 256 + 4 * F.lane);
        const unsigned long long ow = *(const GAS unsigned long long*)(qkvob + (size_t)t * 4096 + 3072 + h * 256 + 4 * F.lane);
        const unsigned o0 = (unsigned)ow, o1 = (unsigned)(ow >> 32);
        const float y0 = s.x * rs * gv.x * bf_lo(o0), y1 = s.y * rs * gv.y * bf_hi(o0), y2 = s.z * rs * gv.z * bf_lo(o1), y3 = s.w * rs * gv.w * bf_hi(o1);
        *(GAS unsigned long long*)(yb + o) = (unsigned long long)pk2(y0, y1) | ((unsigned long long)pk2(y2, y3) << 32);
    }
}

__device__ __forceinline__ void na_naive(Frame& F, const bf16* qkva, const float* rpb, bf16* ya, int T, int gw, int NGW) {
    const int rows = T / 64;
    for (int it = gw; it < MS * 8; it += NGW) {
        const int m = it >> 3, h = it & 7, seq = m / T, t = m % T, r = t >> 6, qc = t & 63;
        int rs = r - 4; rs = rs < 0 ? 0 : (rs > rows - 8 ? rows - 8 : rs);
        int cs = qc - 8; cs = cs < 0 ? 0 : (cs > 48 ? 48 : cs);
        const bf16* qrow = qkva + (size_t)m * 3072 + h * 128;
        float sc[2];
#pragma unroll
        for (int kk = 0; kk < 2; ++kk) { const int kap = F.lane + 64 * kk, j = kap >> 4, cc = kap & 15;
            const int ktok = seq * T + (rs + j) * 64 + cs + cc; const bf16* krow = qkva + (size_t)ktok * 3072 + 1024 + h * 128; float d = 0.f;
#pragma unroll 4
            for (int i = 0; i < 16; ++i) { const v4u qv = *(const GAS v4u*)(qrow + 8 * i), kv = *(const GAS v4u*)(krow + 8 * i);
#pragma unroll
                for (int e = 0; e < 4; ++e) d += bf_lo(qv[e]) * bf_lo(kv[e]) + bf_hi(qv[e]) * bf_hi(kv[e]); }
            sc[kk] = d + rpb[(h * 15 + (rs + j - r + 7)) * 31 + (cs + cc - qc + 15)]; }
        const float mx = wave_max(fmaxf(sc[0], sc[1]), F.lane);
        const float e0 = __expf(sc[0] - mx), e1 = __expf(sc[1] - mx); const float inv = 1.0f / wave_sum(e0 + e1, F.lane);
        const float p0 = e0 * inv, p1 = e1 * inv;
        float o0 = 0.f, o1 = 0.f;
        for (int kap = 0; kap < 128; ++kap) { const int j = kap >> 4, cc = kap & 15; const int ktok = seq * T + (rs + j) * 64 + cs + cc;
            const float p = sh_idx(kap < 64 ? p0 : p1, kap & 63);
            const unsigned vv = *(const GAS unsigned*)(qkva + (size_t)ktok * 3072 + 2048 + h * 128 + 2 * F.lane);
            o0 += p * bf_lo(vv); o1 += p * bf_hi(vv); }
        *(GAS unsigned*)(ya + (size_t)m * 1024 + h * 128 + 2 * F.lane) = pk2(o0, o1);
    }
}
__device__ __forceinline__ void sg_naive(Frame& F, const bf16* zuv, const float* sgr, const float* sgn, const float* ws_, const float* bs, bf16* yc, int gw, int NGW) {
    for (int it = gw; it < MS * 8; it += NGW) {
        const int t = it >> 3, g = it & 7, p = t & 127, cb = t & ~127; const int c = g * 128 + 2 * F.lane;
        const float* wrow = ws_ + ((size_t)g * 128 + p) * 128; float a0 = 0.f, a1 = 0.f;
        for (int q = 0; q < 128; ++q) { const float wq = wrow[q] * sgr[cb + q]; const unsigned zz = *(const GAS unsigned*)(zuv + (size_t)(cb + q) * 2048 + 1024 + c);
            a0 += wq * bf_lo(zz); a1 += wq * bf_hi(zz); }
        const float b = bs[g * 128 + p]; const unsigned uu = *(const GAS unsigned*)(zuv + (size_t)t * 2048 + c);
        const float y0 = bf_lo(uu) * (a0 * sgn[c] + b), y1 = bf_hi(uu) * (a1 * sgn[c + 1] + b);
        *(GAS unsigned*)(yc + (size_t)t * 1024 + c) = pk2(y0, y1);
    }
}
__device__ __forceinline__ void mlstm_naive(Frame& F, int unit, const bf16* qc, const bf16* kc, const bf16* qkvob, const float* gates, float* hf, float* hb, int T) {
    const int es = unit & 3, dir = (unit >> 2) & 1, h = (unit >> 3) & 3, seq = unit >> 5, nc = T / 64, tid = F.tid;
    LAS unsigned char* L = F.lds;
    LAS bf16* Qs = (LAS bf16*)(L);
    LAS bf16* Ks = (LAS bf16*)(L + 33792);
    LAS float* Vs = (LAS float*)(L + 67584);
    LAS float* Ss = (LAS float*)(L + 83968);
    LAS float* NUM = (LAS float*)(L + 100608);
    LAS float* vb = (LAS float*)(L + 116992);
    LAS float* va = vb + 64;
    LAS float* vmr = vb + 128;
    LAS float* vw = vb + 192;
    LAS float* vwi = vb + 256;
    LAS float* NQ = vb + 320;
    LAS float* nst = vb + 384;
    LAS float* scal = vb + 640;
    float* hout = dir ? hb : hf;
    float Creg[32];
#pragma unroll
    for (int i = 0; i < 32; ++i) Creg[i] = 0.f;
    if (tid < 256) nst[tid] = 0.f;
    float m_prev = 0.f;
    const int e = tid & 63, dg = tid >> 6;
    for (int ci = 0; ci < nc; ++ci) {
        __syncthreads();
#pragma unroll
        for (int i = 0; i < 4; ++i) { const int p = tid + 512 * i, tau = p >> 5, c8 = p & 31; const int pos = ci * 64 + tau; const int tok = seq * T + (dir ? T - 1 - pos : pos);
            *(LAS v4u*)(Qs + tau * 264 + c8 * 8) = *(const GAS v4u*)(qc + (size_t)tok * 1024 + h * 256 + c8 * 8);
            *(LAS v4u*)(Ks + tau * 264 + c8 * 8) = *(const GAS v4u*)(kc + (size_t)tok * 1024 + h * 256 + c8 * 8); }
        { const int tau = tid >> 3, c8 = tid & 7; const int pos = ci * 64 + tau; const int tok = seq * T + (dir ? T - 1 - pos : pos);
            const v4u vv = *(const GAS v4u*)(qkvob + (size_t)tok * 4096 + 2048 + h * 256 + es * 64 + c8 * 8);
#pragma unroll
            for (int j = 0; j < 4; ++j) { Vs[tau * 64 + c8 * 8 + 2 * j] = bf_lo(vv[j]); Vs[tau * 64 + c8 * 8 + 2 * j + 1] = bf_hi(vv[j]); } }
        if (tid < 64) {
            const int pos = ci * 64 + tid; const int tok = seq * T + (dir ? T - 1 - pos : pos);
            const float ipre = gates[(size_t)tok * 16 + dir * 8 + h], fpre = gates[(size_t)tok * 16 + dir * 8 + 4 + h];
            const float logf = fminf(fpre, 0.f) - log1pf(__expf(-fabsf(fpre)));
            float b = logf;
#pragma unroll
            for (int o = 1; o < 64; o <<= 1) { const float y = sh_up(b, o, tid); if (tid >= o) b += y; }
            const float a = ipre - b; float pm = a;
#pragma unroll
            for (int o = 1; o < 64; o <<= 1) { const float y = sh_up(pm, o, tid); if (tid >= o) pm = fmaxf(pm, y); }
            const float mrow = fmaxf(b + m_prev, b + pm);
            const float blast = sh_idx(b, 63), amax = sh_idx(pm, 63);
            const float mnew = fmaxf(blast + m_prev, blast + amax);
            vb[tid] = b; va[tid] = a; vmr[tid] = mrow; vw[tid] = __expf(blast + a - mnew); vwi[tid] = __expf(b + m_prev - mrow);
            if (tid == 0) { scal[0] = __expf(blast + m_prev - mnew); scal[1] = mnew; }
        }
#pragma unroll
        for (int i = 0; i < 8; ++i) NUM[tid + 512 * i] = 0.f;
        __syncthreads();
        const float decay = scal[0]; m_prev = scal[1];
        {
            const int tau = tid >> 3, sg = tid & 7; float rowpart = 0.f; const float bt = vb[tau], mr = vmr[tau];
#pragma unroll 1
            for (int j = 0; j < 8; ++j) { const int s = sg * 8 + j; float val = 0.f;
                if (s <= tau) { float d = 0.f;
#pragma unroll 4
                    for (int c8 = 0; c8 < 32; ++c8) { const v4u qv = *(const LAS v4u*)(Qs + tau * 264 + c8 * 8), kv = *(const LAS v4u*)(Ks + s * 264 + c8 * 8);
#pragma unroll
                        for (int x = 0; x < 4; ++x) d += bf_lo(qv[x]) * bf_lo(kv[x]) + bf_hi(qv[x]) * bf_hi(kv[x]); }
                    val = d * __expf(bt + va[s] - mr); }
                Ss[tau * 65 + s] = val; rowpart += val; }
            float qn = 0.f;
#pragma unroll 4
            for (int c8 = 0; c8 < 4; ++c8) { const v4u qv = *(const LAS v4u*)(Qs + tau * 264 + sg * 32 + c8 * 8);
#pragma unroll
                for (int x = 0; x < 4; ++x) qn += bf_lo(qv[x]) * nst[sg * 32 + c8 * 8 + 2 * x] + bf_hi(qv[x]) * nst[sg * 32 + c8 * 8 + 2 * x + 1]; }
            float tot = rowpart + vwi[tau] * qn;
            tot += sh_xor(tot, 1, F.lane); tot += sh_xor(tot, 2, F.lane); tot += sh_xor(tot, 4, F.lane);
            if (sg == 0) NQ[tau] = tot;
        }
        {
#pragma unroll 1
            for (int tau = 0; tau < 64; ++tau) { float part = 0.f;
#pragma unroll
                for (int c8 = 0; c8 < 4; ++c8) { const v4u qv = *(const LAS v4u*)(Qs + tau * 264 + dg * 32 + c8 * 8);
#pragma unroll
                    for (int x = 0; x < 4; ++x) part += bf_lo(qv[x]) * Creg[c8 * 8 + 2 * x] + bf_hi(qv[x]) * Creg[c8 * 8 + 2 * x + 1]; }
                __hip_atomic_fetch_add(&NUM[tau * 64 + e], vwi[tau] * part, __ATOMIC_RELAXED, __HIP_MEMORY_SCOPE_WORKGROUP); }
        }
        __syncthreads();
        {
#pragma unroll 1
            for (int j = 0; j < 8; ++j) { const int tau = dg * 8 + j; float acc = 0.f;
#pragma unroll 8
                for (int s = 0; s < 64; ++s) acc += Ss[tau * 65 + s] * Vs[s * 64 + e];
                __hip_atomic_fetch_add(&NUM[tau * 64 + e], acc, __ATOMIC_RELAXED, __HIP_MEMORY_SCOPE_WORKGROUP); }
        }
        __syncthreads();
#pragma unroll
        for (int i = 0; i < 8; ++i) { const int idx = tid + 512 * i, tau = idx >> 6, ee = idx & 63; const int pos = ci * 64 + tau; const int tok = seq * T + (dir ? T - 1 - pos : pos);
            const float den = fmaxf(fabsf(NQ[tau]), __expf(-vmr[tau]));
            hout[(size_t)tok * 1024 + h * 256 + es * 64 + ee] = NUM[idx] / den; }
#pragma unroll
        for (int i = 0; i < 32; ++i) Creg[i] *= decay;
#pragma unroll 1
        for (int s = 0; s < 64; ++s) { const float wv = vw[s] * Vs[s * 64 + e];
#pragma unroll
            for (int c8 = 0; c8 < 4; ++c8) { const v4u kv = *(const LAS v4u*)(Ks + s * 264 + dg * 32 + c8 * 8);
#pragma unroll
                for (int x = 0; x < 4; ++x) { Creg[c8 * 8 + 2 * x] += bf_lo(kv[x]) * wv; Creg[c8 * 8 + 2 * x + 1] += bf_hi(kv[x]) * wv; } } }
        if (tid < 256) { float a = decay * nst[tid];
#pragma unroll 8
            for (int s = 0; s < 64; ++s) a += vw[s] * __uint_as_float(((unsigned)Ks[s * 264 + tid]) << 16);
            nst[tid] = a; }
    }
    __syncthreads();
}

typedef short s16x4 __attribute__((ext_vector_type(4)));
__device__ __forceinline__ bf16x8 tr_pair(const LAS bf16* p0, const LAS bf16* p1) {
    const s16x4 a = __builtin_amdgcn_ds_read_tr16_b64_v4i16((LAS s16x4*)p0), b = __builtin_amdgcn_ds_read_tr16_b64_v4i16((LAS s16x4*)p1);
    return __builtin_shufflevector(a, b, 0, 1, 2, 3, 4, 5, 6, 7);
}
#define MFMA16(a, b, c) __builtin_amdgcn_mfma_f32_16x16x32_bf16((a), (b), (c), 0, 0, 0)

__device__ __forceinline__ void sg_fast(Frame& F, const bf16* zuv, const float* sgr, const float* sgn, const float* ws_, const float* bs, bf16* yc, int u0, int ustride) {
    LAS bf16* Z = (LAS bf16*)F.lds;
    const int lane = F.lane, kg = lane >> 4, li = lane & 15, qq = li >> 2, pp = li & 3;
    for (int unit = u0; unit < (MS / 128) * 8; unit += ustride) {
        const int c = unit >> 3, g = unit & 7, t0 = c * 128;
        __syncthreads();
#pragma unroll
        for (int i = 0; i < 4; ++i) { const int idx = F.tid + 512 * i, row = idx >> 4, ch = idx & 15;
            *(LAS v4u*)(Z + row * 136 + ch * 8) = *(const GAS v4u*)(zuv + (size_t)(t0 + row) * 2048 + 1024 + g * 128 + ch * 8); }
        const int p = F.wave * 16 + li;
        bf16x8 bw[4];
#pragma unroll
        for (int ks = 0; ks < 4; ++ks) { const int q0 = ks * 32 + 8 * kg;
            const f32x4 w0 = *(const GAS f32x4*)(ws_ + ((size_t)g * 128 + p) * 128 + q0), w1 = *(const GAS f32x4*)(ws_ + ((size_t)g * 128 + p) * 128 + q0 + 4);
            const f32x4 r0 = *(const GAS f32x4*)(sgr + t0 + q0), r1 = *(const GAS f32x4*)(sgr + t0 + q0 + 4);
            v4u pk; pk.x = pk2(w0.x * r0.x, w0.y * r0.y); pk.y = pk2(w0.z * r0.z, w0.w * r0.w); pk.z = pk2(w1.x * r1.x, w1.y * r1.y); pk.w = pk2(w1.z * r1.z, w1.w * r1.w);
            bw[ks] = __builtin_bit_cast(bf16x8, pk); }
        __syncthreads();
        const float bsv = bs[g * 128 + p];
#pragma unroll 2
        for (int dt = 0; dt < 8; ++dt) {
            f32x4 acc = (f32x4){0.f, 0.f, 0.f, 0.f};
#pragma unroll
            for (int ks = 0; ks < 4; ++ks) { const LAS bf16* a0 = Z + (ks * 32 + 8 * kg + qq) * 136 + dt * 16 + 4 * pp;
                acc = MFMA16(tr_pair(a0, a0 + 4 * 136), bw[ks], acc); }
            const int d0 = g * 128 + dt * 16 + 4 * kg;
            const f32x4 sg = *(const GAS f32x4*)(sgn + d0);
            const unsigned long long uw = *(const GAS unsigned long long*)(zuv + (size_t)(t0 + p) * 2048 + d0); const unsigned u0w = (unsigned)uw, u1w = (unsigned)(uw >> 32);
            const float y0 = bf_lo(u0w) * (sg.x * acc[0] + bsv), y1 = bf_hi(u0w) * (sg.y * acc[1] + bsv), y2 = bf_lo(u1w) * (sg.z * acc[2] + bsv), y3 = bf_hi(u1w) * (sg.w * acc[3] + bsv);
            *(GAS unsigned long long*)(yc + (size_t)(t0 + p) * 1024 + d0) = (unsigned long long)pk2(y0, y1) | ((unsigned long long)pk2(y2, y3) << 32);
        }
    }
    __syncthreads();
}

__device__ __forceinline__ void na_fast(Frame& F, const bf16* qkva, const float* rpb, bf16* ya, int T, int gw, int NGW) {
    const int rows = T / 64, lane = F.lane, kg = lane >> 4, li = lane & 15, qq = li >> 2, pp = li & 3;
    LAS bf16* Vt = (LAS bf16*)(F.lds + F.wave * 8192);
    for (int it = gw; it < (MS / 16) * 8; it += NGW) {
        const int h = it & 7, blk = it >> 3, n = blk & 3, rowg = blk >> 2, seq = rowg / rows, r = rowg % rows;
        int rs = r - 4; rs = rs < 0 ? 0 : (rs > rows - 8 ? rows - 8 : rs);
        int kc0 = 16 * n - 8; kc0 = kc0 < 0 ? 0 : (kc0 > 32 ? 32 : kc0);
        const int qc = 16 * n + li; const size_t qtok = (size_t)seq * T + r * 64 + qc;
        bf16x8 bq[4];
#pragma unroll
        for (int ks = 0; ks < 4; ++ks) bq[ks] = __builtin_bit_cast(bf16x8, *(const GAS v4u*)(qkva + qtok * 3072 + h * 128 + ks * 32 + 8 * kg));
        f32x4 s[8][2];
#pragma unroll
        for (int j = 0; j < 8; ++j)
#pragma unroll
            for (int ct = 0; ct < 2; ++ct) { const size_t ktok = (size_t)seq * T + (rs + j) * 64 + kc0 + 16 * ct + li; f32x4 a = (f32x4){0.f, 0.f, 0.f, 0.f};
#pragma unroll
                for (int ks = 0; ks < 4; ++ks) a = MFMA16(__builtin_bit_cast(bf16x8, *(const GAS v4u*)(qkva + ktok * 3072 + 1024 + h * 128 + ks * 32 + 8 * kg)), bq[ks], a);
                s[j][ct] = a; }
        int cs = qc - 8; cs = cs < 0 ? 0 : (cs > 48 ? 48 : cs);
        float mx = -3.0e38f;
#pragma unroll
        for (int j = 0; j < 8; ++j)
#pragma unroll
            for (int ct = 0; ct < 2; ++ct)
#pragma unroll
                for (int e = 0; e < 4; ++e) { const int kc = kc0 + 16 * ct + 4 * kg + e; const bool ok = kc >= cs && kc < cs + 16;
                    const int bi = (h * 15 + (rs + j - r + 7)) * 31 + (ok ? kc - qc + 15 : 15);
                    const float v = ok ? s[j][ct][e] + rpb[bi] : -3.0e38f; s[j][ct][e] = v; mx = fmaxf(mx, v); }
        mx = fmaxf(mx, sh_xor(mx, 16, lane)); mx = fmaxf(mx, sh_xor(mx, 32, lane));
        float sum = 0.f;
#pragma unroll
        for (int j = 0; j < 8; ++j)
#pragma unroll
            for (int ct = 0; ct < 2; ++ct)
#pragma unroll
                for (int e = 0; e < 4; ++e) { const float pv = s[j][ct][e] > -1.0e38f ? __expf(s[j][ct][e] - mx) : 0.f; s[j][ct][e] = pv; sum += pv; }
        sum += sh_xor(sum, 16, lane); sum += sh_xor(sum, 32, lane);
        const float inv = 1.0f / sum;
        f32x4 o[8];
#pragma unroll
        for (int dt = 0; dt < 8; ++dt) o[dt] = (f32x4){0.f, 0.f, 0.f, 0.f};
#pragma unroll 1
        for (int j = 0; j < 8; ++j) {
            asm volatile("" ::: "memory");
#pragma unroll
            for (int i = 0; i < 8; ++i) { const int key = 4 * i + kg; const size_t vtok = (size_t)seq * T + (rs + j) * 64 + kc0 + key;
                *(LAS v4u*)(Vt + key * 128 + li * 8) = *(const GAS v4u*)(qkva + vtok * 3072 + 2048 + h * 128 + li * 8); }
            asm volatile("" ::: "memory");
            f32x4 p0, p1;
            p0 = s[0][0]; p1 = s[0][1];
#pragma unroll
            for (int jj = 1; jj < 8; ++jj) if (j == jj) { p0 = s[jj][0]; p1 = s[jj][1]; }
            v4u pk; pk.x = pk2(p0[0], p0[1]); pk.y = pk2(p0[2], p0[3]); pk.z = pk2(p1[0], p1[1]); pk.w = pk2(p1[2], p1[3]);
            const bf16x8 bp = __builtin_bit_cast(bf16x8, pk);
#pragma unroll
            for (int dt = 0; dt < 8; ++dt) { const LAS bf16* a0 = Vt + (4 * kg + qq) * 128 + dt * 16 + 4 * pp;
                o[dt] = MFMA16(tr_pair(a0, a0 + 16 * 128), bp, o[dt]); }
            asm volatile("" ::: "memory");
        }
#pragma unroll
        for (int dt = 0; dt < 8; ++dt) { const f32x4 v = o[dt] * inv;
            *(GAS unsigned long long*)(ya + qtok * 1024 + h * 128 + dt * 16 + 4 * kg) = (unsigned long long)pk2(v[0], v[1]) | ((unsigned long long)pk2(v[2], v[3]) << 32); }
    }
}

constexpr int NA_KS = 136;
__device__ __forceinline__ void na_wg(Frame& F, const bf16* qkva, const float* rpb, bf16* ya, int T, int u0, int ustride) {
    const int rows = T / 64, nrb = rows / 8, lane = F.lane, kg = lane >> 4, li = lane & 15, qq = li >> 2, pp = li & 3, tid = F.tid;
    LAS bf16* KV = (LAS bf16*)F.lds;
    for (int unit = u0; unit < (MS / 512) * 32; unit += ustride) {
        const int h = unit & 7, n = (unit >> 3) & 3, rb = unit >> 5, seq = rb / nrb, r0 = (rb % nrb) * 8, r = r0 + F.wave;
        int rs = r - 4; rs = rs < 0 ? 0 : (rs > rows - 8 ? rows - 8 : rs);
        int rs0 = r0 - 4; rs0 = rs0 < 0 ? 0 : (rs0 > rows - 8 ? rows - 8 : rs0);
        int rsl = r0 + 3; rsl = rsl > rows - 8 ? rows - 8 : rsl;
        const int nkr = rsl + 8 - rs0;
        int kc0 = 16 * n - 8; kc0 = kc0 < 0 ? 0 : (kc0 > 32 ? 32 : kc0);
        const int qc = 16 * n + li; const size_t qtok = (size_t)seq * T + r * 64 + qc;
        const size_t tok0 = (size_t)seq * T + rs0 * 64 + kc0;
        __syncthreads();
        const unsigned lo = (unsigned)(((tid >> 4) * 3072 + (tid & 15) * 8) * 2);
        const char* ubase = (const char*)(qkva + tok0 * 3072 + 1024 + h * 128);
        LAS bf16* lk = KV + (tid >> 4) * NA_KS + (tid & 15) * 8;
        v4u pv[15];
#pragma unroll
        for (int i = 0; i < 15; ++i) { pv[i] = (v4u){0u, 0u, 0u, 0u};
            if (i < nkr) { const char* ub = ubase + (size_t)i * (64 * 3072 * 2);
                *(LAS v4u*)(lk + i * 32 * NA_KS) = *(const GAS v4u*)(ub + lo);
                if (i < 8) pv[i] = *(const GAS v4u*)(ub + 2048 + lo); } }
        bf16x8 bq[4];
#pragma unroll
        for (int ks = 0; ks < 4; ++ks) bq[ks] = __builtin_bit_cast(bf16x8, *(const GAS v4u*)(qkva + qtok * 3072 + h * 128 + ks * 32 + 8 * kg));
        __syncthreads();
        const int lr0 = rs - rs0;
        f32x4 s[8][2];
#pragma unroll
        for (int j = 0; j < 8; ++j)
#pragma unroll
            for (int ct = 0; ct < 2; ++ct) { const LAS bf16* kp = KV + ((lr0 + j) * 32 + ct * 16 + li) * NA_KS + 8 * kg; f32x4 a = (f32x4){0.f, 0.f, 0.f, 0.f};
#pragma unroll
                for (int ks = 0; ks < 4; ++ks) a = MFMA16(__builtin_bit_cast(bf16x8, *(const LAS v4u*)(kp + ks * 32)), bq[ks], a);
                s[j][ct] = a; }
#pragma unroll
        for (int i = 8; i < 15; ++i) { if (i < nkr) pv[i] = *(const GAS v4u*)(ubase + (size_t)i * (64 * 3072 * 2) + 2048 + lo); }
        int cs = qc - 8; cs = cs < 0 ? 0 : (cs > 48 ? 48 : cs);
        float mx = -3.0e38f;
#pragma unroll
        for (int j = 0; j < 8; ++j)
#pragma unroll
            for (int ct = 0; ct < 2; ++ct)
#pragma unroll
                for (int e = 0; e < 4; ++e) { const int kc = kc0 + 16 * ct + 4 * kg + e; const bool ok = kc >= cs && kc < cs + 16;
                    const int bi = (h * 15 + (rs + j - r + 7)) * 31 + (ok ? kc - qc + 15 : 15);
                    const float v = ok ? s[j][ct][e] + rpb[bi] : -3.0e38f; s[j][ct][e] = v; mx = fmaxf(mx, v); }
        mx = fmaxf(mx, sh_xor(mx, 16, lane)); mx = fmaxf(mx, sh_xor(mx, 32, lane));
        float sum = 0.f;
#pragma unroll
        for (int j = 0; j < 8; ++j)
#pragma unroll
            for (int ct = 0; ct < 2; ++ct)
#pragma unroll
                for (int e = 0; e < 4; ++e) { const float pvv = s[j][ct][e] > -1.0e38f ? __expf(s[j][ct][e] - mx) : 0.f; s[j][ct][e] = pvv; sum += pvv; }
        sum += sh_xor(sum, 16, lane); sum += sh_xor(sum, 32, lane);
        const float inv = 1.0f / sum;
        __syncthreads();
#pragma unroll
        for (int i = 0; i < 15; ++i) { if (i < nkr) *(LAS v4u*)(lk + i * 32 * NA_KS) = pv[i]; }
        __syncthreads();
        f32x4 o[8];
#pragma unroll
        for (int dt = 0; dt < 8; ++dt) o[dt] = (f32x4){0.f, 0.f, 0.f, 0.f};
#pragma unroll
        for (int j = 0; j < 8; ++j) {
            v4u pk; pk.x = pk2(s[j][0][0], s[j][0][1]); pk.y = pk2(s[j][0][2], s[j][0][3]); pk.z = pk2(s[j][1][0], s[j][1][1]); pk.w = pk2(s[j][1][2], s[j][1][3]);
            const bf16x8 bp = __builtin_bit_cast(bf16x8, pk);
#pragma unroll
            for (int dt = 0; dt < 8; ++dt) { const LAS bf16* a0 = KV + ((lr0 + j) * 32 + 4 * kg + qq) * NA_KS + dt * 16 + 4 * pp;
                o[dt] = MFMA16(tr_pair(a0, a0 + 16 * NA_KS), bp, o[dt]); }
        }
#pragma unroll
        for (int dt = 0; dt < 8; ++dt) { const f32x4 v = o[dt] * inv;
            *(GAS unsigned long long*)(ya + qtok * 1024 + h * 128 + dt * 16 + 4 * kg) = (unsigned long long)pk2(v[0], v[1]) | ((unsigned long long)pk2(v[2], v[3]) << 32); }
    }
    __syncthreads();
}

constexpr int GS_STRIDE = 65536;
constexpr int ML_QS = 264, ML_VS = 72;
constexpr int ML_OFF_Q = 0, ML_OFF_K = 33792, ML_OFF_CT = 67584, ML_OFF_V = 101376, ML_OFF_WV = 110592, ML_OFF_ST = 119808, ML_OFF_VEC = 129024, ML_OFF_N = 130560, ML_OFF_CM = 131584, ML_LDS_END = 133120;
static_assert(ML_LDS_END <= LDSCTL_OFF, "mLSTM LDS map");

__device__ __forceinline__ void ml_gate_local(Frame& F, const float* gates, float* gs, float* gd, int T, int nchains) {
    const int gw = F.vcu * NWAVES + F.wave, NGW = F.G * NWAVES, lane = F.lane, nc = T / 64;
    for (int it = gw; it < nchains * nc; it += NGW) {
        const int chain = it / nc, ci = it % nc, seq = chain >> 3, h = (chain >> 1) & 3, dir = chain & 1;
        const int pos = ci * 64 + lane; const size_t tok = (size_t)seq * T + (dir ? T - 1 - pos : pos);
        const float ipre = gates[tok * 16 + dir * 8 + h], fpre = gates[tok * 16 + dir * 8 + 4 + h];
        const float logf = fminf(fpre, 0.f) - log1pf(__expf(-fabsf(fpre)));
        float b = logf;
#pragma unroll
        for (int o = 1; o < 64; o <<= 1) { const float y = sh_up(b, o, lane); if (lane >= o) b += y; }
        const float a = ipre - b; float pm = a;
#pragma unroll
        for (int o = 1; o < 64; o <<= 1) { const float y = sh_up(pm, o, lane); if (lane >= o) pm = fmaxf(pm, y); }
        const size_t o = (size_t)chain * T + pos;
        gs[o] = b; gs[GS_STRIDE + o] = a; gs[2 * GS_STRIDE + o] = pm;
        if (lane == 63) { gd[chain * 128 + ci] = b; gd[2048 + chain * 128 + ci] = b + pm; }
    }
}
__device__ __forceinline__ void ml_chain_m(Frame& F, const float* gd, int chain, int nc, LAS float* cm) {
    if (F.wave == 0) {
        const int lane = F.lane, cpl = nc >> 6;
        float sB0, sD0, sB1 = 0.f, sD1 = -3.0e38f;
        if (cpl == 2) { sB0 = gd[chain * 128 + 2 * lane]; sD0 = gd[2048 + chain * 128 + 2 * lane]; sB1 = gd[chain * 128 + 2 * lane + 1]; sD1 = gd[2048 + chain * 128 + 2 * lane + 1]; }
        else { sB0 = gd[chain * 128 + lane]; sD0 = gd[2048 + chain * 128 + lane]; }
        float B = sB0, Dm = sD0;
        if (cpl == 2) { Dm = fmaxf(sD0 + sB1, sD1); B = sB0 + sB1; }
#pragma unroll
        for (int o = 1; o < 64; o <<= 1) { const float Bp = sh_up(B, o, lane), Dp = sh_up(Dm, o, lane); if (lane >= o) { Dm = fmaxf(Dp + B, Dm); B = Bp + B; } }
        const float mend = fmaxf(B, Dm);
        float mp0 = sh_up(mend, 1, lane); if (lane == 0) mp0 = 0.f;
        const float mn0 = fmaxf(mp0 + sB0, sD0);
        if (cpl == 2) { const float mn1 = fmaxf(mn0 + sB1, sD1);
            cm[2 * lane] = sB0; cm[2 * lane + 1] = sB1; cm[128 + 2 * lane] = mp0; cm[128 + 2 * lane + 1] = mn0; cm[256 + 2 * lane] = mn0; cm[256 + 2 * lane + 1] = mn1; }
        else { cm[lane] = sB0; cm[128 + lane] = mp0; cm[256 + lane] = mn0; }
    }
    __syncthreads();
}

__device__ __forceinline__ void ml_cupdate(f32x4 (&cst)[2][4], const LAS bf16* Ks, const LAS bf16* WV, float decay, int wave, int kg, int qq, int pp) {
#pragma unroll
    for (int dd = 0; dd < 2; ++dd)
#pragma unroll
        for (int et = 0; et < 4; ++et) cst[dd][et] = cst[dd][et] * decay;
#pragma unroll
    for (int ks = 0; ks < 2; ++ks) {
        bf16x8 af[2], bfv[4];
#pragma unroll
        for (int dd = 0; dd < 2; ++dd) { const LAS bf16* p = Ks + (ks * 32 + 8 * kg + qq) * ML_QS + (2 * wave + dd) * 16 + 4 * pp; af[dd] = tr_pair(p, p + 4 * ML_QS); }
#pragma unroll
        for (int et = 0; et < 4; ++et) { const LAS bf16* p = WV + (ks * 32 + 8 * kg + qq) * ML_VS + et * 16 + 4 * pp; bfv[et] = tr_pair(p, p + 4 * ML_VS); }
#pragma unroll
        for (int dd = 0; dd < 2; ++dd)
#pragma unroll
            for (int et = 0; et < 4; ++et) cst[dd][et] = MFMA16(af[dd], bfv[et], cst[dd][et]);
    }
}

__device__ __forceinline__ void ml_phaseA(Frame& F, int unit, const bf16* kc, const bf16* qkvob, const float* gs, const float* gd, float* lst, float* nloc, int T) {
    const int nseg = T / 1024, es = unit & 3, cs_ = unit >> 2, seg = cs_ % nseg, chain = cs_ / nseg, seq = chain >> 3, h = (chain >> 1) & 3, dir = chain & 1;
    if (seg == nseg - 1) return;
    const int tid = F.tid, lane = F.lane, kg = lane >> 4, li = lane & 15, qq = li >> 2, pp = li & 3, wave = F.wave;
    LAS bf16* Ks = (LAS bf16*)(F.lds + ML_OFF_K); LAS bf16* WV = (LAS bf16*)(F.lds + ML_OFF_WV); LAS float* wvec = (LAS float*)(F.lds + ML_OFF_VEC); LAS float* cm = (LAS float*)(F.lds + ML_OFF_CM);
    __syncthreads();
    ml_chain_m(F, gd, chain, T / 64, cm);
    f32x4 cst[2][4];
#pragma unroll
    for (int dd = 0; dd < 2; ++dd)
#pragma unroll
        for (int et = 0; et < 4; ++et) cst[dd][et] = (f32x4){0.f, 0.f, 0.f, 0.f};
    float nacc = 0.f;
    v4u pk[4], pv; float pw, pwv;
#define MLA_LOAD(ci_) do { const int ci__ = (ci_); \
        _Pragma("unroll") for (int i = 0; i < 4; ++i) { const int idx = tid + 512 * i, tau = idx >> 5, c8 = idx & 31; const int pos = ci__ * 64 + tau; const size_t tok = (size_t)seq * T + (dir ? T - 1 - pos : pos); \
            pk[i] = *(const GAS v4u*)(kc + tok * 1024 + h * 256 + c8 * 8); } \
        { const int tau = tid >> 3, c8 = tid & 7; const int pos = ci__ * 64 + tau; const size_t tok = (size_t)seq * T + (dir ? T - 1 - pos : pos); \
            pv = *(const GAS v4u*)(qkvob + tok * 4096 + 2048 + h * 256 + es * 64 + c8 * 8); pw = gs[GS_STRIDE + (size_t)chain * T + pos]; } \
        pwv = gs[GS_STRIDE + (size_t)chain * T + ci__ * 64 + (tid & 63)]; } while (0)
    MLA_LOAD(seg * 16);
    for (int cc = 0; cc < 16; ++cc) {
        const int ci = seg * 16 + cc;
        __syncthreads();
#pragma unroll
        for (int i = 0; i < 4; ++i) { const int idx = tid + 512 * i, tau = idx >> 5, c8 = idx & 31; *(LAS v4u*)(Ks + tau * ML_QS + c8 * 8) = pk[i]; }
        const float cB = cm[ci], cmp = cm[128 + ci], cmn = cm[256 + ci];
        { const int tau = tid >> 3, c8 = tid & 7; const float w = __expf(cB + pw - cmn);
            v4u o; o.x = pk2(bf_lo(pv.x) * w, bf_hi(pv.x) * w); o.y = pk2(bf_lo(pv.y) * w, bf_hi(pv.y) * w); o.z = pk2(bf_lo(pv.z) * w, bf_hi(pv.z) * w); o.w = pk2(bf_lo(pv.w) * w, bf_hi(pv.w) * w);
            *(LAS v4u*)(WV + tau * ML_VS + c8 * 8) = o; }
        if (tid < 64) wvec[tid] = __expf(cB + pwv - cmn);
        const float decay = __expf(cB + cmp - cmn);
        __syncthreads();
        if (cc + 1 < 16) MLA_LOAD(ci + 1);
        ml_cupdate(cst, Ks, WV, decay, wave, kg, qq, pp);
        if (tid < 64) { float a = decay * nacc;
#pragma unroll 8
            for (int s = 0; s < 64; ++s) a += wvec[s] * __uint_as_float(((unsigned)Ks[s * ML_QS + es * 64 + tid]) << 16);
            nacc = a; }
    }
#undef MLA_LOAD
    float* dst = lst + (size_t)unit * 32 * 512 + tid;
#pragma unroll
    for (int dd = 0; dd < 2; ++dd)
#pragma unroll
        for (int et = 0; et < 4; ++et)
#pragma unroll
            for (int r = 0; r < 4; ++r) dst[(dd * 16 + et * 4 + r) * 512] = cst[dd][et][r];
    if (tid < 64) nloc[(size_t)(chain * nseg + seg) * 256 + es * 64 + tid] = nacc;
    __syncthreads();
}

__device__ __forceinline__ void ml_phaseC(Frame& F, int unit, const bf16* qc, const bf16* kc, const bf16* qkvob, const float* gs, const float* gd, const float* lst, const float* nloc, float* hf, float* hb, int T) {
    const int nseg = T / 1024, es = unit & 3, cs_ = unit >> 2, seg = cs_ % nseg, chain = cs_ / nseg, seq = chain >> 3, h = (chain >> 1) & 3, dir = chain & 1;
    const int tid = F.tid, lane = F.lane, kg = lane >> 4, li = lane & 15, qq = li >> 2, pp = li & 3, wave = F.wave;
    LAS bf16* Qs = (LAS bf16*)(F.lds + ML_OFF_Q); LAS bf16* Ks = (LAS bf16*)(F.lds + ML_OFF_K); LAS bf16* CT = (LAS bf16*)(F.lds + ML_OFF_CT);
    LAS bf16* Vs = (LAS bf16*)(F.lds + ML_OFF_V); LAS bf16* WV = (LAS bf16*)(F.lds + ML_OFF_WV); LAS bf16* ST = (LAS bf16*)(F.lds + ML_OFF_ST);
    LAS float* vec = (LAS float*)(F.lds + ML_OFF_VEC);
    LAS float* nst = (LAS float*)(F.lds + ML_OFF_N);
    LAS float* cm = (LAS float*)(F.lds + ML_OFF_CM);
    float* hout = dir ? hb : hf;
    __syncthreads();
    ml_chain_m(F, gd, chain, T / 64, cm);
    f32x4 cst[2][4];
#pragma unroll
    for (int dd = 0; dd < 2; ++dd)
#pragma unroll
        for (int et = 0; et < 4; ++et) cst[dd][et] = (f32x4){0.f, 0.f, 0.f, 0.f};
    float nreg = 0.f;
    for (int i = 0; i < seg; ++i) {
        float sb = 0.f;
        for (int c = 0; c < 16; ++c) sb += cm[i * 16 + c];
        const float P = __expf(sb + cm[128 + i * 16] - cm[256 + i * 16 + 15]);
        const float* src = lst + (size_t)(((chain * nseg + i) << 2) + es) * 32 * 512 + tid;
#pragma unroll
        for (int dd = 0; dd < 2; ++dd)
#pragma unroll
            for (int et = 0; et < 4; ++et)
#pragma unroll
                for (int r = 0; r < 4; ++r) cst[dd][et][r] = P * cst[dd][et][r] + src[(dd * 16 + et * 4 + r) * 512];
        if (tid < 256) nreg = P * nreg + nloc[(size_t)(chain * nseg + i) * 256 + tid];
    }
    if (tid < 256) nst[tid] = nreg;
#pragma unroll
    for (int dd = 0; dd < 2; ++dd)
#pragma unroll
        for (int et = 0; et < 4; ++et) { const int e = et * 16 + li, d = (2 * wave + dd) * 16 + 4 * kg;
            *(LAS unsigned long long*)(CT + e * ML_QS + d) = (unsigned long long)pk2(cst[dd][et][0], cst[dd][et][1]) | ((unsigned long long)pk2(cst[dd][et][2], cst[dd][et][3]) << 32); }
    const int tt = wave >> 1, x0 = 2 * (wave & 1);
    v4u pq[4], pk[4], pv; float pw, pgb = 0.f, pga = 0.f, pgm = 0.f;
#define ML_LOAD(ci_) do { const int ci__ = (ci_); \
        _Pragma("unroll") for (int i = 0; i < 4; ++i) { const int idx = tid + 512 * i, tau = idx >> 5, c8 = idx & 31; const int pos = ci__ * 64 + tau; const size_t tok = (size_t)seq * T + (dir ? T - 1 - pos : pos); \
            pq[i] = *(const GAS v4u*)(qc + tok * 1024 + h * 256 + c8 * 8); pk[i] = *(const GAS v4u*)(kc + tok * 1024 + h * 256 + c8 * 8); } \
        { const int tau = tid >> 3, c8 = tid & 7; const int pos = ci__ * 64 + tau; const size_t tok = (size_t)seq * T + (dir ? T - 1 - pos : pos); \
            pv = *(const GAS v4u*)(qkvob + tok * 4096 + 2048 + h * 256 + es * 64 + c8 * 8); pw = gs[GS_STRIDE + (size_t)chain * T + pos]; } \
        if (tid < 64) { const size_t o_ = (size_t)chain * T + ci__ * 64 + tid; pgb = gs[o_]; pga = gs[GS_STRIDE + o_]; pgm = gs[2 * GS_STRIDE + o_]; } } while (0)
    ML_LOAD(seg * 16);
    for (int cc = 0; cc < 16; ++cc) {
        const int ci = seg * 16 + cc;
#pragma unroll
        for (int i = 0; i < 4; ++i) { const int idx = tid + 512 * i, tau = idx >> 5, c8 = idx & 31; *(LAS v4u*)(Qs + tau * ML_QS + c8 * 8) = pq[i]; *(LAS v4u*)(Ks + tau * ML_QS + c8 * 8) = pk[i]; }
        const float cB = cm[ci], cmp = cm[128 + ci], cmn = cm[256 + ci];
        { const int tau = tid >> 3, c8 = tid & 7; *(LAS v4u*)(Vs + tau * ML_VS + c8 * 8) = pv; const float w = __expf(cB + pw - cmn);
            v4u o; o.x = pk2(bf_lo(pv.x) * w, bf_hi(pv.x) * w); o.y = pk2(bf_lo(pv.y) * w, bf_hi(pv.y) * w); o.z = pk2(bf_lo(pv.z) * w, bf_hi(pv.z) * w); o.w = pk2(bf_lo(pv.w) * w, bf_hi(pv.w) * w);
            *(LAS v4u*)(WV + tau * ML_VS + c8 * 8) = o; }
        if (tid < 64) { const float mrow = fmaxf(pgb + cmp, pgb + pgm);
            vec[tid] = pgb; vec[64 + tid] = pga; vec[128 + tid] = mrow; vec[192 + tid] = __expf(cB + pga - cmn); vec[256 + tid] = __expf(pgb + cmp - mrow); vec[320 + tid] = 0.f; }
        const float decay = __expf(cB + cmp - cmn);
        __syncthreads();
        if (cc + 1 < 16) ML_LOAD(ci + 1);
        { const int t = tid >> 3, part = tid & 7; float qn = 0.f;
#pragma unroll
            for (int c8 = 0; c8 < 4; ++c8) { const v4u qv = *(const LAS v4u*)(Qs + t * ML_QS + part * 32 + c8 * 8);
#pragma unroll
                for (int x = 0; x < 4; ++x) qn += bf_lo(qv[x]) * nst[part * 32 + c8 * 8 + 2 * x] + bf_hi(qv[x]) * nst[part * 32 + c8 * 8 + 2 * x + 1]; }
            qn += sh_xor(qn, 1, lane); qn += sh_xor(qn, 2, lane); qn += sh_xor(qn, 4, lane);
            if (part == 0) __hip_atomic_fetch_add(&vec[320 + t], vec[256 + t] * qn, __ATOMIC_RELAXED, __HIP_MEMORY_SCOPE_WORKGROUP); }
        bf16x8 qf[8];
#pragma unroll
        for (int ks = 0; ks < 8; ++ks) qf[ks] = __builtin_bit_cast(bf16x8, *(const LAS v4u*)(Qs + (tt * 16 + li) * ML_QS + ks * 32 + 8 * kg));
        { const int t = tt * 16 + li; const float bt = vec[t], mrt = vec[128 + t]; float rsum = 0.f;
#pragma unroll
            for (int x = 0; x < 2; ++x) { const int st = x0 + x; f32x4 a = (f32x4){0.f, 0.f, 0.f, 0.f};
#pragma unroll
                for (int ks = 0; ks < 8; ++ks) a = MFMA16(__builtin_bit_cast(bf16x8, *(const LAS v4u*)(Ks + (st * 16 + li) * ML_QS + ks * 32 + 8 * kg)), qf[ks], a);
                float v[4];
#pragma unroll
                for (int r = 0; r < 4; ++r) { const int s = st * 16 + 4 * kg + r; v[r] = (s <= t) ? a[r] * __expf(bt + vec[64 + s] - mrt) : 0.f; rsum += v[r]; }
                *(LAS unsigned long long*)(ST + t * ML_VS + st * 16 + 4 * kg) = (unsigned long long)pk2(v[0], v[1]) | ((unsigned long long)pk2(v[2], v[3]) << 32); }
            rsum += sh_xor(rsum, 16, lane); rsum += sh_xor(rsum, 32, lane);
            if (kg == 0) __hip_atomic_fetch_add(&vec[320 + t], rsum, __ATOMIC_RELAXED, __HIP_MEMORY_SCOPE_WORKGROUP); }
        f32x4 accn[2];
#pragma unroll
        for (int x = 0; x < 2; ++x) { const int et = x0 + x; f32x4 a = (f32x4){0.f, 0.f, 0.f, 0.f};
#pragma unroll
            for (int ks = 0; ks < 8; ++ks) a = MFMA16(qf[ks], __builtin_bit_cast(bf16x8, *(const LAS v4u*)(CT + (et * 16 + li) * ML_QS + ks * 32 + 8 * kg)), a);
#pragma unroll
            for (int r = 0; r < 4; ++r) a[r] *= vec[256 + tt * 16 + 4 * kg + r];
            accn[x] = a; }
        __syncthreads();
#pragma unroll
        for (int ks = 0; ks < 2; ++ks) { const bf16x8 sa = __builtin_bit_cast(bf16x8, *(const LAS v4u*)(ST + (tt * 16 + li) * ML_VS + ks * 32 + 8 * kg));
#pragma unroll
            for (int x = 0; x < 2; ++x) { const LAS bf16* p = Vs + (ks * 32 + 8 * kg + qq) * ML_VS + (x0 + x) * 16 + 4 * pp; accn[x] = MFMA16(sa, tr_pair(p, p + 4 * ML_VS), accn[x]); } }
#pragma unroll
        for (int r = 0; r < 4; ++r) { const int t = tt * 16 + 4 * kg + r; const float den = fmaxf(fabsf(vec[320 + t]), __expf(-vec[128 + t])); const float inv = 1.0f / den;
            const int pos = ci * 64 + t; const size_t tok = (size_t)seq * T + (dir ? T - 1 - pos : pos);
#pragma unroll
            for (int x = 0; x < 2; ++x) hout[tok * 1024 + h * 256 + es * 64 + (x0 + x) * 16 + li] = accn[x][r] * inv; }
        ml_cupdate(cst, Ks, WV, decay, wave, kg, qq, pp);
#pragma unroll
        for (int dd = 0; dd < 2; ++dd)
#pragma unroll
            for (int et = 0; et < 4; ++et) { const int e = et * 16 + li, d = (2 * wave + dd) * 16 + 4 * kg;
                *(LAS unsigned long long*)(CT + e * ML_QS + d) = (unsigned long long)pk2(cst[dd][et][0], cst[dd][et][1]) | ((unsigned long long)pk2(cst[dd][et][2], cst[dd][et][3]) << 32); }
        if (tid < 256) { float a = decay * nst[tid];
#pragma unroll 8
            for (int s = 0; s < 64; ++s) a += vec[192 + s] * __uint_as_float(((unsigned)Ks[s * ML_QS + tid]) << 16);
            nst[tid] = a; }
        __syncthreads();
    }
#undef ML_LOAD
}

constexpr int ML2_WS = 88;
constexpr int ML2_OFF_Q = 0, ML2_OFF_K = 33792, ML2_OFF_CT = 67584, ML2_OFF_V = 109824, ML2_OFF_WV = 119040, ML2_OFF_ST = 130304, ML2_OFF_VEC = 139520, ML2_OFF_CM = 140288, ML2_LDS_END = 141824;
static_assert(ML2_LDS_END <= LDSCTL_OFF, "mLSTM v2 LDS map");
constexpr int ML2_NREG = 40;

__device__ __forceinline__ void ml2_cupdate(f32x4 (&cst)[2][5], const LAS bf16* Ks, const LAS bf16* WV, float decay, int wave, int kg, int qq, int pp) {
#pragma unroll
    for (int dd = 0; dd < 2; ++dd)
#pragma unroll
        for (int et = 0; et < 5; ++et) cst[dd][et] = cst[dd][et] * decay;
#pragma unroll
    for (int ks = 0; ks < 2; ++ks) {
        bf16x8 af[2], bfv[5];
#pragma unroll
        for (int dd = 0; dd < 2; ++dd) { const LAS bf16* p = Ks + (ks * 32 + 8 * kg + qq) * ML_QS + (2 * wave + dd) * 16 + 4 * pp; af[dd] = tr_pair(p, p + 4 * ML_QS); }
#pragma unroll
        for (int et = 0; et < 5; ++et) { const LAS bf16* p = WV + (ks * 32 + 8 * kg + qq) * ML2_WS + et * 16 + 4 * pp; bfv[et] = tr_pair(p, p + 4 * ML2_WS); }
#pragma unroll
        for (int dd = 0; dd < 2; ++dd)
#pragma unroll
            for (int et = 0; et < 5; ++et) cst[dd][et] = MFMA16(af[dd], bfv[et], cst[dd][et]);
    }
}
__device__ __forceinline__ void ml2_stage_wv(LAS bf16* WV, int tau, int c8, const v4u& pv, float w) {
    v4u o; o.x = pk2(bf_lo(pv.x) * w, bf_hi(pv.x) * w); o.y = pk2(bf_lo(pv.y) * w, bf_hi(pv.y) * w); o.z = pk2(bf_lo(pv.z) * w, bf_hi(pv.z) * w); o.w = pk2(bf_lo(pv.w) * w, bf_hi(pv.w) * w);
    *(LAS v4u*)(WV + tau * ML2_WS + c8 * 8) = o;
    if (c8 == 0) { v4u e; e.x = pk2(w, 0.f); e.y = 0u; e.z = 0u; e.w = 0u; *(LAS v4u*)(WV + tau * ML2_WS + 64) = e; *(LAS v4u*)(WV + tau * ML2_WS + 72) = (v4u){0u, 0u, 0u, 0u}; }
}

__device__ __forceinline__ void ml2_phaseS(Frame& F, const bf16* qc, const bf16* kc, float* gs, const float* gd, bf16* stg, int T, int u0, int ustride) {
    const int nc = T / 64, gpc = nc / 4, tid = F.tid, lane = F.lane, kg = lane >> 4, li = lane & 15, wave = F.wave;
    LAS bf16* Qs = (LAS bf16*)(F.lds + ML2_OFF_Q); LAS bf16* Ks = (LAS bf16*)(F.lds + ML2_OFF_K);
    LAS float* vec = (LAS float*)(F.lds + ML2_OFF_VEC);
    LAS float* nqs = (LAS float*)(F.lds + ML2_OFF_ST);
    LAS float* cm = (LAS float*)(F.lds + ML2_OFF_CM);
    const int tt = wave >> 1, x0 = 2 * (wave & 1);
    for (int grp = u0; grp < 256; grp += ustride) {
        const int chain = grp / gpc, c0 = (grp % gpc) * 4, seq = chain >> 3, h = (chain >> 1) & 3, dir = chain & 1;
        __syncthreads();
        ml_chain_m(F, gd, chain, nc, cm);
        v4u pq[4], pk[4]; float pgb = 0.f, pga = 0.f, pgm = 0.f;
#define MLS_LOAD(ci_) do { const int ci__ = (ci_); \
        _Pragma("unroll") for (int i = 0; i < 4; ++i) { const int idx = tid + 512 * i, tau = idx >> 5, c8 = idx & 31; const int pos = ci__ * 64 + tau; const size_t tok = (size_t)seq * T + (dir ? T - 1 - pos : pos); \
            pq[i] = *(const GAS v4u*)(qc + tok * 1024 + h * 256 + c8 * 8); pk[i] = *(const GAS v4u*)(kc + tok * 1024 + h * 256 + c8 * 8); } \
        if (tid < 64) { const size_t o_ = (size_t)chain * T + ci__ * 64 + tid; pgb = gs[o_]; pga = gs[GS_STRIDE + o_]; pgm = gs[2 * GS_STRIDE + o_]; } } while (0)
        MLS_LOAD(c0);
        for (int cc = 0; cc < 4; ++cc) {
            const int ci = c0 + cc; const float cmp = cm[128 + ci];
#pragma unroll
            for (int i = 0; i < 4; ++i) { const int idx = tid + 512 * i, tau = idx >> 5, c8 = idx & 31; *(LAS v4u*)(Qs + tau * ML_QS + c8 * 8) = pq[i]; *(LAS v4u*)(Ks + tau * ML_QS + c8 * 8) = pk[i]; }
            float my_b = 0.f, my_mr = 0.f;
            if (tid < 64) { my_b = pgb; my_mr = fmaxf(pgb + cmp, pgb + pgm); vec[tid] = pgb; vec[64 + tid] = pga; vec[128 + tid] = my_mr; nqs[tid] = 0.f; }
            __syncthreads();
            if (cc + 1 < 4) MLS_LOAD(ci + 1);
            { const int t = tt * 16 + li; const float bt = vec[t], mrt = vec[128 + t]; float rsum = 0.f;
                bf16* dst = stg + ((size_t)chain * nc + ci) * 4096 + t * 64;
#pragma unroll
                for (int x = 0; x < 2; ++x) { const int st = x0 + x; f32x4 a = (f32x4){0.f, 0.f, 0.f, 0.f};
#pragma unroll
                    for (int ks = 0; ks < 8; ++ks) a = MFMA16(__builtin_bit_cast(bf16x8, *(const LAS v4u*)(Ks + (st * 16 + li) * ML_QS + ks * 32 + 8 * kg)),
                                                             __builtin_bit_cast(bf16x8, *(const LAS v4u*)(Qs + (tt * 16 + li) * ML_QS + ks * 32 + 8 * kg)), a);
                    float v[4];
#pragma unroll
                    for (int r = 0; r < 4; ++r) { const int s = st * 16 + 4 * kg + r; v[r] = (s <= t) ? a[r] * __expf(bt + vec[64 + s] - mrt) : 0.f; rsum += v[r]; }
                    *(GAS unsigned long long*)(dst + st * 16 + 4 * kg) = (unsigned long long)pk2(v[0], v[1]) | ((unsigned long long)pk2(v[2], v[3]) << 32); }
                rsum += sh_xor(rsum, 16, lane); rsum += sh_xor(rsum, 32, lane);
                if (kg == 0) __hip_atomic_fetch_add(&nqs[t], rsum, __ATOMIC_RELAXED, __HIP_MEMORY_SCOPE_WORKGROUP); }
            __syncthreads();
            if (tid < 64) { const size_t o = (size_t)chain * T + ci * 64 + tid;
                gs[3 * GS_STRIDE + o] = __expf(my_b + cmp - my_mr); gs[4 * GS_STRIDE + o] = nqs[tid]; gs[5 * GS_STRIDE + o] = __expf(-my_mr); }
            __syncthreads();
        }
#undef MLS_LOAD
    }
}

__device__ __forceinline__ void ml2_phaseA(Frame& F, int unit, const bf16* kc, const bf16* qkvob, const float* gs, const float* gd, float* lst, int T) {
    const int nseg = T / 1024, es = unit & 3, cs_ = unit >> 2, seg = cs_ % nseg, chain = cs_ / nseg, seq = chain >> 3, h = (chain >> 1) & 3, dir = chain & 1;
    if (seg == nseg - 1) return;
    const int tid = F.tid, lane = F.lane, kg = lane >> 4, li = lane & 15, qq = li >> 2, pp = li & 3, wave = F.wave;
    LAS bf16* Ks = (LAS bf16*)(F.lds + ML2_OFF_K); LAS bf16* WV = (LAS bf16*)(F.lds + ML2_OFF_WV); LAS float* cm = (LAS float*)(F.lds + ML2_OFF_CM);
    __syncthreads();
    ml_chain_m(F, gd, chain, T / 64, cm);
    f32x4 cst[2][5];
#pragma unroll
    for (int dd = 0; dd < 2; ++dd)
#pragma unroll
        for (int et = 0; et < 5; ++et) cst[dd][et] = (f32x4){0.f, 0.f, 0.f, 0.f};
    v4u pk[4], pv; float pw;
#define MLA_LOAD(ci_) do { const int ci__ = (ci_); \
        _Pragma("unroll") for (int i = 0; i < 4; ++i) { const int idx = tid + 512 * i, tau = idx >> 5, c8 = idx & 31; const int pos = ci__ * 64 + tau; const size_t tok = (size_t)seq * T + (dir ? T - 1 - pos : pos); \
            pk[i] = *(const GAS v4u*)(kc + tok * 1024 + h * 256 + c8 * 8); } \
        { const int tau = tid >> 3, c8 = tid & 7; const int pos = ci__ * 64 + tau; const size_t tok = (size_t)seq * T + (dir ? T - 1 - pos : pos); \
            pv = *(const GAS v4u*)(qkvob + tok * 4096 + 2048 + h * 256 + es * 64 + c8 * 8); pw = gs[GS_STRIDE + (size_t)chain * T + pos]; } } while (0)
    MLA_LOAD(seg * 16);
    for (int cc = 0; cc < 16; ++cc) {
        const int ci = seg * 16 + cc;
        __syncthreads();
#pragma unroll
        for (int i = 0; i < 4; ++i) { const int idx = tid + 512 * i, tau = idx >> 5, c8 = idx & 31; *(LAS v4u*)(Ks + tau * ML_QS + c8 * 8) = pk[i]; }
        const float cB = cm[ci], cmp = cm[128 + ci], cmn = cm[256 + ci];
        ml2_stage_wv(WV, tid >> 3, tid & 7, pv, __expf(cB + pw - cmn));
        const float decay = __expf(cB + cmp - cmn);
        __syncthreads();
        if (cc + 1 < 16) MLA_LOAD(ci + 1);
        ml2_cupdate(cst, Ks, WV, decay, wave, kg, qq, pp);
    }
#undef MLA_LOAD
    float* dst = lst + (size_t)unit * ML2_NREG * 512 + tid;
#pragma unroll
    for (int dd = 0; dd < 2; ++dd)
#pragma unroll
        for (int et = 0; et < 5; ++et)
#pragma unroll
            for (int r = 0; r < 4; ++r) dst[(dd * 20 + et * 4 + r) * 512] = cst[dd][et][r];
    __syncthreads();
}

__device__ __forceinline__ void ml2_write_ct(LAS bf16* CT, const f32x4 (&cst)[2][5], int wave, int kg, int li) {
#pragma unroll
    for (int dd = 0; dd < 2; ++dd) { const int d = (2 * wave + dd) * 16 + 4 * kg;
#pragma unroll
        for (int et = 0; et < 4; ++et) *(LAS unsigned long long*)(CT + (et * 16 + li) * ML_QS + d) = (unsigned long long)pk2(cst[dd][et][0], cst[dd][et][1]) | ((unsigned long long)pk2(cst[dd][et][2], cst[dd][et][3]) << 32);
        if (li == 0) *(LAS unsigned long long*)(CT + 64 * ML_QS + d) = (unsigned long long)pk2(cst[dd][4][0], cst[dd][4][1]) | ((unsigned long long)pk2(cst[dd][4][2], cst[dd][4][3]) << 32); }
}

__device__ __forceinline__ void ml2_phaseC(Frame& F, int unit, const bf16* qc, const bf16* kc, const bf16* qkvob, const float* gs, const float* gd, const float* lst, const bf16* stg, float* hf, float* hb, int T) {
    const int nseg = T / 1024, nc = T / 64, es = unit & 3, cs_ = unit >> 2, seg = cs_ % nseg, chain = cs_ / nseg, seq = chain >> 3, h = (chain >> 1) & 3, dir = chain & 1;
    const int tid = F.tid, lane = F.lane, kg = lane >> 4, li = lane & 15, qq = li >> 2, pp = li & 3, wave = F.wave;
    LAS bf16* Qs = (LAS bf16*)(F.lds + ML2_OFF_Q); LAS bf16* Ks = (LAS bf16*)(F.lds + ML2_OFF_K); LAS bf16* CT = (LAS bf16*)(F.lds + ML2_OFF_CT);
    LAS bf16* Vs = (LAS bf16*)(F.lds + ML2_OFF_V); LAS bf16* WV = (LAS bf16*)(F.lds + ML2_OFF_WV); LAS bf16* ST = (LAS bf16*)(F.lds + ML2_OFF_ST);
    LAS float* vec = (LAS float*)(F.lds + ML2_OFF_VEC);
    LAS float* cm = (LAS float*)(F.lds + ML2_OFF_CM);
    float* hout = dir ? hb : hf;
    __syncthreads();
    ml_chain_m(F, gd, chain, nc, cm);
    f32x4 cst[2][5];
#pragma unroll
    for (int dd = 0; dd < 2; ++dd)
#pragma unroll
        for (int et = 0; et < 5; ++et) cst[dd][et] = (f32x4){0.f, 0.f, 0.f, 0.f};
    for (int i = 0; i < seg; ++i) {
        float sb = 0.f;
        for (int c = 0; c < 16; ++c) sb += cm[i * 16 + c];
        const float P = __expf(sb + cm[128 + i * 16] - cm[256 + i * 16 + 15]);
        const float* src = lst + (size_t)(((chain * nseg + i) << 2) + es) * ML2_NREG * 512 + tid;
#pragma unroll
        for (int dd = 0; dd < 2; ++dd)
#pragma unroll
            for (int et = 0; et < 5; ++et)
#pragma unroll
                for (int r = 0; r < 4; ++r) cst[dd][et][r] = P * cst[dd][et][r] + src[(dd * 20 + et * 4 + r) * 512];
    }
    for (int i = tid; i < 15 * ML_QS / 2; i += 512) ((LAS unsigned*)(CT + 65 * ML_QS))[i] = 0u;
    const int tt = wave >> 1, x0 = 2 * (wave & 1);
    v4u pq[4], pk[4], pv, pst; float pw, pg0 = 0.f, pg1 = 0.f, pg2 = 0.f;
#define MLC_LOAD(ci_) do { const int ci__ = (ci_); \
        _Pragma("unroll") for (int i = 0; i < 4; ++i) { const int idx = tid + 512 * i, tau = idx >> 5, c8 = idx & 31; const int pos = ci__ * 64 + tau; const size_t tok = (size_t)seq * T + (dir ? T - 1 - pos : pos); \
            pq[i] = *(const GAS v4u*)(qc + tok * 1024 + h * 256 + c8 * 8); pk[i] = *(const GAS v4u*)(kc + tok * 1024 + h * 256 + c8 * 8); } \
        { const int tau = tid >> 3, c8 = tid & 7; const int pos = ci__ * 64 + tau; const size_t tok = (size_t)seq * T + (dir ? T - 1 - pos : pos); \
            pv = *(const GAS v4u*)(qkvob + tok * 4096 + 2048 + h * 256 + es * 64 + c8 * 8); pw = gs[GS_STRIDE + (size_t)chain * T + pos]; \
            pst = *(const GAS v4u*)(stg + ((size_t)chain * nc + ci__) * 4096 + tau * 64 + c8 * 8); } \
        if (tid < 64) { const size_t o_ = (size_t)chain * T + ci__ * 64 + tid; pg0 = gs[3 * GS_STRIDE + o_]; pg1 = gs[4 * GS_STRIDE + o_]; pg2 = gs[5 * GS_STRIDE + o_]; } } while (0)
    MLC_LOAD(seg * 16);
    for (int cc = 0; cc < 16; ++cc) {
        const int ci = seg * 16 + cc;
        ml2_write_ct(CT, cst, wave, kg, li);
#pragma unroll
        for (int i = 0; i < 4; ++i) { const int idx = tid + 512 * i, tau = idx >> 5, c8 = idx & 31; *(LAS v4u*)(Qs + tau * ML_QS + c8 * 8) = pq[i]; *(LAS v4u*)(Ks + tau * ML_QS + c8 * 8) = pk[i]; }
        const float cB = cm[ci], cmp = cm[128 + ci], cmn = cm[256 + ci];
        { const int tau = tid >> 3, c8 = tid & 7; *(LAS v4u*)(Vs + tau * ML_VS + c8 * 8) = pv; *(LAS v4u*)(ST + tau * ML_VS + c8 * 8) = pst;
            ml2_stage_wv(WV, tau, c8, pv, __expf(cB + pw - cmn)); }
        if (tid < 64) { vec[tid] = pg0; vec[64 + tid] = pg1; vec[128 + tid] = pg2; }
        const float decay = __expf(cB + cmp - cmn);
        __syncthreads();
        if (cc + 1 < 16) MLC_LOAD(ci + 1);
        f32x4 accn[3];
        { bf16x8 qf[8];
#pragma unroll
            for (int ks = 0; ks < 8; ++ks) qf[ks] = __builtin_bit_cast(bf16x8, *(const LAS v4u*)(Qs + (tt * 16 + li) * ML_QS + ks * 32 + 8 * kg));
#pragma unroll
            for (int x = 0; x < 3; ++x) { const int et = x < 2 ? x0 + x : 4; f32x4 a = (f32x4){0.f, 0.f, 0.f, 0.f};
#pragma unroll
                for (int ks = 0; ks < 8; ++ks) a = MFMA16(qf[ks], __builtin_bit_cast(bf16x8, *(const LAS v4u*)(CT + (et * 16 + li) * ML_QS + ks * 32 + 8 * kg)), a);
                accn[x] = a; } }
        float wi[4], inv[4];
#pragma unroll
        for (int r = 0; r < 4; ++r) { const int t = tt * 16 + 4 * kg + r; wi[r] = vec[t]; const float qn = sh_idx(accn[2][r], lane & 48);
            const float nq = vec[64 + t] + wi[r] * qn; inv[r] = 1.0f / fmaxf(fabsf(nq), vec[128 + t]); }
#pragma unroll
        for (int x = 0; x < 2; ++x)
#pragma unroll
            for (int r = 0; r < 4; ++r) accn[x][r] *= wi[r];
#pragma unroll
        for (int ks = 0; ks < 2; ++ks) { const bf16x8 sa = __builtin_bit_cast(bf16x8, *(const LAS v4u*)(ST + (tt * 16 + li) * ML_VS + ks * 32 + 8 * kg));
#pragma unroll
            for (int x = 0; x < 2; ++x) { const LAS bf16* p = Vs + (ks * 32 + 8 * kg + qq) * ML_VS + (x0 + x) * 16 + 4 * pp; accn[x] = MFMA16(sa, tr_pair(p, p + 4 * ML_VS), accn[x]); } }
#pragma unroll
        for (int r = 0; r < 4; ++r) { const int t = tt * 16 + 4 * kg + r; const int pos = ci * 64 + t; const size_t tok = (size_t)seq * T + (dir ? T - 1 - pos : pos);
#pragma unroll
            for (int x = 0; x < 2; ++x) hout[tok * 1024 + h * 256 + es * 64 + (x0 + x) * 16 + li] = accn[x][r] * inv[r]; }
        ml2_cupdate(cst, Ks, WV, decay, wave, kg, qq, pp);
        __syncthreads();
    }
#undef MLC_LOAD
}

#ifndef KNOB_NO_ROW
#define KNOB_NO_ROW 0
#endif
#ifndef KNOB_NO_WIN
#define KNOB_NO_WIN 0
#endif
#ifndef KNOB_NO_PREP
#define KNOB_NO_PREP 0
#endif
#ifndef KNOB_NO_ML
#define KNOB_NO_ML 0
#endif
#ifndef KNOB_NO_NA
#define KNOB_NO_NA 0
#endif
#ifndef KNOB_NO_SG
#define KNOB_NO_SG 0
#endif
#ifndef KNOB_NO_COMB
#define KNOB_NO_COMB 0
#endif
#ifndef KNOB_NO_MERGE
#define KNOB_NO_MERGE 0
#endif
#ifndef KNOB_NO_WOUT
#define KNOB_NO_WOUT 0
#endif
#ifndef KNOB_NO_UP
#define KNOB_NO_UP 0
#endif
#ifndef KNOB_NO_DOWN
#define KNOB_NO_DOWN 0
#endif
#ifndef KNOB_NO_P0
#define KNOB_NO_P0 0
#endif
#ifndef USE_ML_V2
#define USE_ML_V2 1
#endif
#ifndef USE_NA_WG
#define USE_NA_WG 1
#endif
#ifndef USE_NA_FAST
#define USE_NA_FAST 1
#endif
#ifndef USE_SG_FAST
#define USE_SG_FAST 1
#endif
#ifndef REP_P0
#define REP_P0 1
#endif
#ifndef REP_ROW
#define REP_ROW 1
#endif
#ifndef REP_PA
#define REP_PA 1
#endif
#ifndef REP_NA
#define REP_NA 1
#endif
#ifndef REP_SG
#define REP_SG 1
#endif
#ifndef REP_WIN
#define REP_WIN 1
#endif
#ifndef REP_MERGE
#define REP_MERGE 1
#endif
#ifndef REP_WOUT
#define REP_WOUT 1
#endif
#ifndef REP_UP
#define REP_UP 1
#endif
#ifndef REP_DOWN
#define REP_DOWN 1
#endif
#ifndef REP_MIX1
#define REP_MIX1 1
#endif
#ifndef REP_MIX2
#define REP_MIX2 1
#endif
#ifndef REP_PREP
#define REP_PREP 1
#endif
#ifndef REP_COMB
#define REP_COMB 1
#endif
#ifndef REP_BAR
#define REP_BAR 1
#endif
#ifndef USE_ML_FAST
#define USE_ML_FAST 1
#endif
constexpr int STEPS_PER = 12, N_STEPS = 1 + NSLAB * DEPTH * STEPS_PER;
__global__ void __launch_bounds__(NWAVES * 64, 2) trunk_fwd(Args args) {
    extern __shared__ __attribute__((aligned(16))) unsigned char lds[];
    const int wave_s = __builtin_amdgcn_readfirstlane((int)threadIdx.x >> 6);
#define MKF() Frame F; { unsigned ones_; asm volatile("s_mov_b32 %0, -1" : "=s"(ones_)); int t_ = wave_s * 64 + (int)__builtin_amdgcn_mbcnt_hi(ones_, __builtin_amdgcn_mbcnt_lo(ones_, 0u)); F.lds = (LAS unsigned char*)lds; F.tid = t_; F.lane = t_ & 63; F.wave = __builtin_amdgcn_readfirstlane(t_ >> 6); \
        F.G = gridDim.x; const int bx_ = blockIdx.x; F.vcu = (F.G % 8 == 0) ? (bx_ % 8) * (F.G / 8) + bx_ / 8 : bx_; }
#define ARGS() ({ const __attribute__((address_space(4))) Args* _p = (const __attribute__((address_space(4))) Args*)__builtin_amdgcn_kernarg_segment_ptr(); asm volatile("" : "+s"(_p)); _p; })
    gu32* ctl = (gu32*)(ARGS()->ws + WS_CTL);
    for (int u = threadIdx.x; u < (LDS_BYTES - LDSCTL_OFF) / 4; u += NWAVES * 64) ((LAS unsigned*)((LAS unsigned char*)lds + LDSCTL_OFF))[u] = 0u;
    __syncthreads();
    volatile LAS unsigned* MISC = (volatile LAS unsigned*)((LAS unsigned char*)lds + MISC_OFF);
    XcdBarrier bar = xcd_barrier_post((unsigned*)ctl + CW_BAR, MISC + 8);
    const int lo = ARGS()->ph_lo, hi = ARGS()->ph_hi;
#define IN(k) (lo <= (k) && (k) < hi)
#define SEAM(k) do { if (IN(k) && IN((k) + 1)) { _Pragma("unroll") for (int rb_ = 0; rb_ < REP_BAR; ++rb_) xcd_barrier(bar); } } while (0)

#define WSB(T_, off) ((T_*)(A->ws + (off)))
#define Hb WSB(bf16, WS_H)
#define QKVA WSB(bf16, WS_QKVA)
#define QKVOB WSB(bf16, WS_QKVOB)
#define ZUV WSB(bf16, WS_ZUV)
#define Ub WSB(bf16, WS_U)
#define Gb WSB(bf16, WS_G)
#define GATES WSB(float, WS_GATES)
#define SGR WSB(float, WS_SGR)
#define QC WSB(bf16, WS_QC)
#define KC WSB(bf16, WS_KC)
#define Yb WSB(bf16, WS_Y)
#define HF WSB(float, WS_HF)
#define HB WSB(float, WS_HB)
#define MRG WSB(float, WS_MRG)
#define MRGB WSB(bf16, WS_MRGB)
#define Tb WSB(float, WS_T)
#define GSb WSB(float, WS_GS)
#define GDb WSB(float, WS_GD)
#define LSTb WSB(float, WS_LST)
#define NLOCb WSB(float, WS_NLOC)
#define LST2b WSB(float, WS_LST2)
#define STGb WSB(bf16, WS_STG)

    if (IN(0) && !KNOB_NO_P0) { MKF();
        LAS float* scr = (LAS float*)(F.lds + RING_OFF + F.wave * 16384);
        _Pragma("unroll") for (int rep_ = 0; rep_ < REP_P0; ++rep_) for (int l = 0; l < DEPTH; ++l) {
            const auto* A = ARGS(); unsigned char* wl = A->ws + WS_W + (size_t)l * WL_BYTES;
            p0_win(F, A->w_in + (size_t)l * D * D_IN, (bf16*)(wl + WL_IN), scr);
            p0_matrix(F, A->w_a + (size_t)l * NA_W * D, NA_W, D, (bf16*)(wl + WL_ABC), scr);
            p0_matrix(F, A->w_b + (size_t)l * ML_W * D, ML_W, D, (bf16*)(wl + WL_ABC) + (size_t)D * 1024, scr);
            p0_matrix(F, A->w_c + (size_t)l * SG_W * D, SG_W, D, (bf16*)(wl + WL_ABC) + (size_t)2 * D * 1024, scr);
            p0_matrix(F, A->w_out + (size_t)l * D * D, D, D, (bf16*)(wl + WL_OUT), scr);
            p0_matrix(F, A->w_up + (size_t)l * D * DFF, D, DFF, (bf16*)(wl + WL_UP), scr);
            p0_matrix(F, A->w_down + (size_t)l * DFF * D, DFF, D, (bf16*)(wl + WL_DN), scr);
        }
    }
    SEAM(0);

    for (int s = 0; s < NSLAB; ++s) {
        const int T = s < 4 ? 4096 : 8192, nseq = MS / T;
        for (int l = 0; l < DEPTH; ++l) {
            const int sb = 1 + (s * DEPTH + l) * STEPS_PER;
            if (sb + STEPS_PER <= lo || sb >= hi) continue;
#define XIN0 (s < 4 ? A->x_prompt + (size_t)s * MS * D : A->x_sample + (size_t)(s - 4) * MS * D)
#define XO (A->out + (size_t)s * MS * D)
#define WL (A->ws + WS_W + (size_t)l * WL_BYTES)
            if (IN(sb + 0) && l == 0 && !KNOB_NO_ROW) { MKF(); const auto* A = ARGS(); row_phase(F, XIN0, nullptr, nullptr, nullptr, A->pre_mix_g, Hb); }
            SEAM(sb + 0);
            if (IN(sb + 1) && !KNOB_NO_WIN) { MKF(); const auto* A = ARGS();
                pg8::Gemm g{Hb, (const bf16*)(WL + WL_IN), MS, N_IN_PAD, D, 0, 0}; pg8::StaticOrder S; S.init(MS, N_IN_PAD, (int)gridDim.x, (int)blockIdx.x);
                pg8::EpiIn E{QKVA, QKVOB, ZUV, Gb, GATES, A->b_gate + l * 16};
                _Pragma("unroll") for (int rep_ = 0; rep_ < REP_WIN; ++rep_) pg8::gemm_phase<pg8::EpiIn, pg8::StaticOrder, true, true>((PG8_LAS unsigned char*)lds + RING_OFF, g, S, E, wave_s);
            }
            SEAM(sb + 1);
            if (IN(sb + 2) && !KNOB_NO_PREP) { MKF(); const auto* A = ARGS(); _Pragma("unroll") for (int rep_ = 0; rep_ < REP_PREP; ++rep_) { prep_phase(F, QKVOB, A->conv_w + (size_t)l * 3 * 2048, QC, KC, ZUV, SGR, T); if (USE_ML_FAST) ml_gate_local(F, GATES, GSb, GDb, T, nseq * 8); } }
            SEAM(sb + 2);
            if (IN(sb + 3)) { MKF(); const auto* A = ARGS();
                if (USE_ML_FAST) {
                  _Pragma("unroll") for (int rep_ = 0; rep_ < REP_MIX1; ++rep_) {
                    _Pragma("unroll") for (int r2_ = 0; r2_ < REP_PA; ++r2_) { if (USE_ML_V2) { for (int unit = F.vcu; unit < 256; unit += F.G) ml2_phaseA(F, unit, KC, QKVOB, GSb, GDb, LST2b, T); ml2_phaseS(F, QC, KC, GSb, GDb, STGb, T, F.vcu, F.G); }
                        else for (int unit = F.vcu; unit < 256; unit += F.G) ml_phaseA(F, unit, KC, QKVOB, GSb, GDb, LSTb, NLOCb, T); }
                    const int gw = F.vcu * NWAVES + F.wave, NGW = F.G * NWAVES;
                    _Pragma("unroll") for (int r2_ = 0; r2_ < REP_NA; ++r2_) { if (USE_NA_WG) na_wg(F, QKVA, A->na_rpb + (size_t)l * 8 * 15 * 31, Yb, T, F.vcu, F.G); else na_fast(F, QKVA, A->na_rpb + (size_t)l * 8 * 15 * 31, Yb, T, gw, NGW); }
                    _Pragma("unroll") for (int r2_ = 0; r2_ < REP_SG; ++r2_) sg_fast(F, ZUV, SGR, A->sg_norm_g + l * 1024, A->w_s + (size_t)l * 8 * 128 * 128, A->b_s + l * 1024, Yb + (size_t)2 * MS * 1024, F.vcu, F.G);
                  }
                } else {
                    const int nml = nseq * 32;
                    if (F.vcu < nml) mlstm_naive(F, F.vcu, QC, KC, QKVOB, GATES, HF, HB, T);
                    else { const int gw = (F.vcu - nml) * NWAVES + F.wave, NGW = (F.G - nml) * NWAVES;
                        na_fast(F, QKVA, A->na_rpb + (size_t)l * 8 * 15 * 31, Yb, T, gw, NGW);
                        sg_fast(F, ZUV, SGR, A->sg_norm_g + l * 1024, A->w_s + (size_t)l * 8 * 128 * 128, A->b_s + l * 1024, Yb + (size_t)2 * MS * 1024, F.vcu - nml, F.G - nml); }
                }
            }
            SEAM(sb + 3);
            if (IN(sb + 4) && USE_ML_FAST) { MKF(); const auto* A = ARGS();
                _Pragma("unroll") for (int rep_ = 0; rep_ < REP_MIX2; ++rep_) { if (USE_ML_V2) { for (int unit = F.vcu; unit < 256; unit += F.G) ml2_phaseC(F, unit, QC, KC, QKVOB, GSb, GDb, LST2b, STGb, HF, HB, T); }
                    else for (int unit = F.vcu; unit < 256; unit += F.G) ml_phaseC(F, unit, QC, KC, QKVOB, GSb, GDb, LSTb, NLOCb, HF, HB, T); }
            }
            SEAM(sb + 4);
            if (IN(sb + 5) && !KNOB_NO_COMB) { MKF(); const auto* A = ARGS(); _Pragma("unroll") for (int rep_ = 0; rep_ < REP_COMB; ++rep_) comb_phase(F, HF, HB, QKVOB, A->ml_norm_g + l * 1024, Yb + (size_t)MS * 1024); }
            SEAM(sb + 5);
            if (IN(sb + 6) && !KNOB_NO_MERGE) { MKF(); const auto* A = ARGS();
                pg8::Gemm g{Yb, (const bf16*)(WL + WL_ABC), MS, D, 1024, (size_t)MS * 1024 * 2, (size_t)D * 1024 * 2}; pg8::ZOrder<3> S; S.init(MS, D, (int)gridDim.x, (int)blockIdx.x);
                pg8::EpiMergeH E{Gb, MRGB};
                _Pragma("unroll") for (int rep_ = 0; rep_ < REP_MERGE; ++rep_) pg8::gemm_phase<pg8::EpiMergeH, pg8::ZOrder<3>, true, true>((PG8_LAS unsigned char*)lds + RING_OFF, g, S, E, wave_s);
            }
            SEAM(sb + 6);
            if (IN(sb + 7) && !KNOB_NO_WOUT) { MKF(); const auto* A = ARGS();
                pg8::Gemm g{MRGB, (const bf16*)(WL + WL_OUT), MS, D, D, 0, 0}; pg8::StaticOrder S; S.init(MS, D, (int)gridDim.x, (int)blockIdx.x);
                pg8::EpiF32 E{Tb, D};
                _Pragma("unroll") for (int rep_ = 0; rep_ < REP_WOUT; ++rep_) pg8::gemm_phase<pg8::EpiF32, pg8::StaticOrder, true, true>((PG8_LAS unsigned char*)lds + RING_OFF, g, S, E, wave_s);
            }
            SEAM(sb + 7);
            if (IN(sb + 8) && !KNOB_NO_ROW) { MKF(); const auto* A = ARGS(); _Pragma("unroll") for (int rep_ = 1; rep_ < REP_ROW; ++rep_) row_phase(F, l == 0 ? XIN0 : XO, Tb, A->post_mix_g + l * D, WSB(float, WS_MRG), A->pre_mlp_g + l * D, WSB(bf16, WS_HF)); row_phase(F, l == 0 ? XIN0 : XO, Tb, A->post_mix_g + l * D, XO, A->pre_mlp_g + l * D, Hb); }
            SEAM(sb + 8);
            if (IN(sb + 9) && !KNOB_NO_UP) { MKF(); const auto* A = ARGS();
                pg8::Gemm g{Hb, (const bf16*)(WL + WL_UP), MS, DFF, D, 0, 0}; pg8::StaticOrder S; S.init(MS, DFF, (int)gridDim.x, (int)blockIdx.x);
                pg8::EpiRelu2 E{Ub, DFF};
                _Pragma("unroll") for (int rep_ = 0; rep_ < REP_UP; ++rep_) pg8::gemm_phase<pg8::EpiRelu2, pg8::StaticOrder, true, true>((PG8_LAS unsigned char*)lds + RING_OFF, g, S, E, wave_s);
            }
            SEAM(sb + 9);
            if (IN(sb + 10) && !KNOB_NO_DOWN) { MKF(); const auto* A = ARGS();
                pg8::Gemm g{Ub, (const bf16*)(WL + WL_DN), MS, D, DFF, 0, 0}; pg8::StaticOrder S; S.init(MS, D, (int)gridDim.x, (int)blockIdx.x);
                pg8::EpiF32 E{Tb, D};
                _Pragma("unroll") for (int rep_ = 0; rep_ < REP_DOWN; ++rep_) pg8::gemm_phase<pg8::EpiF32, pg8::StaticOrder, true, true>((PG8_LAS unsigned char*)lds + RING_OFF, g, S, E, wave_s);
            }
            SEAM(sb + 10);
            if (IN(sb + 11) && !KNOB_NO_ROW) { MKF(); const auto* A = ARGS(); _Pragma("unroll") for (int rep_ = 1; rep_ < REP_ROW; ++rep_) row_phase(F, XO, Tb, A->post_mlp_g + l * D, WSB(float, WS_MRG), l + 1 < DEPTH ? A->pre_mix_g + (l + 1) * D : nullptr, l + 1 < DEPTH ? WSB(bf16, WS_HF) : nullptr); row_phase(F, XO, Tb, A->post_mlp_g + l * D, XO, l + 1 < DEPTH ? A->pre_mix_g + (l + 1) * D : nullptr, l + 1 < DEPTH ? Hb : nullptr); }
            SEAM(sb + 11);
        }
    }
#undef IN
#undef SEAM
}

#ifndef MK_LAUNCH_PER_STEP
#define MK_LAUNCH_PER_STEP 0
#endif
extern "C" void kernel_launch(void* const* d_in, const int* in_sizes, int n_in, void* d_out, int out_size, void* d_ws, size_t ws_size, hipStream_t stream) {
    static int grid = 0;
    if (grid == 0) {
        if (n_in != 20 || in_sizes[0] != M_PROMPT * D || in_sizes[1] != M_SAMPLE * D || out_size != M_ALL * D || ws_size < WS_END) {
            fprintf(stderr, "kernel_launch: unexpected shapes (n_in %d, in0 %d, in1 %d, out %d, ws %zu); nothing launched\n", n_in, n_in > 0 ? in_sizes[0] : -1, n_in > 1 ? in_sizes[1] : -1, out_size, ws_size); grid = -1; return; }
        int dev = 0, cus = 0;
        if (hipGetDevice(&dev) != hipSuccess || hipDeviceGetAttribute(&cus, hipDeviceAttributeMultiprocessorCount, dev) != hipSuccess) { grid = -1; return; }
        if (hipFuncSetAttribute((const void*)trunk_fwd, hipFuncAttributeMaxDynamicSharedMemorySize, LDS_BYTES) != hipSuccess) { fprintf(stderr, "kernel_launch: hipFuncSetAttribute failed\n"); grid = -1; return; }
        int per_cu = 0;
        if (hipOccupancyMaxActiveBlocksPerMultiprocessor(&per_cu, (const void*)trunk_fwd, NWAVES * 64, LDS_BYTES) != hipSuccess || per_cu < 1)
            fprintf(stderr, "kernel_launch: note: occupancy query reports %d workgroups per CU\n", per_cu);
        (void)hipGetLastError();
        grid = cus;
    }
    if (grid < 0) return;
    if (hipMemsetAsync((char*)d_ws + WS_CTL, 0, CTL_ZERO_BYTES, stream) != hipSuccess) return;
    Args a{};
    a.x_prompt = (const float*)d_in[0]; a.x_sample = (const float*)d_in[1]; a.pre_mix_g = (const float*)d_in[2]; a.post_mix_g = (const float*)d_in[3];
    a.pre_mlp_g = (const float*)d_in[4]; a.post_mlp_g = (const float*)d_in[5]; a.w_in = (const float*)d_in[6]; a.b_gate = (const float*)d_in[7];
    a.conv_w = (const float*)d_in[8]; a.na_rpb = (const float*)d_in[9]; a.ml_norm_g = (const float*)d_in[10]; a.sg_norm_g = (const float*)d_in[11];
    a.w_s = (const float*)d_in[12]; a.b_s = (const float*)d_in[13]; a.w_a = (const float*)d_in[14]; a.w_b = (const float*)d_in[15]; a.w_c = (const float*)d_in[16];
    a.w_out = (const float*)d_in[17]; a.w_up = (const float*)d_in[18]; a.w_down = (const float*)d_in[19];
    a.out = (float*)d_out; a.ws = (unsigned char*)d_ws;
#if MK_LAUNCH_PER_STEP
    for (int k = 0; k < N_STEPS; ++k) { a.ph_lo = k; a.ph_hi = k + 1; hipLaunchKernelGGL(trunk_fwd, dim3(grid), dim3(NWAVES * 64), LDS_BYTES, stream, a); }
#else
    a.ph_lo = 0; a.ph_hi = N_STEPS;
    hipLaunchKernelGGL(trunk_fwd, dim3(grid), dim3(NWAVES * 64), LDS_BYTES, stream, a);
#endif
}
```
